# Optimizing an MI355X kernel written in HIP

```python
import math
import jax, jax.numpy as jnp
from jax import lax
import numpy as np

D_MODEL = 1024
BATCH = 2
SEQ = 8192
DEPTH = 1

HEAD_DIM = 64
N_HEADS_MOBA = 8
N_HEADS_SB = 8
W_MOBA = N_HEADS_MOBA * HEAD_DIM
W_SB = N_HEADS_SB * HEAD_DIM
MOBA_BLOCK = 256
MOBA_TOPK = 3
Q_CHUNK = 128
PEER_HEADS = 8
PEER_NKEYS = 128
PEER_N_EXPERTS = PEER_NKEYS * PEER_NKEYS
PEER_QDIM = 256
PEER_HALF = PEER_QDIM // 2
PEER_TOPK = 16
PEER_TOK_CHUNK = 128
RMS_EPS = 1e-6
IN_SPLITS = [W_MOBA, W_MOBA, W_MOBA, W_SB, W_SB, W_SB, D_MODEL, D_MODEL]
IN_WIDTH = sum(IN_SPLITS)

kernel_name = "hybrid_moba_stickbreak_peer_block"


def rmsnorm(x, g):
    xf = x.astype(jnp.float32)
    y = xf * lax.rsqrt(jnp.mean(xf * xf, axis=-1, keepdims=True) + RMS_EPS)
    return (y * g.astype(jnp.float32)).astype(x.dtype)


def alibi_slopes(n_heads):
    return jnp.exp2(-8.0 * jnp.arange(1, n_heads + 1, dtype=jnp.float32) / n_heads)


def _heads(t, n):
    b, s, _ = t.shape
    return t.reshape(b, s, n, HEAD_DIM).transpose(0, 2, 1, 3)


def _merge(t):
    b, h, s, dh = t.shape
    return t.transpose(0, 2, 1, 3).reshape(b, s, h * dh)


def moba_attention(q, k, v):
    B, H, S, dh = q.shape
    nb = -(-S // MOBA_BLOCK)
    pad = nb * MOBA_BLOCK - S
    kp = jnp.pad(k, ((0, 0), (0, 0), (0, pad), (0, 0)))
    vp = jnp.pad(v, ((0, 0), (0, 0), (0, pad), (0, 0)))
    kb = kp.reshape(B, H, nb, MOBA_BLOCK, dh)
    vb = vp.reshape(B, H, nb, MOBA_BLOCK, dh)
    kmean = jnp.mean(kb.astype(jnp.float32), axis=3)
    ksel = min(MOBA_TOPK, nb)
    scale = dh ** -0.5
    slope = alibi_slopes(H).reshape(1, H, 1, 1)
    slope5 = slope[..., None]
    bidx = jnp.arange(B)[:, None, None, None]
    hidx = jnp.arange(H)[None, :, None, None]
    n_chunks = S // Q_CHUNK
    qc = q.reshape(B, H, n_chunks, Q_CHUNK, dh).transpose(2, 0, 1, 3, 4)

    def chunk(args):
        q_blk, c = args
        qf = q_blk.astype(jnp.float32)
        t = c * Q_CHUNK + jnp.arange(Q_CHUNK)
        own = (c * Q_CHUNK) // MOBA_BLOCK
        bs = jnp.einsum('bhqd,bhnd->bhqn', qf, kmean)
        bs = jnp.where(jnp.arange(nb) < own, bs, -jnp.inf)
        _, top_i = lax.top_k(bs, ksel)
        valid = top_i < own
        k_sel = kb[bidx, hidx, top_i].astype(jnp.float32)
        v_sel = vb[bidx, hidx, top_i].astype(jnp.float32)
        s_pos = top_i[..., None] * MOBA_BLOCK + jnp.arange(MOBA_BLOCK)
        dist_sel = (t[:, None, None] - s_pos).astype(jnp.float32)
        sc_sel = jnp.einsum('bhqd,bhqnkd->bhqnk', qf, k_sel) * scale - slope5 * dist_sel
        sc_sel = jnp.where(valid[..., None], sc_sel, -jnp.inf).reshape(B, H, Q_CHUNK, ksel * MOBA_BLOCK)
        k_own = lax.dynamic_slice_in_dim(kp, own * MOBA_BLOCK, MOBA_BLOCK, axis=2).astype(jnp.float32)
        v_own = lax.dynamic_slice_in_dim(vp, own * MOBA_BLOCK, MOBA_BLOCK, axis=2).astype(jnp.float32)
        s_own = own * MOBA_BLOCK + jnp.arange(MOBA_BLOCK)
        dist_own = (t[:, None] - s_own[None, :]).astype(jnp.float32)
        sc_own = jnp.einsum('bhqd,bhkd->bhqk', qf, k_own) * scale - slope * dist_own
        sc_own = jnp.where(s_own[None, :] <= t[:, None], sc_own, -jnp.inf)
        p = jax.nn.softmax(jnp.concatenate([sc_sel, sc_own], axis=-1), axis=-1)
        p_sel = p[..., :ksel * MOBA_BLOCK].reshape(B, H, Q_CHUNK, ksel, MOBA_BLOCK)
        p_own = p[..., ksel * MOBA_BLOCK:]
        o = (jnp.einsum('bhqnk,bhqnkd->bhqd', p_sel, v_sel)
             + jnp.einsum('bhqk,bhkd->bhqd', p_own, v_own))
        return o.astype(q.dtype)

    out = lax.map(chunk, (qc, jnp.arange(n_chunks)))
    return out.transpose(1, 2, 0, 3, 4).reshape(B, H, S, dh)


def stick_breaking_attention(q, k, v):
    B, H, S, dh = q.shape
    scale = dh ** -0.5
    kf = k.astype(jnp.float32)
    vf = v.astype(jnp.float32)
    s_idx = jnp.arange(S)
    n_chunks = S // Q_CHUNK
    qc = q.reshape(B, H, n_chunks, Q_CHUNK, dh).transpose(2, 0, 1, 3, 4)

    def chunk(args):
        q_blk, c = args
        t = c * Q_CHUNK + jnp.arange(Q_CHUNK)
        z = jnp.einsum('bhqd,bhkd->bhqk', q_blk.astype(jnp.float32), kf) * scale
        strict = s_idx[None, :] < t[:, None]
        log_1m = jnp.where(strict, jax.nn.log_sigmoid(-z), 0.0)
        suffix = lax.cumsum(log_1m, axis=3, reverse=True) - log_1m
        w = jnp.where(strict, jnp.exp(jax.nn.log_sigmoid(z) + suffix), 0.0)
        return jnp.einsum('bhqk,bhkd->bhqd', w, vf).astype(q.dtype)

    out = lax.map(chunk, (qc, jnp.arange(n_chunks)))
    return out.transpose(1, 2, 0, 3, 4).reshape(B, H, S, dh)


def peer_ffn(x, w_q, sub_keys, expert_u, expert_v):
    B, S, D = x.shape
    T = B * S
    xt = x.reshape(T // PEER_TOK_CHUNK, PEER_TOK_CHUNK, D)
    skf = sub_keys.astype(jnp.float32)

    def chunk(x_blk):
        tc = x_blk.shape[0]
        qh = (x_blk @ w_q).astype(jnp.float32).reshape(tc, PEER_HEADS, 2, PEER_HALF)
        scores = jnp.einsum('thpc,hpnc->thpn', qh, skf)
        s_top, i_top = lax.top_k(scores, PEER_TOPK)
        cand = s_top[:, :, 0, :, None] + s_top[:, :, 1, None, :]
        cand_idx = i_top[:, :, 0, :, None] * PEER_NKEYS + i_top[:, :, 1, None, :]
        c_s, c_pos = lax.top_k(cand.reshape(tc, PEER_HEADS, PEER_TOPK * PEER_TOPK), PEER_TOPK)
        e_idx = jnp.take_along_axis(cand_idx.reshape(tc, PEER_HEADS, PEER_TOPK * PEER_TOPK), c_pos, axis=-1)
        g = jax.nn.softmax(c_s, axis=-1)
        u = expert_u[e_idx].astype(jnp.float32)
        v = expert_v[e_idx].astype(jnp.float32)
        a = jax.nn.gelu(jnp.einsum('td,thkd->thk', x_blk.astype(jnp.float32), u), approximate=False)
        return jnp.einsum('thk,thkd->td', g * a, v).astype(x.dtype)

    return lax.map(chunk, xt).reshape(B, S, D)


def setup_inputs(seed: int = 0) -> dict:
    key = jax.random.key(seed)
    ks = jax.random.split(key, 12)
    f32 = jnp.float32
    x = jax.random.normal(ks[0], (BATCH, SEQ, D_MODEL), f32)
    norm1_g = 1.0 + 0.01 * jax.random.normal(ks[1], (DEPTH, D_MODEL), f32)
    w_in = jax.random.normal(ks[2], (DEPTH, D_MODEL, IN_WIDTH), f32) * D_MODEL ** -0.5
    w_out_moba = jax.random.normal(ks[3], (DEPTH, W_MOBA, D_MODEL), f32) * W_MOBA ** -0.5
    w_out_sb = jax.random.normal(ks[4], (DEPTH, W_SB, D_MODEL), f32) * W_SB ** -0.5
    w_mix_out = jax.random.normal(ks[5], (DEPTH, D_MODEL, D_MODEL), f32) * D_MODEL ** -0.5
    norm2_g = 1.0 + 0.01 * jax.random.normal(ks[6], (DEPTH, D_MODEL), f32)
    peer_w_q = jax.random.normal(ks[7], (DEPTH, D_MODEL, PEER_HEADS * PEER_QDIM), f32) * D_MODEL ** -0.5
    peer_sub_keys = jax.random.normal(ks[8], (DEPTH, PEER_HEADS, 2, PEER_NKEYS, PEER_HALF), f32) * PEER_HALF ** -0.5
    peer_u = jax.random.normal(ks[9], (DEPTH, PEER_N_EXPERTS, D_MODEL), f32) * D_MODEL ** -0.5
    peer_v = jax.random.normal(ks[10], (DEPTH, PEER_N_EXPERTS, D_MODEL), f32) * PEER_HEADS ** -0.5
    final_norm_g = 1.0 + 0.01 * jax.random.normal(ks[11], (D_MODEL,), f32)
    return {"x": x, "norm1_g": norm1_g, "w_in": w_in, "w_out_moba": w_out_moba,
            "w_out_sb": w_out_sb, "w_mix_out": w_mix_out, "norm2_g": norm2_g,
            "peer_w_q": peer_w_q, "peer_sub_keys": peer_sub_keys, "peer_u": peer_u,
            "peer_v": peer_v, "final_norm_g": final_norm_g}


def reference(x, norm1_g, w_in, w_out_moba, w_out_sb, w_mix_out, norm2_g,
              peer_w_q, peer_sub_keys, peer_u, peer_v, final_norm_g):
    split_at = [int(i) for i in np.cumsum(IN_SPLITS)[:-1]]
    h = x
    for l in range(DEPTH):
        xn = rmsnorm(h, norm1_g[l])
        proj = xn @ w_in[l]
        q_a, k_a, v_a, q_b, k_b, v_b, gate_a, gate_b = jnp.split(proj, split_at, axis=-1)
        y_a = _merge(moba_attention(_heads(q_a, N_HEADS_MOBA), _heads(k_a, N_HEADS_MOBA),
                                    _heads(v_a, N_HEADS_MOBA))) @ w_out_moba[l]
        y_b = _merge(stick_breaking_attention(_heads(q_b, N_HEADS_SB), _heads(k_b, N_HEADS_SB),
                                              _heads(v_b, N_HEADS_SB))) @ w_out_sb[l]
        mixed = jax.nn.sigmoid(gate_a) * y_a + jax.nn.sigmoid(gate_b) * y_b
        h = h + mixed @ w_mix_out[l]
        h = h + peer_ffn(rmsnorm(h, norm2_g[l]), peer_w_q[l], peer_sub_keys[l], peer_u[l], peer_v[l])
    return rmsnorm(h, final_norm_g)
```

```cpp
#include <hip/hip_runtime.h>
#include <cstdio>
#include <cstdint>

#define DI __device__ __forceinline__
typedef unsigned short bf16_t;
typedef short bf16x8 __attribute__((ext_vector_type(8)));
typedef float f32x4 __attribute__((ext_vector_type(4)));
typedef unsigned u32x4 __attribute__((ext_vector_type(4)));
typedef unsigned u32x2 __attribute__((ext_vector_type(2)));

constexpr int NBATCH = 2, SEQ = 8192, T = NBATCH * SEQ, DM = 1024;
constexpr int NH = 8, HD = 64, WA = 512;
constexpr int INW = 5120, QKVW = 3072, GATEW = 2048;
constexpr int MBLK = 256, NBLK = SEQ / MBLK;
constexpr int PNK = 128, PTOPK = 16, NEXP = 16384, PQW = 2048;
constexpr float RMS_EPS = 1e-6f;
constexpr int NTHREADS = 512, NWAVES = 8;
static_assert((T / 128) * 8 * 32 == 2 * NEXP && (T / 128) * 8 * 16 == T, "P8 side work: 32 expert rows and 16 h rows per item cover all rows");
constexpr int LDS_BYTES = 163840;
#ifndef PROBE_REP
#define PROBE_REP -1
#endif

constexpr size_t MiB = 1u << 20;
constexpr size_t WS_CTL = 0;
constexpr size_t WS_KSUM = 65536;
constexpr size_t WS_SWMAX = 196608;
constexpr size_t WS_WIN = 1 * MiB;
constexpr size_t WS_WOA = 11 * MiB;
constexpr size_t WS_WMIX = 13 * MiB;
constexpr size_t WS_WQ = 15 * MiB;
constexpr size_t WS_SK = 19 * MiB;
constexpr size_t WS_RS1 = 19 * MiB + 512 * 1024;
constexpr size_t WS_RS2 = WS_RS1 + 65536;
constexpr size_t WS_XB = 24 * MiB;
constexpr size_t WS_OA = 24 * MiB;
constexpr size_t WS_EIDX = 24 * MiB;
constexpr size_t WS_GW = 28 * MiB;
constexpr size_t WS_QK = 56 * MiB;
constexpr size_t WS_KF = 88 * MiB;
constexpr size_t WS_VT = 120 * MiB;
constexpr size_t WS_MIXED = 56 * MiB;
constexpr size_t WS_HB = 88 * MiB;
constexpr size_t WS_GATES = 152 * MiB;
constexpr size_t WS_Q2 = 152 * MiB;
constexpr size_t WS_SU = 20 * MiB;
constexpr size_t WS_SV = WS_SU + 65536;
constexpr size_t WS_SSP = 36 * MiB;
constexpr size_t WS_SH = WS_SSP + 524288;
constexpr size_t WS_WSC = WS_SH + 65536;
constexpr size_t WS_WH = 37 * MiB;
constexpr size_t WS_WL = 39 * MiB;
constexpr size_t WS_H8 = 40 * MiB;
constexpr size_t WS_AP = 152 * MiB;
constexpr size_t WS_U8 = 216 * MiB;
constexpr size_t WS_V8 = 232 * MiB;
constexpr size_t WS_END = 248 * MiB;

struct Params {
    const float *x, *g1, *w_in, *w_oa, *w_ob, *w_mix, *g2, *w_q, *skeys, *pu, *pv, *gf;
    float* out; unsigned char* ws; int ph_lo, ph_hi;
};

DI unsigned f2bf(float f) { unsigned u = __float_as_uint(f); return (u + 0x7fffu + ((u >> 16) & 1u)) >> 16; }
DI float bf2f(unsigned h) { return __uint_as_float(h << 16); }
DI float bflo(unsigned w) { return __uint_as_float(w << 16); }
DI float bfhi(unsigned w) { return __uint_as_float(w & 0xffff0000u); }
typedef __bf16 bf16x2_t __attribute__((ext_vector_type(2)));
typedef float f32x2_t __attribute__((ext_vector_type(2)));
DI unsigned cvtpk(float lo, float hi) { f32x2_t v = {lo, hi}; bf16x2_t b = __builtin_convertvector(v, bf16x2_t); return __builtin_bit_cast(unsigned, b); }
DI unsigned pk2(float lo, float hi) { return cvtpk(lo, hi); }
DI unsigned q8x4(float a, float b, float c, float d, float isc) {
    const float M = 12582912.f;
    const unsigned fa = __float_as_uint(fmaf(a, isc, M)), fb = __float_as_uint(fmaf(b, isc, M)), fc = __float_as_uint(fmaf(c, isc, M)), fd = __float_as_uint(fmaf(d, isc, M));
    return __builtin_amdgcn_perm(fb, fa, 0x0c0c0400u) | __builtin_amdgcn_perm(fd, fc, 0x04000c0cu);
}
DI float wave_sum(float v) {
#pragma unroll
    for (int o = 32; o >= 1; o >>= 1) v += __shfl_xor(v, o);
    return v;
}
DI void load_row64(const bf16_t* p, float* o) {
#pragma unroll
    for (int i = 0; i < 8; ++i) {
        u32x4 w = *(const u32x4*)(p + 8 * i);
        o[8 * i + 0] = bflo(w.x); o[8 * i + 1] = bfhi(w.x); o[8 * i + 2] = bflo(w.y); o[8 * i + 3] = bfhi(w.y);
        o[8 * i + 4] = bflo(w.z); o[8 * i + 5] = bfhi(w.z); o[8 * i + 6] = bflo(w.w); o[8 * i + 7] = bfhi(w.w);
    }
}
DI float sigmoidf_(float x) { return __builtin_amdgcn_rcpf(1.f + __builtin_amdgcn_exp2f(x * -1.4426950408889634f)); }

DI void transpose_item(const float* W, int K, int N, bf16_t* WT, int ldk, int koff, const float* ks, float* scr, int item, int lane) {
    const int nblk = N / 32, kb = item / nblk, nb = item % nblk, k0 = 64 * kb, n0 = 32 * nb;
    float tv[32];
#pragma unroll
    for (int i = 0; i < 32; ++i) tv[i] = W[(size_t)(k0 + 2 * i + (lane >> 5)) * N + n0 + (lane & 31)];
    if (ks) {
#pragma unroll
        for (int i = 0; i < 32; ++i) tv[i] *= ks[k0 + 2 * i + (lane >> 5)];
    }
#pragma unroll
    for (int i = 0; i < 32; ++i) scr[(2 * i + (lane >> 5)) * 33 + (lane & 31)] = tv[i];
    asm volatile("s_waitcnt lgkmcnt(0)" ::: "memory");
    const int c = lane & 7;
#pragma unroll
    for (int j = 0; j < 4; ++j) { const int n = (lane >> 3) + 8 * j; const float* sp = scr + (8 * c) * 33 + n;
        u32x4 o; o.x = pk2(sp[0 * 33], sp[1 * 33]); o.y = pk2(sp[2 * 33], sp[3 * 33]); o.z = pk2(sp[4 * 33], sp[5 * 33]); o.w = pk2(sp[6 * 33], sp[7 * 33]);
        *(u32x4*)(WT + (size_t)(n0 + n) * ldk + koff + k0 + 8 * c) = o; }
    asm volatile("s_waitcnt lgkmcnt(0)" ::: "memory");
}

namespace pg8 {
#define PG8_LAS __attribute__((address_space(3)))
typedef unsigned short bf16_t;
typedef short bf16x8 __attribute__((ext_vector_type(8)));
typedef float f32x4 __attribute__((ext_vector_type(4)));
typedef int i32x4 __attribute__((ext_vector_type(4)));
typedef unsigned u32x4 __attribute__((ext_vector_type(4)));
template <bool I8> struct AccT { typedef f32x4 type; };
template <> struct AccT<true> { typedef i32x4 type; };
constexpr int BM = 256, BK = 64, HALF = 128, HTB = HALF * BK * 2  , STAGE_BYTES = 8 * HTB, NXCD = 8, WGM = 8;

__host__ __device__ __forceinline__ int lds_byte(int r, int c) { const int st = (r >> 4) * 2 + (c >> 5), rr = r & 15, cc = c & 31, ob = rr * 64 + cc * 2; return st * 1024 + (ob ^ (((ob >> 9) & 1) << 5)); }
__host__ __device__ __forceinline__ void stage_rc(int b, int& R, int& C) { const int st = b / 1024, sb = b % 1024, swz = sb ^ (((sb >> 9) & 1) << 5); R = (st >> 1) * 16 + swz / 64; C = (st & 1) * 32 + (swz % 64) / 2; }
__host__ __device__ __forceinline__ int perm32(int rho) { const int n = rho >> 4, i = rho & 15; return 8 * (i >> 2) + 4 * n + (i & 3); }

struct Unit { int pm, pn; };
struct Gemm { const bf16_t* A; const bf16_t* Bt; int M, N, K; };

struct StaticOrder {
    int nM, nN, nwg, G, c;
    __host__ __device__ void init(int M, int N, int G_, int c_) { nM = M / BM; nN = N / BM; nwg = nM * nN; G = G_; c = c_; }
    __host__ __device__ bool next(int i, Unit& u) const {
        const long L = (long)i * G + c; if (L >= nwg) return false;
        int wgid = (int)L; { const int q = nwg / NXCD, r = nwg % NXCD, xcd = wgid % NXCD, off = wgid / NXCD; wgid = (xcd < r ? xcd * (q + 1) : r * (q + 1) + (xcd - r) * q) + off; }
        const int nig = WGM * nN, gid = wgid / nig, fm = gid * WGM, gsz = (nM - fm) < WGM ? (nM - fm) : WGM;
        u.pm = fm + ((wgid % nig) % gsz); u.pn = (wgid % nig) / gsz; return true;
    }
    __device__ __forceinline__ void a_ready(const Unit&) const {}
    __device__ __forceinline__ void done(const Unit&) const {}
};
__device__ __forceinline__ unsigned cvt_pk_bf16(float lo, float hi) { unsigned r; asm volatile("v_cvt_pk_bf16_f32 %0, %1, %2" : "=v"(r) : "v"(lo), "v"(hi)); return r; }
template <class Epi, class Sched, bool ALIGN_EPI = false, bool SP2 = false, bool MIDK = false>
__device__ __forceinline__ void gemm_phase(PG8_LAS unsigned char* lds, const Gemm g, const Sched& S, const Epi& E) {
    const int tid = threadIdx.x, wid = __builtin_amdgcn_readfirstlane(tid >> 6), lane = tid & 63, wr = wid >> 2, wc = wid & 3, fr = lane & 15, fq = lane >> 4;
    const int K = g.K, nt = K / BK;
    unsigned voffA[2], voffB[2];
#pragma unroll
    for (int i = 0; i < 2; ++i) { int R, C; stage_rc(tid * 16 + i * 8192, R, C); const int Rb = Epi::PERM ? ((R & ~31) + perm32(R & 31)) : R;
        voffA[i] = (unsigned)(R * K + C) * 2u; voffB[i] = (unsigned)(Rb * K + C) * 2u; }
    const size_t kstep = (size_t)(BK * 2);
    const size_t hstep = (size_t)HALF * K * 2;
    const size_t tstep = 2 * hstep;
    const unsigned ldsw = (unsigned)wid * 1024u;
    const int aoff = lds_byte(wr * 64 + fr, fq * 8), boff = lds_byte(wc * 32 + fr, fq * 8);
#define PG8_SA(b, h) (((b) * 2 + (h)) * HTB)
#define PG8_SB(b, h) ((4 + (b) * 2 + (h)) * HTB)
#define PG8_STAGE(bufoff, gbase, voff) do { _Pragma("unroll") for (int _i = 0; _i < 2; ++_i) \
        __builtin_amdgcn_global_load_lds((const unsigned*)((const char*)(gbase) + (voff)[_i]), (PG8_LAS unsigned*)(lds + (bufoff) + ldsw + _i * 8192), 16, 0, 0); } while (0)
#define PG8_LDA(dst, b, h) do { _Pragma("unroll") for (int m = 0; m < 4; ++m) _Pragma("unroll") for (int k = 0; k < 2; ++k) dst[m][k] = *(const PG8_LAS bf16x8*)(lds + PG8_SA(b, h) + aoff + m * 2048 + k * 1024); } while (0)
#define PG8_LDB(dst, b, h) do { _Pragma("unroll") for (int n = 0; n < 2; ++n) _Pragma("unroll") for (int k = 0; k < 2; ++k) dst[n][k] = *(const PG8_LAS bf16x8*)(lds + PG8_SB(b, h) + boff + n * 2048 + k * 1024); } while (0)
#define PG8_MMA(ai, bj, At, Bt) do { __builtin_amdgcn_s_setprio(1); _Pragma("unroll") for (int m = 0; m < 4; ++m) _Pragma("unroll") for (int n = 0; n < 2; ++n) _Pragma("unroll") for (int k = 0; k < 2; ++k) \
        { if constexpr (Epi::I8) acc[ai][bj][m][n] = __builtin_amdgcn_mfma_i32_16x16x64_i8(__builtin_bit_cast(i32x4, Bt[n][k]), __builtin_bit_cast(i32x4, At[m][k]), acc[ai][bj][m][n], 0, 0, 0); \
          else acc[ai][bj][m][n] = __builtin_amdgcn_mfma_f32_16x16x32_bf16(Bt[n][k], At[m][k], acc[ai][bj][m][n], 0, 0, 0); } __builtin_amdgcn_s_setprio(0); } while (0)
#define PG8_WAIT_V(n) asm volatile("s_waitcnt vmcnt(" #n ")" ::: "memory")
#define PG8_WAIT_L(n) asm volatile("s_waitcnt lgkmcnt(" #n ")" ::: "memory")
#define PG8_BAR __builtin_amdgcn_s_barrier()
#define PG8_SCHED __builtin_amdgcn_sched_barrier(0)
    Unit cur, nxt; int ui = 0;
    if (!S.next(0, cur)) return;
    typedef typename AccT<Epi::I8>::type acc_t;
    acc_t acc[2][2][4][2];
    if constexpr (Epi::HAS_INIT) E.init(acc, cur, wr, wc, fr, fq);
    else {
#pragma unroll
    for (int a = 0; a < 2; ++a)
#pragma unroll
        for (int b = 0; b < 2; ++b)
#pragma unroll
            for (int m = 0; m < 4; ++m)
#pragma unroll
                for (int n = 0; n < 2; ++n) acc[a][b][m][n] = acc_t{};
    }
    bf16x8 At[4][2], B0[2][2], B1[2][2];
    const char* cA = (const char*)g.A + (size_t)cur.pm * tstep; const char* cB = (const char*)g.Bt + (size_t)cur.pn * tstep;
    S.a_ready(cur);
    if constexpr (SP2) {
        PG8_STAGE(PG8_SB(0, 0), cB, voffB); PG8_STAGE(PG8_SB(0, 1), cB + hstep, voffB); PG8_STAGE(PG8_SA(0, 0), cA, voffA); PG8_STAGE(PG8_SA(0, 1), cA + hstep, voffA);
        if (wr == 1) PG8_BAR;
        PG8_WAIT_V(2); PG8_BAR;
        PG8_STAGE(PG8_SB(1, 0), cB + kstep, voffB); PG8_STAGE(PG8_SA(1, 0), cA + kstep, voffA); PG8_STAGE(PG8_SB(1, 1), cB + hstep + kstep, voffB);
        PG8_WAIT_V(6); PG8_BAR;
    } else {
        PG8_STAGE(PG8_SB(0, 0), cB, voffB); PG8_STAGE(PG8_SA(0, 0), cA, voffA); PG8_STAGE(PG8_SB(0, 1), cB + hstep, voffB); PG8_STAGE(PG8_SA(0, 1), cA + hstep, voffA);
        if (wr == 1) PG8_BAR;
        PG8_WAIT_V(4); PG8_BAR;
        PG8_STAGE(PG8_SB(1, 0), cB + kstep, voffB); PG8_STAGE(PG8_SA(1, 0), cA + kstep, voffA); PG8_STAGE(PG8_SB(1, 1), cB + hstep + kstep, voffB);
        PG8_WAIT_V(6); PG8_BAR;
    }
    for (;;) {
        const bool has_next = S.next(ui + 1, nxt);
        const char* nA = has_next ? (const char*)g.A + (size_t)nxt.pm * tstep : cA; const char* nB = has_next ? (const char*)g.Bt + (size_t)nxt.pn * tstep : cB;
        for (int t = 0; t < nt; t += 2) {
            if constexpr (MIDK) { if (t == nt / 2) E.mid(acc, cur, wr, wc, fr, fq); }
            const bool last = (t == nt - 2);
            const char* a1 = cA + (size_t)(t + 1) * kstep;
            const char* a2 = last ? nA : cA + (size_t)(t + 2) * kstep; const char* b2 = last ? nB : cB + (size_t)(t + 2) * kstep;
            const char* a3 = a2 + kstep; const char* b3 = b2 + kstep;
            if (last && has_next) S.a_ready(nxt);
            if constexpr (SP2) {
            PG8_LDB(B0, 0, 0); PG8_LDB(B1, 0, 1); PG8_SCHED; PG8_LDA(At, 0, 0); PG8_STAGE(PG8_SA(1, 1), a1 + hstep, voffA);
            PG8_WAIT_V(8); PG8_WAIT_L(0); PG8_BAR; PG8_MMA(0, 0, At, B0); PG8_MMA(0, 1, At, B1); PG8_BAR; PG8_SCHED;
            PG8_LDA(At, 0, 1); PG8_STAGE(PG8_SB(0, 0), b2, voffB); PG8_STAGE(PG8_SB(0, 1), b2 + hstep, voffB); PG8_STAGE(PG8_SA(0, 0), a2, voffA);
            PG8_WAIT_V(8); PG8_WAIT_L(0); PG8_BAR; PG8_MMA(1, 0, At, B0); PG8_MMA(1, 1, At, B1); PG8_BAR; PG8_SCHED;
            PG8_LDB(B0, 1, 0); PG8_LDB(B1, 1, 1); PG8_SCHED; PG8_LDA(At, 1, 0); PG8_STAGE(PG8_SA(0, 1), a2 + hstep, voffA);
            PG8_WAIT_V(8); PG8_WAIT_L(0); PG8_BAR; PG8_MMA(0, 0, At, B0); PG8_MMA(0, 1, At, B1); PG8_BAR; PG8_SCHED;
            PG8_LDA(At, 1, 1); PG8_STAGE(PG8_SB(1, 0), b3, voffB); PG8_STAGE(PG8_SB(1, 1), b3 + hstep, voffB); PG8_STAGE(PG8_SA(1, 0), a3, voffA);
            PG8_WAIT_V(8); PG8_WAIT_L(0); PG8_BAR; PG8_MMA(1, 0, At, B0); PG8_MMA(1, 1, At, B1); PG8_BAR; PG8_SCHED;
            } else {
            PG8_LDB(B0, 0, 0); PG8_SCHED; PG8_LDA(At, 0, 0); PG8_STAGE(PG8_SA(1, 1), a1 + hstep, voffA);
            PG8_WAIT_L(8); PG8_BAR; PG8_WAIT_L(0); PG8_MMA(0, 0, At, B0); PG8_BAR; PG8_SCHED;
            PG8_LDB(B1, 0, 1); PG8_STAGE(PG8_SB(0, 0), b2, voffB);
            PG8_BAR; PG8_WAIT_L(0); PG8_MMA(0, 1, At, B1); PG8_BAR;
            PG8_LDA(At, 0, 1); PG8_STAGE(PG8_SA(0, 0), a2, voffA);
            PG8_BAR; PG8_WAIT_L(0); PG8_MMA(1, 0, At, B0); PG8_BAR; PG8_SCHED;
            PG8_STAGE(PG8_SB(0, 1), b2 + hstep, voffB);
            PG8_WAIT_V(6); PG8_BAR; PG8_MMA(1, 1, At, B1); PG8_BAR;
            PG8_LDB(B0, 1, 0); PG8_SCHED; PG8_LDA(At, 1, 0); PG8_STAGE(PG8_SA(0, 1), a2 + hstep, voffA);
            PG8_WAIT_L(8); PG8_BAR; PG8_WAIT_L(0); PG8_MMA(0, 0, At, B0); PG8_BAR; PG8_SCHED;
            PG8_LDB(B1, 1, 1); PG8_STAGE(PG8_SB(1, 0), b3, voffB);
            PG8_BAR; PG8_WAIT_L(0); PG8_MMA(0, 1, At, B1); PG8_BAR;
            PG8_LDA(At, 1, 1); PG8_STAGE(PG8_SA(1, 0), a3, voffA);
            PG8_BAR; PG8_WAIT_L(0); PG8_MMA(1, 0, At, B0); PG8_BAR; PG8_SCHED;
            PG8_STAGE(PG8_SB(1, 1), b3 + hstep, voffB);
            PG8_WAIT_V(6); PG8_BAR; PG8_MMA(1, 1, At, B1); PG8_BAR;
            }
        }
        if constexpr (ALIGN_EPI) { if (wr == 0) PG8_BAR; }
        if constexpr (!Epi::AFTER_DRAIN) { E(acc, cur, wr, wc, fr, fq); S.done(cur); }
        if (!has_next) break;
        if constexpr (Epi::HAS_INIT) E.init(acc, nxt, wr, wc, fr, fq);
        else {
#pragma unroll
        for (int a = 0; a < 2; ++a)
#pragma unroll
            for (int b = 0; b < 2; ++b)
#pragma unroll
                for (int m = 0; m < 4; ++m)
#pragma unroll
                    for (int n = 0; n < 2; ++n) acc[a][b][m][n] = acc_t{};
        }
        cur = nxt; cA = nA; cB = nB; ++ui;
        if constexpr (ALIGN_EPI) { if (wr == 1) PG8_BAR; }
    }
    PG8_WAIT_V(0);
    if constexpr (!ALIGN_EPI) { if (wr == 0) PG8_BAR; }
    PG8_BAR;
    if constexpr (Epi::AFTER_DRAIN) { E.fused(acc, cur, wr, wc, fr, fq, lds, wid, lane); S.done(cur); }
#undef PG8_SA
#undef PG8_SB
#undef PG8_STAGE
#undef PG8_LDA
#undef PG8_LDB
#undef PG8_MMA
#undef PG8_WAIT_V
#undef PG8_WAIT_L
#undef PG8_BAR
#undef PG8_SCHED
}
}

#define EPI_FOR(...) _Pragma("unroll") for (int ai = 0; ai < 2; ++ai) _Pragma("unroll") for (int m = 0; m < 4; ++m) { const int row = u.pm * 256 + ai * 128 + wr * 64 + m * 16 + fr; \
    _Pragma("unroll") for (int bj = 0; bj < 2; ++bj) { const int col = u.pn * 256 + bj * 128 + wc * 32 + 8 * fq; const f32x4 a0 = acc[ai][bj][m][0], a1 = acc[ai][bj][m][1]; __VA_ARGS__ } }
DI u32x4 pack8bf(f32x4 a, f32x4 b) { u32x4 w; w.x = pk2(a.x, a.y); w.y = pk2(a.z, a.w); w.z = pk2(b.x, b.y); w.w = pk2(b.z, b.w); return w; }
constexpr float C2 = 0.125f * 1.4426950408889634f;
struct EpiInProj {
    static constexpr bool PERM = true, AFTER_DRAIN = false, HAS_INIT = false, I8 = true;
    bf16_t* QK; bf16_t* KF; bf16_t* VT; bf16_t* GATES; const float* RS1  ; const float* SW  ; float* KSUM; bool ksum_on;
    DI void operator()(const pg8::i32x4 (&iacc)[2][2][4][2], const pg8::Unit& u, int wr, int wc, int fr, int fq) const {
        f32x4 acc[2][2][4][2];
#pragma unroll
        for (int bj = 0; bj < 2; ++bj) {
            const float* swp = SW + u.pn * 256 + bj * 128 + wc * 32 + 8 * fq;
            const f32x4 c0 = *(const f32x4*)swp * (1.f / 127.f), c1 = *(const f32x4*)(swp + 4) * (1.f / 127.f);
#pragma unroll
            for (int ai = 0; ai < 2; ++ai)
#pragma unroll
                for (int m = 0; m < 4; ++m) { acc[ai][bj][m][0] = __builtin_convertvector(iacc[ai][bj][m][0], f32x4) * c0; acc[ai][bj][m][1] = __builtin_convertvector(iacc[ai][bj][m][1], f32x4) * c1; }
        }
        const int seg = (u.pn * 256) >> 9;
        if (seg == 2 || seg == 5) {
            const int kind = seg == 5;
            EPI_FOR({
                const float rs = RS1[row]; const int bb = row >> 13, key = row & (SEQ - 1), kp = key & 15;
                const int nn = col - (kind ? 2560 : 1024), dim = nn & 63;
                bf16_t* vt = VT + (((size_t)((kind * 2 + bb) * NH + (nn >> 6)) * 256 + (key >> 5)) * 4 + ((dim >> 5) * 2 + ((key >> 4) & 1))) * 512 + (((kp >> 2) & 1) * 32 + (dim & 31)) * 8 + 4 * (kp >> 3) + (kp & 3);
                vt[0] = (bf16_t)f2bf(a0.x * rs); vt[8] = (bf16_t)f2bf(a0.y * rs); vt[16] = (bf16_t)f2bf(a0.z * rs); vt[24] = (bf16_t)f2bf(a0.w * rs);
                vt[32] = (bf16_t)f2bf(a1.x * rs); vt[40] = (bf16_t)f2bf(a1.y * rs); vt[48] = (bf16_t)f2bf(a1.z * rs); vt[56] = (bf16_t)f2bf(a1.w * rs);
            })
        } else if (seg == 1 || seg == 4) {
            const int kind = seg == 4;
            float cs[16];
#pragma unroll
            for (int i = 0; i < 16; ++i) cs[i] = 0.f;
            EPI_FOR({
                const float rs = RS1[row]; const f32x4 v0 = a0 * rs, v1 = a1 * rs;
                const int bb = row >> 13, key = row & (SEQ - 1), nn = col - (kind ? 2048 : 512), dim = nn & 63;
                *(u32x4*)(KF + (((size_t)((kind * 2 + bb) * NH + (nn >> 6)) * 256 + (key >> 5)) * 4 + (dim >> 4)) * 512 + (((dim >> 3) & 1) * 32 + (key & 31)) * 8) = pack8bf(v0, v1);
                if (seg == 1) { cs[bj * 8 + 0] += v0.x; cs[bj * 8 + 1] += v0.y; cs[bj * 8 + 2] += v0.z; cs[bj * 8 + 3] += v0.w; cs[bj * 8 + 4] += v1.x; cs[bj * 8 + 5] += v1.y; cs[bj * 8 + 6] += v1.z; cs[bj * 8 + 7] += v1.w; }
            })
            if (seg == 1 && ksum_on) {
                const bool b3 = (fr & 8) != 0, b2 = (fr & 4) != 0, b1 = (fr & 2) != 0, b0 = (fr & 1) != 0;
                float v8[8], v4[4];
#pragma unroll
                for (int i = 0; i < 8; ++i) v8[i] = (b3 ? cs[8 + i] : cs[i]) + __shfl_xor(b3 ? cs[i] : cs[8 + i], 8);
#pragma unroll
                for (int i = 0; i < 4; ++i) v4[i] = (b2 ? v8[4 + i] : v8[i]) + __shfl_xor(b2 ? v8[i] : v8[4 + i], 4);
                const float v20 = (b1 ? v4[2] : v4[0]) + __shfl_xor(b1 ? v4[0] : v4[2], 2), v21 = (b1 ? v4[3] : v4[1]) + __shfl_xor(b1 ? v4[1] : v4[3], 2);
                const float v1_ = (b0 ? v21 : v20) + __shfl_xor(b0 ? v20 : v21, 1);
                const int c = u.pn * 256 + (fr >> 3) * 128 + wc * 32 + 8 * fq + (fr & 7) - 512, row0 = u.pm * 256;
                atomicAdd(KSUM + ((size_t)(((row0 >> 13) * NH + (c >> 6)) * NBLK + ((row0 & (SEQ - 1)) >> 8))) * HD + (c & 63), v1_);
            }
        } else if (seg < 6) {
            const int cshift = seg == 3 ? -1024 : 0;
            EPI_FOR({ const float rs = RS1[row] * C2; *(u32x4*)(QK + (size_t)row * 1024 + col + cshift) = pack8bf(a0 * rs, a1 * rs); })
        } else {
            EPI_FOR({
                const float rs = RS1[row]; const f32x4 v0 = a0 * rs, v1 = a1 * rs;
                const f32x4 s0 = {sigmoidf_(v0.x), sigmoidf_(v0.y), sigmoidf_(v0.z), sigmoidf_(v0.w)}, s1 = {sigmoidf_(v1.x), sigmoidf_(v1.y), sigmoidf_(v1.z), sigmoidf_(v1.w)};
                *(u32x4*)(GATES + (size_t)row * GATEW + col - QKVW) = pack8bf(s0, s1);
            })
        }
    }
};
struct EpiMix {
    static constexpr bool PERM = true, AFTER_DRAIN = false, HAS_INIT = false, I8 = false;
    const bf16_t* GATES; bf16_t* MIXED;
    DI void mid(f32x4 (&acc)[2][2][4][2], const pg8::Unit& u, int wr, int wc, int fr_in, int fq_in) const {
        int fr = fr_in, fq = fq_in; asm volatile("" : "+v"(fr), "+v"(fq));
#pragma unroll
        for (int ai = 0; ai < 2; ++ai)
#pragma unroll
            for (int m = 0; m < 4; ++m) { const int row = u.pm * 256 + ai * 128 + wr * 64 + m * 16 + fr;
#pragma unroll
                for (int bj = 0; bj < 2; ++bj) { const int col = u.pn * 256 + bj * 128 + wc * 32 + 8 * fq;
                    const u32x4 ga = *(const u32x4*)(GATES + (size_t)row * GATEW + col), gb = *(const u32x4*)(GATES + (size_t)row * GATEW + 1024 + col);
                    const float r0 = bflo(ga.x) * __builtin_amdgcn_rcpf(fmaxf(bflo(gb.x), 1e-30f)), r1 = bfhi(ga.x) * __builtin_amdgcn_rcpf(fmaxf(bfhi(gb.x), 1e-30f));
                    const float r2 = bflo(ga.y) * __builtin_amdgcn_rcpf(fmaxf(bflo(gb.y), 1e-30f)), r3 = bfhi(ga.y) * __builtin_amdgcn_rcpf(fmaxf(bfhi(gb.y), 1e-30f));
                    const float r4 = bflo(ga.z) * __builtin_amdgcn_rcpf(fmaxf(bflo(gb.z), 1e-30f)), r5 = bfhi(ga.z) * __builtin_amdgcn_rcpf(fmaxf(bfhi(gb.z), 1e-30f));
                    const float r6 = bflo(ga.w) * __builtin_amdgcn_rcpf(fmaxf(bflo(gb.w), 1e-30f)), r7 = bfhi(ga.w) * __builtin_amdgcn_rcpf(fmaxf(bfhi(gb.w), 1e-30f));
                    acc[ai][bj][m][0] = acc[ai][bj][m][0] * (f32x4){r0, r1, r2, r3}; acc[ai][bj][m][1] = acc[ai][bj][m][1] * (f32x4){r4, r5, r6, r7}; }
                __builtin_amdgcn_sched_barrier(0); }
    }
    DI void operator()(const f32x4 (&acc)[2][2][4][2], const pg8::Unit& u, int wr, int wc, int fr, int fq) const {
        EPI_FOR({
            const u32x4 gb = *(const u32x4*)(GATES + (size_t)row * GATEW + 1024 + col);
            const f32x4 s0 = {fmaxf(bflo(gb.x), 1e-30f), fmaxf(bfhi(gb.x), 1e-30f), fmaxf(bflo(gb.y), 1e-30f), fmaxf(bfhi(gb.y), 1e-30f)};
            const f32x4 s1 = {fmaxf(bflo(gb.z), 1e-30f), fmaxf(bfhi(gb.z), 1e-30f), fmaxf(bflo(gb.w), 1e-30f), fmaxf(bfhi(gb.w), 1e-30f)};
            *(u32x4*)(MIXED + (size_t)row * DM + col) = pack8bf(a0 * s0, a1 * s1);
        })
    }
};
struct EpiResid {
    static constexpr bool PERM = true, AFTER_DRAIN = false, HAS_INIT = true, I8 = false;
    const float* X; bf16_t* HB;
    DI void init(f32x4 (&acc)[2][2][4][2], const pg8::Unit& u, int wr, int wc, int fr, int fq) const {
#pragma unroll
        for (int ai = 0; ai < 2; ++ai)
#pragma unroll
            for (int m = 0; m < 4; ++m) { const int row = u.pm * 256 + ai * 128 + wr * 64 + m * 16 + fr;
#pragma unroll
                for (int bj = 0; bj < 2; ++bj) { const float* xp = X + (size_t)row * DM + u.pn * 256 + bj * 128 + wc * 32 + 8 * fq; acc[ai][bj][m][0] = *(const f32x4*)xp; acc[ai][bj][m][1] = *(const f32x4*)(xp + 4); } }
    }
    DI void operator()(const f32x4 (&acc)[2][2][4][2], const pg8::Unit& u, int wr, int wc, int fr, int fq) const {
        EPI_FOR({ *(u32x4*)(HB + (size_t)row * DM + col) = pack8bf(a0, a1); })
    }
};
struct EpiPeerQ {
    static constexpr bool PERM = true, AFTER_DRAIN = false, HAS_INIT = false, I8 = false;
    bf16_t* Q2;
    DI void operator()(const f32x4 (&acc)[2][2][4][2], const pg8::Unit& u, int wr, int wc, int fr, int fq) const {
        EPI_FOR({ *(u32x4*)(Q2 + (size_t)row * PQW + col) = pack8bf(a0, a1); })
    }
};


DI void h_rows4(const bf16_t* H, float* RS2, float* SH, signed char* H8, int row0, int stride, int lane) {
    u32x4 a[4][2];
#pragma unroll
    for (int k = 0; k < 4; ++k)
#pragma unroll
        for (int j = 0; j < 2; ++j) a[k][j] = *(const u32x4*)(H + (size_t)(row0 + k * stride) * DM + lane * 16 + 8 * j);
#pragma unroll
    for (int k = 0; k < 4; ++k) {
        const int row = row0 + k * stride;
        float v[16];
#pragma unroll
        for (int j = 0; j < 2; ++j) { v[8 * j] = bflo(a[k][j].x); v[8 * j + 1] = bfhi(a[k][j].x); v[8 * j + 2] = bflo(a[k][j].y); v[8 * j + 3] = bfhi(a[k][j].y);
            v[8 * j + 4] = bflo(a[k][j].z); v[8 * j + 5] = bfhi(a[k][j].z); v[8 * j + 6] = bflo(a[k][j].w); v[8 * j + 7] = bfhi(a[k][j].w); }
        float ss = 0.f, am = 0.f;
#pragma unroll
        for (int j = 0; j < 16; ++j) { ss += v[j] * v[j]; am = fmaxf(am, fabsf(v[j])); }
        ss = wave_sum(ss);
#pragma unroll
        for (int o = 32; o >= 1; o >>= 1) am = fmaxf(am, __shfl_xor(am, o));
        const float sc = am > 0.f ? am * (1.f / 127.f) : 1.f, isc = 1.f / sc;
        unsigned w[4];
#pragma unroll
        for (int j = 0; j < 4; ++j) w[j] = q8x4(v[4 * j], v[4 * j + 1], v[4 * j + 2], v[4 * j + 3], isc);
        *(u32x4*)(H8 + (size_t)row * DM + lane * 16) = (u32x4){w[0], w[1], w[2], w[3]};
        if (lane == 0) { RS2[row] = rsqrtf(ss * (1.f / DM) + RMS_EPS); SH[row] = sc; }
    }
}

template <int NR>
DI void quant_rows(const float* pu, const float* pv, const float* g2, unsigned char* U8, unsigned char* V8, float* SU, float* SV, int row0, int stride, int lane) {
    f32x4 a[NR][4];
#pragma unroll
    for (int k = 0; k < NR; ++k) { const int row = row0 + k * stride, isv = row >= NEXP, e = row - (isv ? NEXP : 0); const float* src = (isv ? pv : pu) + (size_t)e * DM + lane * 16;
#pragma unroll
        for (int j = 0; j < 4; ++j) a[k][j] = *(const f32x4*)(src + 4 * j); }
    f32x4 gq[4];
#pragma unroll
    for (int j = 0; j < 4; ++j) gq[j] = *(const f32x4*)(g2 + lane * 16 + 4 * j);
#pragma unroll
    for (int k = 0; k < NR; ++k) {
        const int row = row0 + k * stride, isv = row >= NEXP, e = row - (isv ? NEXP : 0);
        float v[16];
#pragma unroll
        for (int j = 0; j < 4; ++j) { const f32x4 x = isv ? a[k][j] : a[k][j] * gq[j]; v[4 * j] = x.x; v[4 * j + 1] = x.y; v[4 * j + 2] = x.z; v[4 * j + 3] = x.w; }
        float am = 0.f;
#pragma unroll
        for (int j = 0; j < 16; ++j) am = fmaxf(am, fabsf(v[j]));
#pragma unroll
        for (int o = 32; o >= 1; o >>= 1) am = fmaxf(am, __shfl_xor(am, o));
        const float sc = am > 0.f ? am * (1.f / 127.f) : 1.f, isc = 1.f / sc;
        unsigned w[4];
#pragma unroll
        for (int j = 0; j < 4; ++j) w[j] = q8x4(v[4 * j], v[4 * j + 1], v[4 * j + 2], v[4 * j + 3], isc);
        unsigned char* dst = (isv ? V8 : U8) + ((size_t)((lane >> 3) * NEXP + e)) * 128 + (lane & 7) * 16;
        *(u32x4*)dst = (u32x4){w[0], w[1], w[2], w[3]};
        if (lane == 0) (isv ? SV : SU)[e] = sc;
    }
}

typedef float f32x16 __attribute__((ext_vector_type(16)));
#define MFMA32(a, b, c) __builtin_amdgcn_mfma_f32_32x32x16_bf16((a), (b), (c), 0, 0, 0)
constexpr float FLT_MIN_ = 1.17549435e-38f;

struct KV { bf16x8 k[4], v[4]; };
DI void load_kv(KV& f, const bf16_t* kp, const bf16_t* vp) {
#pragma unroll
    for (int i = 0; i < 4; ++i) { f.k[i] = *(const bf16x8*)(kp + 512 * i); f.v[i] = *(const bf16x8*)(vp + 512 * i); }
}
DI void load_kv_async(KV& f, const bf16_t* kp, const bf16_t* vp) {
    asm volatile("global_load_dwordx4 %0, %4, off\n\tglobal_load_dwordx4 %1, %4, off offset:1024\n\tglobal_load_dwordx4 %2, %4, off offset:2048\n\tglobal_load_dwordx4 %3, %4, off offset:3072"
                 : "=&v"(f.k[0]), "=&v"(f.k[1]), "=&v"(f.k[2]), "=&v"(f.k[3]) : "v"(kp) : "memory");
    asm volatile("global_load_dwordx4 %0, %4, off\n\tglobal_load_dwordx4 %1, %4, off offset:1024\n\tglobal_load_dwordx4 %2, %4, off offset:2048\n\tglobal_load_dwordx4 %3, %4, off offset:3072"
                 : "=&v"(f.v[0]), "=&v"(f.v[1]), "=&v"(f.v[2]), "=&v"(f.v[3]) : "v"(vp) : "memory");
}
#define KV_WAIT_K(f, N) asm volatile("s_waitcnt vmcnt(" #N ")" : "+v"(f.k[0]), "+v"(f.k[1]), "+v"(f.k[2]), "+v"(f.k[3]) :: "memory")
#define KV_WAIT_V(f, N) asm volatile("s_waitcnt vmcnt(" #N ")" : "+v"(f.v[0]), "+v"(f.v[1]), "+v"(f.v[2]), "+v"(f.v[3]) :: "memory")
DI bf16x8 pack8(const f32x16& p, int s) {
    u32x4 w;
    if (s == 0) { w.x = cvtpk(p[0], p[1]); w.y = cvtpk(p[2], p[3]); w.z = cvtpk(p[4], p[5]); w.w = cvtpk(p[6], p[7]); }
    else { w.x = cvtpk(p[8], p[9]); w.y = cvtpk(p[10], p[11]); w.z = cvtpk(p[12], p[13]); w.w = cvtpk(p[14], p[15]); }
    return __builtin_bit_cast(bf16x8, w);
}
struct SmState { float m, l; f32x16 o0, o1; };
typedef float f32x2 __attribute__((ext_vector_type(2)));
DI float sum16(const f32x16& p) {
    const f32x2 s0 = (f32x2){p[0], p[1]} + (f32x2){p[2], p[3]}, s1 = (f32x2){p[4], p[5]} + (f32x2){p[6], p[7]};
    const f32x2 s2 = (f32x2){p[8], p[9]} + (f32x2){p[10], p[11]}, s3 = (f32x2){p[12], p[13]} + (f32x2){p[14], p[15]};
    const f32x2 t0 = s0 + s1, t1 = s2 + s3, u = t0 + t1;
    return u.x + u.y;
}
constexpr float LAZY_THR = 1.0995116e12f;
template <int WK = -1, int WV = -1>
DI void moba_tile_first(SmState& st, KV& f, const bf16x8 (&qf)[4], float bias0, float slopeL, int maskrow, int hh) {
    f32x16 acc;
#pragma unroll
    for (int r = 0; r < 16; ++r) acc[r] = bias0 + slopeL * (float)((r & 3) + 8 * (r >> 2));
    if constexpr (WK == 12) KV_WAIT_K(f, 12); else if constexpr (WK == 4) KV_WAIT_K(f, 4);
#pragma unroll
    for (int ks = 0; ks < 4; ++ks) acc = MFMA32(f.k[ks], qf[ks], acc);
    if (maskrow < 32) {
#pragma unroll
        for (int r = 0; r < 16; ++r) if ((r & 3) + 8 * (r >> 2) + 4 * hh > maskrow) acc[r] = -1e30f;
    }
    float tm = acc[0];
#pragma unroll
    for (int r = 1; r < 16; ++r) tm = fmaxf(tm, acc[r]);
    tm = fmaxf(tm, __shfl_xor(tm, 32));
    f32x16 pw;
#pragma unroll
    for (int r = 0; r < 16; ++r) pw[r] = __builtin_amdgcn_exp2f(acc[r] - tm);
    st.m = tm; st.l = sum16(pw);
    const bf16x8 p0 = pack8(pw, 0), p1 = pack8(pw, 1);
    if constexpr (WV == 8) KV_WAIT_V(f, 8); else if constexpr (WV == 0) KV_WAIT_V(f, 0);
    f32x16 z;
#pragma unroll
    for (int r = 0; r < 16; ++r) z[r] = 0.f;
    st.o0 = MFMA32(f.v[0], p0, z); st.o0 = MFMA32(f.v[1], p1, st.o0);
    st.o1 = MFMA32(f.v[2], p0, z); st.o1 = MFMA32(f.v[3], p1, st.o1);
}
template <int WK = -1, int WV = -1>
DI void moba_tile_lazy(SmState& st, KV& f, const bf16x8 (&qf)[4], float bias0, float slopeL, int hh) {
    f32x16 acc;
    const float b0 = bias0 - st.m;
#pragma unroll
    for (int r = 0; r < 16; ++r) acc[r] = b0 + slopeL * (float)((r & 3) + 8 * (r >> 2));
    if constexpr (WK == 12) KV_WAIT_K(f, 12); else if constexpr (WK == 4) KV_WAIT_K(f, 4);
#pragma unroll
    for (int ks = 0; ks < 4; ++ks) acc = MFMA32(f.k[ks], qf[ks], acc);
    f32x16 pw;
#pragma unroll
    for (int r = 0; r < 16; ++r) pw[r] = __builtin_amdgcn_exp2f(acc[r]);
    float ps = sum16(pw);
    if (__builtin_expect(__any(!(ps <= LAZY_THR)), 0)) {
        const int nl = !(ps <= LAZY_THR);
        const bool need = (nl | __shfl_xor(nl, 32)) != 0;
        float tm = acc[0];
#pragma unroll
        for (int r = 1; r < 16; ++r) tm = fmaxf(tm, acc[r]);
        tm = fmaxf(tm, __shfl_xor(tm, 32));
        const float d = need ? tm : 0.f, al = __builtin_amdgcn_exp2f(-d);
        st.m += d; st.l *= al; st.o0 = st.o0 * al; st.o1 = st.o1 * al;
#pragma unroll
        for (int r = 0; r < 16; ++r) pw[r] = __builtin_amdgcn_exp2f(acc[r] - d);
        ps = sum16(pw);
    }
    st.l += ps;
    const bf16x8 p0 = pack8(pw, 0), p1 = pack8(pw, 1);
    if constexpr (WV == 8) KV_WAIT_V(f, 8); else if constexpr (WV == 0) KV_WAIT_V(f, 0);
    st.o0 = MFMA32(f.v[0], p0, st.o0); st.o0 = MFMA32(f.v[1], p1, st.o0);
    st.o1 = MFMA32(f.v[2], p0, st.o1); st.o1 = MFMA32(f.v[3], p1, st.o1);
}
DI void moba_pass_own(SmState& st, const bf16x8 (&qf)[4], const bf16_t* kt0, const bf16_t* vt0, int w, int maskrow, float bb, float slopeL, int hh) {
    KV fa, fb;
    const float bs = slopeL * 32.f;
    load_kv(fa, kt0 + (size_t)w * 2048, vt0 + (size_t)w * 2048);
    if (w >= 1) load_kv(fb, kt0 + (size_t)(w - 1) * 2048, vt0 + (size_t)(w - 1) * 2048);
    moba_tile_first(st, fa, qf, bb + (float)w * bs, slopeL, maskrow, hh);
#pragma unroll 1
    for (int kt = w - 1; kt >= 0; kt -= 2) {
        if (kt >= 1) load_kv(fa, kt0 + (size_t)(kt - 1) * 2048, vt0 + (size_t)(kt - 1) * 2048);
        moba_tile_lazy(st, fb, qf, bb + (float)kt * bs, slopeL, hh);
        if (kt >= 1) {
            if (kt >= 2) load_kv(fb, kt0 + (size_t)(kt - 2) * 2048, vt0 + (size_t)(kt - 2) * 2048);
            moba_tile_lazy(st, fa, qf, bb + (float)(kt - 1) * bs, slopeL, hh);
        }
    }
}
template <bool MASKED>
DI void sb_tile(f32x16& o0, f32x16& o1, float& carry, const KV& f, const bf16x8 (&qf)[4], int maskrow, int hh) {
    f32x16 acc;
#pragma unroll
    for (int r = 0; r < 16; ++r) acc[r] = 0.f;
#pragma unroll
    for (int ks = 0; ks < 4; ++ks) acc = MFMA32(f.k[ks], qf[ks], acc);
    float bt[16], fc[16];
#pragma unroll
    for (int r = 0; r < 16; ++r) {
        const float z = acc[r];
        const float e = __builtin_amdgcn_exp2f(-fabsf(z)), rr = __builtin_amdgcn_rcpf(1.f + e), er = e * rr;
        const bool pos = z >= 0.f, msk = MASKED && ((r & 3) + 8 * (r >> 2) + 4 * hh) >= maskrow;
        bt[r] = msk ? 0.f : (pos ? rr : er);
        fc[r] = msk ? 1.f : (pos ? er : rr);
    }
    float G[4], Gp[4], wf[16];
#pragma unroll
    for (int g = 0; g < 4; ++g) {
        const float s3 = fc[4 * g + 3], s2 = s3 * fc[4 * g + 2], s1 = s2 * fc[4 * g + 1];
        G[g] = s1 * fc[4 * g];
        wf[4 * g + 3] = bt[4 * g + 3]; wf[4 * g + 2] = bt[4 * g + 2] * s3; wf[4 * g + 1] = bt[4 * g + 1] * s2; wf[4 * g] = bt[4 * g] * s1;
    }
#pragma unroll
    for (int g = 0; g < 4; ++g) Gp[g] = __shfl_xor(G[g], 32);
    const float T0 = G[0] * Gp[0], T1 = G[1] * Gp[1], T2 = G[2] * Gp[2], T3 = G[3] * Gp[3];
    const float RR2 = T3, RR1 = T3 * T2, RR0 = RR1 * T1, total = RR0 * T0;
    float base[4];
    base[3] = carry * (hh == 0 ? Gp[3] : 1.f);
    base[2] = carry * RR2 * (hh == 0 ? Gp[2] : 1.f);
    base[1] = carry * RR1 * (hh == 0 ? Gp[1] : 1.f);
    base[0] = carry * RR0 * (hh == 0 ? Gp[0] : 1.f);
    f32x16 pw;
#pragma unroll
    for (int r = 0; r < 16; ++r) pw[r] = wf[r] * base[r >> 2];
    carry *= total;
    const bf16x8 p0 = pack8(pw, 0), p1 = pack8(pw, 1);
    o0 = MFMA32(f.v[0], p0, o0); o0 = MFMA32(f.v[1], p1, o0);
    o1 = MFMA32(f.v[2], p0, o1); o1 = MFMA32(f.v[3], p1, o1);
}
DI void store_o(bf16_t* orow  , const f32x16& o0, const f32x16& o1, float sc) {
#pragma unroll
    for (int g = 0; g < 4; ++g) {
        u32x2 a; a.x = cvtpk(o0[4 * g] * sc, o0[4 * g + 1] * sc); a.y = cvtpk(o0[4 * g + 2] * sc, o0[4 * g + 3] * sc); *(u32x2*)(orow + 8 * g) = a;
        u32x2 c; c.x = cvtpk(o1[4 * g] * sc, o1[4 * g + 1] * sc); c.y = cvtpk(o1[4 * g + 2] * sc, o1[4 * g + 3] * sc); *(u32x2*)(orow + 32 + 8 * g) = c;
    }
}
constexpr int ML_OPART = 0;
constexpr int ML_ML = 4 * 256 * 68 * 2;
constexpr int ML_LISTS = ML_ML + 4 * 256 * 2 * 4;
constexpr int ML_SELS = ML_LISTS + 32 * 256;
constexpr int ML_CNT = ML_SELS + 1024;
constexpr int ML_UST = ML_CNT + 128;
constexpr int ML_QCTR = ML_UST + 144;
constexpr int ML_ITEM = ML_QCTR + 16;
constexpr int ML_UJ = ML_ITEM + 16;
static_assert(ML_UJ + 64 <= LDS_BYTES - 16, "MoBA LDS map");
DI void top3_insert(float s, int b, float& v0, float& v1, float& v2, int& i0, int& i1, int& i2) {
    const bool g0 = s > v0, g1 = s > v1, g2 = s > v2;
    v2 = g1 ? v1 : (g2 ? s : v2); i2 = g1 ? i1 : (g2 ? b : i2);
    v1 = g0 ? v0 : (g1 ? s : v1); i1 = g0 ? i0 : (g1 ? b : i1);
    v0 = g0 ? s : v0; i0 = g0 ? b : i0;
}
DI int p3_order(int i) {
    constexpr unsigned long long W0 = 0x1918171612151413ull, W1 = 0x1d1c1e1b0b1f1a11ull, W2 = 0x08070d0e0f0c0a10ull, W3 = 0x0001020403050906ull;
    const unsigned long long w = (i >> 3) == 0 ? W0 : ((i >> 3) == 1 ? W1 : ((i >> 3) == 2 ? W2 : W3));
    return (int)((w >> (8 * (i & 7))) & 255ull);
}
DI void sb_group(const bf16_t* QK, const bf16_t* KF, const bf16_t* VT, bf16_t* OB, int b, int head, int qt) {
    const int tid = threadIdx.x, wave = tid >> 6; int lane = tid & 63;
    asm volatile("" : "+v"(lane));
    const int r = lane & 31, hh = lane >> 5;
    const bf16_t* kp = KF + (size_t)((1 * 2 + b) * NH + head) * 256 * 2048 + lane * 8;
    const bf16_t* vp = VT + (size_t)((1 * 2 + b) * NH + head) * 256 * 2048 + lane * 8;
    const int kt0 = 8 * qt + wave, t = 32 * kt0 + r;
    const bf16_t* qp = QK + (size_t)(b * SEQ + t) * 1024 + 512 + head * HD + 8 * hh;
    bf16x8 qf[4];
#pragma unroll
    for (int ks = 0; ks < 4; ++ks) qf[ks] = *(const bf16x8*)(qp + 16 * ks);
    f32x16 o0, o1;
#pragma unroll
    for (int x = 0; x < 16; ++x) { o0[x] = 0.f; o1[x] = 0.f; }
    float carry = 1.f;
    KV fa, fb;
    int kt = kt0;
    load_kv(fa, kp + (size_t)kt * 2048, vp + (size_t)kt * 2048);
    if (kt >= 1) load_kv(fb, kp + (size_t)(kt - 1) * 2048, vp + (size_t)(kt - 1) * 2048);
    asm volatile("" ::: "memory");
    sb_tile<true>(o0, o1, carry, fa, qf, r, hh);
    if (!(kt < 1 || __all(carry < FLT_MIN_))) {
        for (;;) {
            if (kt >= 2) load_kv(fa, kp + (size_t)(kt - 2) * 2048, vp + (size_t)(kt - 2) * 2048);
            asm volatile("" ::: "memory");
            sb_tile<false>(o0, o1, carry, fb, qf, 32, hh);
            if (kt < 2 || __all(carry < FLT_MIN_)) break;
            if (kt >= 3) load_kv(fb, kp + (size_t)(kt - 3) * 2048, vp + (size_t)(kt - 3) * 2048);
            asm volatile("" ::: "memory");
            sb_tile<false>(o0, o1, carry, fa, qf, 32, hh);
            if (kt < 3 || __all(carry < FLT_MIN_)) break;
            kt -= 2;
        }
    }
    store_o(OB + (size_t)(b * SEQ + t) * (2 * WA) + WA + head * HD + 4 * hh, o0, o1, 1.f);
}
DI void moba_group(unsigned char* lds, const bf16_t* QK, const bf16_t* KF, const bf16_t* VT, const float* KSUM, bf16_t* OA, int b, int head, int og, bool with_sb, unsigned* nextctr) {
    const int tid = threadIdx.x, wave = tid >> 6; int lane = tid & 63;
    asm volatile("" : "+v"(lane));
    const int r = lane & 31, hh = lane >> 5;
    bf16_t* OPART = (bf16_t*)(lds + ML_OPART); float* MLS = (float*)(lds + ML_ML); unsigned char* LISTS = lds + ML_LISTS; unsigned char* SELS = lds + ML_SELS;
    int* CNT = (int*)(lds + ML_CNT); int* UST = (int*)(lds + ML_UST);
    const float slopeL = 1.4426950408889634f * exp2f(-(float)(head + 1));
    const bf16_t* kp = KF + (size_t)((0 * 2 + b) * NH + head) * 256 * 2048 + lane * 8;
    const bf16_t* vp = VT + (size_t)((0 * 2 + b) * NH + head) * 256 * 2048 + lane * 8;
    const bf16_t* qbase = QK + (size_t)(b * SEQ) * 1024 + head * HD + 8 * hh;
    __syncthreads();
    unsigned nk = 0;
    if (tid == 0) nk = atomicAdd(nextctr, 1u);
    if (tid < 32) CNT[tid] = 0;
    __syncthreads();
    {
        const int c = 32 * wave + r;
        const bf16_t* qp = qbase + (size_t)(256 * og + c) * 1024;
        bf16x8 qf[4];
#pragma unroll
        for (int ks = 0; ks < 4; ++ks) qf[ks] = *(const bf16x8*)(qp + 16 * ks);
        f32x16 acc;
#pragma unroll
        for (int i = 0; i < 16; ++i) acc[i] = 0.f;
        const float* km = KSUM + ((size_t)(b * NH + head) * NBLK + r) * HD + 8 * hh;
#pragma unroll
        for (int ks = 0; ks < 4; ++ks) {
            const f32x4 s0 = *(const f32x4*)(km + 16 * ks) * (1.f / MBLK), s1 = *(const f32x4*)(km + 16 * ks + 4) * (1.f / MBLK);
            const float mv[8] = {s0.x, s0.y, s0.z, s0.w, s1.x, s1.y, s1.z, s1.w};
            unsigned hb[8], lb[8];
#pragma unroll
            for (int e = 0; e < 8; ++e) { hb[e] = f2bf(mv[e]); lb[e] = f2bf(mv[e] - bf2f(hb[e])); }
            const u32x4 hw = {hb[0] | (hb[1] << 16), hb[2] | (hb[3] << 16), hb[4] | (hb[5] << 16), hb[6] | (hb[7] << 16)};
            const u32x4 lw = {lb[0] | (lb[1] << 16), lb[2] | (lb[3] << 16), lb[4] | (lb[5] << 16), lb[6] | (lb[7] << 16)};
            acc = MFMA32(__builtin_bit_cast(bf16x8, hw), qf[ks], acc); acc = MFMA32(__builtin_bit_cast(bf16x8, lw), qf[ks], acc);
        }
        float v0 = -INFINITY, v1 = -INFINITY, v2 = -INFINITY; int i0 = -1, i1 = -1, i2 = -1;
#pragma unroll
        for (int i = 0; i < 16; ++i) { const int blk = (i & 3) + 8 * (i >> 2) + 4 * hh; const float sv = blk < og ? acc[i] : -INFINITY; top3_insert(sv, blk, v0, v1, v2, i0, i1, i2); }
        const float pv0 = __shfl_xor(v0, 32), pv1 = __shfl_xor(v1, 32), pv2 = __shfl_xor(v2, 32);
        const int pi0 = __shfl_xor(i0, 32), pi1 = __shfl_xor(i1, 32), pi2 = __shfl_xor(i2, 32);
        top3_insert(pv0, pi0, v0, v1, v2, i0, i1, i2); top3_insert(pv1, pi1, v0, v1, v2, i0, i1, i2); top3_insert(pv2, pi2, v0, v1, v2, i0, i1, i2);
        if (hh == 0) {
            SELS[c * 4 + 0] = (unsigned char)(i0 < 0 ? 255 : i0); SELS[c * 4 + 1] = (unsigned char)(i1 < 0 ? 255 : i1); SELS[c * 4 + 2] = (unsigned char)(i2 < 0 ? 255 : i2);
            if (i0 >= 0) { const int ps = atomicAdd(&CNT[i0], 1); LISTS[i0 * 256 + ps] = (unsigned char)c; }
            if (i1 >= 0) { const int ps = atomicAdd(&CNT[i1], 1); LISTS[i1 * 256 + ps] = (unsigned char)c; }
            if (i2 >= 0) { const int ps = atomicAdd(&CNT[i2], 1); LISTS[i2 * 256 + ps] = (unsigned char)c; }
        }
    }
    __syncthreads();
    if (wave == 0) {
        const int jx = lane & 31, n = (CNT[jx] + 31) >> 5;
        int inc = n;
#pragma unroll
        for (int o = 1; o < 32; o <<= 1) { const int v = __shfl_up(inc, o, 32); if (jx >= o) inc += v; }
        const int st0 = inc - n;
        if (lane < 32) {
            UST[jx] = st0;
            unsigned char* UJ = lds + ML_UJ;
            for (int q = 0; q < n; ++q) UJ[st0 + q] = (unsigned char)jx;
            if (jx == 31) UST[32] = inc;
        }
        if (lane == 0) { *(volatile int*)(lds + ML_QCTR) = 0; *(volatile int*)(lds + ML_ITEM) = (int)nk; }
    }
    __syncthreads();
    {
        const int Usel = UST[32], Utot = Usel + 8;
        int* qctr = (int*)(lds + ML_QCTR);
        int u = 0;
        if (lane == 0) u = atomicAdd(qctr, 1);
        u = __builtin_amdgcn_readfirstlane(u);
        const int sb_after = __builtin_amdgcn_readfirstlane(wave) >> 1;
        bool sb_done = !with_sb; int nun = 0;
        for (;;) {
            const bool have = u < Utot;
            if (!sb_done && (nun == sb_after || !have)) { sb_group(QK, KF, VT, OA, b, head, og); sb_done = true; }
            if (!have) break;
            ++nun;
            int un = 0;
            if (lane == 0) un = atomicAdd(qctr, 1);
            int j, slot, qi; bool valid;
            SmState st;
            if (u < Usel) {
                j = __builtin_amdgcn_readfirstlane((int)(lds + ML_UJ)[u]);
                const bf16_t* kt0 = kp + (size_t)(8 * j) * 2048; const bf16_t* vt0 = vp + (size_t)(8 * j) * 2048;
                KV fa, fb;
                load_kv_async(fa, kt0 + 7 * 2048, vt0 + 7 * 2048); load_kv_async(fb, kt0 + 6 * 2048, vt0 + 6 * 2048);
                const int i = u - UST[j], idx = 32 * i + r;
                valid = idx < CNT[j];
                qi = LISTS[j * 256 + (valid ? idx : 32 * i)];
                slot = (SELS[qi * 4] == j) ? 0 : ((SELS[qi * 4 + 1] == j) ? 1 : 2);
                const int t = 256 * og + qi;
                const bf16_t* qp = qbase + (size_t)t * 1024;
                bf16x8 qf[4];
#pragma unroll
                for (int ks = 0; ks < 4; ++ks) qf[ks] = *(const bf16x8*)(qp + 16 * ks);
                const float bb = slopeL * (float)(256 * j + 4 * hh - t), bs = slopeL * 32.f;
                moba_tile_first<12, 8>(st, fa, qf, bb + 7.f * bs, slopeL, 64, hh);   load_kv_async(fa, kt0 + 5 * 2048, vt0 + 5 * 2048);
                moba_tile_lazy<12, 8>(st, fb, qf, bb + 6.f * bs, slopeL, hh);        load_kv_async(fb, kt0 + 4 * 2048, vt0 + 4 * 2048);
                moba_tile_lazy<12, 8>(st, fa, qf, bb + 5.f * bs, slopeL, hh);        load_kv_async(fa, kt0 + 3 * 2048, vt0 + 3 * 2048);
                moba_tile_lazy<12, 8>(st, fb, qf, bb + 4.f * bs, slopeL, hh);        load_kv_async(fb, kt0 + 2 * 2048, vt0 + 2 * 2048);
                moba_tile_lazy<12, 8>(st, fa, qf, bb + 3.f * bs, slopeL, hh);        load_kv_async(fa, kt0 + 1 * 2048, vt0 + 1 * 2048);
                moba_tile_lazy<12, 8>(st, fb, qf, bb + 2.f * bs, slopeL, hh);        load_kv_async(fb, kt0, vt0);
                moba_tile_lazy<12, 8>(st, fa, qf, bb + bs, slopeL, hh);
                moba_tile_lazy<4, 0>(st, fb, qf, bb, slopeL, hh);
            } else {
                const int w = 7 - (u - Usel);
                j = og; qi = 32 * w + r; valid = true; slot = 3;
                const int t = 256 * og + qi;
                const bf16_t* qp = qbase + (size_t)t * 1024;
                bf16x8 qf[4];
#pragma unroll
                for (int ks = 0; ks < 4; ++ks) qf[ks] = *(const bf16x8*)(qp + 16 * ks);
                moba_pass_own(st, qf, kp + (size_t)(8 * og) * 2048, vp + (size_t)(8 * og) * 2048, w, r, slopeL * (float)(256 * og + 4 * hh - t), slopeL, hh);
            }
            const float lt = st.l + __shfl_xor(st.l, 32), inv = 1.f / lt;
            if (valid) {
                bf16_t* op = OPART + (size_t)(slot * 256 + qi) * 68 + 4 * hh;
#pragma unroll
                for (int g = 0; g < 4; ++g) {
                    u32x2 a; a.x = cvtpk(st.o0[4 * g] * inv, st.o0[4 * g + 1] * inv); a.y = cvtpk(st.o0[4 * g + 2] * inv, st.o0[4 * g + 3] * inv); *(u32x2*)(op + 8 * g) = a;
                    u32x2 c; c.x = cvtpk(st.o1[4 * g] * inv, st.o1[4 * g + 1] * inv); c.y = cvtpk(st.o1[4 * g + 2] * inv, st.o1[4 * g + 3] * inv); *(u32x2*)(op + 32 + 8 * g) = c;
                }
                if (hh == 0) { MLS[(slot * 256 + qi) * 2] = st.m; MLS[(slot * 256 + qi) * 2 + 1] = lt; }
            }
            u = __builtin_amdgcn_readfirstlane(un);
        }
    }
    __syncthreads();
    {
        const int c = 32 * wave + r, t = 256 * og + c;
        float M = -1e30f, ms[4], ls[4];
#pragma unroll
        for (int sl = 0; sl < 4; ++sl) {
            const bool v = sl == 3 || SELS[c * 4 + sl] != 255;
            ms[sl] = v ? MLS[(sl * 256 + c) * 2] : -1e30f; ls[sl] = v ? MLS[(sl * 256 + c) * 2 + 1] : 0.f;
            M = fmaxf(M, ms[sl]);
        }
        float L = 0.f; f32x16 o0, o1;
#pragma unroll
        for (int x = 0; x < 16; ++x) { o0[x] = 0.f; o1[x] = 0.f; }
#pragma unroll
        for (int sl = 0; sl < 4; ++sl) {
            const float w = ls[sl] * __builtin_amdgcn_exp2f(ms[sl] - M);
            L += w;
            const bf16_t* op = OPART + (size_t)(sl * 256 + c) * 68 + 4 * hh;
            if (ls[sl] > 0.f) {
#pragma unroll
                for (int g = 0; g < 4; ++g) {
                    const u32x2 a = *(const u32x2*)(op + 8 * g), cc = *(const u32x2*)(op + 32 + 8 * g);
                    o0[4 * g] += w * bflo(a.x); o0[4 * g + 1] += w * bfhi(a.x); o0[4 * g + 2] += w * bflo(a.y); o0[4 * g + 3] += w * bfhi(a.y);
                    o1[4 * g] += w * bflo(cc.x); o1[4 * g + 1] += w * bfhi(cc.x); o1[4 * g + 2] += w * bflo(cc.y); o1[4 * g + 3] += w * bfhi(cc.y);
                }
            }
        }
        store_o(OA + (size_t)(b * SEQ + t) * (2 * WA) + head * HD + 4 * hh, o0, o1, 1.f / L);
    }
}


#define CE(a, b) do { const unsigned lo_ = min(a, b), hi_ = max(a, b); a = lo_; b = hi_; } while (0)
DI void sort16_asc(unsigned (&k)[16]) {
    CE(k[0], k[1]); CE(k[2], k[3]); CE(k[0], k[2]); CE(k[1], k[3]); CE(k[1], k[2]); CE(k[4], k[5]); CE(k[6], k[7]); CE(k[4], k[6]); CE(k[5], k[7]); CE(k[5], k[6]);
    CE(k[0], k[4]); CE(k[2], k[6]); CE(k[2], k[4]); CE(k[1], k[5]); CE(k[3], k[7]); CE(k[3], k[5]); CE(k[1], k[2]); CE(k[3], k[4]); CE(k[5], k[6]); CE(k[8], k[9]);
    CE(k[10], k[11]); CE(k[8], k[10]); CE(k[9], k[11]); CE(k[9], k[10]); CE(k[12], k[13]); CE(k[14], k[15]); CE(k[12], k[14]); CE(k[13], k[15]); CE(k[13], k[14]);
    CE(k[8], k[12]); CE(k[10], k[14]); CE(k[10], k[12]); CE(k[9], k[13]); CE(k[11], k[15]); CE(k[11], k[13]); CE(k[9], k[10]); CE(k[11], k[12]); CE(k[13], k[14]);
    CE(k[0], k[8]); CE(k[4], k[12]); CE(k[4], k[8]); CE(k[2], k[10]); CE(k[6], k[14]); CE(k[6], k[10]); CE(k[2], k[4]); CE(k[6], k[8]); CE(k[10], k[12]);
    CE(k[1], k[9]); CE(k[5], k[13]); CE(k[5], k[9]); CE(k[3], k[11]); CE(k[7], k[15]); CE(k[7], k[11]); CE(k[3], k[5]); CE(k[7], k[9]); CE(k[11], k[13]);
    CE(k[1], k[2]); CE(k[3], k[4]); CE(k[5], k[6]); CE(k[7], k[8]); CE(k[9], k[10]); CE(k[11], k[12]); CE(k[13], k[14]);
}
DI void bitonic16_asc(unsigned (&k)[16]) {
    CE(k[0], k[8]); CE(k[1], k[9]); CE(k[2], k[10]); CE(k[3], k[11]); CE(k[4], k[12]); CE(k[5], k[13]); CE(k[6], k[14]); CE(k[7], k[15]); CE(k[0], k[4]);
    CE(k[1], k[5]); CE(k[2], k[6]); CE(k[3], k[7]); CE(k[8], k[12]); CE(k[9], k[13]); CE(k[10], k[14]); CE(k[11], k[15]); CE(k[0], k[2]); CE(k[1], k[3]);
    CE(k[4], k[6]); CE(k[5], k[7]); CE(k[8], k[10]); CE(k[9], k[11]); CE(k[12], k[14]); CE(k[13], k[15]); CE(k[0], k[1]); CE(k[2], k[3]); CE(k[4], k[5]);
    CE(k[6], k[7]); CE(k[8], k[9]); CE(k[10], k[11]); CE(k[12], k[13]); CE(k[14], k[15]);
}

DI unsigned fkey(float v, unsigned idx) { unsigned b = __float_as_uint(v); b = (b & 0x80000000u) ? ~b : (b | 0x80000000u); return (b & ~127u) | idx; }
DI float fkey_val(unsigned k) { unsigned b = k & ~127u; b = (b & 0x80000000u) ? (b & 0x7fffffffu) : ~b; return __uint_as_float(b); }
DI void top16_of_128(const f32x4 (&acc)[8], int g, unsigned (&t)[16]) {
    unsigned ka[16], kb[16];
#pragma unroll
    for (int ni = 0; ni < 4; ++ni)
#pragma unroll
        for (int j = 0; j < 4; ++j) { ka[4 * ni + j] = fkey(acc[ni][j], 16 * ni + 4 * g + j); kb[4 * ni + j] = fkey(acc[ni + 4][j], 16 * (ni + 4) + 4 * g + j); }
    sort16_asc(ka); sort16_asc(kb);
#pragma unroll
    for (int i = 0; i < 16; ++i) t[i] = max(ka[i], kb[15 - i]);
    bitonic16_asc(t);
#pragma unroll
    for (int xo = 16; xo <= 32; xo <<= 1) {
        unsigned pp[16];
#pragma unroll
        for (int i = 0; i < 16; ++i) pp[i] = (unsigned)__shfl_xor((int)t[i], xo);
#pragma unroll
        for (int i = 0; i < 16; ++i) t[i] = max(t[i], pp[15 - i]);
        bitonic16_asc(t);
    }
}

#define LAS __attribute__((address_space(3)))
#define XB_TMO      128
#define XB_XCNT(j)  (256  + 64 * (j))
#define XB_XSUB(j)  (1280 + 64 * (j))
#define XB_XGEN(j)  (2304 + 64 * (j))
#define XB_TOP      3328
#define XB_TOPGEN   3392
#define XCD_BAR_WORDS 3456
#define XB_SPIN_CAP (1u << 18)

__device__ __forceinline__ unsigned xb_ld(unsigned* p)              { return __hip_atomic_load(p, __ATOMIC_RELAXED, __HIP_MEMORY_SCOPE_AGENT); }
__device__ __forceinline__ unsigned xb_add(unsigned* p, unsigned v) { return __hip_atomic_fetch_add(p, v, __ATOMIC_RELAXED, __HIP_MEMORY_SCOPE_AGENT); }
__device__ __forceinline__ unsigned xb_xcc_id() { return (unsigned)__builtin_amdgcn_s_getreg((3 << 11) | 20) & 0xFu; }
#define XB_SPIN(cond, bar) do { unsigned _sp = 0; while (cond) { __builtin_amdgcn_s_sleep(1); \
    if ((++_sp & 255u) == 0u) { if (xb_ld(&(bar)[XB_TMO])) break; if (_sp > XB_SPIN_CAP) { atomicAdd(&(bar)[XB_TMO], 1u); break; } } } } while (0)

struct XcdBarrier {
    unsigned* bar; unsigned x;
    volatile LAS unsigned* st;
};

__device__ __forceinline__ XcdBarrier xcd_barrier_post(unsigned* bar, volatile LAS unsigned* st) {
    XcdBarrier b; b.bar = bar; b.x = xb_xcc_id(); b.st = st;
    if (threadIdx.x == 0) (void)xb_add(&bar[XB_XCNT(b.x)], 1u);
    return b;
}
__device__ __forceinline__ void xcd_barrier_complete(unsigned* bar, unsigned x, unsigned& nloc, unsigned& nx) {
    const unsigned G = gridDim.x * gridDim.y * gridDim.z;
    unsigned sum, cnt, mine, sp = 0u;
    for (;;) {
        sum = 0u; cnt = 0u; mine = 0u;
#pragma unroll
        for (unsigned j = 0; j < 16; ++j) { const unsigned c = xb_ld(&bar[XB_XCNT(j)]); sum += c; cnt += (c > 0u) ? 1u : 0u; mine = (j == x) ? c : mine; }
        if (sum == G) break;
        __builtin_amdgcn_s_sleep(1);
        if ((++sp & 255u) == 0u) { if (xb_ld(&bar[XB_TMO])) break; if (sp > XB_SPIN_CAP) { atomicAdd(&bar[XB_TMO], 1u); break; } }
    }
    nloc = mine > 0u ? mine : 1u; nx = cnt > 0u ? cnt : 1u;
}

__device__ __forceinline__ void xcd_barrier(const XcdBarrier& b) {
    asm volatile("s_waitcnt vmcnt(0)" ::: "memory");
    __syncthreads();
    if (threadIdx.x == 0) {
        unsigned* bar = b.bar;
        __builtin_amdgcn_s_waitcnt(0);
        unsigned nloc = b.st[0], nx = b.st[1];
        if (nloc == 0u) { xcd_barrier_complete(bar, b.x, nloc, nx); b.st[0] = nloc; b.st[1] = nx; }
        const unsigned old = xb_add(&bar[XB_XSUB(b.x)], 1u);
        const unsigned gen = old / nloc;
        if (old + 1u == (gen + 1u) * nloc) {
            __builtin_amdgcn_fence(__ATOMIC_RELEASE, "agent");
            asm volatile("s_waitcnt vmcnt(0)" ::: "memory");
            const unsigned og = xb_add(&bar[XB_TOP], 1u);
            const unsigned tg = og / nx;
            if (og + 1u == (tg + 1u) * nx) xb_add(&bar[XB_TOPGEN], 1u);
            else XB_SPIN(xb_ld(&bar[XB_TOPGEN]) == tg, bar);
            __builtin_amdgcn_fence(__ATOMIC_ACQUIRE, "agent");
            xb_add(&bar[XB_XGEN(b.x)], 1u);
            asm volatile("s_waitcnt vmcnt(0)" ::: "memory");
        } else {
            XB_SPIN(xb_ld(&bar[XB_XGEN(b.x)]) == gen, bar);
            __builtin_amdgcn_fence(__ATOMIC_ACQUIRE, "agent");
            asm volatile("s_waitcnt vmcnt(0)" ::: "memory");
        }
    }
    __syncthreads();
}


__global__ void __launch_bounds__(NTHREADS, 2) fwd_kernel(Params p) {
    extern __shared__ __attribute__((aligned(16))) unsigned char lds[];
    const int tid = threadIdx.x, lane = tid & 63, wave = tid >> 6;
    const int G = gridDim.x, bid = blockIdx.x;
    const long gtid = (long)bid * NTHREADS + tid, gth = (long)G * NTHREADS;
    const int gwave = bid * NWAVES + wave, ngw = G * NWAVES;
    unsigned char* ws = p.ws;
    bf16_t* WIN = (bf16_t*)(ws + WS_WIN); bf16_t* WOA = (bf16_t*)(ws + WS_WOA);
    bf16_t* WMIX = (bf16_t*)(ws + WS_WMIX); bf16_t* WQ = (bf16_t*)(ws + WS_WQ); bf16_t* SK = (bf16_t*)(ws + WS_SK);
    float* RS1 = (float*)(ws + WS_RS1); float* RS2 = (float*)(ws + WS_RS2);
    bf16_t* XB = (bf16_t*)(ws + WS_XB); bf16_t* OA = (bf16_t*)(ws + WS_OA);
    unsigned short* EIDX = (unsigned short*)(ws + WS_EIDX); float* GW = (float*)(ws + WS_GW);
    bf16_t* QK = (bf16_t*)(ws + WS_QK); bf16_t* KF = (bf16_t*)(ws + WS_KF); bf16_t* VT = (bf16_t*)(ws + WS_VT); bf16_t* MIXED = (bf16_t*)(ws + WS_MIXED); bf16_t* HB = (bf16_t*)(ws + WS_HB);
    bf16_t* GATES = (bf16_t*)(ws + WS_GATES); bf16_t* Q2 = (bf16_t*)(ws + WS_Q2);
    float* SU = (float*)(ws + WS_SU); float* SV = (float*)(ws + WS_SV); float* SSP = (float*)(ws + WS_SSP); float* SH = (float*)(ws + WS_SH);
    signed char* H8 = (signed char*)(ws + WS_H8); int* AP = (int*)(ws + WS_AP); unsigned char* U8 = ws + WS_U8; unsigned char* V8 = ws + WS_V8;
    unsigned* CTL = (unsigned*)(ws + WS_CTL); float* KSUM = (float*)(ws + WS_KSUM); float* SWMAX = (float*)(ws + WS_SWMAX); float* WSC = (float*)(ws + WS_WSC); signed char* WH = (signed char*)(ws + WS_WH); signed char* WL = (signed char*)(ws + WS_WL);
    volatile LAS unsigned* bst = (volatile LAS unsigned*)((LAS unsigned char*)lds + (LDS_BYTES - 16));
    if (tid < 4) bst[tid] = 0u;
    __syncthreads();
    const XcdBarrier xbar = xcd_barrier_post((unsigned*)(ws + WS_CTL) + 1024, bst);
    const int lo = p.ph_lo, hi = p.ph_hi;
#ifdef ONLY_PHASE
#define IN(k) ((k) == ONLY_PHASE && lo <= (k) && (k) < hi)
#else
#define IN(k) (lo <= (k) && (k) < hi)
#endif
#define SEAM(k) do { if (IN(k) && IN((k) + 1)) xcd_barrier(xbar); } while (0)

    for (int rep_ = 0; rep_ < (IN(0) ? 1 : 0); ++rep_) {
        for (int nb = bid; nb < INW / 32; nb += G) {
            float* scr = (float*)(lds + wave * (128 * 33 * 4));
            float* AMX = (float*)(lds + 8 * (128 * 33 * 4));
            const int n0 = 32 * nb, kw = 128 * wave;
            float am = 0.f;
            __syncthreads();
            {
#pragma unroll
                for (int hf = 0; hf < 2; ++hf) {
                    float wv[32], gv[32];
#pragma unroll
                    for (int i = 0; i < 32; ++i) { const int kk = 64 * hf + 2 * i + (lane >> 5); wv[i] = p.w_in[(size_t)(kw + kk) * INW + n0 + (lane & 31)]; gv[i] = p.g1[kw + kk]; }
#pragma unroll
                    for (int i = 0; i < 32; ++i) { const int kk = 64 * hf + 2 * i + (lane >> 5); const float v = wv[i] * gv[i]; scr[kk * 33 + (lane & 31)] = v; am = fmaxf(am, fabsf(v)); }
                }
            }
            am = fmaxf(am, __shfl_xor(am, 32));
            if (lane < 32) AMX[wave * 32 + lane] = am;
            __syncthreads();
            const int kc = lane & 15;
#pragma unroll
            for (int j = 0; j < 8; ++j) {
                const int n = (lane >> 4) + 4 * j;
                float cm = AMX[n];
#pragma unroll
                for (int w2 = 1; w2 < 8; ++w2) cm = fmaxf(cm, AMX[w2 * 32 + n]);
                const float isc = cm > 0.f ? 127.f / cm : 0.f;
                const float* sp = scr + (8 * kc) * 33 + n;
                unsigned lo, hi;
                lo = q8x4(sp[0], sp[33], sp[66], sp[99], isc); hi = q8x4(sp[4 * 33], sp[5 * 33], sp[6 * 33], sp[7 * 33], isc);
                *(u32x2*)((signed char*)WIN + (size_t)(n0 + n) * DM + kw + 8 * kc) = (u32x2){lo, hi};
                if (wave == 0 && kc == 0) SWMAX[n0 + n] = cm;
            }
        }
        __syncthreads();
        {
            float* scr = (float*)(lds + wave * 16384);
            constexpr int I_OA = (WA / 64) * (DM / 32), I_MIX = (DM / 64) * (DM / 32), I_Q = (DM / 64) * (PQW / 32);
            for (int it = gwave; it < 2 * I_OA + I_MIX + I_Q; it += ngw) {
                int r = it;
                if (r < I_OA) { transpose_item(p.w_oa, WA, DM, WOA, 2 * WA, 0, nullptr, scr, r, lane); continue; } r -= I_OA;
                if (r < I_OA) { transpose_item(p.w_ob, WA, DM, WOA, 2 * WA, WA, nullptr, scr, r, lane); continue; } r -= I_OA;
                if (r < I_MIX) { transpose_item(p.w_mix, DM, DM, WMIX, DM, 0, nullptr, scr, r, lane); continue; } r -= I_MIX;
                transpose_item(p.w_q, DM, PQW, WQ, DM, 0, p.g2, scr, r, lane);
            }
            for (long i = gtid; i < 16L * 128 * 128; i += gth) SK[i] = (bf16_t)f2bf(p.skeys[i]);
        }
        for (int row0 = gwave; row0 < T; row0 += 8 * ngw) {
            f32x4 xv[8][4];
#pragma unroll
            for (int k = 0; k < 8; ++k) {
                const int row = row0 + k * ngw;
                if (row < T) {
#pragma unroll
                    for (int j = 0; j < 4; ++j) xv[k][j] = ((const f32x4*)(p.x + (size_t)row * DM) + lane)[64 * j];
                }
            }
#pragma unroll
            for (int k = 0; k < 8; ++k) {
                const int row = row0 + k * ngw;
                if (row < T) {
                    float sq = 0.f, am = 0.f;
#pragma unroll
                    for (int j = 0; j < 4; ++j) { const f32x4 v = xv[k][j]; sq += v.x * v.x + v.y * v.y + v.z * v.z + v.w * v.w; am = fmaxf(fmaxf(am, fmaxf(fabsf(v.x), fabsf(v.y))), fmaxf(fabsf(v.z), fabsf(v.w))); }
                    sq = wave_sum(sq);
#pragma unroll
                    for (int o = 32; o >= 1; o >>= 1) am = fmaxf(am, __shfl_xor(am, o));
                    const float sc = am > 0.f ? am * (1.f / 127.f) : 1.f, isc = 1.f / sc;
                    unsigned* ob = (unsigned*)(XB + (size_t)row * (DM / 2)) + lane;
#pragma unroll
                    for (int j = 0; j < 4; ++j) { const f32x4 v = xv[k][j]; ob[64 * j] = q8x4(v.x, v.y, v.z, v.w, isc); }
                    if (lane == 0) RS1[row] = sc * rsqrtf(sq * (1.f / DM) + RMS_EPS);
                }
            }
        }
    }
    SEAM(0);

    for (int rep_ = 0; rep_ < (IN(1) ? (PROBE_REP == 1 ? 2 : 1) : 0); ++rep_) {
        pg8::Gemm gm{XB, WIN, T, INW, DM / 2}; pg8::StaticOrder S; S.init(T, INW, G, bid);
        EpiInProj E{QK, KF, VT, GATES, RS1, SWMAX, KSUM, rep_ == 0};
        pg8::gemm_phase<EpiInProj, pg8::StaticOrder, true, true>((PG8_LAS unsigned char*)lds, gm, S, E);
    }
    SEAM(1);

    for (int rep_ = 0; rep_ < (IN(3) ? (PROBE_REP == 3 ? 2 : 1) : 0); ++rep_) {
        {
            volatile int* ibox = (volatile int*)(lds + ML_ITEM);
            const unsigned xcc = (unsigned)__builtin_amdgcn_s_getreg((3 << 11) | 20) & 7u;
            unsigned* Q3 = CTL + 64 + (rep_ ? 8 : 0);
            int qx = (int)xcc;
            __syncthreads();
            if (tid == 0) ibox[0] = (int)atomicAdd(&Q3[qx], 1u);
            __syncthreads();
            for (;;) {
                int k = __builtin_amdgcn_readfirstlane(ibox[0]);
                if (k >= 64) {
                    __syncthreads();
                    if (wave == 0) {
                        unsigned v = 64u;
                        if (lane < 8) v = __hip_atomic_load(&Q3[(xcc + (unsigned)lane) & 7u], __ATOMIC_RELAXED, __HIP_MEMORY_SCOPE_AGENT);
                        const unsigned long long m = __ballot(v < 64u);
                        int nq = -1; unsigned nk = 64u;
                        if (m != 0ull) { nq = (int)((xcc + (unsigned)__builtin_ctzll(m)) & 7u); if (lane == 0) nk = atomicAdd(&Q3[nq], 1u); }
                        if (lane == 0) { ibox[0] = (int)nk; ibox[1] = nq; }
                    }
                    __syncthreads();
                    const int nq = __builtin_amdgcn_readfirstlane(ibox[1]);
                    if (nq < 0) break;
                    qx = nq;
                    continue;
                }
                const int oi = k >> 1;
                const int og = p3_order(oi), bh = 2 * qx + (k & 1);
                moba_group(lds, QK, KF, VT, KSUM, OA, bh >> 3, bh & 7, og, true, &Q3[qx]);
            }
        }
    }
    SEAM(3);

    for (int rep_ = 0; rep_ < (IN(4) ? 1 : 0); ++rep_) {
        pg8::Gemm gm{OA, WOA, T, DM, 2 * WA}; pg8::StaticOrder S; S.init(T, DM, G, bid);
        EpiMix E{GATES, MIXED};
        pg8::gemm_phase<EpiMix, pg8::StaticOrder, true, true, true>((PG8_LAS unsigned char*)lds, gm, S, E);
    }
    SEAM(4);

    for (int rep_ = 0; rep_ < (IN(5) ? (PROBE_REP == 5 ? 2 : 1) : 0); ++rep_) {
        pg8::Gemm gm{MIXED, WMIX, T, DM, DM}; pg8::StaticOrder S; S.init(T, DM, G, bid);
        EpiResid E{p.x, HB};
        pg8::gemm_phase<EpiResid, pg8::StaticOrder, true, true>((PG8_LAS unsigned char*)lds, gm, S, E);
    }
    SEAM(5);

    for (int rep_ = 0; rep_ < (IN(7) ? 1 : 0); ++rep_) {
        pg8::Gemm gm{HB, WQ, T, PQW, DM}; pg8::StaticOrder S; S.init(T, PQW, G, bid);
        EpiPeerQ E{Q2};
        pg8::gemm_phase<EpiPeerQ, pg8::StaticOrder, true, true>((PG8_LAS unsigned char*)lds, gm, S, E);
    }
    SEAM(7);

    for (int rep_ = 0; rep_ < (IN(8) ? (PROBE_REP == 8 ? 2 : 1) : 0); ++rep_) {
        bf16_t* Qs = (bf16_t*)lds;
        bf16_t* Ks = Qs + 128 * 264;
        unsigned* LST = (unsigned*)(lds + 128 * 264 * 2 + 2 * 128 * 136 * 2);
        int h_loaded = -1;
        __syncthreads();
        if (bid < (T / 128) * 8) {
            const int h0 = bid & 7, t00 = (bid >> 3) * 128;
#pragma unroll
            for (int i = 0; i < 8; ++i) { const int c = tid + i * NTHREADS, r = c >> 5, ch = c & 31; *(u32x4*)(Qs + r * 264 + ch * 8) = *(const u32x4*)(Q2 + (size_t)(t00 + r) * PQW + h0 * 256 + ch * 8); }
        }
        for (int it = bid; it < (T / 128) * 8; it += G) {
            const int h = it & 7, t0 = (it >> 3) * 128;
            if (h != h_loaded) {
#pragma unroll
                for (int i = 0; i < 8; ++i) {
                    const int c = tid + i * NTHREADS, r = c >> 4, ch = c & 15;
                    *(u32x4*)(Ks + r * 136 + ch * 8) = *(const u32x4*)(SK + (size_t)(2 * h * 128 + r) * 128 + ch * 8);
                }
                h_loaded = h;
            }
            __syncthreads();
#pragma unroll 1
            for (int ph = 0; ph < 2; ++ph) {
                f32x4 acc[8];
#pragma unroll
                for (int ni = 0; ni < 8; ++ni) acc[ni] = (f32x4){0.f, 0.f, 0.f, 0.f};
#pragma unroll
                for (int ks = 0; ks < 4; ++ks) {
                    const bf16x8 qf = *(const bf16x8*)(Qs + (wave * 16 + (lane & 15)) * 264 + ph * 128 + ks * 32 + (lane >> 4) * 8);
#pragma unroll
                    for (int ni = 0; ni < 8; ++ni) {
                        const bf16x8 kf = *(const bf16x8*)(Ks + (ph * 128 + ni * 16 + (lane & 15)) * 136 + ks * 32 + (lane >> 4) * 8);
                        acc[ni] = __builtin_amdgcn_mfma_f32_16x16x32_bf16(kf, qf, acc[ni], 0, 0, 0);
                    }
                }
                unsigned tk[16];
                top16_of_128(acc, lane >> 4, tk);
                if (lane < 16) {
                    unsigned* dst = LST + ((wave * 16 + lane) * 2 + ph) * 16;
#pragma unroll
                    for (int i = 0; i < 4; ++i) { u32x4 w; w.x = tk[15 - 4 * i]; w.y = tk[14 - 4 * i]; w.z = tk[13 - 4 * i]; w.w = tk[12 - 4 * i]; *(u32x4*)(dst + 4 * i) = w; }
                }
            }
            __syncthreads();
            if (tid >= 128 && it + G < (T / 128) * 8) {
                const int itn = it + G, hn = itn & 7, tn0 = (itn >> 3) * 128;
                for (int c = tid - 128; c < 128 * 32; c += NTHREADS - 128) { const int r = c >> 5, ch = c & 31; *(u32x4*)(Qs + r * 264 + ch * 8) = *(const u32x4*)(Q2 + (size_t)(tn0 + r) * PQW + hn * 256 + ch * 8); }
            }
            if (wave >= 6) quant_rows<8>(p.pu, p.pv, p.g2, U8, V8, SU, SV, it * 32 + 16 + (wave - 6) * 8, 1, lane);
            else if (wave >= 2) quant_rows<4>(p.pu, p.pv, p.g2, U8, V8, SU, SV, it * 32 + (wave - 2) * 4, 1, lane);
            if (tid >= 128 && tid < 384) h_rows4(HB, RS2, SH, H8, it * 16 + (wave - 2) * 4, 1, lane);
            if (tid < 128) {
                const unsigned* La = LST + (tid * 2) * 16; const unsigned* Lb = La + 16;
                float cand[16];
                const float b0 = fkey_val(Lb[0]);
#pragma unroll
                for (int i = 0; i < 4; ++i) { const u32x4 w = *(const u32x4*)(La + 4 * i); cand[4 * i] = fkey_val(w.x) + b0; cand[4 * i + 1] = fkey_val(w.y) + b0; cand[4 * i + 2] = fkey_val(w.z) + b0; cand[4 * i + 3] = fkey_val(w.w) + b0; }
                unsigned long long ptrs = 0ull;
                float selv[16]; unsigned sele[16];
#pragma unroll
                for (int r = 0; r < 16; ++r) {
                    float best = cand[0];
#pragma unroll
                    for (int i = 1; i < 16; ++i) best = fmaxf(best, cand[i]);
                    int istar = 15;
#pragma unroll
                    for (int i = 14; i >= 0; --i) istar = (cand[i] == best) ? i : istar;
                    const int j = (int)((ptrs >> (4 * istar)) & 15ull);
                    const unsigned ka = La[istar], kb = Lb[j];
                    selv[r] = best; sele[r] = (ka & 127u) * PNK + (kb & 127u);
                    const bool more = j < 15;
                    const float nc = more ? fkey_val(ka) + fkey_val(Lb[more ? j + 1 : j]) : -INFINITY;
                    if (more) ptrs += 1ull << (4 * istar);
#pragma unroll
                    for (int i = 0; i < 16; ++i) cand[i] = (i == istar) ? nc : cand[i];
                }
                float* go = GW + (size_t)(t0 + tid) * 128 + h * 16;
#pragma unroll
                for (int r = 0; r < 8; ++r) *(unsigned*)(EIDX + (size_t)(t0 + tid) * 128 + r * 16 + 2 * h) = sele[r] | (sele[r + 8] << 16);
#pragma unroll
                for (int i = 0; i < 4; ++i) *(f32x4*)(go + 4 * i) = (f32x4){selv[4 * i], selv[4 * i + 1], selv[4 * i + 2], selv[4 * i + 3]};
            }
        }
    }
    SEAM(8);

#define PEER_ID(ia, ib, i) ((((i) < 8 ? (ia) : (ib))[((i) & 7) >> 1] >> (((i) & 1) * 16)) & 0xffffu)
#define PEER_ROWS4(dst, base, ia, ib, m) do { _Pragma("unroll") for (int q_ = 0; q_ < 4; ++q_) dst[4 * (m) + q_] = *(const u32x4*)((base) + (unsigned)(PEER_ID(ia, ib, 4 * (m) + q_) * 128u + jp16)); } while (0)
#define PEER_IDS(ia, ib, t) do { const unsigned short* ep_ = EIDX + (size_t)(t) * 128; ia = *(const u32x4*)(ep_ + (unsigned)(g * 16)); ib = *(const u32x4*)(ep_ + (unsigned)(g * 16 + 8)); } while (0)
    for (int rep_ = 0; rep_ < (IN(9) ? (PROBE_REP == 9 ? 2 : 1) : 0); ++rep_) {
        volatile int* ubox = (volatile int*)lds;
        const unsigned xcc = (unsigned)__builtin_amdgcn_s_getreg((3 << 11) | 20) & 7u;
        int ln = lane; asm volatile("" : "+v"(ln));
        const int g = ln >> 3, jp = ln & 7;
        const bool b2 = (ln & 4) != 0, b1 = (ln & 2) != 0, b0 = (ln & 1) != 0;
        const int wv = __builtin_amdgcn_readfirstlane(wave); const unsigned jp16 = (unsigned)jp * 16u;
        constexpr int NTW = 32;
        for (int k8 = 0; k8 < 8; ++k8) {
            const int sl = (int)((xcc + k8) & 7u);
            const unsigned char* U8s = U8 + (size_t)sl * NEXP * 128;
            for (;;) {
                __syncthreads();
                if (tid == 0) ubox[0] = (int)atomicAdd(&CTL[(rep_ ? 32 : 0) + sl], 1u);
                __syncthreads();
                const int u = __builtin_amdgcn_readfirstlane(ubox[0]);
                if (u >= T / (8 * NTW)) break;
                const int tb = u * (8 * NTW) + wv;
#define P1_HQ(hq, t) hq = *(const u32x4*)(H8 + (size_t)(t) * DM + sl * 128 + jp16)
#define P1_DOT4(d, rw, hq, m) do { _Pragma("unroll") for (int q_ = 0; q_ < 4; ++q_) { int x_ = __builtin_amdgcn_sdot4((int)hq.x, (int)rw[4 * (m) + q_].x, 0, false); x_ = __builtin_amdgcn_sdot4((int)hq.y, (int)rw[4 * (m) + q_].y, x_, false); \
        x_ = __builtin_amdgcn_sdot4((int)hq.z, (int)rw[4 * (m) + q_].z, x_, false); d[4 * (m) + q_] = __builtin_amdgcn_sdot4((int)hq.w, (int)rw[4 * (m) + q_].w, x_, false); } } while (0)
#define P1_FINISH(d_, t) do { int v8_[8], v4_[4]; \
    _Pragma("unroll") for (int i_ = 0; i_ < 8; ++i_) v8_[i_] = (b2 ? d_[8 + i_] : d_[i_]) + __shfl_xor(b2 ? d_[i_] : d_[8 + i_], 4); \
    _Pragma("unroll") for (int i_ = 0; i_ < 4; ++i_) v4_[i_] = (b1 ? v8_[4 + i_] : v8_[i_]) + __shfl_xor(b1 ? v8_[i_] : v8_[4 + i_], 2); \
    const int k0_ = (b0 ? v4_[2] : v4_[0]) + __shfl_xor(b0 ? v4_[0] : v4_[2], 1), k1_ = (b0 ? v4_[3] : v4_[1]) + __shfl_xor(b0 ? v4_[1] : v4_[3], 1); \
    int* ap_ = AP + ((size_t)sl * T + (t)) * 128 + 16 * jp + g; ap_[0] = k0_; ap_[8] = k1_; } while (0)
#define P1_STEP(rw, hq, ea, eb, i, REISSUE) do { int d_[16]; \
    _Pragma("unroll") for (int m_ = 0; m_ < 4; ++m_) { P1_DOT4(d_, rw, hq, m_); __builtin_amdgcn_sched_barrier(0); if (REISSUE) { PEER_ROWS4(rw, U8s, ea, eb, m_); __builtin_amdgcn_sched_barrier(0); } } \
    P1_FINISH(d_, tb + 8 * (i)); } while (0)
                u32x4 e0a, e0b, e1a, e1b, h0, h1, rwA[16], rwB[16];
                PEER_IDS(e0a, e0b, tb); PEER_IDS(e1a, e1b, tb + 8); P1_HQ(h0, tb);
#pragma unroll
                for (int m_ = 0; m_ < 4; ++m_) PEER_ROWS4(rwA, U8s, e0a, e0b, m_);
#pragma unroll
                for (int m_ = 0; m_ < 4; ++m_) PEER_ROWS4(rwB, U8s, e1a, e1b, m_);
                PEER_IDS(e0a, e0b, tb + 16);
#pragma unroll 1
                for (int i = 0; i < NTW - 2; i += 2) {
                    PEER_IDS(e1a, e1b, tb + 8 * (i + 3));
                    P1_HQ(h1, tb + 8 * (i + 1));
                    P1_STEP(rwA, h0, e0a, e0b, i, true);
                    { const int tn = tb + 8 * (i + 4 < NTW ? i + 4 : NTW - 1); PEER_IDS(e0a, e0b, tn); }
                    P1_HQ(h0, tb + 8 * (i + 2));
                    P1_STEP(rwB, h1, e1a, e1b, i + 1, true);
                }
                P1_HQ(h1, tb + 8 * (NTW - 1));
                P1_STEP(rwA, h0, e0a, e0b, NTW - 2, false);
                P1_STEP(rwB, h1, e1a, e1b, NTW - 1, false);
            }
        }
    }
    SEAM(9);

    for (int rep_ = 0; rep_ < (IN(10) ? (PROBE_REP == 10 ? 2 : 1) : 0); ++rep_) {
        for (int t = gwave; t < T; t += ngw) {
            int s0 = 0, s1 = 0;
#pragma unroll
            for (int q = 0; q < 8; ++q) { const int* ap = AP + ((size_t)q * T + t) * 128; s0 += ap[lane]; s1 += ap[64 + lane]; }
            const int p0 = (lane & 7) * 16 + (lane >> 3), p1 = p0 + 8;
            const int e0 = EIDX[(size_t)t * 128 + p0], e1 = EIDX[(size_t)t * 128 + p1];
            const float sc = SH[t] * RS2[t];
            const float a0 = (float)s0 * (sc * SU[e0]), a1 = (float)s1 * (sc * SU[e1]);
            const float rs2t = RS2[t];
            const float c0 = GW[(size_t)t * 128 + lane] * rs2t, c1 = GW[(size_t)t * 128 + 64 + lane] * rs2t;
            float m0 = c0, m1 = c1;
#pragma unroll
            for (int o = 8; o >= 1; o >>= 1) { m0 = fmaxf(m0, __shfl_xor(m0, o)); m1 = fmaxf(m1, __shfl_xor(m1, o)); }
            const float x0e = __expf(c0 - m0), x1e = __expf(c1 - m1);
            float z0 = x0e, z1 = x1e;
#pragma unroll
            for (int o = 8; o >= 1; o >>= 1) { z0 += __shfl_xor(z0, o); z1 += __shfl_xor(z1, o); }
            const float w0 = (x0e * __builtin_amdgcn_rcpf(z0)) * (0.5f * a0 * (1.f + erff(a0 * 0.70710678118654752f))) * SV[e0];
            const float w1 = (x1e * __builtin_amdgcn_rcpf(z1)) * (0.5f * a1 * (1.f + erff(a1 * 0.70710678118654752f))) * SV[e1];
            float wm = fmaxf(fabsf(w0), fabsf(w1));
#pragma unroll
            for (int o = 32; o >= 1; o >>= 1) wm = fmaxf(wm, __shfl_xor(wm, o));
            const float wsc = wm > 0.f ? wm * (1.f / 127.f) : 1.f, iw = 1.f / wsc;
            const float x0 = w0 * iw, x1 = w1 * iw;
            int h0 = (int)rintf(x0), h1 = (int)rintf(x1);
            h0 = h0 < -127 ? -127 : (h0 > 127 ? 127 : h0); h1 = h1 < -127 ? -127 : (h1 > 127 ? 127 : h1);
            WH[(size_t)t * 128 + p0] = (signed char)h0; WH[(size_t)t * 128 + p1] = (signed char)h1;
            if (lane == 0) WSC[t] = wsc;
        }
    }
    SEAM(10);

    for (int rep_ = 0; rep_ < (IN(11) ? (PROBE_REP == 11 ? 2 : 1) : 0); ++rep_) {
        const bool dry_ = (PROBE_REP == 11) && rep_ == 0;
        volatile int* ubox = (volatile int*)lds;
        const unsigned xcc = (unsigned)__builtin_amdgcn_s_getreg((3 << 11) | 20) & 7u;
        int ln = lane; asm volatile("" : "+v"(ln));
        const int g = ln >> 3, jp = ln & 7;
        const bool b5 = (ln & 32) != 0, b4 = (ln & 16) != 0, b3 = (ln & 8) != 0;
        const int wv = __builtin_amdgcn_readfirstlane(wave); const unsigned jp16 = (unsigned)jp * 16u;
        constexpr int NTW = 32;
        for (int k8 = 0; k8 < 8; ++k8) {
            const int sl = (int)((xcc + k8) & 7u);
            const unsigned char* V8s = V8 + (size_t)sl * NEXP * 128;
            for (;;) {
                __syncthreads();
                if (tid == 0) ubox[0] = (int)atomicAdd(&CTL[(dry_ ? 48 : 16) + sl], 1u);
                __syncthreads();
                const int u = __builtin_amdgcn_readfirstlane(ubox[0]);
                if (u >= T / (8 * NTW)) break;
                const int tb = u * (8 * NTW) + wv;
#define P2_WM(wh, hv, wsc, t) do { wh = *(const u32x4*)(WH + (size_t)(t) * 128 + (unsigned)(g * 16)); { const unsigned hw_ = *(const unsigned*)(HB + (size_t)(t) * DM + sl * 128 + (unsigned)(jp * 16 + 2 * g)); hv = (f32x2_t){bflo(hw_), bfhi(hw_)}; } wsc = WSC[t]; } while (0)
#define P2_COL(rw, wh, ah, c, cb, m) do { const unsigned t0_ = __builtin_amdgcn_perm(rw[4 * (m) + 1].c, rw[4 * (m)].c, 0x05010400u), t1_ = __builtin_amdgcn_perm(rw[4 * (m) + 3].c, rw[4 * (m) + 2].c, 0x05010400u); \
    const unsigned t2_ = __builtin_amdgcn_perm(rw[4 * (m) + 1].c, rw[4 * (m)].c, 0x07030602u), t3_ = __builtin_amdgcn_perm(rw[4 * (m) + 3].c, rw[4 * (m) + 2].c, 0x07030602u); \
    ah[(cb) + 0] = __builtin_amdgcn_sdot4((int)__builtin_amdgcn_perm(t1_, t0_, 0x05040100u), (int)wh[m], ah[(cb) + 0], false); ah[(cb) + 1] = __builtin_amdgcn_sdot4((int)__builtin_amdgcn_perm(t1_, t0_, 0x07060302u), (int)wh[m], ah[(cb) + 1], false); \
    ah[(cb) + 2] = __builtin_amdgcn_sdot4((int)__builtin_amdgcn_perm(t3_, t2_, 0x05040100u), (int)wh[m], ah[(cb) + 2], false); ah[(cb) + 3] = __builtin_amdgcn_sdot4((int)__builtin_amdgcn_perm(t3_, t2_, 0x07060302u), (int)wh[m], ah[(cb) + 3], false); } while (0)
#define P2_FINISH(d_, hv, wsc, t) do { int v8_[8], v4_[4]; \
    _Pragma("unroll") for (int i_ = 0; i_ < 8; ++i_) v8_[i_] = (b5 ? d_[8 + i_] : d_[i_]) + __shfl_xor(b5 ? d_[i_] : d_[8 + i_], 32); \
    _Pragma("unroll") for (int i_ = 0; i_ < 4; ++i_) v4_[i_] = (b4 ? v8_[4 + i_] : v8_[i_]) + __shfl_xor(b4 ? v8_[i_] : v8_[4 + i_], 16); \
    const int k0_ = (b3 ? v4_[2] : v4_[0]) + __shfl_xor(b3 ? v4_[0] : v4_[2], 8), k1_ = (b3 ? v4_[3] : v4_[1]) + __shfl_xor(b3 ? v4_[1] : v4_[3], 8); \
    bf16_t* orow_ = MIXED + (size_t)(t) * DM + sl * 128 + jp * 16 + 2 * g;     \
    const unsigned ob_ = cvtpk((hv).x + (float)k0_ * (wsc), (hv).y + (float)k1_ * (wsc)); const float o0_ = bflo(ob_), o1_ = bfhi(ob_); \
    if (!dry_) *(unsigned*)orow_ = ob_; \
    const float ss_ = wave_sum(o0_ * o0_ + o1_ * o1_); if (ln == 0 && !dry_) SSP[(size_t)(t) * 8 + sl] = ss_; asm volatile("" :: "v"(ss_)); } while (0)
#define P2_STEP(rw, wh, hv, wsc, ea, eb, i, REISSUE) do { int d_[16]; _Pragma("unroll") for (int i_ = 0; i_ < 16; ++i_) d_[i_] = 0; \
    _Pragma("unroll") for (int m_ = 0; m_ < 4; ++m_) { P2_COL(rw, wh, d_, x, 0, m_); P2_COL(rw, wh, d_, y, 4, m_); P2_COL(rw, wh, d_, z, 8, m_); P2_COL(rw, wh, d_, w, 12, m_); __builtin_amdgcn_sched_barrier(0); \
        if (REISSUE) { PEER_ROWS4(rw, V8s, ea, eb, m_); __builtin_amdgcn_sched_barrier(0); } } \
    P2_FINISH(d_, hv, wsc, tb + 8 * (i)); } while (0)
                u32x4 e0a, e0b, e1a, e1b, w0, w1, rwA[16], rwB[16]; f32x2_t hv0, hv1; float ws0, ws1;
                PEER_IDS(e0a, e0b, tb); PEER_IDS(e1a, e1b, tb + 8); P2_WM(w0, hv0, ws0, tb);
#pragma unroll
                for (int m_ = 0; m_ < 4; ++m_) PEER_ROWS4(rwA, V8s, e0a, e0b, m_);
#pragma unroll
                for (int m_ = 0; m_ < 4; ++m_) PEER_ROWS4(rwB, V8s, e1a, e1b, m_);
                PEER_IDS(e0a, e0b, tb + 16);
#pragma unroll 1
                for (int i = 0; i < NTW - 2; i += 2) {
                    PEER_IDS(e1a, e1b, tb + 8 * (i + 3));
                    P2_WM(w1, hv1, ws1, tb + 8 * (i + 1));
                    P2_STEP(rwA, w0, hv0, ws0, e0a, e0b, i, true);
                    { const int tn = tb + 8 * (i + 4 < NTW ? i + 4 : NTW - 1); PEER_IDS(e0a, e0b, tn); }
                    P2_WM(w0, hv0, ws0, tb + 8 * (i + 2));
                    P2_STEP(rwB, w1, hv1, ws1, e1a, e1b, i + 1, true);
                }
                P2_WM(w1, hv1, ws1, tb + 8 * (NTW - 1));
                P2_STEP(rwA, w0, hv0, ws0, e0a, e0b, NTW - 2, false);
                P2_STEP(rwB, w1, hv1, ws1, e1a, e1b, NTW - 1, false);
            }
        }
    }
    SEAM(11);

    for (int rep_ = 0; rep_ < (IN(12) ? 1 : 0); ++rep_) {
        for (int row = gwave; row < T; row += ngw) {
            float tot = 0.f;
#pragma unroll
            for (int q = 0; q < 8; ++q) tot += SSP[(size_t)row * 8 + q];
            const float rs = rsqrtf(tot * (1.f / DM) + RMS_EPS);
            f32x4* orow = (f32x4*)(p.out + (size_t)row * DM) + lane; const u32x2* ob = (const u32x2*)(MIXED + (size_t)row * DM) + lane;
#pragma unroll
            for (int j = 0; j < 4; ++j) { const f32x4 gv = ((const f32x4*)p.gf)[lane + 64 * j]; const u32x2 w = ob[64 * j]; orow[64 * j] = (f32x4){bflo(w.x), bfhi(w.x), bflo(w.y), bfhi(w.y)} * rs * gv; }
        }
    }
#undef IN
#undef SEAM
}

extern "C" void kernel_launch(void* const* d_in, const int* in_sizes, int n_in, void* d_out, int out_size, void* d_ws, size_t ws_size, hipStream_t stream) {
    static int grid = 0;
    if (grid == 0) {
        int dev = 0, cus = 0, per_cu = 0;
        (void)hipGetDevice(&dev);
        (void)hipDeviceGetAttribute(&cus, hipDeviceAttributeMultiprocessorCount, dev);
        (void)hipFuncSetAttribute((const void*)fwd_kernel, hipFuncAttributeMaxDynamicSharedMemorySize, LDS_BYTES);
        (void)hipOccupancyMaxActiveBlocksPerMultiprocessor(&per_cu, (const void*)fwd_kernel, NTHREADS, LDS_BYTES);
        if (per_cu < 1) { fprintf(stderr, "kernel_launch: occupancy query says %d blocks per CU\n", per_cu); per_cu = 1; }
        grid = cus * 1;
        if (ws_size < WS_END) { fprintf(stderr, "kernel_launch: workspace too small: %zu < %zu\n", ws_size, (size_t)WS_END); grid = -1; }
    }
    if (grid < 0) return;
    Params p{};
    p.x = (const float*)d_in[0]; p.g1 = (const float*)d_in[1]; p.w_in = (const float*)d_in[2]; p.w_oa = (const float*)d_in[3]; p.w_ob = (const float*)d_in[4];
    p.w_mix = (const float*)d_in[5]; p.g2 = (const float*)d_in[6]; p.w_q = (const float*)d_in[7]; p.skeys = (const float*)d_in[8]; p.pu = (const float*)d_in[9];
    p.pv = (const float*)d_in[10]; p.gf = (const float*)d_in[11]; p.out = (float*)d_out; p.ws = (unsigned char*)d_ws;
    p.ph_lo = 0; p.ph_hi = 13;
    if (hipMemsetAsync((char*)d_ws + WS_CTL, 0, 65536 + 131072 + 32768, stream) != hipSuccess) { fprintf(stderr, "kernel_launch: hipMemsetAsync failed\n"); return; }
    hipLaunchKernelGGL(fwd_kernel, dim3(grid), dim3(NTHREADS), LDS_BYTES, stream, p);
}
```

```cpp
#include <hip/hip_runtime.h>
#include <cstdio>
#include <cstdint>

#define DI __device__ __forceinline__
typedef unsigned short bf16_t;
typedef short bf16x8 __attribute__((ext_vector_type(8)));
typedef float f32x4 __attribute__((ext_vector_type(4)));
typedef unsigned u32x4 __attribute__((ext_vector_type(4)));
typedef unsigned u32x2 __attribute__((ext_vector_type(2)));

constexpr int NBATCH = 2, SEQ = 8192, T = NBATCH * SEQ, DM = 1024;
constexpr int NH = 8, HD = 64, WA = 512;
constexpr int INW = 5120, QKVW = 3072, GATEW = 2048;
constexpr int MBLK = 256, NBLK = SEQ / MBLK;
constexpr int PNK = 128, PTOPK = 16, NEXP = 16384, PQW = 2048;
constexpr float RMS_EPS = 1e-6f;
constexpr int NTHREADS = 512, NWAVES = 8;
static_assert((T / 128) * 8 * 32 == 2 * NEXP && (T / 128) * 8 * 16 == T, "P8 side work: 32 expert rows and 16 h rows per item cover all rows");
constexpr int LDS_BYTES = 163840;
#ifndef PROBE_REP
#define PROBE_REP -1
#endif

constexpr size_t MiB = 1u << 20;
constexpr size_t WS_CTL = 0;
constexpr size_t WS_KSUM = 65536;
constexpr size_t WS_SWMAX = 196608;
constexpr size_t WS_WIN = 1 * MiB;
constexpr size_t WS_WOA = 11 * MiB;
constexpr size_t WS_WMIX = 13 * MiB;
constexpr size_t WS_WQ = 15 * MiB;
constexpr size_t WS_SK = 19 * MiB;
constexpr size_t WS_RS1 = 19 * MiB + 512 * 1024;
constexpr size_t WS_RS2 = WS_RS1 + 65536;
constexpr size_t WS_XB = 24 * MiB;
constexpr size_t WS_OA = 24 * MiB;
constexpr size_t WS_EIDX = 24 * MiB;
constexpr size_t WS_GW = 28 * MiB;
constexpr size_t WS_QK = 56 * MiB;
constexpr size_t WS_KF = 88 * MiB;
constexpr size_t WS_VT = 120 * MiB;
constexpr size_t WS_MIXED = 56 * MiB;
constexpr size_t WS_HB = 88 * MiB;
constexpr size_t WS_GATES = 152 * MiB;
constexpr size_t WS_Q2 = 152 * MiB;
constexpr size_t WS_SU = 20 * MiB;
constexpr size_t WS_SV = WS_SU + 65536;
constexpr size_t WS_SSP = 36 * MiB;
constexpr size_t WS_SH = WS_SSP + 524288;
constexpr size_t WS_WSC = WS_SH + 65536;
constexpr size_t WS_WH = 37 * MiB;
constexpr size_t WS_WL = 39 * MiB;
constexpr size_t WS_H8 = 40 * MiB;
constexpr size_t WS_AP = 152 * MiB;
constexpr size_t WS_U8 = 216 * MiB;
constexpr size_t WS_V8 = 232 * MiB;
constexpr size_t WS_END = 248 * MiB;

struct Params {
    const float *x, *g1, *w_in, *w_oa, *w_ob, *w_mix, *g2, *w_q, *skeys, *pu, *pv, *gf;
    float* out; unsigned char* ws; int ph_lo, ph_hi;
};

DI unsigned f2bf(float f) { unsigned u = __float_as_uint(f); return (u + 0x7fffu + ((u >> 16) & 1u)) >> 16; }
DI float bf2f(unsigned h) { return __uint_as_float(h << 16); }
DI float bflo(unsigned w) { return __uint_as_float(w << 16); }
DI float bfhi(unsigned w) { return __uint_as_float(w & 0xffff0000u); }
typedef __bf16 bf16x2_t __attribute__((ext_vector_type(2)));
typedef float f32x2_t __attribute__((ext_vector_type(2)));
DI unsigned cvtpk(float lo, float hi) { f32x2_t v = {lo, hi}; bf16x2_t b = __builtin_convertvector(v, bf16x2_t); return __builtin_bit_cast(unsigned, b); }
DI unsigned pk2(float lo, float hi) { return cvtpk(lo, hi); }
DI unsigned q8x4(float a, float b, float c, float d, float isc) {
    const float M = 12582912.f;
    const unsigned fa = __float_as_uint(fmaf(a, isc, M)), fb = __float_as_uint(fmaf(b, isc, M)), fc = __float_as_uint(fmaf(c, isc, M)), fd = __float_as_uint(fmaf(d, isc, M));
    return __builtin_amdgcn_perm(fb, fa, 0x0c0c0400u) | __builtin_amdgcn_perm(fd, fc, 0x04000c0cu);
}
DI float wave_sum(float v) {
#pragma unroll
    for (int o = 32; o >= 1; o >>= 1) v += __shfl_xor(v, o);
    return v;
}
DI void load_row64(const bf16_t* p, float* o) {
#pragma unroll
    for (int i = 0; i < 8; ++i) {
        u32x4 w = *(const u32x4*)(p + 8 * i);
        o[8 * i + 0] = bflo(w.x); o[8 * i + 1] = bfhi(w.x); o[8 * i + 2] = bflo(w.y); o[8 * i + 3] = bfhi(w.y);
        o[8 * i + 4] = bflo(w.z); o[8 * i + 5] = bfhi(w.z); o[8 * i + 6] = bflo(w.w); o[8 * i + 7] = bfhi(w.w);
    }
}
DI float sigmoidf_(float x) { return __builtin_amdgcn_rcpf(1.f + __builtin_amdgcn_exp2f(x * -1.4426950408889634f)); }

DI void transpose_item(const float* W, int K, int N, bf16_t* WT, int ldk, int koff, const float* ks, float* scr, int item, int lane) {
    const int nblk = N / 32, kb = item / nblk, nb = item % nblk, k0 = 64 * kb, n0 = 32 * nb;
    float tv[32];
#pragma unroll
    for (int i = 0; i < 32; ++i) tv[i] = W[(size_t)(k0 + 2 * i + (lane >> 5)) * N + n0 + (lane & 31)];
    if (ks) {
#pragma unroll
        for (int i = 0; i < 32; ++i) tv[i] *= ks[k0 + 2 * i + (lane >> 5)];
    }
#pragma unroll
    for (int i = 0; i < 32; ++i) scr[(2 * i + (lane >> 5)) * 33 + (lane & 31)] = tv[i];
    asm volatile("s_waitcnt lgkmcnt(0)" ::: "memory");
    const int c = lane & 7;
#pragma unroll
    for (int j = 0; j < 4; ++j) { const int n = (lane >> 3) + 8 * j; const float* sp = scr + (8 * c) * 33 + n;
        u32x4 o; o.x = pk2(sp[0 * 33], sp[1 * 33]); o.y = pk2(sp[2 * 33], sp[3 * 33]); o.z = pk2(sp[4 * 33], sp[5 * 33]); o.w = pk2(sp[6 * 33], sp[7 * 33]);
        *(u32x4*)(WT + (size_t)(n0 + n) * ldk + koff + k0 + 8 * c) = o; }
    asm volatile("s_waitcnt lgkmcnt(0)" ::: "memory");
}

namespace pg8 {
#define PG8_LAS __attribute__((address_space(3)))
typedef unsigned short bf16_t;
typedef short bf16x8 __attribute__((ext_vector_type(8)));
typedef float f32x4 __attribute__((ext_vector_type(4)));
typedef int i32x4 __attribute__((ext_vector_type(4)));
typedef unsigned u32x4 __attribute__((ext_vector_type(4)));
template <bool I8> struct AccT { typedef f32x4 type; };
template <> struct AccT<true> { typedef i32x4 type; };
constexpr int BM = 256, BK = 64, HALF = 128, HTB = HALF * BK * 2  , STAGE_BYTES = 8 * HTB, NXCD = 8, WGM = 8;

__host__ __device__ __forceinline__ int lds_byte(int r, int c) { const int st = (r >> 4) * 2 + (c >> 5), rr = r & 15, cc = c & 31, ob = rr * 64 + cc * 2; return st * 1024 + (ob ^ (((ob >> 9) & 1) << 5)); }
__host__ __device__ __forceinline__ void stage_rc(int b, int& R, int& C) { const int st = b / 1024, sb = b % 1024, swz = sb ^ (((sb >> 9) & 1) << 5); R = (st >> 1) * 16 + swz / 64; C = (st & 1) * 32 + (swz % 64) / 2; }
__host__ __device__ __forceinline__ int perm32(int rho) { const int n = rho >> 4, i = rho & 15; return 8 * (i >> 2) + 4 * n + (i & 3); }

struct Unit { int pm, pn; };
struct Gemm { const bf16_t* A; const bf16_t* Bt; int M, N, K; };

struct StaticOrder {
    int nM, nN, nwg, G, c;
    __host__ __device__ void init(int M, int N, int G_, int c_) { nM = M / BM; nN = N / BM; nwg = nM * nN; G = G_; c = c_; }
    __host__ __device__ bool next(int i, Unit& u) const {
        const long L = (long)i * G + c; if (L >= nwg) return false;
        int wgid = (int)L; { const int q = nwg / NXCD, r = nwg % NXCD, xcd = wgid % NXCD, off = wgid / NXCD; wgid = (xcd < r ? xcd * (q + 1) : r * (q + 1) + (xcd - r) * q) + off; }
        const int nig = WGM * nN, gid = wgid / nig, fm = gid * WGM, gsz = (nM - fm) < WGM ? (nM - fm) : WGM;
        u.pm = fm + ((wgid % nig) % gsz); u.pn = (wgid % nig) / gsz; return true;
    }
    __device__ __forceinline__ void a_ready(const Unit&) const {}
    __device__ __forceinline__ void done(const Unit&) const {}
};
__device__ __forceinline__ unsigned cvt_pk_bf16(float lo, float hi) { unsigned r; asm volatile("v_cvt_pk_bf16_f32 %0, %1, %2" : "=v"(r) : "v"(lo), "v"(hi)); return r; }
template <class Epi, class Sched, bool ALIGN_EPI = false, bool SP2 = false, bool MIDK = false>
__device__ __forceinline__ void gemm_phase(PG8_LAS unsigned char* lds, const Gemm g, const Sched& S, const Epi& E) {
    const int tid = threadIdx.x, wid = __builtin_amdgcn_readfirstlane(tid >> 6), lane = tid & 63, wr = wid >> 2, wc = wid & 3, fr = lane & 15, fq = lane >> 4;
    const int K = g.K, nt = K / BK;
    unsigned voffA[2], voffB[2];
#pragma unroll
    for (int i = 0; i < 2; ++i) { int R, C; stage_rc(tid * 16 + i * 8192, R, C); const int Rb = Epi::PERM ? ((R & ~31) + perm32(R & 31)) : R;
        voffA[i] = (unsigned)(R * K + C) * 2u; voffB[i] = (unsigned)(Rb * K + C) * 2u; }
    const size_t kstep = (size_t)(BK * 2);
    const size_t hstep = (size_t)HALF * K * 2;
    const size_t tstep = 2 * hstep;
    const unsigned ldsw = (unsigned)wid * 1024u;
    const int aoff = lds_byte(wr * 64 + fr, fq * 8), boff = lds_byte(wc * 32 + fr, fq * 8);
#define PG8_SA(b, h) (((b) * 2 + (h)) * HTB)
#define PG8_SB(b, h) ((4 + (b) * 2 + (h)) * HTB)
#define PG8_STAGE(bufoff, gbase, voff) do { _Pragma("unroll") for (int _i = 0; _i < 2; ++_i) \
        __builtin_amdgcn_global_load_lds((const unsigned*)((const char*)(gbase) + (voff)[_i]), (PG8_LAS unsigned*)(lds + (bufoff) + ldsw + _i * 8192), 16, 0, 0); } while (0)
#define PG8_LDA(dst, b, h) do { _Pragma("unroll") for (int m = 0; m < 4; ++m) _Pragma("unroll") for (int k = 0; k < 2; ++k) dst[m][k] = *(const PG8_LAS bf16x8*)(lds + PG8_SA(b, h) + aoff + m * 2048 + k * 1024); } while (0)
#define PG8_LDB(dst, b, h) do { _Pragma("unroll") for (int n = 0; n < 2; ++n) _Pragma("unroll") for (int k = 0; k < 2; ++k) dst[n][k] = *(const PG8_LAS bf16x8*)(lds + PG8_SB(b, h) + boff + n * 2048 + k * 1024); } while (0)
#define PG8_MMA(ai, bj, At, Bt) do { __builtin_amdgcn_s_setprio(1); _Pragma("unroll") for (int m = 0; m < 4; ++m) _Pragma("unroll") for (int n = 0; n < 2; ++n) _Pragma("unroll") for (int k = 0; k < 2; ++k) \
        { if constexpr (Epi::I8) acc[ai][bj][m][n] = __builtin_amdgcn_mfma_i32_16x16x64_i8(__builtin_bit_cast(i32x4, Bt[n][k]), __builtin_bit_cast(i32x4, At[m][k]), acc[ai][bj][m][n], 0, 0, 0); \
          else acc[ai][bj][m][n] = __builtin_amdgcn_mfma_f32_16x16x32_bf16(Bt[n][k], At[m][k], acc[ai][bj][m][n], 0, 0, 0); } __builtin_amdgcn_s_setprio(0); } while (0)
#define PG8_WAIT_V(n) asm volatile("s_waitcnt vmcnt(" #n ")" ::: "memory")
#define PG8_WAIT_L(n) asm volatile("s_waitcnt lgkmcnt(" #n ")" ::: "memory")
#define PG8_BAR __builtin_amdgcn_s_barrier()
#define PG8_SCHED __builtin_amdgcn_sched_barrier(0)
    Unit cur, nxt; int ui = 0;
    if (!S.next(0, cur)) return;
    typedef typename AccT<Epi::I8>::type acc_t;
    acc_t acc[2][2][4][2];
    if constexpr (Epi::HAS_INIT) E.init(acc, cur, wr, wc, fr, fq);
    else {
#pragma unroll
    for (int a = 0; a < 2; ++a)
#pragma unroll
        for (int b = 0; b < 2; ++b)
#pragma unroll
            for (int m = 0; m < 4; ++m)
#pragma unroll
                for (int n = 0; n < 2; ++n) acc[a][b][m][n] = acc_t{};
    }
    bf16x8 At[4][2], B0[2][2], B1[2][2];
    const char* cA = (const char*)g.A + (size_t)cur.pm * tstep; const char* cB = (const char*)g.Bt + (size_t)cur.pn * tstep;
    S.a_ready(cur);
    if constexpr (SP2) {
        PG8_STAGE(PG8_SB(0, 0), cB, voffB); PG8_STAGE(PG8_SB(0, 1), cB + hstep, voffB); PG8_STAGE(PG8_SA(0, 0), cA, voffA); PG8_STAGE(PG8_SA(0, 1), cA + hstep, voffA);
        if (wr == 1) PG8_BAR;
        PG8_WAIT_V(2); PG8_BAR;
        PG8_STAGE(PG8_SB(1, 0), cB + kstep, voffB); PG8_STAGE(PG8_SA(1, 0), cA + kstep, voffA); PG8_STAGE(PG8_SB(1, 1), cB + hstep + kstep, voffB);
        PG8_WAIT_V(6); PG8_BAR;
    } else {
        PG8_STAGE(PG8_SB(0, 0), cB, voffB); PG8_STAGE(PG8_SA(0, 0), cA, voffA); PG8_STAGE(PG8_SB(0, 1), cB + hstep, voffB); PG8_STAGE(PG8_SA(0, 1), cA + hstep, voffA);
        if (wr == 1) PG8_BAR;
        PG8_WAIT_V(4); PG8_BAR;
        PG8_STAGE(PG8_SB(1, 0), cB + kstep, voffB); PG8_STAGE(PG8_SA(1, 0), cA + kstep, voffA); PG8_STAGE(PG8_SB(1, 1), cB + hstep + kstep, voffB);
        PG8_WAIT_V(6); PG8_BAR;
    }
    for (;;) {
        const bool has_next = S.next(ui + 1, nxt);
        const char* nA = has_next ? (const char*)g.A + (size_t)nxt.pm * tstep : cA; const char* nB = has_next ? (const char*)g.Bt + (size_t)nxt.pn * tstep : cB;
        for (int t = 0; t < nt; t += 2) {
            if constexpr (MIDK) { if (t == nt / 2) E.mid(acc, cur, wr, wc, fr, fq); }
            const bool last = (t == nt - 2);
            const char* a1 = cA + (size_t)(t + 1) * kstep;
            const char* a2 = last ? nA : cA + (size_t)(t + 2) * kstep; const char* b2 = last ? nB : cB + (size_t)(t + 2) * kstep;
            const char* a3 = a2 + kstep; const char* b3 = b2 + kstep;
            if (last && has_next) S.a_ready(nxt);
            if constexpr (SP2) {
            PG8_LDB(B0, 0, 0); PG8_LDB(B1, 0, 1); PG8_SCHED; PG8_LDA(At, 0, 0); PG8_STAGE(PG8_SA(1, 1), a1 + hstep, voffA);
            PG8_WAIT_V(8); PG8_WAIT_L(0); PG8_BAR; PG8_MMA(0, 0, At, B0); PG8_MMA(0, 1, At, B1); PG8_BAR; PG8_SCHED;
            PG8_LDA(At, 0, 1); PG8_STAGE(PG8_SB(0, 0), b2, voffB); PG8_STAGE(PG8_SB(0, 1), b2 + hstep, voffB); PG8_STAGE(PG8_SA(0, 0), a2, voffA);
            PG8_WAIT_V(8); PG8_WAIT_L(0); PG8_BAR; PG8_MMA(1, 0, At, B0); PG8_MMA(1, 1, At, B1); PG8_BAR; PG8_SCHED;
            PG8_LDB(B0, 1, 0); PG8_LDB(B1, 1, 1); PG8_SCHED; PG8_LDA(At, 1, 0); PG8_STAGE(PG8_SA(0, 1), a2 + hstep, voffA);
            PG8_WAIT_V(8); PG8_WAIT_L(0); PG8_BAR; PG8_MMA(0, 0, At, B0); PG8_MMA(0, 1, At, B1); PG8_BAR; PG8_SCHED;
            PG8_LDA(At, 1, 1); PG8_STAGE(PG8_SB(1, 0), b3, voffB); PG8_STAGE(PG8_SB(1, 1), b3 + hstep, voffB); PG8_STAGE(PG8_SA(1, 0), a3, voffA);
            PG8_WAIT_V(8); PG8_WAIT_L(0); PG8_BAR; PG8_MMA(1, 0, At, B0); PG8_MMA(1, 1, At, B1); PG8_BAR; PG8_SCHED;
            } else {
            PG8_LDB(B0, 0, 0); PG8_SCHED; PG8_LDA(At, 0, 0); PG8_STAGE(PG8_SA(1, 1), a1 + hstep, voffA);
            PG8_WAIT_L(8); PG8_BAR; PG8_WAIT_L(0); PG8_MMA(0, 0, At, B0); PG8_BAR; PG8_SCHED;
            PG8_LDB(B1, 0, 1); PG8_STAGE(PG8_SB(0, 0), b2, voffB);
            PG8_BAR; PG8_WAIT_L(0); PG8_MMA(0, 1, At, B1); PG8_BAR;
            PG8_LDA(At, 0, 1); PG8_STAGE(PG8_SA(0, 0), a2, voffA);
            PG8_BAR; PG8_WAIT_L(0); PG8_MMA(1, 0, At, B0); PG8_BAR; PG8_SCHED;
            PG8_STAGE(PG8_SB(0, 1), b2 + hstep, voffB);
            PG8_WAIT_V(6); PG8_BAR; PG8_MMA(1, 1, At, B1); PG8_BAR;
            PG8_LDB(B0, 1, 0); PG8_SCHED; PG8_LDA(At, 1, 0); PG8_STAGE(PG8_SA(0, 1), a2 + hstep, voffA);
            PG8_WAIT_L(8); PG8_BAR; PG8_WAIT_L(0); PG8_MMA(0, 0, At, B0); PG8_BAR; PG8_SCHED;
            PG8_LDB(B1, 1, 1); PG8_STAGE(PG8_SB(1, 0), b3, voffB);
            PG8_BAR; PG8_WAIT_L(0); PG8_MMA(0, 1, At, B1); PG8_BAR;
            PG8_LDA(At, 1, 1); PG8_STAGE(PG8_SA(1, 0), a3, voffA);
            PG8_BAR; PG8_WAIT_L(0); PG8_MMA(1, 0, At, B0); PG8_BAR; PG8_SCHED;
            PG8_STAGE(PG8_SB(1, 1), b3 + hstep, voffB);
            PG8_WAIT_V(6); PG8_BAR; PG8_MMA(1, 1, At, B1); PG8_BAR;
            }
        }
        if constexpr (ALIGN_EPI) { if (wr == 0) PG8_BAR; }
        if constexpr (!Epi::AFTER_DRAIN) { E(acc, cur, wr, wc, fr, fq); S.done(cur); }
        if (!has_next) break;
        if constexpr (Epi::HAS_INIT) E.init(acc, nxt, wr, wc, fr, fq);
        else {
#pragma unroll
        for (int a = 0; a < 2; ++a)
#pragma unroll
            for (int b = 0; b < 2; ++b)
#pragma unroll
                for (int m = 0; m < 4; ++m)
#pragma unroll
                    for (int n = 0; n < 2; ++n) acc[a][b][m][n] = acc_t{};
        }
        cur = nxt; cA = nA; cB = nB; ++ui;
        if constexpr (ALIGN_EPI) { if (wr == 1) PG8_BAR; }
    }
    PG8_WAIT_V(0);
    if constexpr (!ALIGN_EPI) { if (wr == 0) PG8_BAR; }
    PG8_BAR;
    if constexpr (Epi::AFTER_DRAIN) { E.fused(acc, cur, wr, wc, fr, fq, lds, wid, lane); S.done(cur); }
#undef PG8_SA
#undef PG8_SB
#undef PG8_STAGE
#undef PG8_LDA
#undef PG8_LDB
#undef PG8_MMA
#undef PG8_WAIT_V
#undef PG8_WAIT_L
#undef PG8_BAR
#undef PG8_SCHED
}
}

#define EPI_FOR(...) _Pragma("unroll") for (int ai = 0; ai < 2; ++ai) _Pragma("unroll") for (int m = 0; m < 4; ++m) { const int row = u.pm * 256 + ai * 128 + wr * 64 + m * 16 + fr; \
    _Pragma("unroll") for (int bj = 0; bj < 2; ++bj) { const int col = u.pn * 256 + bj * 128 + wc * 32 + 8 * fq; const f32x4 a0 = acc[ai][bj][m][0], a1 = acc[ai][bj][m][1]; __VA_ARGS__ } }
DI u32x4 pack8bf(f32x4 a, f32x4 b) { u32x4 w; w.x = pk2(a.x, a.y); w.y = pk2(a.z, a.w); w.z = pk2(b.x, b.y); w.w = pk2(b.z, b.w); return w; }
constexpr float C2 = 0.125f * 1.4426950408889634f;
struct EpiInProj {
    static constexpr bool PERM = true, AFTER_DRAIN = false, HAS_INIT = false, I8 = true;
    bf16_t* QK; bf16_t* KF; bf16_t* VT; bf16_t* GATES; const float* RS1  ; const float* SW  ; float* KSUM; bool ksum_on;
    DI void operator()(const pg8::i32x4 (&iacc)[2][2][4][2], const pg8::Unit& u, int wr, int wc, int fr, int fq) const {
        f32x4 acc[2][2][4][2];
#pragma unroll
        for (int bj = 0; bj < 2; ++bj) {
            const float* swp = SW + u.pn * 256 + bj * 128 + wc * 32 + 8 * fq;
            const f32x4 c0 = *(const f32x4*)swp * (1.f / 127.f), c1 = *(const f32x4*)(swp + 4) * (1.f / 127.f);
#pragma unroll
            for (int ai = 0; ai < 2; ++ai)
#pragma unroll
                for (int m = 0; m < 4; ++m) { acc[ai][bj][m][0] = __builtin_convertvector(iacc[ai][bj][m][0], f32x4) * c0; acc[ai][bj][m][1] = __builtin_convertvector(iacc[ai][bj][m][1], f32x4) * c1; }
        }
        const int seg = (u.pn * 256) >> 9;
        if (seg == 2 || seg == 5) {
            const int kind = seg == 5;
            EPI_FOR({
                const float rs = RS1[row]; const int bb = row >> 13, key = row & (SEQ - 1), kp = key & 15;
                const int nn = col - (kind ? 2560 : 1024), dim = nn & 63;
                bf16_t* vt = VT + (((size_t)((kind * 2 + bb) * NH + (nn >> 6)) * 256 + (key >> 5)) * 4 + ((dim >> 5) * 2 + ((key >> 4) & 1))) * 512 + (((kp >> 2) & 1) * 32 + (dim & 31)) * 8 + 4 * (kp >> 3) + (kp & 3);
                vt[0] = (bf16_t)f2bf(a0.x * rs); vt[8] = (bf16_t)f2bf(a0.y * rs); vt[16] = (bf16_t)f2bf(a0.z * rs); vt[24] = (bf16_t)f2bf(a0.w * rs);
                vt[32] = (bf16_t)f2bf(a1.x * rs); vt[40] = (bf16_t)f2bf(a1.y * rs); vt[48] = (bf16_t)f2bf(a1.z * rs); vt[56] = (bf16_t)f2bf(a1.w * rs);
            })
        } else if (seg == 1 || seg == 4) {
            const int kind = seg == 4;
            float cs[16];
#pragma unroll
            for (int i = 0; i < 16; ++i) cs[i] = 0.f;
            EPI_FOR({
                const float rs = RS1[row]; const f32x4 v0 = a0 * rs, v1 = a1 * rs;
                const int bb = row >> 13, key = row & (SEQ - 1), nn = col - (kind ? 2048 : 512), dim = nn & 63;
                *(u32x4*)(KF + (((size_t)((kind * 2 + bb) * NH + (nn >> 6)) * 256 + (key >> 5)) * 4 + (dim >> 4)) * 512 + (((dim >> 3) & 1) * 32 + (key & 31)) * 8) = pack8bf(v0, v1);
                if (seg == 1) { cs[bj * 8 + 0] += v0.x; cs[bj * 8 + 1] += v0.y; cs[bj * 8 + 2] += v0.z; cs[bj * 8 + 3] += v0.w; cs[bj * 8 + 4] += v1.x; cs[bj * 8 + 5] += v1.y; cs[bj * 8 + 6] += v1.z; cs[bj * 8 + 7] += v1.w; }
            })
            if (seg == 1 && ksum_on) {
                const bool b3 = (fr & 8) != 0, b2 = (fr & 4) != 0, b1 = (fr & 2) != 0, b0 = (fr & 1) != 0;
                float v8[8], v4[4];
#pragma unroll
                for (int i = 0; i < 8; ++i) v8[i] = (b3 ? cs[8 + i] : cs[i]) + __shfl_xor(b3 ? cs[i] : cs[8 + i], 8);
#pragma unroll
                for (int i = 0; i < 4; ++i) v4[i] = (b2 ? v8[4 + i] : v8[i]) + __shfl_xor(b2 ? v8[i] : v8[4 + i], 4);
                const float v20 = (b1 ? v4[2] : v4[0]) + __shfl_xor(b1 ? v4[0] : v4[2], 2), v21 = (b1 ? v4[3] : v4[1]) + __shfl_xor(b1 ? v4[1] : v4[3], 2);
                const float v1_ = (b0 ? v21 : v20) + __shfl_xor(b0 ? v20 : v21, 1);
                const int c = u.pn * 256 + (fr >> 3) * 128 + wc * 32 + 8 * fq + (fr & 7) - 512, row0 = u.pm * 256;
                atomicAdd(KSUM + ((size_t)(((row0 >> 13) * NH + (c >> 6)) * NBLK + ((row0 & (SEQ - 1)) >> 8))) * HD + (c & 63), v1_);
            }
        } else if (seg < 6) {
            const int cshift = seg == 3 ? -1024 : 0;
            EPI_FOR({ const float rs = RS1[row] * C2; *(u32x4*)(QK + (size_t)row * 1024 + col + cshift) = pack8bf(a0 * rs, a1 * rs); })
        } else {
            EPI_FOR({
                const float rs = RS1[row]; const f32x4 v0 = a0 * rs, v1 = a1 * rs;
                const f32x4 s0 = {sigmoidf_(v0.x), sigmoidf_(v0.y), sigmoidf_(v0.z), sigmoidf_(v0.w)}, s1 = {sigmoidf_(v1.x), sigmoidf_(v1.y), sigmoidf_(v1.z), sigmoidf_(v1.w)};
                *(u32x4*)(GATES + (size_t)row * GATEW + col - QKVW) = pack8bf(s0, s1);
            })
        }
    }
};
struct EpiMix {
    static constexpr bool PERM = true, AFTER_DRAIN = false, HAS_INIT = false, I8 = false;
    const bf16_t* GATES; bf16_t* MIXED;
    DI void mid(f32x4 (&acc)[2][2][4][2], const pg8::Unit& u, int wr, int wc, int fr_in, int fq_in) const {
        int fr = fr_in, fq = fq_in; asm volatile("" : "+v"(fr), "+v"(fq));
#pragma unroll
        for (int ai = 0; ai < 2; ++ai)
#pragma unroll
            for (int m = 0; m < 4; ++m) { const int row = u.pm * 256 + ai * 128 + wr * 64 + m * 16 + fr;
#pragma unroll
                for (int bj = 0; bj < 2; ++bj) { const int col = u.pn * 256 + bj * 128 + wc * 32 + 8 * fq;
                    const u32x4 ga = *(const u32x4*)(GATES + (size_t)row * GATEW + col), gb = *(const u32x4*)(GATES + (size_t)row * GATEW + 1024 + col);
                    const float r0 = bflo(ga.x) * __builtin_amdgcn_rcpf(fmaxf(bflo(gb.x), 1e-30f)), r1 = bfhi(ga.x) * __builtin_amdgcn_rcpf(fmaxf(bfhi(gb.x), 1e-30f));
                    const float r2 = bflo(ga.y) * __builtin_amdgcn_rcpf(fmaxf(bflo(gb.y), 1e-30f)), r3 = bfhi(ga.y) * __builtin_amdgcn_rcpf(fmaxf(bfhi(gb.y), 1e-30f));
                    const float r4 = bflo(ga.z) * __builtin_amdgcn_rcpf(fmaxf(bflo(gb.z), 1e-30f)), r5 = bfhi(ga.z) * __builtin_amdgcn_rcpf(fmaxf(bfhi(gb.z), 1e-30f));
                    const float r6 = bflo(ga.w) * __builtin_amdgcn_rcpf(fmaxf(bflo(gb.w), 1e-30f)), r7 = bfhi(ga.w) * __builtin_amdgcn_rcpf(fmaxf(bfhi(gb.w), 1e-30f));
                    acc[ai][bj][m][0] = acc[ai][bj][m][0] * (f32x4){r0, r1, r2, r3}; acc[ai][bj][m][1] = acc[ai][bj][m][1] * (f32x4){r4, r5, r6, r7}; }
                __builtin_amdgcn_sched_barrier(0); }
    }
    DI void operator()(const f32x4 (&acc)[2][2][4][2], const pg8::Unit& u, int wr, int wc, int fr, int fq) const {
        EPI_FOR({
            const u32x4 gb = *(const u32x4*)(GATES + (size_t)row * GATEW + 1024 + col);
            const f32x4 s0 = {fmaxf(bflo(gb.x), 1e-30f), fmaxf(bfhi(gb.x), 1e-30f), fmaxf(bflo(gb.y), 1e-30f), fmaxf(bfhi(gb.y), 1e-30f)};
            const f32x4 s1 = {fmaxf(bflo(gb.z), 1e-30f), fmaxf(bfhi(gb.z), 1e-30f), fmaxf(bflo(gb.w), 1e-30f), fmaxf(bfhi(gb.w), 1e-30f)};
            *(u32x4*)(MIXED + (size_t)row * DM + col) = pack8bf(a0 * s0, a1 * s1);
        })
    }
};
struct EpiResid {
    static constexpr bool PERM = true, AFTER_DRAIN = false, HAS_INIT = true, I8 = false;
    const float* X; bf16_t* HB;
    DI void init(f32x4 (&acc)[2][2][4][2], const pg8::Unit& u, int wr, int wc, int fr, int fq) const {
#pragma unroll
        for (int ai = 0; ai < 2; ++ai)
#pragma unroll
            for (int m = 0; m < 4; ++m) { const int row = u.pm * 256 + ai * 128 + wr * 64 + m * 16 + fr;
#pragma unroll
                for (int bj = 0; bj < 2; ++bj) { const float* xp = X + (size_t)row * DM + u.pn * 256 + bj * 128 + wc * 32 + 8 * fq; acc[ai][bj][m][0] = *(const f32x4*)xp; acc[ai][bj][m][1] = *(const f32x4*)(xp + 4); } }
    }
    DI void operator()(const f32x4 (&acc)[2][2][4][2], const pg8::Unit& u, int wr, int wc, int fr, int fq) const {
        EPI_FOR({ *(u32x4*)(HB + (size_t)row * DM + col) = pack8bf(a0, a1); })
    }
};
struct EpiPeerQ {
    static constexpr bool PERM = true, AFTER_DRAIN = false, HAS_INIT = false, I8 = false;
    bf16_t* Q2;
    DI void operator()(const f32x4 (&acc)[2][2][4][2], const pg8::Unit& u, int wr, int wc, int fr, int fq) const {
        EPI_FOR({ *(u32x4*)(Q2 + (size_t)row * PQW + col) = pack8bf(a0, a1); })
    }
};


DI void h_rows4(const bf16_t* H, float* RS2, float* SH, signed char* H8, int row0, int stride, int lane) {
    u32x4 a[4][2];
#pragma unroll
    for (int k = 0; k < 4; ++k)
#pragma unroll
        for (int j = 0; j < 2; ++j) a[k][j] = *(const u32x4*)(H + (size_t)(row0 + k * stride) * DM + lane * 16 + 8 * j);
#pragma unroll
    for (int k = 0; k < 4; ++k) {
        const int row = row0 + k * stride;
        float v[16];
#pragma unroll
        for (int j = 0; j < 2; ++j) { v[8 * j] = bflo(a[k][j].x); v[8 * j + 1] = bfhi(a[k][j].x); v[8 * j + 2] = bflo(a[k][j].y); v[8 * j + 3] = bfhi(a[k][j].y);
            v[8 * j + 4] = bflo(a[k][j].z); v[8 * j + 5] = bfhi(a[k][j].z); v[8 * j + 6] = bflo(a[k][j].w); v[8 * j + 7] = bfhi(a[k][j].w); }
        float ss = 0.f, am = 0.f;
#pragma unroll
        for (int j = 0; j < 16; ++j) { ss += v[j] * v[j]; am = fmaxf(am, fabsf(v[j])); }
        ss = wave_sum(ss);
#pragma unroll
        for (int o = 32; o >= 1; o >>= 1) am = fmaxf(am, __shfl_xor(am, o));
        const float sc = am > 0.f ? am * (1.f / 127.f) : 1.f, isc = 1.f / sc;
        unsigned w[4];
#pragma unroll
        for (int j = 0; j < 4; ++j) w[j] = q8x4(v[4 * j], v[4 * j + 1], v[4 * j + 2], v[4 * j + 3], isc);
        *(u32x4*)(H8 + (size_t)row * DM + lane * 16) = (u32x4){w[0], w[1], w[2], w[3]};
        if (lane == 0) { RS2[row] = rsqrtf(ss * (1.f / DM) + RMS_EPS); SH[row] = sc; }
    }
}

template <int NR>
DI void quant_rows(const float* pu, const float* pv, const float* g2, unsigned char* U8, unsigned char* V8, float* SU, float* SV, int row0, int stride, int lane) {
    f32x4 a[NR][4];
#pragma unroll
    for (int k = 0; k < NR; ++k) { const int row = row0 + k * stride, isv = row >= NEXP, e = row - (isv ? NEXP : 0); const float* src = (isv ? pv : pu) + (size_t)e * DM + lane * 16;
#pragma unroll
        for (int j = 0; j < 4; ++j) a[k][j] = *(const f32x4*)(src + 4 * j); }
    f32x4 gq[4];
#pragma unroll
    for (int j = 0; j < 4; ++j) gq[j] = *(const f32x4*)(g2 + lane * 16 + 4 * j);
#pragma unroll
    for (int k = 0; k < NR; ++k) {
        const int row = row0 + k * stride, isv = row >= NEXP, e = row - (isv ? NEXP : 0);
        float v[16];
#pragma unroll
        for (int j = 0; j < 4; ++j) { const f32x4 x = isv ? a[k][j] : a[k][j] * gq[j]; v[4 * j] = x.x; v[4 * j + 1] = x.y; v[4 * j + 2] = x.z; v[4 * j + 3] = x.w; }
        float am = 0.f;
#pragma unroll
        for (int j = 0; j < 16; ++j) am = fmaxf(am, fabsf(v[j]));
#pragma unroll
        for (int o = 32; o >= 1; o >>= 1) am = fmaxf(am, __shfl_xor(am, o));
        const float sc = am > 0.f ? am * (1.f / 127.f) : 1.f, isc = 1.f / sc;
        unsigned w[4];
#pragma unroll
        for (int j = 0; j < 4; ++j) w[j] = q8x4(v[4 * j], v[4 * j + 1], v[4 * j + 2], v[4 * j + 3], isc);
        unsigned char* dst = (isv ? V8 : U8) + ((size_t)((lane >> 3) * NEXP + e)) * 128 + (lane & 7) * 16;
        *(u32x4*)dst = (u32x4){w[0], w[1], w[2], w[3]};
        if (lane == 0) (isv ? SV : SU)[e] = sc;
    }
}

typedef float f32x16 __attribute__((ext_vector_type(16)));
#define MFMA32(a, b, c) __builtin_amdgcn_mfma_f32_32x32x16_bf16((a), (b), (c), 0, 0, 0)
constexpr float FLT_MIN_ = 1.17549435e-38f;

struct KV { bf16x8 k[4], v[4]; };
DI void load_kv(KV& f, const bf16_t* kp, const bf16_t* vp) {
#pragma unroll
    for (int i = 0; i < 4; ++i) { f.k[i] = *(const bf16x8*)(kp + 512 * i); f.v[i] = *(const bf16x8*)(vp + 512 * i); }
}
DI void load_kv_async(KV& f, const bf16_t* kp, const bf16_t* vp) {
    asm volatile("global_load_dwordx4 %0, %4, off\n\tglobal_load_dwordx4 %1, %4, off offset:1024\n\tglobal_load_dwordx4 %2, %4, off offset:2048\n\tglobal_load_dwordx4 %3, %4, off offset:3072"
                 : "=&v"(f.k[0]), "=&v"(f.k[1]), "=&v"(f.k[2]), "=&v"(f.k[3]) : "v"(kp) : "memory");
    asm volatile("global_load_dwordx4 %0, %4, off\n\tglobal_load_dwordx4 %1, %4, off offset:1024\n\tglobal_load_dwordx4 %2, %4, off offset:2048\n\tglobal_load_dwordx4 %3, %4, off offset:3072"
                 : "=&v"(f.v[0]), "=&v"(f.v[1]), "=&v"(f.v[2]), "=&v"(f.v[3]) : "v"(vp) : "memory");
}
#define KV_WAIT_K(f, N) asm volatile("s_waitcnt vmcnt(" #N ")" : "+v"(f.k[0]), "+v"(f.k[1]), "+v"(f.k[2]), "+v"(f.k[3]) :: "memory")
#define KV_WAIT_V(f, N) asm volatile("s_waitcnt vmcnt(" #N ")" : "+v"(f.v[0]), "+v"(f.v[1]), "+v"(f.v[2]), "+v"(f.v[3]) :: "memory")
DI bf16x8 pack8(const f32x16& p, int s) {
    u32x4 w;
    if (s == 0) { w.x = cvtpk(p[0], p[1]); w.y = cvtpk(p[2], p[3]); w.z = cvtpk(p[4], p[5]); w.w = cvtpk(p[6], p[7]); }
    else { w.x = cvtpk(p[8], p[9]); w.y = cvtpk(p[10], p[11]); w.z = cvtpk(p[12], p[13]); w.w = cvtpk(p[14], p[15]); }
    return __builtin_bit_cast(bf16x8, w);
}
struct SmState { float m, l; f32x16 o0, o1; };
typedef float f32x2 __attribute__((ext_vector_type(2)));
DI float sum16(const f32x16& p) {
    const f32x2 s0 = (f32x2){p[0], p[1]} + (f32x2){p[2], p[3]}, s1 = (f32x2){p[4], p[5]} + (f32x2){p[6], p[7]};
    const f32x2 s2 = (f32x2){p[8], p[9]} + (f32x2){p[10], p[11]}, s3 = (f32x2){p[12], p[13]} + (f32x2){p[14], p[15]};
    const f32x2 t0 = s0 + s1, t1 = s2 + s3, u = t0 + t1;
    return u.x + u.y;
}
constexpr float LAZY_THR = 1.0995116e12f;
template <int WK = -1, int WV = -1>
DI void moba_tile_first(SmState& st, KV& f, const bf16x8 (&qf)[4], float bias0, float slopeL, int maskrow, int hh) {
    f32x16 acc;
#pragma unroll
    for (int r = 0; r < 16; ++r) acc[r] = bias0 + slopeL * (float)((r & 3) + 8 * (r >> 2));
    if constexpr (WK == 12) KV_WAIT_K(f, 12); else if constexpr (WK == 4) KV_WAIT_K(f, 4);
#pragma unroll
    for (int ks = 0; ks < 4; ++ks) acc = MFMA32(f.k[ks], qf[ks], acc);
    if (maskrow < 32) {
#pragma unroll
        for (int r = 0; r < 16; ++r) if ((r & 3) + 8 * (r >> 2) + 4 * hh > maskrow) acc[r] = -1e30f;
    }
    float tm = acc[0];
#pragma unroll
    for (int r = 1; r < 16; ++r) tm = fmaxf(tm, acc[r]);
    tm = fmaxf(tm, __shfl_xor(tm, 32));
    f32x16 pw;
#pragma unroll
    for (int r = 0; r < 16; ++r) pw[r] = __builtin_amdgcn_exp2f(acc[r] - tm);
    st.m = tm; st.l = sum16(pw);
    const bf16x8 p0 = pack8(pw, 0), p1 = pack8(pw, 1);
    if constexpr (WV == 8) KV_WAIT_V(f, 8); else if constexpr (WV == 0) KV_WAIT_V(f, 0);
    f32x16 z;
#pragma unroll
    for (int r = 0; r < 16; ++r) z[r] = 0.f;
    st.o0 = MFMA32(f.v[0], p0, z); st.o0 = MFMA32(f.v[1], p1, st.o0);
    st.o1 = MFMA32(f.v[2], p0, z); st.o1 = MFMA32(f.v[3], p1, st.o1);
}
template <int WK = -1, int WV = -1>
DI void moba_tile_lazy(SmState& st, KV& f, const bf16x8 (&qf)[4], float bias0, float slopeL, int hh) {
    f32x16 acc;
    const float b0 = bias0 - st.m;
#pragma unroll
    for (int r = 0; r < 16; ++r) acc[r] = b0 + slopeL * (float)((r & 3) + 8 * (r >> 2));
    if constexpr (WK == 12) KV_WAIT_K(f, 12); else if constexpr (WK == 4) KV_WAIT_K(f, 4);
#pragma unroll
    for (int ks = 0; ks < 4; ++ks) acc = MFMA32(f.k[ks], qf[ks], acc);
    f32x16 pw;
#pragma unroll
    for (int r = 0; r < 16; ++r) pw[r] = __builtin_amdgcn_exp2f(acc[r]);
    float ps = sum16(pw);
    if (__builtin_expect(__any(!(ps <= LAZY_THR)), 0)) {
        const int nl = !(ps <= LAZY_THR);
        const bool need = (nl | __shfl_xor(nl, 32)) != 0;
        float tm = acc[0];
#pragma unroll
        for (int r = 1; r < 16; ++r) tm = fmaxf(tm, acc[r]);
        tm = fmaxf(tm, __shfl_xor(tm, 32));
        const float d = need ? tm : 0.f, al = __builtin_amdgcn_exp2f(-d);
        st.m += d; st.l *= al; st.o0 = st.o0 * al; st.o1 = st.o1 * al;
#pragma unroll
        for (int r = 0; r < 16; ++r) pw[r] = __builtin_amdgcn_exp2f(acc[r] - d);
        ps = sum16(pw);
    }
    st.l += ps;
    const bf16x8 p0 = pack8(pw, 0), p1 = pack8(pw, 1);
    if constexpr (WV == 8) KV_WAIT_V(f, 8); else if constexpr (WV == 0) KV_WAIT_V(f, 0);
    st.o0 = MFMA32(f.v[0], p0, st.o0); st.o0 = MFMA32(f.v[1], p1, st.o0);
    st.o1 = MFMA32(f.v[2], p0, st.o1); st.o1 = MFMA32(f.v[3], p1, st.o1);
}
DI void moba_pass_own(SmState& st, const bf16x8 (&qf)[4], const bf16_t* kt0, const bf16_t* vt0, int w, int maskrow, float bb, float slopeL, int hh) {
    KV fa, fb;
    const float bs = slopeL * 32.f;
    load_kv(fa, kt0 + (size_t)w * 2048, vt0 + (size_t)w * 2048);
    if (w >= 1) load_kv(fb, kt0 + (size_t)(w - 1) * 2048, vt0 + (size_t)(w - 1) * 2048);
    moba_tile_first(st, fa, qf, bb + (float)w * bs, slopeL, maskrow, hh);
#pragma unroll 1
    for (int kt = w - 1; kt >= 0; kt -= 2) {
        if (kt >= 1) load_kv(fa, kt0 + (size_t)(kt - 1) * 2048, vt0 + (size_t)(kt - 1) * 2048);
        moba_tile_lazy(st, fb, qf, bb + (float)kt * bs, slopeL, hh);
        if (kt >= 1) {
            if (kt >= 2) load_kv(fb, kt0 + (size_t)(kt - 2) * 2048, vt0 + (size_t)(kt - 2) * 2048);
            moba_tile_lazy(st, fa, qf, bb + (float)(kt - 1) * bs, slopeL, hh);
        }
    }
}
template <bool MASKED>
DI void sb_tile(f32x16& o0, f32x16& o1, float& carry, const KV& f, const bf16x8 (&qf)[4], int maskrow, int hh) {
    f32x16 acc;
#pragma unroll
    for (int r = 0; r < 16; ++r) acc[r] = 0.f;
#pragma unroll
    for (int ks = 0; ks < 4; ++ks) acc = MFMA32(f.k[ks], qf[ks], acc);
    float bt[16], fc[16];
#pragma unroll
    for (int r = 0; r < 16; ++r) {
        const float z = acc[r];
        const float e = __builtin_amdgcn_exp2f(-fabsf(z)), rr = __builtin_amdgcn_rcpf(1.f + e), er = e * rr;
        const bool pos = z >= 0.f, msk = MASKED && ((r & 3) + 8 * (r >> 2) + 4 * hh) >= maskrow;
        bt[r] = msk ? 0.f : (pos ? rr : er);
        fc[r] = msk ? 1.f : (pos ? er : rr);
    }
    float G[4], Gp[4], wf[16];
#pragma unroll
    for (int g = 0; g < 4; ++g) {
        const float s3 = fc[4 * g + 3], s2 = s3 * fc[4 * g + 2], s1 = s2 * fc[4 * g + 1];
        G[g] = s1 * fc[4 * g];
        wf[4 * g + 3] = bt[4 * g + 3]; wf[4 * g + 2] = bt[4 * g + 2] * s3; wf[4 * g + 1] = bt[4 * g + 1] * s2; wf[4 * g] = bt[4 * g] * s1;
    }
#pragma unroll
    for (int g = 0; g < 4; ++g) Gp[g] = __shfl_xor(G[g], 32);
    const float T0 = G[0] * Gp[0], T1 = G[1] * Gp[1], T2 = G[2] * Gp[2], T3 = G[3] * Gp[3];
    const float RR2 = T3, RR1 = T3 * T2, RR0 = RR1 * T1, total = RR0 * T0;
    float base[4];
    base[3] = carry * (hh == 0 ? Gp[3] : 1.f);
    base[2] = carry * RR2 * (hh == 0 ? Gp[2] : 1.f);
    base[1] = carry * RR1 * (hh == 0 ? Gp[1] : 1.f);
    base[0] = carry * RR0 * (hh == 0 ? Gp[0] : 1.f);
    f32x16 pw;
#pragma unroll
    for (int r = 0; r < 16; ++r) pw[r] = wf[r] * base[r >> 2];
    carry *= total;
    const bf16x8 p0 = pack8(pw, 0), p1 = pack8(pw, 1);
    o0 = MFMA32(f.v[0], p0, o0); o0 = MFMA32(f.v[1], p1, o0);
    o1 = MFMA32(f.v[2], p0, o1); o1 = MFMA32(f.v[3], p1, o1);
}
DI void store_o(bf16_t* orow  , const f32x16& o0, const f32x16& o1, float sc) {
#pragma unroll
    for (int g = 0; g < 4; ++g) {
        u32x2 a; a.x = cvtpk(o0[4 * g] * sc, o0[4 * g + 1] * sc); a.y = cvtpk(o0[4 * g + 2] * sc, o0[4 * g + 3] * sc); *(u32x2*)(orow + 8 * g) = a;
        u32x2 c; c.x = cvtpk(o1[4 * g] * sc, o1[4 * g + 1] * sc); c.y = cvtpk(o1[4 * g + 2] * sc, o1[4 * g + 3] * sc); *(u32x2*)(orow + 32 + 8 * g) = c;
    }
}
constexpr int ML_OPART = 0;
constexpr int ML_ML = 4 * 256 * 68 * 2;
constexpr int ML_LISTS = ML_ML + 4 * 256 * 2 * 4;
constexpr int ML_SELS = ML_LISTS + 32 * 256;
constexpr int ML_CNT = ML_SELS + 1024;
constexpr int ML_UST = ML_CNT + 128;
constexpr int ML_QCTR = ML_UST + 144;
constexpr int ML_ITEM = ML_QCTR + 16;
constexpr int ML_UJ = ML_ITEM + 16;
static_assert(ML_UJ + 64 <= LDS_BYTES - 16, "MoBA LDS map");
DI void top3_insert(float s, int b, float& v0, float& v1, float& v2, int& i0, int& i1, int& i2) {
    const bool g0 = s > v0, g1 = s > v1, g2 = s > v2;
    v2 = g1 ? v1 : (g2 ? s : v2); i2 = g1 ? i1 : (g2 ? b : i2);
    v1 = g0 ? v0 : (g1 ? s : v1); i1 = g0 ? i0 : (g1 ? b : i1);
    v0 = g0 ? s : v0; i0 = g0 ? b : i0;
}
DI int p3_order(int i) {
    constexpr unsigned long long W0 = 0x1918171612151413ull, W1 = 0x1d1c1e1b0b1f1a11ull, W2 = 0x08070d0e0f0c0a10ull, W3 = 0x0001020403050906ull;
    const unsigned long long w = (i >> 3) == 0 ? W0 : ((i >> 3) == 1 ? W1 : ((i >> 3) == 2 ? W2 : W3));
    return (int)((w >> (8 * (i & 7))) & 255ull);
}
DI void sb_group(const bf16_t* QK, const bf16_t* KF, const bf16_t* VT, bf16_t* OB, int b, int head, int qt) {
    const int tid = threadIdx.x, wave = tid >> 6; int lane = tid & 63;
    asm volatile("" : "+v"(lane));
    const int r = lane & 31, hh = lane >> 5;
    const bf16_t* kp = KF + (size_t)((1 * 2 + b) * NH + head) * 256 * 2048 + lane * 8;
    const bf16_t* vp = VT + (size_t)((1 * 2 + b) * NH + head) * 256 * 2048 + lane * 8;
    const int kt0 = 8 * qt + wave, t = 32 * kt0 + r;
    const bf16_t* qp = QK + (size_t)(b * SEQ + t) * 1024 + 512 + head * HD + 8 * hh;
    bf16x8 qf[4];
#pragma unroll
    for (int ks = 0; ks < 4; ++ks) qf[ks] = *(const bf16x8*)(qp + 16 * ks);
    f32x16 o0, o1;
#pragma unroll
    for (int x = 0; x < 16; ++x) { o0[x] = 0.f; o1[x] = 0.f; }
    float carry = 1.f;
    KV fa, fb;
    int kt = kt0;
    load_kv(fa, kp + (size_t)kt * 2048, vp + (size_t)kt * 2048);
    if (kt >= 1) load_kv(fb, kp + (size_t)(kt - 1) * 2048, vp + (size_t)(kt - 1) * 2048);
    asm volatile("" ::: "memory");
    sb_tile<true>(o0, o1, carry, fa, qf, r, hh);
    if (!(kt < 1 || __all(carry < FLT_MIN_))) {
        for (;;) {
            if (kt >= 2) load_kv(fa, kp + (size_t)(kt - 2) * 2048, vp + (size_t)(kt - 2) * 2048);
            asm volatile("" ::: "memory");
            sb_tile<false>(o0, o1, carry, fb, qf, 32, hh);
            if (kt < 2 || __all(carry < FLT_MIN_)) break;
            if (kt >= 3) load_kv(fb, kp + (size_t)(kt - 3) * 2048, vp + (size_t)(kt - 3) * 2048);
            asm volatile("" ::: "memory");
            sb_tile<false>(o0, o1, carry, fa, qf, 32, hh);
            if (kt < 3 || __all(carry < FLT_MIN_)) break;
            kt -= 2;
        }
    }
    store_o(OB + (size_t)(b * SEQ + t) * (2 * WA) + WA + head * HD + 4 * hh, o0, o1, 1.f);
}
DI void moba_group(unsigned char* lds, const bf16_t* QK, const bf16_t* KF, const bf16_t* VT, const float* KSUM, bf16_t* OA, int b, int head, int og, bool with_sb, unsigned* nextctr) {
    const int tid = threadIdx.x, wave = tid >> 6; int lane = tid & 63;
    asm volatile("" : "+v"(lane));
    const int r = lane & 31, hh = lane >> 5;
    bf16_t* OPART = (bf16_t*)(lds + ML_OPART); float* MLS = (float*)(lds + ML_ML); unsigned char* LISTS = lds + ML_LISTS; unsigned char* SELS = lds + ML_SELS;
    int* CNT = (int*)(lds + ML_CNT); int* UST = (int*)(lds + ML_UST);
    const float slopeL = 1.4426950408889634f * exp2f(-(float)(head + 1));
    const bf16_t* kp = KF + (size_t)((0 * 2 + b) * NH + head) * 256 * 2048 + lane * 8;
    const bf16_t* vp = VT + (size_t)((0 * 2 + b) * NH + head) * 256 * 2048 + lane * 8;
    const bf16_t* qbase = QK + (size_t)(b * SEQ) * 1024 + head * HD + 8 * hh;
    __syncthreads();
    unsigned nk = 0;
    if (tid == 0) nk = atomicAdd(nextctr, 1u);
    if (tid < 32) CNT[tid] = 0;
    __syncthreads();
    {
        const int c = 32 * wave + r;
        const bf16_t* qp = qbase + (size_t)(256 * og + c) * 1024;
        bf16x8 qf[4];
#pragma unroll
        for (int ks = 0; ks < 4; ++ks) qf[ks] = *(const bf16x8*)(qp + 16 * ks);
        f32x16 acc;
#pragma unroll
        for (int i = 0; i < 16; ++i) acc[i] = 0.f;
        const float* km = KSUM + ((size_t)(b * NH + head) * NBLK + r) * HD + 8 * hh;
#pragma unroll
        for (int ks = 0; ks < 4; ++ks) {
            const f32x4 s0 = *(const f32x4*)(km + 16 * ks) * (1.f / MBLK), s1 = *(const f32x4*)(km + 16 * ks + 4) * (1.f / MBLK);
            const float mv[8] = {s0.x, s0.y, s0.z, s0.w, s1.x, s1.y, s1.z, s1.w};
            unsigned hb[8], lb[8];
#pragma unroll
            for (int e = 0; e < 8; ++e) { hb[e] = f2bf(mv[e]); lb[e] = f2bf(mv[e] - bf2f(hb[e])); }
            const u32x4 hw = {hb[0] | (hb[1] << 16), hb[2] | (hb[3] << 16), hb[4] | (hb[5] << 16), hb[6] | (hb[7] << 16)};
            const u32x4 lw = {lb[0] | (lb[1] << 16), lb[2] | (lb[3] << 16), lb[4] | (lb[5] << 16), lb[6] | (lb[7] << 16)};
            acc = MFMA32(__builtin_bit_cast(bf16x8, hw), qf[ks], acc); acc = MFMA32(__builtin_bit_cast(bf16x8, lw), qf[ks], acc);
        }
        float v0 = -INFINITY, v1 = -INFINITY, v2 = -INFINITY; int i0 = -1, i1 = -1, i2 = -1;
#pragma unroll
        for (int i = 0; i < 16; ++i) { const int blk = (i & 3) + 8 * (i >> 2) + 4 * hh; const float sv = blk < og ? acc[i] : -INFINITY; top3_insert(sv, blk, v0, v1, v2, i0, i1, i2); }
        const float pv0 = __shfl_xor(v0, 32), pv1 = __shfl_xor(v1, 32), pv2 = __shfl_xor(v2, 32);
        const int pi0 = __shfl_xor(i0, 32), pi1 = __shfl_xor(i1, 32), pi2 = __shfl_xor(i2, 32);
        top3_insert(pv0, pi0, v0, v1, v2, i0, i1, i2); top3_insert(pv1, pi1, v0, v1, v2, i0, i1, i2); top3_insert(pv2, pi2, v0, v1, v2, i0, i1, i2);
        if (hh == 0) {
            SELS[c * 4 + 0] = (unsigned char)(i0 < 0 ? 255 : i0); SELS[c * 4 + 1] = (unsigned char)(i1 < 0 ? 255 : i1); SELS[c * 4 + 2] = (unsigned char)(i2 < 0 ? 255 : i2);
            if (i0 >= 0) { const int ps = atomicAdd(&CNT[i0], 1); LISTS[i0 * 256 + ps] = (unsigned char)c; }
            if (i1 >= 0) { const int ps = atomicAdd(&CNT[i1], 1); LISTS[i1 * 256 + ps] = (unsigned char)c; }
            if (i2 >= 0) { const int ps = atomicAdd(&CNT[i2], 1); LISTS[i2 * 256 + ps] = (unsigned char)c; }
        }
    }
    __syncthreads();
    if (wave == 0) {
        const int jx = lane & 31, n = (CNT[jx] + 31) >> 5;
        int inc = n;
#pragma unroll
        for (int o = 1; o < 32; o <<= 1) { const int v = __shfl_up(inc, o, 32); if (jx >= o) inc += v; }
        const int st0 = inc - n;
        if (lane < 32) {
            UST[jx] = st0;
            unsigned char* UJ = lds + ML_UJ;
            for (int q = 0; q < n; ++q) UJ[st0 + q] = (unsigned char)jx;
            if (jx == 31) UST[32] = inc;
        }
        if (lane == 0) { *(volatile int*)(lds + ML_QCTR) = 0; *(volatile int*)(lds + ML_ITEM) = (int)nk; }
    }
    __syncthreads();
    {
        const int Usel = UST[32], Utot = Usel + 8;
        int* qctr = (int*)(lds + ML_QCTR);
        int u = 0;
        if (lane == 0) u = atomicAdd(qctr, 1);
        u = __builtin_amdgcn_readfirstlane(u);
        const int sb_after = __builtin_amdgcn_readfirstlane(wave) >> 1;
        bool sb_done = !with_sb; int nun = 0;
        for (;;) {
            const bool have = u < Utot;
            if (!sb_done && (nun == sb_after || !have)) { sb_group(QK, KF, VT, OA, b, head, og); sb_done = true; }
            if (!have) break;
            ++nun;
            int un = 0;
            if (lane == 0) un = atomicAdd(qctr, 1);
            int j, slot, qi; bool valid;
            SmState st;
            if (u < Usel) {
                j = __builtin_amdgcn_readfirstlane((int)(lds + ML_UJ)[u]);
                const bf16_t* kt0 = kp + (size_t)(8 * j) * 2048; const bf16_t* vt0 = vp + (size_t)(8 * j) * 2048;
                KV fa, fb;
                load_kv_async(fa, kt0 + 7 * 2048, vt0 + 7 * 2048); load_kv_async(fb, kt0 + 6 * 2048, vt0 + 6 * 2048);
                const int i = u - UST[j], idx = 32 * i + r;
                valid = idx < CNT[j];
                qi = LISTS[j * 256 + (valid ? idx : 32 * i)];
                slot = (SELS[qi * 4] == j) ? 0 : ((SELS[qi * 4 + 1] == j) ? 1 : 2);
                const int t = 256 * og + qi;
                const bf16_t* qp = qbase + (size_t)t * 1024;
                bf16x8 qf[4];
#pragma unroll
                for (int ks = 0; ks < 4; ++ks) qf[ks] = *(const bf16x8*)(qp + 16 * ks);
                const float bb = slopeL * (float)(256 * j + 4 * hh - t), bs = slopeL * 32.f;
                moba_tile_first<12, 8>(st, fa, qf, bb + 7.f * bs, slopeL, 64, hh);   load_kv_async(fa, kt0 + 5 * 2048, vt0 + 5 * 2048);
                moba_tile_lazy<12, 8>(st, fb, qf, bb + 6.f * bs, slopeL, hh);        load_kv_async(fb, kt0 + 4 * 2048, vt0 + 4 * 2048);
                moba_tile_lazy<12, 8>(st, fa, qf, bb + 5.f * bs, slopeL, hh);        load_kv_async(fa, kt0 + 3 * 2048, vt0 + 3 * 2048);
                moba_tile_lazy<12, 8>(st, fb, qf, bb + 4.f * bs, slopeL, hh);        load_kv_async(fb, kt0 + 2 * 2048, vt0 + 2 * 2048);
                moba_tile_lazy<12, 8>(st, fa, qf, bb + 3.f * bs, slopeL, hh);        load_kv_async(fa, kt0 + 1 * 2048, vt0 + 1 * 2048);
                moba_tile_lazy<12, 8>(st, fb, qf, bb + 2.f * bs, slopeL, hh);        load_kv_async(fb, kt0, vt0);
                moba_tile_lazy<12, 8>(st, fa, qf, bb + bs, slopeL, hh);
                moba_tile_lazy<4, 0>(st, fb, qf, bb, slopeL, hh);
            } else {
                const int w = 7 - (u - Usel);
                j = og; qi = 32 * w + r; valid = true; slot = 3;
                const int t = 256 * og + qi;
                const bf16_t* qp = qbase + (size_t)t * 1024;
                bf16x8 qf[4];
#pragma unroll
                for (int ks = 0; ks < 4; ++ks) qf[ks] = *(const bf16x8*)(qp + 16 * ks);
                moba_pass_own(st, qf, kp + (size_t)(8 * og) * 2048, vp + (size_t)(8 * og) * 2048, w, r, slopeL * (float)(256 * og + 4 * hh - t), slopeL, hh);
            }
            const float lt = st.l + __shfl_xor(st.l, 32), inv = 1.f / lt;
            if (valid) {
                bf16_t* op = OPART + (size_t)(slot * 256 + qi) * 68 + 4 * hh;
#pragma unroll
                for (int g = 0; g < 4; ++g) {
                    u32x2 a; a.x = cvtpk(st.o0[4 * g] * inv, st.o0[4 * g + 1] * inv); a.y = cvtpk(st.o0[4 * g + 2] * inv, st.o0[4 * g + 3] * inv); *(u32x2*)(op + 8 * g) = a;
                    u32x2 c; c.x = cvtpk(st.o1[4 * g] * inv, st.o1[4 * g + 1] * inv); c.y = cvtpk(st.o1[4 * g + 2] * inv, st.o1[4 * g + 3] * inv); *(u32x2*)(op + 32 + 8 * g) = c;
                }
                if (hh == 0) { MLS[(slot * 256 + qi) * 2] = st.m; MLS[(slot * 256 + qi) * 2 + 1] = lt; }
            }
            u = __builtin_amdgcn_readfirstlane(un);
        }
    }
    __syncthreads();
    {
        const int c = 32 * wave + r, t = 256 * og + c;
        float M = -1e30f, ms[4], ls[4];
#pragma unroll
        for (int sl = 0; sl < 4; ++sl) {
            const bool v = sl == 3 || SELS[c * 4 + sl] != 255;
            ms[sl] = v ? MLS[(sl * 256 + c) * 2] : -1e30f; ls[sl] = v ? MLS[(sl * 256 + c) * 2 + 1] : 0.f;
            M = fmaxf(M, ms[sl]);
        }
        float L = 0.f; f32x16 o0, o1;
#pragma unroll
        for (int x = 0; x < 16; ++x) { o0[x] = 0.f; o1[x] = 0.f; }
#pragma unroll
        for (int sl = 0; sl < 4; ++sl) {
            const float w = ls[sl] * __builtin_amdgcn_exp2f(ms[sl] - M);
            L += w;
            const bf16_t* op = OPART + (size_t)(sl * 256 + c) * 68 + 4 * hh;
            if (ls[sl] > 0.f) {
#pragma unroll
                for (int g = 0; g < 4; ++g) {
                    const u32x2 a = *(const u32x2*)(op + 8 * g), cc = *(const u32x2*)(op + 32 + 8 * g);
                    o0[4 * g] += w * bflo(a.x); o0[4 * g + 1] += w * bfhi(a.x); o0[4 * g + 2] += w * bflo(a.y); o0[4 * g + 3] += w * bfhi(a.y);
                    o1[4 * g] += w * bflo(cc.x); o1[4 * g + 1] += w * bfhi(cc.x); o1[4 * g + 2] += w * bflo(cc.y); o1[4 * g + 3] += w * bfhi(cc.y);
                }
            }
        }
        store_o(OA + (size_t)(b * SEQ + t) * (2 * WA) + head * HD + 4 * hh, o0, o1, 1.f / L);
    }
}


#define CE(a, b) do { const unsigned lo_ = min(a, b), hi_ = max(a, b); a = lo_; b = hi_; } while (0)
DI void sort16_asc(unsigned (&k)[16]) {
    CE(k[0], k[1]); CE(k[2], k[3]); CE(k[0], k[2]); CE(k[1], k[3]); CE(k[1], k[2]); CE(k[4], k[5]); CE(k[6], k[7]); CE(k[4], k[6]); CE(k[5], k[7]); CE(k[5], k[6]);
    CE(k[0], k[4]); CE(k[2], k[6]); CE(k[2], k[4]); CE(k[1], k[5]); CE(k[3], k[7]); CE(k[3], k[5]); CE(k[1], k[2]); CE(k[3], k[4]); CE(k[5], k[6]); CE(k[8], k[9]);
    CE(k[10], k[11]); CE(k[8], k[10]); CE(k[9], k[11]); CE(k[9], k[10]); CE(k[12], k[13]); CE(k[14], k[15]); CE(k[12], k[14]); CE(k[13], k[15]); CE(k[13], k[14]);
    CE(k[8], k[12]); CE(k[10], k[14]); CE(k[10], k[12]); CE(k[9], k[13]); CE(k[11], k[15]); CE(k[11], k[13]); CE(k[9], k[10]); CE(k[11], k[12]); CE(k[13], k[14]);
    CE(k[0], k[8]); CE(k[4], k[12]); CE(k[4], k[8]); CE(k[2], k[10]); CE(k[6], k[14]); CE(k[6], k[10]); CE(k[2], k[4]); CE(k[6], k[8]); CE(k[10], k[12]);
    CE(k[1], k[9]); CE(k[5], k[13]); CE(k[5], k[9]); CE(k[3], k[11]); CE(k[7], k[15]); CE(k[7], k[11]); CE(k[3], k[5]); CE(k[7], k[9]); CE(k[11], k[13]);
    CE(k[1], k[2]); CE(k[3], k[4]); CE(k[5], k[6]); CE(k[7], k[8]); CE(k[9], k[10]); CE(k[11], k[12]); CE(k[13], k[14]);
}
DI void bitonic16_asc(unsigned (&k)[16]) {
    CE(k[0], k[8]); CE(k[1], k[9]); CE(k[2], k[10]); CE(k[3], k[11]); CE(k[4], k[12]); CE(k[5], k[13]); CE(k[6], k[14]); CE(k[7], k[15]); CE(k[0], k[4]);
    CE(k[1], k[5]); CE(k[2], k[6]); CE(k[3], k[7]); CE(k[8], k[12]); CE(k[9], k[13]); CE(k[10], k[14]); CE(k[11], k[15]); CE(k[0], k[2]); CE(k[1], k[3]);
    CE(k[4], k[6]); CE(k[5], k[7]); CE(k[8], k[10]); CE(k[9], k[11]); CE(k[12], k[14]); CE(k[13], k[15]); CE(k[0], k[1]); CE(k[2], k[3]); CE(k[4], k[5]);
    CE(k[6], k[7]); CE(k[8], k[9]); CE(k[10], k[11]); CE(k[12], k[13]); CE(k[14], k[15]);
}

DI unsigned fkey(float v, unsigned idx) { unsigned b = __float_as_uint(v); b = (b & 0x80000000u) ? ~b : (b | 0x80000000u); return (b & ~127u) | idx; }
DI float fkey_val(unsigned k) { unsigned b = k & ~127u; b = (b & 0x80000000u) ? (b & 0x7fffffffu) : ~b; return __uint_as_float(b); }
DI void top16_of_128(const f32x4 (&acc)[8], int g, unsigned (&t)[16]) {
    unsigned ka[16], kb[16];
#pragma unroll
    for (int ni = 0; ni < 4; ++ni)
#pragma unroll
        for (int j = 0; j < 4; ++j) { ka[4 * ni + j] = fkey(acc[ni][j], 16 * ni + 4 * g + j); kb[4 * ni + j] = fkey(acc[ni + 4][j], 16 * (ni + 4) + 4 * g + j); }
    sort16_asc(ka); sort16_asc(kb);
#pragma unroll
    for (int i = 0; i < 16; ++i) t[i] = max(ka[i], kb[15 - i]);
    bitonic16_asc(t);
#pragma unroll
    for (int xo = 16; xo <= 32; xo <<= 1) {
        unsigned pp[16];
#pragma unroll
        for (int i = 0; i < 16; ++i) pp[i] = (unsigned)__shfl_xor((int)t[i], xo);
#pragma unroll
        for (int i = 0; i < 16; ++i) t[i] = max(t[i], pp[15 - i]);
        bitonic16_asc(t);
    }
}

#define LAS __attribute__((address_space(3)))
#define XB_TMO      128
#define XB_XCNT(j)  (256  + 64 * (j))
#define XB_XSUB(j)  (1280 + 64 * (j))
#define XB_XGEN(j)  (2304 + 64 * (j))
#define XB_TOP      3328
#define XB_TOPGEN   3392
#define XCD_BAR_WORDS 3456
#define XB_SPIN_CAP (1u << 18)

__device__ __forceinline__ unsigned xb_ld(unsigned* p)              { return __hip_atomic_load(p, __ATOMIC_RELAXED, __HIP_MEMORY_SCOPE_AGENT); }
__device__ __forceinline__ unsigned xb_add(unsigned* p, unsigned v) { return __hip_atomic_fetch_add(p, v, __ATOMIC_RELAXED, __HIP_MEMORY_SCOPE_AGENT); }
__device__ __forceinline__ unsigned xb_xcc_id() { return (unsigned)__builtin_amdgcn_s_getreg((3 << 11) | 20) & 0xFu; }
#define XB_SPIN(cond, bar) do { unsigned _sp = 0; while (cond) { __builtin_amdgcn_s_sleep(1); \
    if ((++_sp & 255u) == 0u) { if (xb_ld(&(bar)[XB_TMO])) break; if (_sp > XB_SPIN_CAP) { atomicAdd(&(bar)[XB_TMO], 1u); break; } } } } while (0)

struct XcdBarrier {
    unsigned* bar; unsigned x;
    volatile LAS unsigned* st;
};

__device__ __forceinline__ XcdBarrier xcd_barrier_post(unsigned* bar, volatile LAS unsigned* st) {
    XcdBarrier b; b.bar = bar; b.x = xb_xcc_id(); b.st = st;
    if (threadIdx.x == 0) (void)xb_add(&bar[XB_XCNT(b.x)], 1u);
    return b;
}
__device__ __forceinline__ void xcd_barrier_complete(unsigned* bar, unsigned x, unsigned& nloc, unsigned& nx) {
    const unsigned G = gridDim.x * gridDim.y * gridDim.z;
    unsigned sum, cnt, mine, sp = 0u;
    for (;;) {
        sum = 0u; cnt = 0u; mine = 0u;
#pragma unroll
        for (unsigned j = 0; j < 16; ++j) { const unsigned c = xb_ld(&bar[XB_XCNT(j)]); sum += c; cnt += (c > 0u) ? 1u : 0u; mine = (j == x) ? c : mine; }
        if (sum == G) break;
        __builtin_amdgcn_s_sleep(1);
        if ((++sp & 255u) == 0u) { if (xb_ld(&bar[XB_TMO])) break; if (sp > XB_SPIN_CAP) { atomicAdd(&bar[XB_TMO], 1u); break; } }
    }
    nloc = mine > 0u ? mine : 1u; nx = cnt > 0u ? cnt : 1u;
}

__device__ __forceinline__ void xcd_barrier(const XcdBarrier& b) {
    asm volatile("s_waitcnt vmcnt(0)" ::: "memory");
    __syncthreads();
    if (threadIdx.x == 0) {
        unsigned* bar = b.bar;
        __builtin_amdgcn_s_waitcnt(0);
        unsigned nloc = b.st[0], nx = b.st[1];
        if (nloc == 0u) { xcd_barrier_complete(bar, b.x, nloc, nx); b.st[0] = nloc; b.st[1] = nx; }
        const unsigned old = xb_add(&bar[XB_XSUB(b.x)], 1u);
        const unsigned gen = old / nloc;
        if (old + 1u == (gen + 1u) * nloc) {
            __builtin_amdgcn_fence(__ATOMIC_RELEASE, "agent");
            asm volatile("s_waitcnt vmcnt(0)" ::: "memory");
            const unsigned og = xb_add(&bar[XB_TOP], 1u);
            const unsigned tg = og / nx;
            if (og + 1u == (tg + 1u) * nx) xb_add(&bar[XB_TOPGEN], 1u);
            else XB_SPIN(xb_ld(&bar[XB_TOPGEN]) == tg, bar);
            __builtin_amdgcn_fence(__ATOMIC_ACQUIRE, "agent");
            xb_add(&bar[XB_XGEN(b.x)], 1u);
            asm volatile("s_waitcnt vmcnt(0)" ::: "memory");
        } else {
            XB_SPIN(xb_ld(&bar[XB_XGEN(b.x)]) == gen, bar);
            __builtin_amdgcn_fence(__ATOMIC_ACQUIRE, "agent");
            asm volatile("s_waitcnt vmcnt(0)" ::: "memory");
        }
    }
    __syncthreads();
}


__global__ void __launch_bounds__(NTHREADS, 2) fwd_kernel(Params p) {
    extern __shared__ __attribute__((aligned(16))) unsigned char lds[];
    const int tid = threadIdx.x, lane = tid & 63, wave = tid >> 6;
    const int G = gridDim.x, bid = blockIdx.x;
    const long gtid = (long)bid * NTHREADS + tid, gth = (long)G * NTHREADS;
    const int gwave = bid * NWAVES + wave, ngw = G * NWAVES;
    unsigned char* ws = p.ws;
    bf16_t* WIN = (bf16_t*)(ws + WS_WIN); bf16_t* WOA = (bf16_t*)(ws + WS_WOA);
    bf16_t* WMIX = (bf16_t*)(ws + WS_WMIX); bf16_t* WQ = (bf16_t*)(ws + WS_WQ); bf16_t* SK = (bf16_t*)(ws + WS_SK);
    float* RS1 = (float*)(ws + WS_RS1); float* RS2 = (float*)(ws + WS_RS2);
    bf16_t* XB = (bf16_t*)(ws + WS_XB); bf16_t* OA = (bf16_t*)(ws + WS_OA);
    unsigned short* EIDX = (unsigned short*)(ws + WS_EIDX); float* GW = (float*)(ws + WS_GW);
    bf16_t* QK = (bf16_t*)(ws + WS_QK); bf16_t* KF = (bf16_t*)(ws + WS_KF); bf16_t* VT = (bf16_t*)(ws + WS_VT); bf16_t* MIXED = (bf16_t*)(ws + WS_MIXED); bf16_t* HB = (bf16_t*)(ws + WS_HB);
    bf16_t* GATES = (bf16_t*)(ws + WS_GATES); bf16_t* Q2 = (bf16_t*)(ws + WS_Q2);
    float* SU = (float*)(ws + WS_SU); float* SV = (float*)(ws + WS_SV); float* SSP = (float*)(ws + WS_SSP); float* SH = (float*)(ws + WS_SH);
    signed char* H8 = (signed char*)(ws + WS_H8); int* AP = (int*)(ws + WS_AP); unsigned char* U8 = ws + WS_U8; unsigned char* V8 = ws + WS_V8;
    unsigned* CTL = (unsigned*)(ws + WS_CTL); float* KSUM = (float*)(ws + WS_KSUM); float* SWMAX = (float*)(ws + WS_SWMAX); float* WSC = (float*)(ws + WS_WSC); signed char* WH = (signed char*)(ws + WS_WH); signed char* WL = (signed char*)(ws + WS_WL);
    volatile LAS unsigned* bst = (volatile LAS unsigned*)((LAS unsigned char*)lds + (LDS_BYTES - 16));
    if (tid < 4) bst[tid] = 0u;
    __syncthreads();
    const XcdBarrier xbar = xcd_barrier_post((unsigned*)(ws + WS_CTL) + 1024, bst);
    const int lo = p.ph_lo, hi = p.ph_hi;
#ifdef ONLY_PHASE
#define IN(k) ((k) == ONLY_PHASE && lo <= (k) && (k) < hi)
#else
#define IN(k) (lo <= (k) && (k) < hi)
#endif
#define SEAM(k) do { if (IN(k) && IN((k) + 1)) xcd_barrier(xbar); } while (0)

    for (int rep_ = 0; rep_ < (IN(0) ? 1 : 0); ++rep_) {
        for (int nb = bid; nb < INW / 32; nb += G) {
            float* scr = (float*)(lds + wave * (128 * 33 * 4));
            float* AMX = (float*)(lds + 8 * (128 * 33 * 4));
            const int n0 = 32 * nb, kw = 128 * wave;
            float am = 0.f;
            __syncthreads();
            {
#pragma unroll
                for (int hf = 0; hf < 2; ++hf) {
                    float wv[32], gv[32];
#pragma unroll
                    for (int i = 0; i < 32; ++i) { const int kk = 64 * hf + 2 * i + (lane >> 5); wv[i] = p.w_in[(size_t)(kw + kk) * INW + n0 + (lane & 31)]; gv[i] = p.g1[kw + kk]; }
#pragma unroll
                    for (int i = 0; i < 32; ++i) { const int kk = 64 * hf + 2 * i + (lane >> 5); const float v = wv[i] * gv[i]; scr[kk * 33 + (lane & 31)] = v; am = fmaxf(am, fabsf(v)); }
                }
            }
            am = fmaxf(am, __shfl_xor(am, 32));
            if (lane < 32) AMX[wave * 32 + lane] = am;
            __syncthreads();
            const int kc = lane & 15;
#pragma unroll
            for (int j = 0; j < 8; ++j) {
                const int n = (lane >> 4) + 4 * j;
                float cm = AMX[n];
#pragma unroll
                for (int w2 = 1; w2 < 8; ++w2) cm = fmaxf(cm, AMX[w2 * 32 + n]);
                const float isc = cm > 0.f ? 127.f / cm : 0.f;
                const float* sp = scr + (8 * kc) * 33 + n;
                unsigned lo, hi;
                lo = q8x4(sp[0], sp[33], sp[66], sp[99], isc); hi = q8x4(sp[4 * 33], sp[5 * 33], sp[6 * 33], sp[7 * 33], isc);
                *(u32x2*)((signed char*)WIN + (size_t)(n0 + n) * DM + kw + 8 * kc) = (u32x2){lo, hi};
                if (wave == 0 && kc == 0) SWMAX[n0 + n] = cm;
            }
        }
        __syncthreads();
        {
            float* scr = (float*)(lds + wave * 16384);
            constexpr int I_OA = (WA / 64) * (DM / 32), I_MIX = (DM / 64) * (DM / 32), I_Q = (DM / 64) * (PQW / 32);
            for (int it = gwave; it < 2 * I_OA + I_MIX + I_Q; it += ngw) {
                int r = it;
                if (r < I_OA) { transpose_item(p.w_oa, WA, DM, WOA, 2 * WA, 0, nullptr, scr, r, lane); continue; } r -= I_OA;
                if (r < I_OA) { transpose_item(p.w_ob, WA, DM, WOA, 2 * WA, WA, nullptr, scr, r, lane); continue; } r -= I_OA;
                if (r < I_MIX) { transpose_item(p.w_mix, DM, DM, WMIX, DM, 0, nullptr, scr, r, lane); continue; } r -= I_MIX;
                transpose_item(p.w_q, DM, PQW, WQ, DM, 0, p.g2, scr, r, lane);
            }
            for (long i = gtid; i < 16L * 128 * 128; i += gth) SK[i] = (bf16_t)f2bf(p.skeys[i]);
        }
        for (int row0 = gwave; row0 < T; row0 += 8 * ngw) {
            f32x4 xv[8][4];
#pragma unroll
            for (int k = 0; k < 8; ++k) {
                const int row = row0 + k * ngw;
                if (row < T) {
#pragma unroll
                    for (int j = 0; j < 4; ++j) xv[k][j] = ((const f32x4*)(p.x + (size_t)row * DM) + lane)[64 * j];
                }
            }
#pragma unroll
            for (int k = 0; k < 8; ++k) {
                const int row = row0 + k * ngw;
                if (row < T) {
                    float sq = 0.f, am = 0.f;
#pragma unroll
                    for (int j = 0; j < 4; ++j) { const f32x4 v = xv[k][j]; sq += v.x * v.x + v.y * v.y + v.z * v.z + v.w * v.w; am = fmaxf(fmaxf(am, fmaxf(fabsf(v.x), fabsf(v.y))), fmaxf(fabsf(v.z), fabsf(v.w))); }
                    sq = wave_sum(sq);
#pragma unroll
                    for (int o = 32; o >= 1; o >>= 1) am = fmaxf(am, __shfl_xor(am, o));
                    const float sc = am > 0.f ? am * (1.f / 127.f) : 1.f, isc = 1.f / sc;
                    unsigned* ob = (unsigned*)(XB + (size_t)row * (DM / 2)) + lane;
#pragma unroll
                    for (int j = 0; j < 4; ++j) { const f32x4 v = xv[k][j]; ob[64 * j] = q8x4(v.x, v.y, v.z, v.w, isc); }
                    if (lane == 0) RS1[row] = sc * rsqrtf(sq * (1.f / DM) + RMS_EPS);
                }
            }
        }
    }
    SEAM(0);

    for (int rep_ = 0; rep_ < (IN(1) ? (PROBE_REP == 1 ? 2 : 1) : 0); ++rep_) {
        pg8::Gemm gm{XB, WIN, T, INW, DM / 2}; pg8::StaticOrder S; S.init(T, INW, G, bid);
        EpiInProj E{QK, KF, VT, GATES, RS1, SWMAX, KSUM, rep_ == 0};
        pg8::gemm_phase<EpiInProj, pg8::StaticOrder, true, true>((PG8_LAS unsigned char*)lds, gm, S, E);
    }
    SEAM(1);

    for (int rep_ = 0; rep_ < (IN(3) ? (PROBE_REP == 3 ? 2 : 1) : 0); ++rep_) {
        {
            volatile int* ibox = (volatile int*)(lds + ML_ITEM);
            const unsigned xcc = (unsigned)__builtin_amdgcn_s_getreg((3 << 11) | 20) & 7u;
            unsigned* Q3 = CTL + 64 + (rep_ ? 8 : 0);
            int qx = (int)xcc;
            __syncthreads();
            if (tid == 0) ibox[0] = (int)atomicAdd(&Q3[qx], 1u);
            __syncthreads();
            for (;;) {
                int k = __builtin_amdgcn_readfirstlane(ibox[0]);
                if (k >= 64) {
                    __syncthreads();
                    if (wave == 0) {
                        unsigned v = 64u;
                        if (lane < 8) v = __hip_atomic_load(&Q3[(xcc + (unsigned)lane) & 7u], __ATOMIC_RELAXED, __HIP_MEMORY_SCOPE_AGENT);
                        const unsigned long long m = __ballot(v < 64u);
                        int nq = -1; unsigned nk = 64u;
                        if (m != 0ull) { nq = (int)((xcc + (unsigned)__builtin_ctzll(m)) & 7u); if (lane == 0) nk = atomicAdd(&Q3[nq], 1u); }
                        if (lane == 0) { ibox[0] = (int)nk; ibox[1] = nq; }
                    }
                    __syncthreads();
                    const int nq = __builtin_amdgcn_readfirstlane(ibox[1]);
                    if (nq < 0) break;
                    qx = nq;
                    continue;
                }
                const int oi = k >> 1;
                const int og = p3_order(oi), bh = 2 * qx + (k & 1);
                moba_group(lds, QK, KF, VT, KSUM, OA, bh >> 3, bh & 7, og, true, &Q3[qx]);
            }
        }
    }
    SEAM(3);

    for (int rep_ = 0; rep_ < (IN(4) ? 1 : 0); ++rep_) {
        pg8::Gemm gm{OA, WOA, T, DM, 2 * WA}; pg8::StaticOrder S; S.init(T, DM, G, bid);
        EpiMix E{GATES, MIXED};
        pg8::gemm_phase<EpiMix, pg8::StaticOrder, true, true, true>((PG8_LAS unsigned char*)lds, gm, S, E);
    }
    SEAM(4);

    for (int rep_ = 0; rep_ < (IN(5) ? (PROBE_REP == 5 ? 2 : 1) : 0); ++rep_) {
        pg8::Gemm gm{MIXED, WMIX, T, DM, DM}; pg8::StaticOrder S; S.init(T, DM, G, bid);
        EpiResid E{p.x, HB};
        pg8::gemm_phase<EpiResid, pg8::StaticOrder, true, true>((PG8_LAS unsigned char*)lds, gm, S, E);
    }
    SEAM(5);

    for (int rep_ = 0; rep_ < (IN(7) ? 1 : 0); ++rep_) {
        pg8::Gemm gm{HB, WQ, T, PQW, DM}; pg8::StaticOrder S; S.init(T, PQW, G, bid);
        EpiPeerQ E{Q2};
        pg8::gemm_phase<EpiPeerQ, pg8::StaticOrder, true, true>((PG8_LAS unsigned char*)lds, gm, S, E);
    }
    SEAM(7);

    for (int rep_ = 0; rep_ < (IN(8) ? (PROBE_REP == 8 ? 2 : 1) : 0); ++rep_) {
        bf16_t* Qs = (bf16_t*)lds;
        bf16_t* Ks = Qs + 128 * 264;
        unsigned* LST = (unsigned*)(lds + 128 * 264 * 2 + 2 * 128 * 136 * 2);
        int h_loaded = -1;
        __syncthreads();
        if (bid < (T / 128) * 8) {
            const int h0 = bid & 7, t00 = (bid >> 3) * 128;
#pragma unroll
            for (int i = 0; i < 8; ++i) { const int c = tid + i * NTHREADS, r = c >> 5, ch = c & 31; *(u32x4*)(Qs + r * 264 + ch * 8) = *(const u32x4*)(Q2 + (size_t)(t00 + r) * PQW + h0 * 256 + ch * 8); }
        }
        for (int it = bid; it < (T / 128) * 8; it += G) {
            const int h = it & 7, t0 = (it >> 3) * 128;
            if (h != h_loaded) {
#pragma unroll
                for (int i = 0; i < 8; ++i) {
                    const int c = tid + i * NTHREADS, r = c >> 4, ch = c & 15;
                    *(u32x4*)(Ks + r * 136 + ch * 8) = *(const u32x4*)(SK + (size_t)(2 * h * 128 + r) * 128 + ch * 8);
                }
                h_loaded = h;
            }
            __syncthreads();
#pragma unroll 1
            for (int ph = 0; ph < 2; ++ph) {
                f32x4 acc[8];
#pragma unroll
                for (int ni = 0; ni < 8; ++ni) acc[ni] = (f32x4){0.f, 0.f, 0.f, 0.f};
#pragma unroll
                for (int ks = 0; ks < 4; ++ks) {
                    const bf16x8 qf = *(const bf16x8*)(Qs + (wave * 16 + (lane & 15)) * 264 + ph * 128 + ks * 32 + (lane >> 4) * 8);
#pragma unroll
                    for (int ni = 0; ni < 8; ++ni) {
                        const bf16x8 kf = *(const bf16x8*)(Ks + (ph * 128 + ni * 16 + (lane & 15)) * 136 + ks * 32 + (lane >> 4) * 8);
                        acc[ni] = __builtin_amdgcn_mfma_f32_16x16x32_bf16(kf, qf, acc[ni], 0, 0, 0);
                    }
                }
                unsigned tk[16];
                top16_of_128(acc, lane >> 4, tk);
                if (lane < 16) {
                    unsigned* dst = LST + ((wave * 16 + lane) * 2 + ph) * 16;
#pragma unroll
                    for (int i = 0; i < 4; ++i) { u32x4 w; w.x = tk[15 - 4 * i]; w.y = tk[14 - 4 * i]; w.z = tk[13 - 4 * i]; w.w = tk[12 - 4 * i]; *(u32x4*)(dst + 4 * i) = w; }
                }
            }
            __syncthreads();
            if (tid >= 128 && it + G < (T / 128) * 8) {
                const int itn = it + G, hn = itn & 7, tn0 = (itn >> 3) * 128;
                for (int c = tid - 128; c < 128 * 32; c += NTHREADS - 128) { const int r = c >> 5, ch = c & 31; *(u32x4*)(Qs + r * 264 + ch * 8) = *(const u32x4*)(Q2 + (size_t)(tn0 + r) * PQW + hn * 256 + ch * 8); }
            }
            if (wave >= 6) quant_rows<8>(p.pu, p.pv, p.g2, U8, V8, SU, SV, it * 32 + 16 + (wave - 6) * 8, 1, lane);
            else if (wave >= 2) quant_rows<4>(p.pu, p.pv, p.g2, U8, V8, SU, SV, it * 32 + (wave - 2) * 4, 1, lane);
            if (tid >= 128 && tid < 384) h_rows4(HB, RS2, SH, H8, it * 16 + (wave - 2) * 4, 1, lane);
            if (tid < 128) {
                const unsigned* La = LST + (tid * 2) * 16; const unsigned* Lb = La + 16;
                float cand[16];
                const float b0 = fkey_val(Lb[0]);
#pragma unroll
                for (int i = 0; i < 4; ++i) { const u32x4 w = *(const u32x4*)(La + 4 * i); cand[4 * i] = fkey_val(w.x) + b0; cand[4 * i + 1] = fkey_val(w.y) + b0; cand[4 * i + 2] = fkey_val(w.z) + b0; cand[4 * i + 3] = fkey_val(w.w) + b0; }
                unsigned long long ptrs = 0ull;
                float selv[16]; unsigned sele[16];
#pragma unroll
                for (int r = 0; r < 16; ++r) {
                    float best = cand[0];
#pragma unroll
                    for (int i = 1; i < 16; ++i) best = fmaxf(best, cand[i]);
                    int istar = 15;
#pragma unroll
                    for (int i = 14; i >= 0; --i) istar = (cand[i] == best) ? i : istar;
                    const int j = (int)((ptrs >> (4 * istar)) & 15ull);
                    const unsigned ka = La[istar], kb = Lb[j];
                    selv[r] = best; sele[r] = (ka & 127u) * PNK + (kb & 127u);
                    const bool more = j < 15;
                    const float nc = more ? fkey_val(ka) + fkey_val(Lb[more ? j + 1 : j]) : -INFINITY;
                    if (more) ptrs += 1ull << (4 * istar);
#pragma unroll
                    for (int i = 0; i < 16; ++i) cand[i] = (i == istar) ? nc : cand[i];
                }
                float* go = GW + (size_t)(t0 + tid) * 128 + h * 16;
#pragma unroll
                for (int r = 0; r < 8; ++r) *(unsigned*)(EIDX + (size_t)(t0 + tid) * 128 + r * 16 + 2 * h) = sele[r] | (sele[r + 8] << 16);
#pragma unroll
                for (int i = 0; i < 4; ++i) *(f32x4*)(go + 4 * i) = (f32x4){selv[4 * i], selv[4 * i + 1], selv[4 * i + 2], selv[4 * i + 3]};
            }
        }
    }
    SEAM(8);

#define PEER_ID(ia, ib, i) ((((i) < 8 ? (ia) : (ib))[((i) & 7) >> 1] >> (((i) & 1) * 16)) & 0xffffu)
#define PEER_ROWS4(dst, base, ia, ib, m) do { _Pragma("unroll") for (int q_ = 0; q_ < 4; ++q_) dst[4 * (m) + q_] = *(const u32x4*)((base) + (unsigned)(PEER_ID(ia, ib, 4 * (m) + q_) * 128u + jp16)); } while (0)
#define PEER_IDS(ia, ib, t) do { const unsigned short* ep_ = EIDX + (size_t)(t) * 128; ia = *(const u32x4*)(ep_ + (unsigned)(g * 16)); ib = *(const u32x4*)(ep_ + (unsigned)(g * 16 + 8)); } while (0)
    for (int rep_ = 0; rep_ < (IN(9) ? (PROBE_REP == 9 ? 2 : 1) : 0); ++rep_) {
        volatile int* ubox = (volatile int*)lds;
        const unsigned xcc = (unsigned)__builtin_amdgcn_s_getreg((3 << 11) | 20) & 7u;
        int ln = lane; asm volatile("" : "+v"(ln));
        const int g = ln >> 3, jp = ln & 7;
        const bool b2 = (ln & 4) != 0, b1 = (ln & 2) != 0, b0 = (ln & 1) != 0;
        const int wv = __builtin_amdgcn_readfirstlane(wave); const unsigned jp16 = (unsigned)jp * 16u;
        constexpr int NTW = 32;
        int live = 0xff;
        for (int k8 = 0; k8 < 8; ++k8) {
            const int sl = (int)((xcc + k8) & 7u);
            if (k8 == 1) {
                __syncthreads();
                if (wave == 0) { unsigned v = 0xffffffffu; if (lane < 8) v = __hip_atomic_load(&CTL[(rep_ ? 32 : 0) + lane], __ATOMIC_RELAXED, __HIP_MEMORY_SCOPE_AGENT);
                    const unsigned long long m = __ballot(v < (unsigned)(T / (8 * NTW))); if (lane == 0) ubox[1] = (int)m; }
                __syncthreads();
                live = __builtin_amdgcn_readfirstlane(ubox[1]);
            }
            if (!((live >> sl) & 1)) continue;
            const unsigned char* U8s = U8 + (size_t)sl * NEXP * 128;
            for (;;) {
                __syncthreads();
                if (tid == 0) ubox[0] = (int)atomicAdd(&CTL[(rep_ ? 32 : 0) + sl], 1u);
                __syncthreads();
                const int u = __builtin_amdgcn_readfirstlane(ubox[0]);
                if (u >= T / (8 * NTW)) break;
                const int tb = u * (8 * NTW) + wv;
#define P1_HQ(hq, t) hq = *(const u32x4*)(H8 + (size_t)(t) * DM + sl * 128 + jp16)
#define P1_DOT4(d, rw, hq, m) do { _Pragma("unroll") for (int q_ = 0; q_ < 4; ++q_) { int x_ = __builtin_amdgcn_sdot4((int)hq.x, (int)rw[4 * (m) + q_].x, 0, false); x_ = __builtin_amdgcn_sdot4((int)hq.y, (int)rw[4 * (m) + q_].y, x_, false); \
        x_ = __builtin_amdgcn_sdot4((int)hq.z, (int)rw[4 * (m) + q_].z, x_, false); d[4 * (m) + q_] = __builtin_amdgcn_sdot4((int)hq.w, (int)rw[4 * (m) + q_].w, x_, false); } } while (0)
#define P1_FINISH(d_, t) do { int v8_[8], v4_[4]; \
    _Pragma("unroll") for (int i_ = 0; i_ < 8; ++i_) v8_[i_] = (b2 ? d_[8 + i_] : d_[i_]) + __shfl_xor(b2 ? d_[i_] : d_[8 + i_], 4); \
    _Pragma("unroll") for (int i_ = 0; i_ < 4; ++i_) v4_[i_] = (b1 ? v8_[4 + i_] : v8_[i_]) + __shfl_xor(b1 ? v8_[i_] : v8_[4 + i_], 2); \
    const int k0_ = (b0 ? v4_[2] : v4_[0]) + __shfl_xor(b0 ? v4_[0] : v4_[2], 1), k1_ = (b0 ? v4_[3] : v4_[1]) + __shfl_xor(b0 ? v4_[1] : v4_[3], 1); \
    int* ap_ = AP + ((size_t)sl * T + (t)) * 128 + 16 * jp + g; ap_[0] = k0_; ap_[8] = k1_; } while (0)
#define P1_STEP(rw, hq, ea, eb, i, REISSUE) do { int d_[16]; \
    _Pragma("unroll") for (int m_ = 0; m_ < 4; ++m_) { P1_DOT4(d_, rw, hq, m_); __builtin_amdgcn_sched_barrier(0); if (REISSUE) { PEER_ROWS4(rw, U8s, ea, eb, m_); __builtin_amdgcn_sched_barrier(0); } } \
    P1_FINISH(d_, tb + 8 * (i)); } while (0)
                u32x4 e0a, e0b, e1a, e1b, h0, h1, rwA[16], rwB[16];
                PEER_IDS(e0a, e0b, tb); PEER_IDS(e1a, e1b, tb + 8); P1_HQ(h0, tb);
#pragma unroll
                for (int m_ = 0; m_ < 4; ++m_) PEER_ROWS4(rwA, U8s, e0a, e0b, m_);
#pragma unroll
                for (int m_ = 0; m_ < 4; ++m_) PEER_ROWS4(rwB, U8s, e1a, e1b, m_);
                PEER_IDS(e0a, e0b, tb + 16);
#pragma unroll 1
                for (int i = 0; i < NTW - 2; i += 2) {
                    PEER_IDS(e1a, e1b, tb + 8 * (i + 3));
                    P1_HQ(h1, tb + 8 * (i + 1));
                    P1_STEP(rwA, h0, e0a, e0b, i, true);
                    { const int tn = tb + 8 * (i + 4 < NTW ? i + 4 : NTW - 1); PEER_IDS(e0a, e0b, tn); }
                    P1_HQ(h0, tb + 8 * (i + 2));
                    P1_STEP(rwB, h1, e1a, e1b, i + 1, true);
                }
                P1_HQ(h1, tb + 8 * (NTW - 1));
                P1_STEP(rwA, h0, e0a, e0b, NTW - 2, false);
                P1_STEP(rwB, h1, e1a, e1b, NTW - 1, false);
            }
        }
    }
    SEAM(9);

    for (int rep_ = 0; rep_ < (IN(10) ? (PROBE_REP == 10 ? 2 : 1) : 0); ++rep_) {
        for (int t = gwave; t < T; t += ngw) {
            int s0 = 0, s1 = 0;
#pragma unroll
            for (int q = 0; q < 8; ++q) { const int* ap = AP + ((size_t)q * T + t) * 128; s0 += ap[lane]; s1 += ap[64 + lane]; }
            const int p0 = (lane & 7) * 16 + (lane >> 3), p1 = p0 + 8;
            const int e0 = EIDX[(size_t)t * 128 + p0], e1 = EIDX[(size_t)t * 128 + p1];
            const float sc = SH[t] * RS2[t];
            const float a0 = (float)s0 * (sc * SU[e0]), a1 = (float)s1 * (sc * SU[e1]);
            const float rs2t = RS2[t];
            const float c0 = GW[(size_t)t * 128 + lane] * rs2t, c1 = GW[(size_t)t * 128 + 64 + lane] * rs2t;
            float m0 = c0, m1 = c1;
#pragma unroll
            for (int o = 8; o >= 1; o >>= 1) { m0 = fmaxf(m0, __shfl_xor(m0, o)); m1 = fmaxf(m1, __shfl_xor(m1, o)); }
            const float x0e = __expf(c0 - m0), x1e = __expf(c1 - m1);
            float z0 = x0e, z1 = x1e;
#pragma unroll
            for (int o = 8; o >= 1; o >>= 1) { z0 += __shfl_xor(z0, o); z1 += __shfl_xor(z1, o); }
            const float w0 = (x0e * __builtin_amdgcn_rcpf(z0)) * (0.5f * a0 * (1.f + erff(a0 * 0.70710678118654752f))) * SV[e0];
            const float w1 = (x1e * __builtin_amdgcn_rcpf(z1)) * (0.5f * a1 * (1.f + erff(a1 * 0.70710678118654752f))) * SV[e1];
            float wm = fmaxf(fabsf(w0), fabsf(w1));
#pragma unroll
            for (int o = 32; o >= 1; o >>= 1) wm = fmaxf(wm, __shfl_xor(wm, o));
            const float wsc = wm > 0.f ? wm * (1.f / 127.f) : 1.f, iw = 1.f / wsc;
            const float x0 = w0 * iw, x1 = w1 * iw;
            int h0 = (int)rintf(x0), h1 = (int)rintf(x1);
            h0 = h0 < -127 ? -127 : (h0 > 127 ? 127 : h0); h1 = h1 < -127 ? -127 : (h1 > 127 ? 127 : h1);
            WH[(size_t)t * 128 + p0] = (signed char)h0; WH[(size_t)t * 128 + p1] = (signed char)h1;
            if (lane == 0) WSC[t] = wsc;
        }
    }
    SEAM(10);

    for (int rep_ = 0; rep_ < (IN(11) ? (PROBE_REP == 11 ? 2 : 1) : 0); ++rep_) {
        const bool dry_ = (PROBE_REP == 11) && rep_ == 0;
        volatile int* ubox = (volatile int*)lds;
        const unsigned xcc = (unsigned)__builtin_amdgcn_s_getreg((3 << 11) | 20) & 7u;
        int ln = lane; asm volatile("" : "+v"(ln));
        const int g = ln >> 3, jp = ln & 7;
        const bool b5 = (ln & 32) != 0, b4 = (ln & 16) != 0, b3 = (ln & 8) != 0;
        const int wv = __builtin_amdgcn_readfirstlane(wave); const unsigned jp16 = (unsigned)jp * 16u;
        constexpr int NTW = 32;
        int live = 0xff;
        for (int k8 = 0; k8 < 8; ++k8) {
            const int sl = (int)((xcc + k8) & 7u);
            if (k8 == 1) {
                __syncthreads();
                if (wave == 0) { unsigned v = 0xffffffffu; if (lane < 8) v = __hip_atomic_load(&CTL[(dry_ ? 48 : 16) + lane], __ATOMIC_RELAXED, __HIP_MEMORY_SCOPE_AGENT);
                    const unsigned long long m = __ballot(v < (unsigned)(T / (8 * NTW))); if (lane == 0) ubox[1] = (int)m; }
                __syncthreads();
                live = __builtin_amdgcn_readfirstlane(ubox[1]);
            }
            if (!((live >> sl) & 1)) continue;
            const unsigned char* V8s = V8 + (size_t)sl * NEXP * 128;
            for (;;) {
                __syncthreads();
                if (tid == 0) ubox[0] = (int)atomicAdd(&CTL[(dry_ ? 48 : 16) + sl], 1u);
                __syncthreads();
                const int u = __builtin_amdgcn_readfirstlane(ubox[0]);
                if (u >= T / (8 * NTW)) break;
                const int tb = u * (8 * NTW) + wv;
#define P2_WM(wh, hv, wsc, t) do { wh = *(const u32x4*)(WH + (size_t)(t) * 128 + (unsigned)(g * 16)); { const unsigned hw_ = *(const unsigned*)(HB + (size_t)(t) * DM + sl * 128 + (unsigned)(jp * 16 + 2 * g)); hv = (f32x2_t){bflo(hw_), bfhi(hw_)}; } wsc = WSC[t]; } while (0)
#define P2_COL(rw, wh, ah, c, cb, m) do { const unsigned t0_ = __builtin_amdgcn_perm(rw[4 * (m) + 1].c, rw[4 * (m)].c, 0x05010400u), t1_ = __builtin_amdgcn_perm(rw[4 * (m) + 3].c, rw[4 * (m) + 2].c, 0x05010400u); \
    const unsigned t2_ = __builtin_amdgcn_perm(rw[4 * (m) + 1].c, rw[4 * (m)].c, 0x07030602u), t3_ = __builtin_amdgcn_perm(rw[4 * (m) + 3].c, rw[4 * (m) + 2].c, 0x07030602u); \
    ah[(cb) + 0] = __builtin_amdgcn_sdot4((int)__builtin_amdgcn_perm(t1_, t0_, 0x05040100u), (int)wh[m], ah[(cb) + 0], false); ah[(cb) + 1] = __builtin_amdgcn_sdot4((int)__builtin_amdgcn_perm(t1_, t0_, 0x07060302u), (int)wh[m], ah[(cb) + 1], false); \
    ah[(cb) + 2] = __builtin_amdgcn_sdot4((int)__builtin_amdgcn_perm(t3_, t2_, 0x05040100u), (int)wh[m], ah[(cb) + 2], false); ah[(cb) + 3] = __builtin_amdgcn_sdot4((int)__builtin_amdgcn_perm(t3_, t2_, 0x07060302u), (int)wh[m], ah[(cb) + 3], false); } while (0)
#define P2_FINISH(d_, hv, wsc, t) do { int v8_[8], v4_[4]; \
    _Pragma("unroll") for (int i_ = 0; i_ < 8; ++i_) v8_[i_] = (b5 ? d_[8 + i_] : d_[i_]) + __shfl_xor(b5 ? d_[i_] : d_[8 + i_], 32); \
    _Pragma("unroll") for (int i_ = 0; i_ < 4; ++i_) v4_[i_] = (b4 ? v8_[4 + i_] : v8_[i_]) + __shfl_xor(b4 ? v8_[i_] : v8_[4 + i_], 16); \
    const int k0_ = (b3 ? v4_[2] : v4_[0]) + __shfl_xor(b3 ? v4_[0] : v4_[2], 8), k1_ = (b3 ? v4_[3] : v4_[1]) + __shfl_xor(b3 ? v4_[1] : v4_[3], 8); \
    bf16_t* orow_ = MIXED + (size_t)(t) * DM + sl * 128 + jp * 16 + 2 * g;     \
    const unsigned ob_ = cvtpk((hv).x + (float)k0_ * (wsc), (hv).y + (float)k1_ * (wsc)); const float o0_ = bflo(ob_), o1_ = bfhi(ob_); \
    if (!dry_) *(unsigned*)orow_ = ob_; \
    const float ss_ = wave_sum(o0_ * o0_ + o1_ * o1_); if (ln == 0 && !dry_) SSP[(size_t)(t) * 8 + sl] = ss_; asm volatile("" :: "v"(ss_)); } while (0)
#define P2_STEP(rw, wh, hv, wsc, ea, eb, i, REISSUE) do { int d_[16]; _Pragma("unroll") for (int i_ = 0; i_ < 16; ++i_) d_[i_] = 0; \
    _Pragma("unroll") for (int m_ = 0; m_ < 4; ++m_) { P2_COL(rw, wh, d_, x, 0, m_); P2_COL(rw, wh, d_, y, 4, m_); P2_COL(rw, wh, d_, z, 8, m_); P2_COL(rw, wh, d_, w, 12, m_); __builtin_amdgcn_sched_barrier(0); \
        if (REISSUE) { PEER_ROWS4(rw, V8s, ea, eb, m_); __builtin_amdgcn_sched_barrier(0); } } \
    P2_FINISH(d_, hv, wsc, tb + 8 * (i)); } while (0)
                u32x4 e0a, e0b, e1a, e1b, w0, w1, rwA[16], rwB[16]; f32x2_t hv0, hv1; float ws0, ws1;
                PEER_IDS(e0a, e0b, tb); PEER_IDS(e1a, e1b, tb + 8); P2_WM(w0, hv0, ws0, tb);
#pragma unroll
                for (int m_ = 0; m_ < 4; ++m_) PEER_ROWS4(rwA, V8s, e0a, e0b, m_);
#pragma unroll
                for (int m_ = 0; m_ < 4; ++m_) PEER_ROWS4(rwB, V8s, e1a, e1b, m_);
                PEER_IDS(e0a, e0b, tb + 16);
#pragma unroll 1
                for (int i = 0; i < NTW - 2; i += 2) {
                    PEER_IDS(e1a, e1b, tb + 8 * (i + 3));
                    P2_WM(w1, hv1, ws1, tb + 8 * (i + 1));
                    P2_STEP(rwA, w0, hv0, ws0, e0a, e0b, i, true);
                    { const int tn = tb + 8 * (i + 4 < NTW ? i + 4 : NTW - 1); PEER_IDS(e0a, e0b, tn); }
                    P2_WM(w0, hv0, ws0, tb + 8 * (i + 2));
                    P2_STEP(rwB, w1, hv1, ws1, e1a, e1b, i + 1, true);
                }
                P2_WM(w1, hv1, ws1, tb + 8 * (NTW - 1));
                P2_STEP(rwA, w0, hv0, ws0, e0a, e0b, NTW - 2, false);
                P2_STEP(rwB, w1, hv1, ws1, e1a, e1b, NTW - 1, false);
            }
        }
    }
    SEAM(11);

    for (int rep_ = 0; rep_ < (IN(12) ? 1 : 0); ++rep_) {
        for (int row = gwave; row < T; row += ngw) {
            float tot = 0.f;
#pragma unroll
            for (int q = 0; q < 8; ++q) tot += SSP[(size_t)row * 8 + q];
            const float rs = rsqrtf(tot * (1.f / DM) + RMS_EPS);
            f32x4* orow = (f32x4*)(p.out + (size_t)row * DM) + lane; const u32x2* ob = (const u32x2*)(MIXED + (size_t)row * DM) + lane;
#pragma unroll
            for (int j = 0; j < 4; ++j) { const f32x4 gv = ((const f32x4*)p.gf)[lane + 64 * j]; const u32x2 w = ob[64 * j]; orow[64 * j] = (f32x4){bflo(w.x), bfhi(w.x), bflo(w.y), bfhi(w.y)} * rs * gv; }
        }
    }
#undef IN
#undef SEAM
}

extern "C" void kernel_launch(void* const* d_in, const int* in_sizes, int n_in, void* d_out, int out_size, void* d_ws, size_t ws_size, hipStream_t stream) {
    static int grid = 0;
    if (grid == 0) {
        int dev = 0, cus = 0, per_cu = 0;
        (void)hipGetDevice(&dev);
        (void)hipDeviceGetAttribute(&cus, hipDeviceAttributeMultiprocessorCount, dev);
        (void)hipFuncSetAttribute((const void*)fwd_kernel, hipFuncAttributeMaxDynamicSharedMemorySize, LDS_BYTES);
        (void)hipOccupancyMaxActiveBlocksPerMultiprocessor(&per_cu, (const void*)fwd_kernel, NTHREADS, LDS_BYTES);
        if (per_cu < 1) { fprintf(stderr, "kernel_launch: occupancy query says %d blocks per CU\n", per_cu); per_cu = 1; }
        grid = cus * 1;
        if (ws_size < WS_END) { fprintf(stderr, "kernel_launch: workspace too small: %zu < %zu\n", ws_size, (size_t)WS_END); grid = -1; }
    }
    if (grid < 0) return;
    Params p{};
    p.x = (const float*)d_in[0]; p.g1 = (const float*)d_in[1]; p.w_in = (const float*)d_in[2]; p.w_oa = (const float*)d_in[3]; p.w_ob = (const float*)d_in[4];
    p.w_mix = (const float*)d_in[5]; p.g2 = (const float*)d_in[6]; p.w_q = (const float*)d_in[7]; p.skeys = (const float*)d_in[8]; p.pu = (const float*)d_in[9];
    p.pv = (const float*)d_in[10]; p.gf = (const float*)d_in[11]; p.out = (float*)d_out; p.ws = (unsigned char*)d_ws;
    p.ph_lo = 0; p.ph_hi = 13;
    if (hipMemsetAsync((char*)d_ws + WS_CTL, 0, 65536 + 131072 + 32768, stream) != hipSuccess) { fprintf(stderr, "kernel_launch: hipMemsetAsync failed\n"); return; }
    hipLaunchKernelGGL(fwd_kernel, dim3(grid), dim3(NTHREADS), LDS_BYTES, stream, p);
}
```

```cpp
#include <hip/hip_runtime.h>
#include <cstdio>
#include <cstdint>

#define DI __device__ __forceinline__
typedef unsigned short bf16_t;
typedef short bf16x8 __attribute__((ext_vector_type(8)));
typedef float f32x4 __attribute__((ext_vector_type(4)));
typedef unsigned u32x4 __attribute__((ext_vector_type(4)));
typedef unsigned u32x2 __attribute__((ext_vector_type(2)));

constexpr int NBATCH = 2, SEQ = 8192, T = NBATCH * SEQ, DM = 1024;
constexpr int NH = 8, HD = 64, WA = 512;
constexpr int INW = 5120, QKVW = 3072, GATEW = 2048;
constexpr int MBLK = 256, NBLK = SEQ / MBLK;
constexpr int PNK = 128, PTOPK = 16, NEXP = 16384, PQW = 2048;
constexpr float RMS_EPS = 1e-6f;
constexpr int NTHREADS = 512, NWAVES = 8;
static_assert((T / 128) * 8 * 32 == 2 * NEXP && (T / 128) * 8 * 16 == T, "P8 side work: 32 expert rows and 16 h rows per item cover all rows");
constexpr int LDS_BYTES = 163840;
#ifndef PROBE_REP
#define PROBE_REP -1
#endif

constexpr size_t MiB = 1u << 20;
constexpr size_t WS_CTL = 0;
constexpr size_t WS_KSUM = 65536;
constexpr size_t WS_SWMAX = 196608;
constexpr size_t WS_WIN = 1 * MiB;
constexpr size_t WS_WOA = 11 * MiB;
constexpr size_t WS_WMIX = 13 * MiB;
constexpr size_t WS_WQ = 15 * MiB;
constexpr size_t WS_SK = 19 * MiB;
constexpr size_t WS_RS1 = 19 * MiB + 512 * 1024;
constexpr size_t WS_RS2 = WS_RS1 + 65536;
constexpr size_t WS_XB = 24 * MiB;
constexpr size_t WS_OA = 24 * MiB;
constexpr size_t WS_EIDX = 24 * MiB;
constexpr size_t WS_GW = 28 * MiB;
constexpr size_t WS_QK = 56 * MiB;
constexpr size_t WS_KF = 88 * MiB;
constexpr size_t WS_VT = 120 * MiB;
constexpr size_t WS_MIXED = 56 * MiB;
constexpr size_t WS_HB = 88 * MiB;
constexpr size_t WS_GATES = 152 * MiB;
constexpr size_t WS_Q2 = 152 * MiB;
constexpr size_t WS_SU = 20 * MiB;
constexpr size_t WS_SV = WS_SU + 65536;
constexpr size_t WS_SSP = 36 * MiB;
constexpr size_t WS_SH = WS_SSP + 524288;
constexpr size_t WS_WSC = WS_SH + 65536;
constexpr size_t WS_WH = 37 * MiB;
constexpr size_t WS_WL = 39 * MiB;
constexpr size_t WS_H8 = 40 * MiB;
constexpr size_t WS_AP = 152 * MiB;
constexpr size_t WS_U8 = 216 * MiB;
constexpr size_t WS_V8 = 232 * MiB;
constexpr size_t WS_END = 248 * MiB;

struct Params {
    const float *x, *g1, *w_in, *w_oa, *w_ob, *w_mix, *g2, *w_q, *skeys, *pu, *pv, *gf;
    float* out; unsigned char* ws; int ph_lo, ph_hi;
};

DI unsigned f2bf(float f) { unsigned u = __float_as_uint(f); return (u + 0x7fffu + ((u >> 16) & 1u)) >> 16; }
DI float bf2f(unsigned h) { return __uint_as_float(h << 16); }
DI float bflo(unsigned w) { return __uint_as_float(w << 16); }
DI float bfhi(unsigned w) { return __uint_as_float(w & 0xffff0000u); }
typedef __bf16 bf16x2_t __attribute__((ext_vector_type(2)));
typedef float f32x2_t __attribute__((ext_vector_type(2)));
DI unsigned cvtpk(float lo, float hi) { f32x2_t v = {lo, hi}; bf16x2_t b = __builtin_convertvector(v, bf16x2_t); return __builtin_bit_cast(unsigned, b); }
DI unsigned pk2(float lo, float hi) { return cvtpk(lo, hi); }
DI unsigned q8x4(float a, float b, float c, float d, float isc) {
    const float M = 12582912.f;
    const unsigned fa = __float_as_uint(fmaf(a, isc, M)), fb = __float_as_uint(fmaf(b, isc, M)), fc = __float_as_uint(fmaf(c, isc, M)), fd = __float_as_uint(fmaf(d, isc, M));
    return __builtin_amdgcn_perm(fb, fa, 0x0c0c0400u) | __builtin_amdgcn_perm(fd, fc, 0x04000c0cu);
}
DI float wave_sum(float v) {
#pragma unroll
    for (int o = 32; o >= 1; o >>= 1) v += __shfl_xor(v, o);
    return v;
}
DI void load_row64(const bf16_t* p, float* o) {
#pragma unroll
    for (int i = 0; i < 8; ++i) {
        u32x4 w = *(const u32x4*)(p + 8 * i);
        o[8 * i + 0] = bflo(w.x); o[8 * i + 1] = bfhi(w.x); o[8 * i + 2] = bflo(w.y); o[8 * i + 3] = bfhi(w.y);
        o[8 * i + 4] = bflo(w.z); o[8 * i + 5] = bfhi(w.z); o[8 * i + 6] = bflo(w.w); o[8 * i + 7] = bfhi(w.w);
    }
}
DI float sigmoidf_(float x) { return __builtin_amdgcn_rcpf(1.f + __builtin_amdgcn_exp2f(x * -1.4426950408889634f)); }

DI void transpose_item(const float* W, int K, int N, bf16_t* WT, int ldk, int koff, const float* ks, float* scr, int item, int lane) {
    const int nblk = N / 32, kb = item / nblk, nb = item % nblk, k0 = 64 * kb, n0 = 32 * nb;
    float tv[32];
#pragma unroll
    for (int i = 0; i < 32; ++i) tv[i] = W[(size_t)(k0 + 2 * i + (lane >> 5)) * N + n0 + (lane & 31)];
    if (ks) {
#pragma unroll
        for (int i = 0; i < 32; ++i) tv[i] *= ks[k0 + 2 * i + (lane >> 5)];
    }
#pragma unroll
    for (int i = 0; i < 32; ++i) scr[(2 * i + (lane >> 5)) * 33 + (lane & 31)] = tv[i];
    asm volatile("s_waitcnt lgkmcnt(0)" ::: "memory");
    const int c = lane & 7;
#pragma unroll
    for (int j = 0; j < 4; ++j) { const int n = (lane >> 3) + 8 * j; const float* sp = scr + (8 * c) * 33 + n;
        u32x4 o; o.x = pk2(sp[0 * 33], sp[1 * 33]); o.y = pk2(sp[2 * 33], sp[3 * 33]); o.z = pk2(sp[4 * 33], sp[5 * 33]); o.w = pk2(sp[6 * 33], sp[7 * 33]);
        *(u32x4*)(WT + (size_t)(n0 + n) * ldk + koff + k0 + 8 * c) = o; }
    asm volatile("s_waitcnt lgkmcnt(0)" ::: "memory");
}

namespace pg8 {
#define PG8_LAS __attribute__((address_space(3)))
typedef unsigned short bf16_t;
typedef short bf16x8 __attribute__((ext_vector_type(8)));
typedef float f32x4 __attribute__((ext_vector_type(4)));
typedef int i32x4 __attribute__((ext_vector_type(4)));
typedef unsigned u32x4 __attribute__((ext_vector_type(4)));
template <bool I8> struct AccT { typedef f32x4 type; };
template <> struct AccT<true> { typedef i32x4 type; };
constexpr int BM = 256, BK = 64, HALF = 128, HTB = HALF * BK * 2  , STAGE_BYTES = 8 * HTB, NXCD = 8, WGM = 8;

__host__ __device__ __forceinline__ int lds_byte(int r, int c) { const int st = (r >> 4) * 2 + (c >> 5), rr = r & 15, cc = c & 31, ob = rr * 64 + cc * 2; return st * 1024 + (ob ^ (((ob >> 9) & 1) << 5)); }
__host__ __device__ __forceinline__ void stage_rc(int b, int& R, int& C) { const int st = b / 1024, sb = b % 1024, swz = sb ^ (((sb >> 9) & 1) << 5); R = (st >> 1) * 16 + swz / 64; C = (st & 1) * 32 + (swz % 64) / 2; }
__host__ __device__ __forceinline__ int perm32(int rho) { const int n = rho >> 4, i = rho & 15; return 8 * (i >> 2) + 4 * n + (i & 3); }

struct Unit { int pm, pn; };
struct Gemm { const bf16_t* A; const bf16_t* Bt; int M, N, K; };

struct StaticOrder {
    int nM, nN, nwg, G, c;
    __host__ __device__ void init(int M, int N, int G_, int c_) { nM = M / BM; nN = N / BM; nwg = nM * nN; G = G_; c = c_; }
    __host__ __device__ bool next(int i, Unit& u) const {
        const long L = (long)i * G + c; if (L >= nwg) return false;
        int wgid = (int)L; { const int q = nwg / NXCD, r = nwg % NXCD, xcd = wgid % NXCD, off = wgid / NXCD; wgid = (xcd < r ? xcd * (q + 1) : r * (q + 1) + (xcd - r) * q) + off; }
        const int nig = WGM * nN, gid = wgid / nig, fm = gid * WGM, gsz = (nM - fm) < WGM ? (nM - fm) : WGM;
        u.pm = fm + ((wgid % nig) % gsz); u.pn = (wgid % nig) / gsz; return true;
    }
    __device__ __forceinline__ void a_ready(const Unit&) const {}
    __device__ __forceinline__ void done(const Unit&) const {}
};
__device__ __forceinline__ unsigned cvt_pk_bf16(float lo, float hi) { unsigned r; asm volatile("v_cvt_pk_bf16_f32 %0, %1, %2" : "=v"(r) : "v"(lo), "v"(hi)); return r; }
template <class Epi, class Sched, bool ALIGN_EPI = false, bool SP2 = false, bool MIDK = false>
__device__ __forceinline__ void gemm_phase(PG8_LAS unsigned char* lds, const Gemm g, const Sched& S, const Epi& E) {
    const int tid = threadIdx.x, wid = __builtin_amdgcn_readfirstlane(tid >> 6), lane = tid & 63, wr = wid >> 2, wc = wid & 3, fr = lane & 15, fq = lane >> 4;
    const int K = g.K, nt = K / BK;
    unsigned voffA[2], voffB[2];
#pragma unroll
    for (int i = 0; i < 2; ++i) { int R, C; stage_rc(tid * 16 + i * 8192, R, C); const int Rb = Epi::PERM ? ((R & ~31) + perm32(R & 31)) : R;
        voffA[i] = (unsigned)(R * K + C) * 2u; voffB[i] = (unsigned)(Rb * K + C) * 2u; }
    const size_t kstep = (size_t)(BK * 2);
    const size_t hstep = (size_t)HALF * K * 2;
    const size_t tstep = 2 * hstep;
    const unsigned ldsw = (unsigned)wid * 1024u;
    const int aoff = lds_byte(wr * 64 + fr, fq * 8), boff = lds_byte(wc * 32 + fr, fq * 8);
#define PG8_SA(b, h) (((b) * 2 + (h)) * HTB)
#define PG8_SB(b, h) ((4 + (b) * 2 + (h)) * HTB)
#define PG8_STAGE(bufoff, gbase, voff) do { _Pragma("unroll") for (int _i = 0; _i < 2; ++_i) \
        __builtin_amdgcn_global_load_lds((const unsigned*)((const char*)(gbase) + (voff)[_i]), (PG8_LAS unsigned*)(lds + (bufoff) + ldsw + _i * 8192), 16, 0, 0); } while (0)
#define PG8_LDA(dst, b, h) do { _Pragma("unroll") for (int m = 0; m < 4; ++m) _Pragma("unroll") for (int k = 0; k < 2; ++k) dst[m][k] = *(const PG8_LAS bf16x8*)(lds + PG8_SA(b, h) + aoff + m * 2048 + k * 1024); } while (0)
#define PG8_LDB(dst, b, h) do { _Pragma("unroll") for (int n = 0; n < 2; ++n) _Pragma("unroll") for (int k = 0; k < 2; ++k) dst[n][k] = *(const PG8_LAS bf16x8*)(lds + PG8_SB(b, h) + boff + n * 2048 + k * 1024); } while (0)
#define PG8_MMA(ai, bj, At, Bt) do { __builtin_amdgcn_s_setprio(1); _Pragma("unroll") for (int m = 0; m < 4; ++m) _Pragma("unroll") for (int n = 0; n < 2; ++n) _Pragma("unroll") for (int k = 0; k < 2; ++k) \
        { if constexpr (Epi::I8) acc[ai][bj][m][n] = __builtin_amdgcn_mfma_i32_16x16x64_i8(__builtin_bit_cast(i32x4, Bt[n][k]), __builtin_bit_cast(i32x4, At[m][k]), acc[ai][bj][m][n], 0, 0, 0); \
          else acc[ai][bj][m][n] = __builtin_amdgcn_mfma_f32_16x16x32_bf16(Bt[n][k], At[m][k], acc[ai][bj][m][n], 0, 0, 0); } __builtin_amdgcn_s_setprio(0); } while (0)
#define PG8_WAIT_V(n) asm volatile("s_waitcnt vmcnt(" #n ")" ::: "memory")
#define PG8_WAIT_L(n) asm volatile("s_waitcnt lgkmcnt(" #n ")" ::: "memory")
#define PG8_BAR __builtin_amdgcn_s_barrier()
#define PG8_SCHED __builtin_amdgcn_sched_barrier(0)
    Unit cur, nxt; int ui = 0;
    if (!S.next(0, cur)) return;
    typedef typename AccT<Epi::I8>::type acc_t;
    acc_t acc[2][2][4][2];
    if constexpr (Epi::HAS_INIT) E.init(acc, cur, wr, wc, fr, fq);
    else {
#pragma unroll
    for (int a = 0; a < 2; ++a)
#pragma unroll
        for (int b = 0; b < 2; ++b)
#pragma unroll
            for (int m = 0; m < 4; ++m)
#pragma unroll
                for (int n = 0; n < 2; ++n) acc[a][b][m][n] = acc_t{};
    }
    bf16x8 At[4][2], B0[2][2], B1[2][2];
    const char* cA = (const char*)g.A + (size_t)cur.pm * tstep; const char* cB = (const char*)g.Bt + (size_t)cur.pn * tstep;
    S.a_ready(cur);
    if constexpr (SP2) {
        PG8_STAGE(PG8_SB(0, 0), cB, voffB); PG8_STAGE(PG8_SB(0, 1), cB + hstep, voffB); PG8_STAGE(PG8_SA(0, 0), cA, voffA); PG8_STAGE(PG8_SA(0, 1), cA + hstep, voffA);
        if (wr == 1) PG8_BAR;
        PG8_WAIT_V(2); PG8_BAR;
        PG8_STAGE(PG8_SB(1, 0), cB + kstep, voffB); PG8_STAGE(PG8_SA(1, 0), cA + kstep, voffA); PG8_STAGE(PG8_SB(1, 1), cB + hstep + kstep, voffB);
        PG8_WAIT_V(6); PG8_BAR;
    } else {
        PG8_STAGE(PG8_SB(0, 0), cB, voffB); PG8_STAGE(PG8_SA(0, 0), cA, voffA); PG8_STAGE(PG8_SB(0, 1), cB + hstep, voffB); PG8_STAGE(PG8_SA(0, 1), cA + hstep, voffA);
        if (wr == 1) PG8_BAR;
        PG8_WAIT_V(4); PG8_BAR;
        PG8_STAGE(PG8_SB(1, 0), cB + kstep, voffB); PG8_STAGE(PG8_SA(1, 0), cA + kstep, voffA); PG8_STAGE(PG8_SB(1, 1), cB + hstep + kstep, voffB);
        PG8_WAIT_V(6); PG8_BAR;
    }
    for (;;) {
        const bool has_next = S.next(ui + 1, nxt);
        const char* nA = has_next ? (const char*)g.A + (size_t)nxt.pm * tstep : cA; const char* nB = has_next ? (const char*)g.Bt + (size_t)nxt.pn * tstep : cB;
        for (int t = 0; t < nt; t += 2) {
            if constexpr (MIDK) { if (t == nt / 2) E.mid(acc, cur, wr, wc, fr, fq); }
            const bool last = (t == nt - 2);
            const char* a1 = cA + (size_t)(t + 1) * kstep;
            const char* a2 = last ? nA : cA + (size_t)(t + 2) * kstep; const char* b2 = last ? nB : cB + (size_t)(t + 2) * kstep;
            const char* a3 = a2 + kstep; const char* b3 = b2 + kstep;
            if (last && has_next) S.a_ready(nxt);
            if constexpr (SP2) {
            PG8_LDB(B0, 0, 0); PG8_LDB(B1, 0, 1); PG8_SCHED; PG8_LDA(At, 0, 0); PG8_STAGE(PG8_SA(1, 1), a1 + hstep, voffA);
            PG8_WAIT_V(8); PG8_WAIT_L(0); PG8_BAR; PG8_MMA(0, 0, At, B0); PG8_MMA(0, 1, At, B1); PG8_BAR; PG8_SCHED;
            PG8_LDA(At, 0, 1); PG8_STAGE(PG8_SB(0, 0), b2, voffB); PG8_STAGE(PG8_SB(0, 1), b2 + hstep, voffB); PG8_STAGE(PG8_SA(0, 0), a2, voffA);
            PG8_WAIT_V(8); PG8_WAIT_L(0); PG8_BAR; PG8_MMA(1, 0, At, B0); PG8_MMA(1, 1, At, B1); PG8_BAR; PG8_SCHED;
            PG8_LDB(B0, 1, 0); PG8_LDB(B1, 1, 1); PG8_SCHED; PG8_LDA(At, 1, 0); PG8_STAGE(PG8_SA(0, 1), a2 + hstep, voffA);
            PG8_WAIT_V(8); PG8_WAIT_L(0); PG8_BAR; PG8_MMA(0, 0, At, B0); PG8_MMA(0, 1, At, B1); PG8_BAR; PG8_SCHED;
            PG8_LDA(At, 1, 1); PG8_STAGE(PG8_SB(1, 0), b3, voffB); PG8_STAGE(PG8_SB(1, 1), b3 + hstep, voffB); PG8_STAGE(PG8_SA(1, 0), a3, voffA);
            PG8_WAIT_V(8); PG8_WAIT_L(0); PG8_BAR; PG8_MMA(1, 0, At, B0); PG8_MMA(1, 1, At, B1); PG8_BAR; PG8_SCHED;
            } else {
            PG8_LDB(B0, 0, 0); PG8_SCHED; PG8_LDA(At, 0, 0); PG8_STAGE(PG8_SA(1, 1), a1 + hstep, voffA);
            PG8_WAIT_L(8); PG8_BAR; PG8_WAIT_L(0); PG8_MMA(0, 0, At, B0); PG8_BAR; PG8_SCHED;
            PG8_LDB(B1, 0, 1); PG8_STAGE(PG8_SB(0, 0), b2, voffB);
            PG8_BAR; PG8_WAIT_L(0); PG8_MMA(0, 1, At, B1); PG8_BAR;
            PG8_LDA(At, 0, 1); PG8_STAGE(PG8_SA(0, 0), a2, voffA);
            PG8_BAR; PG8_WAIT_L(0); PG8_MMA(1, 0, At, B0); PG8_BAR; PG8_SCHED;
            PG8_STAGE(PG8_SB(0, 1), b2 + hstep, voffB);
            PG8_WAIT_V(6); PG8_BAR; PG8_MMA(1, 1, At, B1); PG8_BAR;
            PG8_LDB(B0, 1, 0); PG8_SCHED; PG8_LDA(At, 1, 0); PG8_STAGE(PG8_SA(0, 1), a2 + hstep, voffA);
            PG8_WAIT_L(8); PG8_BAR; PG8_WAIT_L(0); PG8_MMA(0, 0, At, B0); PG8_BAR; PG8_SCHED;
            PG8_LDB(B1, 1, 1); PG8_STAGE(PG8_SB(1, 0), b3, voffB);
            PG8_BAR; PG8_WAIT_L(0); PG8_MMA(0, 1, At, B1); PG8_BAR;
            PG8_LDA(At, 1, 1); PG8_STAGE(PG8_SA(1, 0), a3, voffA);
            PG8_BAR; PG8_WAIT_L(0); PG8_MMA(1, 0, At, B0); PG8_BAR; PG8_SCHED;
            PG8_STAGE(PG8_SB(1, 1), b3 + hstep, voffB);
            PG8_WAIT_V(6); PG8_BAR; PG8_MMA(1, 1, At, B1); PG8_BAR;
            }
        }
        if constexpr (ALIGN_EPI) { if (wr == 0) PG8_BAR; }
        if constexpr (!Epi::AFTER_DRAIN) { E(acc, cur, wr, wc, fr, fq); S.done(cur); }
        if (!has_next) break;
        if constexpr (Epi::HAS_INIT) E.init(acc, nxt, wr, wc, fr, fq);
        else {
#pragma unroll
        for (int a = 0; a < 2; ++a)
#pragma unroll
            for (int b = 0; b < 2; ++b)
#pragma unroll
                for (int m = 0; m < 4; ++m)
#pragma unroll
                    for (int n = 0; n < 2; ++n) acc[a][b][m][n] = acc_t{};
        }
        cur = nxt; cA = nA; cB = nB; ++ui;
        if constexpr (ALIGN_EPI) { if (wr == 1) PG8_BAR; }
    }
    PG8_WAIT_V(0);
    if constexpr (!ALIGN_EPI) { if (wr == 0) PG8_BAR; }
    PG8_BAR;
    if constexpr (Epi::AFTER_DRAIN) { E.fused(acc, cur, wr, wc, fr, fq, lds, wid, lane); S.done(cur); }
#undef PG8_SA
#undef PG8_SB
#undef PG8_STAGE
#undef PG8_LDA
#undef PG8_LDB
#undef PG8_MMA
#undef PG8_WAIT_V
#undef PG8_WAIT_L
#undef PG8_BAR
#undef PG8_SCHED
}
}

#define EPI_FOR(...) _Pragma("unroll") for (int ai = 0; ai < 2; ++ai) _Pragma("unroll") for (int m = 0; m < 4; ++m) { const int row = u.pm * 256 + ai * 128 + wr * 64 + m * 16 + fr; \
    _Pragma("unroll") for (int bj = 0; bj < 2; ++bj) { const int col = u.pn * 256 + bj * 128 + wc * 32 + 8 * fq; const f32x4 a0 = acc[ai][bj][m][0], a1 = acc[ai][bj][m][1]; __VA_ARGS__ } }
DI u32x4 pack8bf(f32x4 a, f32x4 b) { u32x4 w; w.x = pk2(a.x, a.y); w.y = pk2(a.z, a.w); w.z = pk2(b.x, b.y); w.w = pk2(b.z, b.w); return w; }
constexpr float C2 = 0.125f * 1.4426950408889634f;
struct EpiInProj {
    static constexpr bool PERM = true, AFTER_DRAIN = false, HAS_INIT = false, I8 = true;
    bf16_t* QK; bf16_t* KF; bf16_t* VT; bf16_t* GATES; const float* RS1  ; const float* SW  ; float* KSUM; bool ksum_on;
    DI void operator()(const pg8::i32x4 (&iacc)[2][2][4][2], const pg8::Unit& u, int wr, int wc, int fr, int fq) const {
        f32x4 acc[2][2][4][2];
#pragma unroll
        for (int bj = 0; bj < 2; ++bj) {
            const float* swp = SW + u.pn * 256 + bj * 128 + wc * 32 + 8 * fq;
            const f32x4 c0 = *(const f32x4*)swp * (1.f / 127.f), c1 = *(const f32x4*)(swp + 4) * (1.f / 127.f);
#pragma unroll
            for (int ai = 0; ai < 2; ++ai)
#pragma unroll
                for (int m = 0; m < 4; ++m) { acc[ai][bj][m][0] = __builtin_convertvector(iacc[ai][bj][m][0], f32x4) * c0; acc[ai][bj][m][1] = __builtin_convertvector(iacc[ai][bj][m][1], f32x4) * c1; }
        }
        const int seg = (u.pn * 256) >> 9;
        if (seg == 2 || seg == 5) {
            const int kind = seg == 5;
            EPI_FOR({
                const float rs = RS1[row]; const int bb = row >> 13, key = row & (SEQ - 1), kp = key & 15;
                const int nn = col - (kind ? 2560 : 1024), dim = nn & 63;
                bf16_t* vt = VT + (((size_t)((kind * 2 + bb) * NH + (nn >> 6)) * 256 + (key >> 5)) * 4 + ((dim >> 5) * 2 + ((key >> 4) & 1))) * 512 + (((kp >> 2) & 1) * 32 + (dim & 31)) * 8 + 4 * (kp >> 3) + (kp & 3);
                vt[0] = (bf16_t)f2bf(a0.x * rs); vt[8] = (bf16_t)f2bf(a0.y * rs); vt[16] = (bf16_t)f2bf(a0.z * rs); vt[24] = (bf16_t)f2bf(a0.w * rs);
                vt[32] = (bf16_t)f2bf(a1.x * rs); vt[40] = (bf16_t)f2bf(a1.y * rs); vt[48] = (bf16_t)f2bf(a1.z * rs); vt[56] = (bf16_t)f2bf(a1.w * rs);
            })
        } else if (seg == 1 || seg == 4) {
            const int kind = seg == 4;
            float cs[16];
#pragma unroll
            for (int i = 0; i < 16; ++i) cs[i] = 0.f;
            EPI_FOR({
                const float rs = RS1[row]; const f32x4 v0 = a0 * rs, v1 = a1 * rs;
                const int bb = row >> 13, key = row & (SEQ - 1), nn = col - (kind ? 2048 : 512), dim = nn & 63;
                *(u32x4*)(KF + (((size_t)((kind * 2 + bb) * NH + (nn >> 6)) * 256 + (key >> 5)) * 4 + (dim >> 4)) * 512 + (((dim >> 3) & 1) * 32 + (key & 31)) * 8) = pack8bf(v0, v1);
                if (seg == 1) { cs[bj * 8 + 0] += v0.x; cs[bj * 8 + 1] += v0.y; cs[bj * 8 + 2] += v0.z; cs[bj * 8 + 3] += v0.w; cs[bj * 8 + 4] += v1.x; cs[bj * 8 + 5] += v1.y; cs[bj * 8 + 6] += v1.z; cs[bj * 8 + 7] += v1.w; }
            })
            if (seg == 1 && ksum_on) {
                const bool b3 = (fr & 8) != 0, b2 = (fr & 4) != 0, b1 = (fr & 2) != 0, b0 = (fr & 1) != 0;
                float v8[8], v4[4];
#pragma unroll
                for (int i = 0; i < 8; ++i) v8[i] = (b3 ? cs[8 + i] : cs[i]) + __shfl_xor(b3 ? cs[i] : cs[8 + i], 8);
#pragma unroll
                for (int i = 0; i < 4; ++i) v4[i] = (b2 ? v8[4 + i] : v8[i]) + __shfl_xor(b2 ? v8[i] : v8[4 + i], 4);
                const float v20 = (b1 ? v4[2] : v4[0]) + __shfl_xor(b1 ? v4[0] : v4[2], 2), v21 = (b1 ? v4[3] : v4[1]) + __shfl_xor(b1 ? v4[1] : v4[3], 2);
                const float v1_ = (b0 ? v21 : v20) + __shfl_xor(b0 ? v20 : v21, 1);
                const int c = u.pn * 256 + (fr >> 3) * 128 + wc * 32 + 8 * fq + (fr & 7) - 512, row0 = u.pm * 256;
                atomicAdd(KSUM + ((size_t)(((row0 >> 13) * NH + (c >> 6)) * NBLK + ((row0 & (SEQ - 1)) >> 8))) * HD + (c & 63), v1_);
            }
        } else if (seg < 6) {
            const int cshift = seg == 3 ? -1024 : 0;
            EPI_FOR({ const float rs = RS1[row] * C2; *(u32x4*)(QK + (size_t)row * 1024 + col + cshift) = pack8bf(a0 * rs, a1 * rs); })
        } else {
            EPI_FOR({
                const float rs = RS1[row]; const f32x4 v0 = a0 * rs, v1 = a1 * rs;
                const f32x4 s0 = {sigmoidf_(v0.x), sigmoidf_(v0.y), sigmoidf_(v0.z), sigmoidf_(v0.w)}, s1 = {sigmoidf_(v1.x), sigmoidf_(v1.y), sigmoidf_(v1.z), sigmoidf_(v1.w)};
                *(u32x4*)(GATES + (size_t)row * GATEW + col - QKVW) = pack8bf(s0, s1);
            })
        }
    }
};
struct EpiMix {
    static constexpr bool PERM = true, AFTER_DRAIN = false, HAS_INIT = false, I8 = false;
    const bf16_t* GATES; bf16_t* MIXED;
    DI void mid(f32x4 (&acc)[2][2][4][2], const pg8::Unit& u, int wr, int wc, int fr_in, int fq_in) const {
        int fr = fr_in, fq = fq_in; asm volatile("" : "+v"(fr), "+v"(fq));
#pragma unroll
        for (int ai = 0; ai < 2; ++ai)
#pragma unroll
            for (int m = 0; m < 4; ++m) { const int row = u.pm * 256 + ai * 128 + wr * 64 + m * 16 + fr;
#pragma unroll
                for (int bj = 0; bj < 2; ++bj) { const int col = u.pn * 256 + bj * 128 + wc * 32 + 8 * fq;
                    const u32x4 ga = *(const u32x4*)(GATES + (size_t)row * GATEW + col), gb = *(const u32x4*)(GATES + (size_t)row * GATEW + 1024 + col);
                    const float r0 = bflo(ga.x) * __builtin_amdgcn_rcpf(fmaxf(bflo(gb.x), 1e-30f)), r1 = bfhi(ga.x) * __builtin_amdgcn_rcpf(fmaxf(bfhi(gb.x), 1e-30f));
                    const float r2 = bflo(ga.y) * __builtin_amdgcn_rcpf(fmaxf(bflo(gb.y), 1e-30f)), r3 = bfhi(ga.y) * __builtin_amdgcn_rcpf(fmaxf(bfhi(gb.y), 1e-30f));
                    const float r4 = bflo(ga.z) * __builtin_amdgcn_rcpf(fmaxf(bflo(gb.z), 1e-30f)), r5 = bfhi(ga.z) * __builtin_amdgcn_rcpf(fmaxf(bfhi(gb.z), 1e-30f));
                    const float r6 = bflo(ga.w) * __builtin_amdgcn_rcpf(fmaxf(bflo(gb.w), 1e-30f)), r7 = bfhi(ga.w) * __builtin_amdgcn_rcpf(fmaxf(bfhi(gb.w), 1e-30f));
                    acc[ai][bj][m][0] = acc[ai][bj][m][0] * (f32x4){r0, r1, r2, r3}; acc[ai][bj][m][1] = acc[ai][bj][m][1] * (f32x4){r4, r5, r6, r7}; }
                __builtin_amdgcn_sched_barrier(0); }
    }
    DI void operator()(const f32x4 (&acc)[2][2][4][2], const pg8::Unit& u, int wr, int wc, int fr, int fq) const {
        EPI_FOR({
            const u32x4 gb = *(const u32x4*)(GATES + (size_t)row * GATEW + 1024 + col);
            const f32x4 s0 = {fmaxf(bflo(gb.x), 1e-30f), fmaxf(bfhi(gb.x), 1e-30f), fmaxf(bflo(gb.y), 1e-30f), fmaxf(bfhi(gb.y), 1e-30f)};
            const f32x4 s1 = {fmaxf(bflo(gb.z), 1e-30f), fmaxf(bfhi(gb.z), 1e-30f), fmaxf(bflo(gb.w), 1e-30f), fmaxf(bfhi(gb.w), 1e-30f)};
            *(u32x4*)(MIXED + (size_t)row * DM + col) = pack8bf(a0 * s0, a1 * s1);
        })
    }
};
struct EpiResid {
    static constexpr bool PERM = true, AFTER_DRAIN = false, HAS_INIT = true, I8 = false;
    const float* X; bf16_t* HB;
    DI void init(f32x4 (&acc)[2][2][4][2], const pg8::Unit& u, int wr, int wc, int fr, int fq) const {
#pragma unroll
        for (int ai = 0; ai < 2; ++ai)
#pragma unroll
            for (int m = 0; m < 4; ++m) { const int row = u.pm * 256 + ai * 128 + wr * 64 + m * 16 + fr;
#pragma unroll
                for (int bj = 0; bj < 2; ++bj) { const float* xp = X + (size_t)row * DM + u.pn * 256 + bj * 128 + wc * 32 + 8 * fq; acc[ai][bj][m][0] = *(const f32x4*)xp; acc[ai][bj][m][1] = *(const f32x4*)(xp + 4); } }
    }
    DI void operator()(const f32x4 (&acc)[2][2][4][2], const pg8::Unit& u, int wr, int wc, int fr, int fq) const {
        EPI_FOR({ *(u32x4*)(HB + (size_t)row * DM + col) = pack8bf(a0, a1); })
    }
};
struct EpiPeerQ {
    static constexpr bool PERM = true, AFTER_DRAIN = false, HAS_INIT = false, I8 = false;
    bf16_t* Q2;
    DI void operator()(const f32x4 (&acc)[2][2][4][2], const pg8::Unit& u, int wr, int wc, int fr, int fq) const {
        EPI_FOR({ *(u32x4*)(Q2 + (size_t)row * PQW + col) = pack8bf(a0, a1); })
    }
};


DI void h_rows4(const bf16_t* H, float* RS2, float* SH, signed char* H8, int row0, int stride, int lane) {
    u32x4 a[4][2];
#pragma unroll
    for (int k = 0; k < 4; ++k)
#pragma unroll
        for (int j = 0; j < 2; ++j) a[k][j] = *(const u32x4*)(H + (size_t)(row0 + k * stride) * DM + lane * 16 + 8 * j);
#pragma unroll
    for (int k = 0; k < 4; ++k) {
        const int row = row0 + k * stride;
        float v[16];
#pragma unroll
        for (int j = 0; j < 2; ++j) { v[8 * j] = bflo(a[k][j].x); v[8 * j + 1] = bfhi(a[k][j].x); v[8 * j + 2] = bflo(a[k][j].y); v[8 * j + 3] = bfhi(a[k][j].y);
            v[8 * j + 4] = bflo(a[k][j].z); v[8 * j + 5] = bfhi(a[k][j].z); v[8 * j + 6] = bflo(a[k][j].w); v[8 * j + 7] = bfhi(a[k][j].w); }
        float ss = 0.f, am = 0.f;
#pragma unroll
        for (int j = 0; j < 16; ++j) { ss += v[j] * v[j]; am = fmaxf(am, fabsf(v[j])); }
        ss = wave_sum(ss);
#pragma unroll
        for (int o = 32; o >= 1; o >>= 1) am = fmaxf(am, __shfl_xor(am, o));
        const float sc = am > 0.f ? am * (1.f / 127.f) : 1.f, isc = 1.f / sc;
        unsigned w[4];
#pragma unroll
        for (int j = 0; j < 4; ++j) w[j] = q8x4(v[4 * j], v[4 * j + 1], v[4 * j + 2], v[4 * j + 3], isc);
        *(u32x4*)(H8 + (size_t)row * DM + lane * 16) = (u32x4){w[0], w[1], w[2], w[3]};
        if (lane == 0) { RS2[row] = rsqrtf(ss * (1.f / DM) + RMS_EPS); SH[row] = sc; }
    }
}

template <int NR>
DI void quant_rows(const float* pu, const float* pv, const float* g2, unsigned char* U8, unsigned char* V8, float* SU, float* SV, int row0, int stride, int lane) {
    f32x4 a[NR][4];
#pragma unroll
    for (int k = 0; k < NR; ++k) { const int row = row0 + k * stride, isv = row >= NEXP, e = row - (isv ? NEXP : 0); const float* src = (isv ? pv : pu) + (size_t)e * DM + lane * 16;
#pragma unroll
        for (int j = 0; j < 4; ++j) a[k][j] = *(const f32x4*)(src + 4 * j); }
    f32x4 gq[4];
#pragma unroll
    for (int j = 0; j < 4; ++j) gq[j] = *(const f32x4*)(g2 + lane * 16 + 4 * j);
#pragma unroll
    for (int k = 0; k < NR; ++k) {
        const int row = row0 + k * stride, isv = row >= NEXP, e = row - (isv ? NEXP : 0);
        float v[16];
#pragma unroll
        for (int j = 0; j < 4; ++j) { const f32x4 x = isv ? a[k][j] : a[k][j] * gq[j]; v[4 * j] = x.x; v[4 * j + 1] = x.y; v[4 * j + 2] = x.z; v[4 * j + 3] = x.w; }
        float am = 0.f;
#pragma unroll
        for (int j = 0; j < 16; ++j) am = fmaxf(am, fabsf(v[j]));
#pragma unroll
        for (int o = 32; o >= 1; o >>= 1) am = fmaxf(am, __shfl_xor(am, o));
        const float sc = am > 0.f ? am * (1.f / 127.f) : 1.f, isc = 1.f / sc;
        unsigned w[4];
#pragma unroll
        for (int j = 0; j < 4; ++j) w[j] = q8x4(v[4 * j], v[4 * j + 1], v[4 * j + 2], v[4 * j + 3], isc);
        unsigned char* dst = (isv ? V8 : U8) + ((size_t)((lane >> 3) * NEXP + e)) * 128 + (lane & 7) * 16;
        *(u32x4*)dst = (u32x4){w[0], w[1], w[2], w[3]};
        if (lane == 0) (isv ? SV : SU)[e] = sc;
    }
}

typedef float f32x16 __attribute__((ext_vector_type(16)));
#define MFMA32(a, b, c) __builtin_amdgcn_mfma_f32_32x32x16_bf16((a), (b), (c), 0, 0, 0)
constexpr float FLT_MIN_ = 1.17549435e-38f;

struct KV { bf16x8 k[4], v[4]; };
DI void load_kv(KV& f, const bf16_t* kp, const bf16_t* vp) {
#pragma unroll
    for (int i = 0; i < 4; ++i) { f.k[i] = *(const bf16x8*)(kp + 512 * i); f.v[i] = *(const bf16x8*)(vp + 512 * i); }
}
DI void load_kv_async(KV& f, const bf16_t* kp, const bf16_t* vp) {
    asm volatile("global_load_dwordx4 %0, %4, off\n\tglobal_load_dwordx4 %1, %4, off offset:1024\n\tglobal_load_dwordx4 %2, %4, off offset:2048\n\tglobal_load_dwordx4 %3, %4, off offset:3072"
                 : "=&v"(f.k[0]), "=&v"(f.k[1]), "=&v"(f.k[2]), "=&v"(f.k[3]) : "v"(kp) : "memory");
    asm volatile("global_load_dwordx4 %0, %4, off\n\tglobal_load_dwordx4 %1, %4, off offset:1024\n\tglobal_load_dwordx4 %2, %4, off offset:2048\n\tglobal_load_dwordx4 %3, %4, off offset:3072"
                 : "=&v"(f.v[0]), "=&v"(f.v[1]), "=&v"(f.v[2]), "=&v"(f.v[3]) : "v"(vp) : "memory");
}
#define KV_WAIT_K(f, N) asm volatile("s_waitcnt vmcnt(" #N ")" : "+v"(f.k[0]), "+v"(f.k[1]), "+v"(f.k[2]), "+v"(f.k[3]) :: "memory")
#define KV_WAIT_V(f, N) asm volatile("s_waitcnt vmcnt(" #N ")" : "+v"(f.v[0]), "+v"(f.v[1]), "+v"(f.v[2]), "+v"(f.v[3]) :: "memory")
DI bf16x8 pack8(const f32x16& p, int s) {
    u32x4 w;
    if (s == 0) { w.x = cvtpk(p[0], p[1]); w.y = cvtpk(p[2], p[3]); w.z = cvtpk(p[4], p[5]); w.w = cvtpk(p[6], p[7]); }
    else { w.x = cvtpk(p[8], p[9]); w.y = cvtpk(p[10], p[11]); w.z = cvtpk(p[12], p[13]); w.w = cvtpk(p[14], p[15]); }
    return __builtin_bit_cast(bf16x8, w);
}
struct SmState { float m, l; f32x16 o0, o1; };
typedef float f32x2 __attribute__((ext_vector_type(2)));
DI float sum16(const f32x16& p) {
    const f32x2 s0 = (f32x2){p[0], p[1]} + (f32x2){p[2], p[3]}, s1 = (f32x2){p[4], p[5]} + (f32x2){p[6], p[7]};
    const f32x2 s2 = (f32x2){p[8], p[9]} + (f32x2){p[10], p[11]}, s3 = (f32x2){p[12], p[13]} + (f32x2){p[14], p[15]};
    const f32x2 t0 = s0 + s1, t1 = s2 + s3, u = t0 + t1;
    return u.x + u.y;
}
constexpr float LAZY_THR = 1.0995116e12f;
template <int WK = -1, int WV = -1>
DI void moba_tile_first(SmState& st, KV& f, const bf16x8 (&qf)[4], float bias0, float slopeL, int maskrow, int hh) {
    f32x16 acc;
#pragma unroll
    for (int r = 0; r < 16; ++r) acc[r] = bias0 + slopeL * (float)((r & 3) + 8 * (r >> 2));
    if constexpr (WK == 12) KV_WAIT_K(f, 12); else if constexpr (WK == 4) KV_WAIT_K(f, 4);
#pragma unroll
    for (int ks = 0; ks < 4; ++ks) acc = MFMA32(f.k[ks], qf[ks], acc);
    if (maskrow < 32) {
#pragma unroll
        for (int r = 0; r < 16; ++r) if ((r & 3) + 8 * (r >> 2) + 4 * hh > maskrow) acc[r] = -1e30f;
    }
    float tm = acc[0];
#pragma unroll
    for (int r = 1; r < 16; ++r) tm = fmaxf(tm, acc[r]);
    tm = fmaxf(tm, __shfl_xor(tm, 32));
    f32x16 pw;
#pragma unroll
    for (int r = 0; r < 16; ++r) pw[r] = __builtin_amdgcn_exp2f(acc[r] - tm);
    st.m = tm; st.l = sum16(pw);
    const bf16x8 p0 = pack8(pw, 0), p1 = pack8(pw, 1);
    if constexpr (WV == 8) KV_WAIT_V(f, 8); else if constexpr (WV == 0) KV_WAIT_V(f, 0);
    f32x16 z;
#pragma unroll
    for (int r = 0; r < 16; ++r) z[r] = 0.f;
    st.o0 = MFMA32(f.v[0], p0, z); st.o0 = MFMA32(f.v[1], p1, st.o0);
    st.o1 = MFMA32(f.v[2], p0, z); st.o1 = MFMA32(f.v[3], p1, st.o1);
}
template <int WK = -1, int WV = -1>
DI void moba_tile_lazy(SmState& st, KV& f, const bf16x8 (&qf)[4], float bias0, float slopeL, int hh) {
    f32x16 acc;
    const float b0 = bias0 - st.m;
#pragma unroll
    for (int r = 0; r < 16; ++r) acc[r] = b0 + slopeL * (float)((r & 3) + 8 * (r >> 2));
    if constexpr (WK == 12) KV_WAIT_K(f, 12); else if constexpr (WK == 4) KV_WAIT_K(f, 4);
#pragma unroll
    for (int ks = 0; ks < 4; ++ks) acc = MFMA32(f.k[ks], qf[ks], acc);
    f32x16 pw;
#pragma unroll
    for (int r = 0; r < 16; ++r) pw[r] = __builtin_amdgcn_exp2f(acc[r]);
    float ps = sum16(pw);
    if (__builtin_expect(__any(!(ps <= LAZY_THR)), 0)) {
        const int nl = !(ps <= LAZY_THR);
        const bool need = (nl | __shfl_xor(nl, 32)) != 0;
        float tm = acc[0];
#pragma unroll
        for (int r = 1; r < 16; ++r) tm = fmaxf(tm, acc[r]);
        tm = fmaxf(tm, __shfl_xor(tm, 32));
        const float d = need ? tm : 0.f, al = __builtin_amdgcn_exp2f(-d);
        st.m += d; st.l *= al; st.o0 = st.o0 * al; st.o1 = st.o1 * al;
#pragma unroll
        for (int r = 0; r < 16; ++r) pw[r] = __builtin_amdgcn_exp2f(acc[r] - d);
        ps = sum16(pw);
    }
    st.l += ps;
    const bf16x8 p0 = pack8(pw, 0), p1 = pack8(pw, 1);
    if constexpr (WV == 8) KV_WAIT_V(f, 8); else if constexpr (WV == 0) KV_WAIT_V(f, 0);
    st.o0 = MFMA32(f.v[0], p0, st.o0); st.o0 = MFMA32(f.v[1], p1, st.o0);
    st.o1 = MFMA32(f.v[2], p0, st.o1); st.o1 = MFMA32(f.v[3], p1, st.o1);
}
DI void moba_pass_own(SmState& st, const bf16x8 (&qf)[4], const bf16_t* kt0, const bf16_t* vt0, int w, int maskrow, float bb, float slopeL, int hh) {
    KV fa, fb;
    const float bs = slopeL * 32.f;
    load_kv(fa, kt0 + (size_t)w * 2048, vt0 + (size_t)w * 2048);
    if (w >= 1) load_kv(fb, kt0 + (size_t)(w - 1) * 2048, vt0 + (size_t)(w - 1) * 2048);
    moba_tile_first(st, fa, qf, bb + (float)w * bs, slopeL, maskrow, hh);
#pragma unroll 1
    for (int kt = w - 1; kt >= 0; kt -= 2) {
        if (kt >= 1) load_kv(fa, kt0 + (size_t)(kt - 1) * 2048, vt0 + (size_t)(kt - 1) * 2048);
        moba_tile_lazy(st, fb, qf, bb + (float)kt * bs, slopeL, hh);
        if (kt >= 1) {
            if (kt >= 2) load_kv(fb, kt0 + (size_t)(kt - 2) * 2048, vt0 + (size_t)(kt - 2) * 2048);
            moba_tile_lazy(st, fa, qf, bb + (float)(kt - 1) * bs, slopeL, hh);
        }
    }
}
template <bool MASKED>
DI void sb_tile(f32x16& o0, f32x16& o1, float& carry, const KV& f, const bf16x8 (&qf)[4], int maskrow, int hh) {
    f32x16 acc;
#pragma unroll
    for (int r = 0; r < 16; ++r) acc[r] = 0.f;
#pragma unroll
    for (int ks = 0; ks < 4; ++ks) acc = MFMA32(f.k[ks], qf[ks], acc);
    float bt[16], fc[16];
#pragma unroll
    for (int r = 0; r < 16; ++r) {
        const float z = acc[r];
        const float e = __builtin_amdgcn_exp2f(-fabsf(z)), rr = __builtin_amdgcn_rcpf(1.f + e), er = e * rr;
        const bool pos = z >= 0.f, msk = MASKED && ((r & 3) + 8 * (r >> 2) + 4 * hh) >= maskrow;
        bt[r] = msk ? 0.f : (pos ? rr : er);
        fc[r] = msk ? 1.f : (pos ? er : rr);
    }
    float G[4], Gp[4], wf[16];
#pragma unroll
    for (int g = 0; g < 4; ++g) {
        const float s3 = fc[4 * g + 3], s2 = s3 * fc[4 * g + 2], s1 = s2 * fc[4 * g + 1];
        G[g] = s1 * fc[4 * g];
        wf[4 * g + 3] = bt[4 * g + 3]; wf[4 * g + 2] = bt[4 * g + 2] * s3; wf[4 * g + 1] = bt[4 * g + 1] * s2; wf[4 * g] = bt[4 * g] * s1;
    }
#pragma unroll
    for (int g = 0; g < 4; ++g) Gp[g] = __shfl_xor(G[g], 32);
    const float T0 = G[0] * Gp[0], T1 = G[1] * Gp[1], T2 = G[2] * Gp[2], T3 = G[3] * Gp[3];
    const float RR2 = T3, RR1 = T3 * T2, RR0 = RR1 * T1, total = RR0 * T0;
    float base[4];
    base[3] = carry * (hh == 0 ? Gp[3] : 1.f);
    base[2] = carry * RR2 * (hh == 0 ? Gp[2] : 1.f);
    base[1] = carry * RR1 * (hh == 0 ? Gp[1] : 1.f);
    base[0] = carry * RR0 * (hh == 0 ? Gp[0] : 1.f);
    f32x16 pw;
#pragma unroll
    for (int r = 0; r < 16; ++r) pw[r] = wf[r] * base[r >> 2];
    carry *= total;
    const bf16x8 p0 = pack8(pw, 0), p1 = pack8(pw, 1);
    o0 = MFMA32(f.v[0], p0, o0); o0 = MFMA32(f.v[1], p1, o0);
    o1 = MFMA32(f.v[2], p0, o1); o1 = MFMA32(f.v[3], p1, o1);
}
DI void store_o(bf16_t* orow  , const f32x16& o0, const f32x16& o1, float sc) {
#pragma unroll
    for (int g = 0; g < 4; ++g) {
        u32x2 a; a.x = cvtpk(o0[4 * g] * sc, o0[4 * g + 1] * sc); a.y = cvtpk(o0[4 * g + 2] * sc, o0[4 * g + 3] * sc); *(u32x2*)(orow + 8 * g) = a;
        u32x2 c; c.x = cvtpk(o1[4 * g] * sc, o1[4 * g + 1] * sc); c.y = cvtpk(o1[4 * g + 2] * sc, o1[4 * g + 3] * sc); *(u32x2*)(orow + 32 + 8 * g) = c;
    }
}
constexpr int ML_OPART = 0;
constexpr int ML_ML = 4 * 256 * 68 * 2;
constexpr int ML_LISTS = ML_ML + 4 * 256 * 2 * 4;
constexpr int ML_SELS = ML_LISTS + 32 * 256;
constexpr int ML_CNT = ML_SELS + 1024;
constexpr int ML_UST = ML_CNT + 128;
constexpr int ML_QCTR = ML_UST + 144;
constexpr int ML_ITEM = ML_QCTR + 16;
constexpr int ML_UJ = ML_ITEM + 16;
static_assert(ML_UJ + 64 <= LDS_BYTES - 16, "MoBA LDS map");
DI void top3_insert(float s, int b, float& v0, float& v1, float& v2, int& i0, int& i1, int& i2) {
    const bool g0 = s > v0, g1 = s > v1, g2 = s > v2;
    v2 = g1 ? v1 : (g2 ? s : v2); i2 = g1 ? i1 : (g2 ? b : i2);
    v1 = g0 ? v0 : (g1 ? s : v1); i1 = g0 ? i0 : (g1 ? b : i1);
    v0 = g0 ? s : v0; i0 = g0 ? b : i0;
}
DI int p3_order(int i) {
    constexpr unsigned long long W0 = 0x1918171612151413ull, W1 = 0x1d1c1e1b0b1f1a11ull, W2 = 0x08070d0e0f0c0a10ull, W3 = 0x0001020403050906ull;
    const unsigned long long w = (i >> 3) == 0 ? W0 : ((i >> 3) == 1 ? W1 : ((i >> 3) == 2 ? W2 : W3));
    return (int)((w >> (8 * (i & 7))) & 255ull);
}
DI void sb_group(const bf16_t* QK, const bf16_t* KF, const bf16_t* VT, bf16_t* OB, int b, int head, int qt) {
    const int tid = threadIdx.x, wave = tid >> 6; int lane = tid & 63;
    asm volatile("" : "+v"(lane));
    const int r = lane & 31, hh = lane >> 5;
    const bf16_t* kp = KF + (size_t)((1 * 2 + b) * NH + head) * 256 * 2048 + lane * 8;
    const bf16_t* vp = VT + (size_t)((1 * 2 + b) * NH + head) * 256 * 2048 + lane * 8;
    const int kt0 = 8 * qt + wave, t = 32 * kt0 + r;
    const bf16_t* qp = QK + (size_t)(b * SEQ + t) * 1024 + 512 + head * HD + 8 * hh;
    bf16x8 qf[4];
#pragma unroll
    for (int ks = 0; ks < 4; ++ks) qf[ks] = *(const bf16x8*)(qp + 16 * ks);
    f32x16 o0, o1;
#pragma unroll
    for (int x = 0; x < 16; ++x) { o0[x] = 0.f; o1[x] = 0.f; }
    float carry = 1.f;
    KV fa, fb;
    int kt = kt0;
    load_kv(fa, kp + (size_t)kt * 2048, vp + (size_t)kt * 2048);
    if (kt >= 1) load_kv(fb, kp + (size_t)(kt - 1) * 2048, vp + (size_t)(kt - 1) * 2048);
    asm volatile("" ::: "memory");
    sb_tile<true>(o0, o1, carry, fa, qf, r, hh);
    if (!(kt < 1 || __all(carry < FLT_MIN_))) {
        for (;;) {
            if (kt >= 2) load_kv(fa, kp + (size_t)(kt - 2) * 2048, vp + (size_t)(kt - 2) * 2048);
            asm volatile("" ::: "memory");
            sb_tile<false>(o0, o1, carry, fb, qf, 32, hh);
            if (kt < 2 || __all(carry < FLT_MIN_)) break;
            if (kt >= 3) load_kv(fb, kp + (size_t)(kt - 3) * 2048, vp + (size_t)(kt - 3) * 2048);
            asm volatile("" ::: "memory");
            sb_tile<false>(o0, o1, carry, fa, qf, 32, hh);
            if (kt < 3 || __all(carry < FLT_MIN_)) break;
            kt -= 2;
        }
    }
    store_o(OB + (size_t)(b * SEQ + t) * (2 * WA) + WA + head * HD + 4 * hh, o0, o1, 1.f);
}
DI void moba_group(unsigned char* lds, const bf16_t* QK, const bf16_t* KF, const bf16_t* VT, const float* KSUM, bf16_t* OA, int b, int head, int og, bool with_sb, unsigned* nextctr) {
    const int tid = threadIdx.x, wave = tid >> 6; int lane = tid & 63;
    asm volatile("" : "+v"(lane));
    const int r = lane & 31, hh = lane >> 5;
    bf16_t* OPART = (bf16_t*)(lds + ML_OPART); float* MLS = (float*)(lds + ML_ML); unsigned char* LISTS = lds + ML_LISTS; unsigned char* SELS = lds + ML_SELS;
    int* CNT = (int*)(lds + ML_CNT); int* UST = (int*)(lds + ML_UST);
    const float slopeL = 1.4426950408889634f * exp2f(-(float)(head + 1));
    const bf16_t* kp = KF + (size_t)((0 * 2 + b) * NH + head) * 256 * 2048 + lane * 8;
    const bf16_t* vp = VT + (size_t)((0 * 2 + b) * NH + head) * 256 * 2048 + lane * 8;
    const bf16_t* qbase = QK + (size_t)(b * SEQ) * 1024 + head * HD + 8 * hh;
    __syncthreads();
    unsigned nk = 0;
    if (tid == 0) nk = atomicAdd(nextctr, 1u);
    if (tid < 32) CNT[tid] = 0;
    __syncthreads();
    {
        const int c = 32 * wave + r;
        const bf16_t* qp = qbase + (size_t)(256 * og + c) * 1024;
        bf16x8 qf[4];
#pragma unroll
        for (int ks = 0; ks < 4; ++ks) qf[ks] = *(const bf16x8*)(qp + 16 * ks);
        f32x16 acc;
#pragma unroll
        for (int i = 0; i < 16; ++i) acc[i] = 0.f;
        const float* km = KSUM + ((size_t)(b * NH + head) * NBLK + r) * HD + 8 * hh;
#pragma unroll
        for (int ks = 0; ks < 4; ++ks) {
            const f32x4 s0 = *(const f32x4*)(km + 16 * ks) * (1.f / MBLK), s1 = *(const f32x4*)(km + 16 * ks + 4) * (1.f / MBLK);
            const float mv[8] = {s0.x, s0.y, s0.z, s0.w, s1.x, s1.y, s1.z, s1.w};
            unsigned hb[8], lb[8];
#pragma unroll
            for (int e = 0; e < 8; ++e) { hb[e] = f2bf(mv[e]); lb[e] = f2bf(mv[e] - bf2f(hb[e])); }
            const u32x4 hw = {hb[0] | (hb[1] << 16), hb[2] | (hb[3] << 16), hb[4] | (hb[5] << 16), hb[6] | (hb[7] << 16)};
            const u32x4 lw = {lb[0] | (lb[1] << 16), lb[2] | (lb[3] << 16), lb[4] | (lb[5] << 16), lb[6] | (lb[7] << 16)};
            acc = MFMA32(__builtin_bit_cast(bf16x8, hw), qf[ks], acc); acc = MFMA32(__builtin_bit_cast(bf16x8, lw), qf[ks], acc);
        }
        float v0 = -INFINITY, v1 = -INFINITY, v2 = -INFINITY; int i0 = -1, i1 = -1, i2 = -1;
#pragma unroll
        for (int i = 0; i < 16; ++i) { const int blk = (i & 3) + 8 * (i >> 2) + 4 * hh; const float sv = blk < og ? acc[i] : -INFINITY; top3_insert(sv, blk, v0, v1, v2, i0, i1, i2); }
        const float pv0 = __shfl_xor(v0, 32), pv1 = __shfl_xor(v1, 32), pv2 = __shfl_xor(v2, 32);
        const int pi0 = __shfl_xor(i0, 32), pi1 = __shfl_xor(i1, 32), pi2 = __shfl_xor(i2, 32);
        top3_insert(pv0, pi0, v0, v1, v2, i0, i1, i2); top3_insert(pv1, pi1, v0, v1, v2, i0, i1, i2); top3_insert(pv2, pi2, v0, v1, v2, i0, i1, i2);
        if (hh == 0) {
            SELS[c * 4 + 0] = (unsigned char)(i0 < 0 ? 255 : i0); SELS[c * 4 + 1] = (unsigned char)(i1 < 0 ? 255 : i1); SELS[c * 4 + 2] = (unsigned char)(i2 < 0 ? 255 : i2);
            if (i0 >= 0) { const int ps = atomicAdd(&CNT[i0], 1); LISTS[i0 * 256 + ps] = (unsigned char)c; }
            if (i1 >= 0) { const int ps = atomicAdd(&CNT[i1], 1); LISTS[i1 * 256 + ps] = (unsigned char)c; }
            if (i2 >= 0) { const int ps = atomicAdd(&CNT[i2], 1); LISTS[i2 * 256 + ps] = (unsigned char)c; }
        }
    }
    __syncthreads();
    if (wave == 0) {
        const int jx = lane & 31, n = (CNT[jx] + 31) >> 5;
        int inc = n;
#pragma unroll
        for (int o = 1; o < 32; o <<= 1) { const int v = __shfl_up(inc, o, 32); if (jx >= o) inc += v; }
        const int st0 = inc - n;
        if (lane < 32) {
            UST[jx] = st0;
            unsigned char* UJ = lds + ML_UJ;
            for (int q = 0; q < n; ++q) UJ[st0 + q] = (unsigned char)jx;
            if (jx == 31) UST[32] = inc;
        }
        if (lane == 0) { *(volatile int*)(lds + ML_QCTR) = 0; *(volatile int*)(lds + ML_ITEM) = (int)nk; }
    }
    __syncthreads();
    {
        const int Usel = UST[32], Utot = Usel + 8;
        int* qctr = (int*)(lds + ML_QCTR);
        int u = 0;
        if (lane == 0) u = atomicAdd(qctr, 1);
        u = __builtin_amdgcn_readfirstlane(u);
        const int sb_after = __builtin_amdgcn_readfirstlane(wave) >> 1;
        bool sb_done = !with_sb; int nun = 0;
        for (;;) {
            const bool have = u < Utot;
            if (!sb_done && (nun == sb_after || !have)) { sb_group(QK, KF, VT, OA, b, head, og); sb_done = true; }
            if (!have) break;
            ++nun;
            int un = 0;
            if (lane == 0) un = atomicAdd(qctr, 1);
            int j, slot, qi; bool valid;
            SmState st;
            if (u < Usel) {
                j = __builtin_amdgcn_readfirstlane((int)(lds + ML_UJ)[u]);
                const bf16_t* kt0 = kp + (size_t)(8 * j) * 2048; const bf16_t* vt0 = vp + (size_t)(8 * j) * 2048;
                KV fa, fb;
                load_kv_async(fa, kt0 + 7 * 2048, vt0 + 7 * 2048); load_kv_async(fb, kt0 + 6 * 2048, vt0 + 6 * 2048);
                const int i = u - UST[j], idx = 32 * i + r;
                valid = idx < CNT[j];
                qi = LISTS[j * 256 + (valid ? idx : 32 * i)];
                slot = (SELS[qi * 4] == j) ? 0 : ((SELS[qi * 4 + 1] == j) ? 1 : 2);
                const int t = 256 * og + qi;
                const bf16_t* qp = qbase + (size_t)t * 1024;
                bf16x8 qf[4];
#pragma unroll
                for (int ks = 0; ks < 4; ++ks) qf[ks] = *(const bf16x8*)(qp + 16 * ks);
                const float bb = slopeL * (float)(256 * j + 4 * hh - t), bs = slopeL * 32.f;
                moba_tile_first<12, 8>(st, fa, qf, bb + 7.f * bs, slopeL, 64, hh);   load_kv_async(fa, kt0 + 5 * 2048, vt0 + 5 * 2048);
                moba_tile_lazy<12, 8>(st, fb, qf, bb + 6.f * bs, slopeL, hh);        load_kv_async(fb, kt0 + 4 * 2048, vt0 + 4 * 2048);
                moba_tile_lazy<12, 8>(st, fa, qf, bb + 5.f * bs, slopeL, hh);        load_kv_async(fa, kt0 + 3 * 2048, vt0 + 3 * 2048);
                moba_tile_lazy<12, 8>(st, fb, qf, bb + 4.f * bs, slopeL, hh);        load_kv_async(fb, kt0 + 2 * 2048, vt0 + 2 * 2048);
                moba_tile_lazy<12, 8>(st, fa, qf, bb + 3.f * bs, slopeL, hh);        load_kv_async(fa, kt0 + 1 * 2048, vt0 + 1 * 2048);
                moba_tile_lazy<12, 8>(st, fb, qf, bb + 2.f * bs, slopeL, hh);        load_kv_async(fb, kt0, vt0);
                moba_tile_lazy<12, 8>(st, fa, qf, bb + bs, slopeL, hh);
                moba_tile_lazy<4, 0>(st, fb, qf, bb, slopeL, hh);
            } else {
                const int w = 7 - (u - Usel);
                j = og; qi = 32 * w + r; valid = true; slot = 3;
                const int t = 256 * og + qi;
                const bf16_t* qp = qbase + (size_t)t * 1024;
                bf16x8 qf[4];
#pragma unroll
                for (int ks = 0; ks < 4; ++ks) qf[ks] = *(const bf16x8*)(qp + 16 * ks);
                moba_pass_own(st, qf, kp + (size_t)(8 * og) * 2048, vp + (size_t)(8 * og) * 2048, w, r, slopeL * (float)(256 * og + 4 * hh - t), slopeL, hh);
            }
            const float lt = st.l + __shfl_xor(st.l, 32), inv = 1.f / lt;
            if (valid) {
                bf16_t* op = OPART + (size_t)(slot * 256 + qi) * 68 + 4 * hh;
#pragma unroll
                for (int g = 0; g < 4; ++g) {
                    u32x2 a; a.x = cvtpk(st.o0[4 * g] * inv, st.o0[4 * g + 1] * inv); a.y = cvtpk(st.o0[4 * g + 2] * inv, st.o0[4 * g + 3] * inv); *(u32x2*)(op + 8 * g) = a;
                    u32x2 c; c.x = cvtpk(st.o1[4 * g] * inv, st.o1[4 * g + 1] * inv); c.y = cvtpk(st.o1[4 * g + 2] * inv, st.o1[4 * g + 3] * inv); *(u32x2*)(op + 32 + 8 * g) = c;
                }
                if (hh == 0) { MLS[(slot * 256 + qi) * 2] = st.m; MLS[(slot * 256 + qi) * 2 + 1] = lt; }
            }
            u = __builtin_amdgcn_readfirstlane(un);
        }
    }
    __syncthreads();
    {
        const int c = 32 * wave + r, t = 256 * og + c;
        float M = -1e30f, ms[4], ls[4];
#pragma unroll
        for (int sl = 0; sl < 4; ++sl) {
            const bool v = sl == 3 || SELS[c * 4 + sl] != 255;
            ms[sl] = v ? MLS[(sl * 256 + c) * 2] : -1e30f; ls[sl] = v ? MLS[(sl * 256 + c) * 2 + 1] : 0.f;
            M = fmaxf(M, ms[sl]);
        }
        float L = 0.f; f32x16 o0, o1;
#pragma unroll
        for (int x = 0; x < 16; ++x) { o0[x] = 0.f; o1[x] = 0.f; }
#pragma unroll
        for (int sl = 0; sl < 4; ++sl) {
            const float w = ls[sl] * __builtin_amdgcn_exp2f(ms[sl] - M);
            L += w;
            const bf16_t* op = OPART + (size_t)(sl * 256 + c) * 68 + 4 * hh;
            if (ls[sl] > 0.f) {
#pragma unroll
                for (int g = 0; g < 4; ++g) {
                    const u32x2 a = *(const u32x2*)(op + 8 * g), cc = *(const u32x2*)(op + 32 + 8 * g);
                    o0[4 * g] += w * bflo(a.x); o0[4 * g + 1] += w * bfhi(a.x); o0[4 * g + 2] += w * bflo(a.y); o0[4 * g + 3] += w * bfhi(a.y);
                    o1[4 * g] += w * bflo(cc.x); o1[4 * g + 1] += w * bfhi(cc.x); o1[4 * g + 2] += w * bflo(cc.y); o1[4 * g + 3] += w * bfhi(cc.y);
                }
            }
        }
        store_o(OA + (size_t)(b * SEQ + t) * (2 * WA) + head * HD + 4 * hh, o0, o1, 1.f / L);
    }
}


#define CE(a, b) do { const unsigned lo_ = min(a, b), hi_ = max(a, b); a = lo_; b = hi_; } while (0)
DI void sort16_asc(unsigned (&k)[16]) {
    CE(k[0], k[1]); CE(k[2], k[3]); CE(k[0], k[2]); CE(k[1], k[3]); CE(k[1], k[2]); CE(k[4], k[5]); CE(k[6], k[7]); CE(k[4], k[6]); CE(k[5], k[7]); CE(k[5], k[6]);
    CE(k[0], k[4]); CE(k[2], k[6]); CE(k[2], k[4]); CE(k[1], k[5]); CE(k[3], k[7]); CE(k[3], k[5]); CE(k[1], k[2]); CE(k[3], k[4]); CE(k[5], k[6]); CE(k[8], k[9]);
    CE(k[10], k[11]); CE(k[8], k[10]); CE(k[9], k[11]); CE(k[9], k[10]); CE(k[12], k[13]); CE(k[14], k[15]); CE(k[12], k[14]); CE(k[13], k[15]); CE(k[13], k[14]);
    CE(k[8], k[12]); CE(k[10], k[14]); CE(k[10], k[12]); CE(k[9], k[13]); CE(k[11], k[15]); CE(k[11], k[13]); CE(k[9], k[10]); CE(k[11], k[12]); CE(k[13], k[14]);
    CE(k[0], k[8]); CE(k[4], k[12]); CE(k[4], k[8]); CE(k[2], k[10]); CE(k[6], k[14]); CE(k[6], k[10]); CE(k[2], k[4]); CE(k[6], k[8]); CE(k[10], k[12]);
    CE(k[1], k[9]); CE(k[5], k[13]); CE(k[5], k[9]); CE(k[3], k[11]); CE(k[7], k[15]); CE(k[7], k[11]); CE(k[3], k[5]); CE(k[7], k[9]); CE(k[11], k[13]);
    CE(k[1], k[2]); CE(k[3], k[4]); CE(k[5], k[6]); CE(k[7], k[8]); CE(k[9], k[10]); CE(k[11], k[12]); CE(k[13], k[14]);
}
DI void bitonic16_asc(unsigned (&k)[16]) {
    CE(k[0], k[8]); CE(k[1], k[9]); CE(k[2], k[10]); CE(k[3], k[11]); CE(k[4], k[12]); CE(k[5], k[13]); CE(k[6], k[14]); CE(k[7], k[15]); CE(k[0], k[4]);
    CE(k[1], k[5]); CE(k[2], k[6]); CE(k[3], k[7]); CE(k[8], k[12]); CE(k[9], k[13]); CE(k[10], k[14]); CE(k[11], k[15]); CE(k[0], k[2]); CE(k[1], k[3]);
    CE(k[4], k[6]); CE(k[5], k[7]); CE(k[8], k[10]); CE(k[9], k[11]); CE(k[12], k[14]); CE(k[13], k[15]); CE(k[0], k[1]); CE(k[2], k[3]); CE(k[4], k[5]);
    CE(k[6], k[7]); CE(k[8], k[9]); CE(k[10], k[11]); CE(k[12], k[13]); CE(k[14], k[15]);
}

DI unsigned fkey(float v, unsigned idx) { unsigned b = __float_as_uint(v); b = (b & 0x80000000u) ? ~b : (b | 0x80000000u); return (b & ~127u) | idx; }
DI float fkey_val(unsigned k) { unsigned b = k & ~127u; b = (b & 0x80000000u) ? (b & 0x7fffffffu) : ~b; return __uint_as_float(b); }
DI void top16_of_128(const f32x4 (&acc)[8], int g, unsigned (&t)[16]) {
    unsigned ka[16], kb[16];
#pragma unroll
    for (int ni = 0; ni < 4; ++ni)
#pragma unroll
        for (int j = 0; j < 4; ++j) { ka[4 * ni + j] = fkey(acc[ni][j], 16 * ni + 4 * g + j); kb[4 * ni + j] = fkey(acc[ni + 4][j], 16 * (ni + 4) + 4 * g + j); }
    sort16_asc(ka); sort16_asc(kb);
#pragma unroll
    for (int i = 0; i < 16; ++i) t[i] = max(ka[i], kb[15 - i]);
    bitonic16_asc(t);
#pragma unroll
    for (int xo = 16; xo <= 32; xo <<= 1) {
        unsigned pp[16];
#pragma unroll
        for (int i = 0; i < 16; ++i) pp[i] = (unsigned)__shfl_xor((int)t[i], xo);
#pragma unroll
        for (int i = 0; i < 16; ++i) t[i] = max(t[i], pp[15 - i]);
        bitonic16_asc(t);
    }
}

#define LAS __attribute__((address_space(3)))
#define XB_TMO      128
#define XB_XCNT(j)  (256  + 64 * (j))
#define XB_XSUB(j)  (1280 + 64 * (j))
#define XB_XGEN(j)  (2304 + 64 * (j))
#define XB_TOP      3328
#define XB_TOPGEN   3392
#define XCD_BAR_WORDS 3456
#define XB_SPIN_CAP (1u << 18)

__device__ __forceinline__ unsigned xb_ld(unsigned* p)              { return __hip_atomic_load(p, __ATOMIC_RELAXED, __HIP_MEMORY_SCOPE_AGENT); }
__device__ __forceinline__ unsigned xb_add(unsigned* p, unsigned v) { return __hip_atomic_fetch_add(p, v, __ATOMIC_RELAXED, __HIP_MEMORY_SCOPE_AGENT); }
__device__ __forceinline__ unsigned xb_xcc_id() { return (unsigned)__builtin_amdgcn_s_getreg((3 << 11) | 20) & 0xFu; }
#define XB_SPIN(cond, bar) do { unsigned _sp = 0; while (cond) { __builtin_amdgcn_s_sleep(1); \
    if ((++_sp & 255u) == 0u) { if (xb_ld(&(bar)[XB_TMO])) break; if (_sp > XB_SPIN_CAP) { atomicAdd(&(bar)[XB_TMO], 1u); break; } } } } while (0)

struct XcdBarrier {
    unsigned* bar; unsigned x;
    volatile LAS unsigned* st;
};

__device__ __forceinline__ XcdBarrier xcd_barrier_post(unsigned* bar, volatile LAS unsigned* st) {
    XcdBarrier b; b.bar = bar; b.x = xb_xcc_id(); b.st = st;
    if (threadIdx.x == 0) (void)xb_add(&bar[XB_XCNT(b.x)], 1u);
    return b;
}
__device__ __forceinline__ void xcd_barrier_complete(unsigned* bar, unsigned x, unsigned& nloc, unsigned& nx) {
    const unsigned G = gridDim.x * gridDim.y * gridDim.z;
    unsigned sum, cnt, mine, sp = 0u;
    for (;;) {
        sum = 0u; cnt = 0u; mine = 0u;
#pragma unroll
        for (unsigned j = 0; j < 16; ++j) { const unsigned c = xb_ld(&bar[XB_XCNT(j)]); sum += c; cnt += (c > 0u) ? 1u : 0u; mine = (j == x) ? c : mine; }
        if (sum == G) break;
        __builtin_amdgcn_s_sleep(1);
        if ((++sp & 255u) == 0u) { if (xb_ld(&bar[XB_TMO])) break; if (sp > XB_SPIN_CAP) { atomicAdd(&bar[XB_TMO], 1u); break; } }
    }
    nloc = mine > 0u ? mine : 1u; nx = cnt > 0u ? cnt : 1u;
}

__device__ __forceinline__ void xcd_barrier(const XcdBarrier& b) {
    asm volatile("s_waitcnt vmcnt(0)" ::: "memory");
    __syncthreads();
    if (threadIdx.x == 0) {
        unsigned* bar = b.bar;
        __builtin_amdgcn_s_waitcnt(0);
        unsigned nloc = b.st[0], nx = b.st[1];
        if (nloc == 0u) { xcd_barrier_complete(bar, b.x, nloc, nx); b.st[0] = nloc; b.st[1] = nx; }
        const unsigned old = xb_add(&bar[XB_XSUB(b.x)], 1u);
        const unsigned gen = old / nloc;
        if (old + 1u == (gen + 1u) * nloc) {
            __builtin_amdgcn_fence(__ATOMIC_RELEASE, "agent");
            asm volatile("s_waitcnt vmcnt(0)" ::: "memory");
            const unsigned og = xb_add(&bar[XB_TOP], 1u);
            const unsigned tg = og / nx;
            if (og + 1u == (tg + 1u) * nx) xb_add(&bar[XB_TOPGEN], 1u);
            else XB_SPIN(xb_ld(&bar[XB_TOPGEN]) == tg, bar);
            __builtin_amdgcn_fence(__ATOMIC_ACQUIRE, "agent");
            xb_add(&bar[XB_XGEN(b.x)], 1u);
            asm volatile("s_waitcnt vmcnt(0)" ::: "memory");
        } else {
            XB_SPIN(xb_ld(&bar[XB_XGEN(b.x)]) == gen, bar);
            __builtin_amdgcn_fence(__ATOMIC_ACQUIRE, "agent");
            asm volatile("s_waitcnt vmcnt(0)" ::: "memory");
        }
    }
    __syncthreads();
}


__global__ void __launch_bounds__(NTHREADS, 2) fwd_kernel(Params p) {
    extern __shared__ __attribute__((aligned(16))) unsigned char lds[];
    const int tid = threadIdx.x, lane = tid & 63, wave = tid >> 6;
    const int G = gridDim.x, bid = blockIdx.x;
    const long gtid = (long)bid * NTHREADS + tid, gth = (long)G * NTHREADS;
    const int gwave = bid * NWAVES + wave, ngw = G * NWAVES;
    unsigned char* ws = p.ws;
    bf16_t* WIN = (bf16_t*)(ws + WS_WIN); bf16_t* WOA = (bf16_t*)(ws + WS_WOA);
    bf16_t* WMIX = (bf16_t*)(ws + WS_WMIX); bf16_t* WQ = (bf16_t*)(ws + WS_WQ); bf16_t* SK = (bf16_t*)(ws + WS_SK);
    float* RS1 = (float*)(ws + WS_RS1); float* RS2 = (float*)(ws + WS_RS2);
    bf16_t* XB = (bf16_t*)(ws + WS_XB); bf16_t* OA = (bf16_t*)(ws + WS_OA);
    unsigned short* EIDX = (unsigned short*)(ws + WS_EIDX); float* GW = (float*)(ws + WS_GW);
    bf16_t* QK = (bf16_t*)(ws + WS_QK); bf16_t* KF = (bf16_t*)(ws + WS_KF); bf16_t* VT = (bf16_t*)(ws + WS_VT); bf16_t* MIXED = (bf16_t*)(ws + WS_MIXED); bf16_t* HB = (bf16_t*)(ws + WS_HB);
    bf16_t* GATES = (bf16_t*)(ws + WS_GATES); bf16_t* Q2 = (bf16_t*)(ws + WS_Q2);
    float* SU = (float*)(ws + WS_SU); float* SV = (float*)(ws + WS_SV); float* SSP = (float*)(ws + WS_SSP); float* SH = (float*)(ws + WS_SH);
    signed char* H8 = (signed char*)(ws + WS_H8); int* AP = (int*)(ws + WS_AP); unsigned char* U8 = ws + WS_U8; unsigned char* V8 = ws + WS_V8;
    unsigned* CTL = (unsigned*)(ws + WS_CTL); float* KSUM = (float*)(ws + WS_KSUM); float* SWMAX = (float*)(ws + WS_SWMAX); float* WSC = (float*)(ws + WS_WSC); signed char* WH = (signed char*)(ws + WS_WH); signed char* WL = (signed char*)(ws + WS_WL);
    volatile LAS unsigned* bst = (volatile LAS unsigned*)((LAS unsigned char*)lds + (LDS_BYTES - 16));
    if (tid < 4) bst[tid] = 0u;
    __syncthreads();
    const XcdBarrier xbar = xcd_barrier_post((unsigned*)(ws + WS_CTL) + 1024, bst);
    const int lo = p.ph_lo, hi = p.ph_hi;
#ifdef ONLY_PHASE
#define IN(k) ((k) == ONLY_PHASE && lo <= (k) && (k) < hi)
#else
#define IN(k) (lo <= (k) && (k) < hi)
#endif
#define SEAM(k) do { if (IN(k) && IN((k) + 1)) xcd_barrier(xbar); } while (0)

    for (int rep_ = 0; rep_ < (IN(0) ? 1 : 0); ++rep_) {
        for (int nb = bid; nb < INW / 32; nb += G) {
            float* scr = (float*)(lds + wave * (128 * 33 * 4));
            float* AMX = (float*)(lds + 8 * (128 * 33 * 4));
            const int n0 = 32 * nb, kw = 128 * wave;
            float am = 0.f;
            __syncthreads();
            {
#pragma unroll
                for (int hf = 0; hf < 2; ++hf) {
                    float wv[32], gv[32];
#pragma unroll
                    for (int i = 0; i < 32; ++i) { const int kk = 64 * hf + 2 * i + (lane >> 5); wv[i] = p.w_in[(size_t)(kw + kk) * INW + n0 + (lane & 31)]; gv[i] = p.g1[kw + kk]; }
#pragma unroll
                    for (int i = 0; i < 32; ++i) { const int kk = 64 * hf + 2 * i + (lane >> 5); const float v = wv[i] * gv[i]; scr[kk * 33 + (lane & 31)] = v; am = fmaxf(am, fabsf(v)); }
                }
            }
            am = fmaxf(am, __shfl_xor(am, 32));
            if (lane < 32) AMX[wave * 32 + lane] = am;
            __syncthreads();
            const int kc = lane & 15;
#pragma unroll
            for (int j = 0; j < 8; ++j) {
                const int n = (lane >> 4) + 4 * j;
                float cm = AMX[n];
#pragma unroll
                for (int w2 = 1; w2 < 8; ++w2) cm = fmaxf(cm, AMX[w2 * 32 + n]);
                const float isc = cm > 0.f ? 127.f / cm : 0.f;
                const float* sp = scr + (8 * kc) * 33 + n;
                unsigned lo, hi;
                lo = q8x4(sp[0], sp[33], sp[66], sp[99], isc); hi = q8x4(sp[4 * 33], sp[5 * 33], sp[6 * 33], sp[7 * 33], isc);
                *(u32x2*)((signed char*)WIN + (size_t)(n0 + n) * DM + kw + 8 * kc) = (u32x2){lo, hi};
                if (wave == 0 && kc == 0) SWMAX[n0 + n] = cm;
            }
        }
        __syncthreads();
        {
            float* scr = (float*)(lds + wave * 16384);
            constexpr int I_OA = (WA / 64) * (DM / 32), I_MIX = (DM / 64) * (DM / 32), I_Q = (DM / 64) * (PQW / 32);
            for (int it = gwave; it < 2 * I_OA + I_MIX + I_Q; it += ngw) {
                int r = it;
                if (r < I_OA) { transpose_item(p.w_oa, WA, DM, WOA, 2 * WA, 0, nullptr, scr, r, lane); continue; } r -= I_OA;
                if (r < I_OA) { transpose_item(p.w_ob, WA, DM, WOA, 2 * WA, WA, nullptr, scr, r, lane); continue; } r -= I_OA;
                if (r < I_MIX) { transpose_item(p.w_mix, DM, DM, WMIX, DM, 0, nullptr, scr, r, lane); continue; } r -= I_MIX;
                transpose_item(p.w_q, DM, PQW, WQ, DM, 0, p.g2, scr, r, lane);
            }
            for (long i = gtid; i < 16L * 128 * 128; i += gth) SK[i] = (bf16_t)f2bf(p.skeys[i]);
        }
        for (int row0 = gwave; row0 < T; row0 += 8 * ngw) {
            f32x4 xv[8][4];
#pragma unroll
            for (int k = 0; k < 8; ++k) {
                const int row = row0 + k * ngw;
                if (row < T) {
#pragma unroll
                    for (int j = 0; j < 4; ++j) xv[k][j] = ((const f32x4*)(p.x + (size_t)row * DM) + lane)[64 * j];
                }
            }
#pragma unroll
            for (int k = 0; k < 8; ++k) {
                const int row = row0 + k * ngw;
                if (row < T) {
                    float sq = 0.f, am = 0.f;
#pragma unroll
                    for (int j = 0; j < 4; ++j) { const f32x4 v = xv[k][j]; sq += v.x * v.x + v.y * v.y + v.z * v.z + v.w * v.w; am = fmaxf(fmaxf(am, fmaxf(fabsf(v.x), fabsf(v.y))), fmaxf(fabsf(v.z), fabsf(v.w))); }
                    sq = wave_sum(sq);
#pragma unroll
                    for (int o = 32; o >= 1; o >>= 1) am = fmaxf(am, __shfl_xor(am, o));
                    const float sc = am > 0.f ? am * (1.f / 127.f) : 1.f, isc = 1.f / sc;
                    unsigned* ob = (unsigned*)(XB + (size_t)row * (DM / 2)) + lane;
#pragma unroll
                    for (int j = 0; j < 4; ++j) { const f32x4 v = xv[k][j]; ob[64 * j] = q8x4(v.x, v.y, v.z, v.w, isc); }
                    if (lane == 0) RS1[row] = sc * rsqrtf(sq * (1.f / DM) + RMS_EPS);
                }
            }
        }
    }
    SEAM(0);

    for (int rep_ = 0; rep_ < (IN(1) ? (PROBE_REP == 1 ? 2 : 1) : 0); ++rep_) {
        pg8::Gemm gm{XB, WIN, T, INW, DM / 2}; pg8::StaticOrder S; S.init(T, INW, G, bid);
        EpiInProj E{QK, KF, VT, GATES, RS1, SWMAX, KSUM, rep_ == 0};
        pg8::gemm_phase<EpiInProj, pg8::StaticOrder, true, true>((PG8_LAS unsigned char*)lds, gm, S, E);
    }
    SEAM(1);

    for (int rep_ = 0; rep_ < (IN(3) ? (PROBE_REP == 3 ? 2 : 1) : 0); ++rep_) {
        {
            volatile int* ibox = (volatile int*)(lds + ML_ITEM);
            const unsigned xcc = (unsigned)__builtin_amdgcn_s_getreg((3 << 11) | 20) & 7u;
            unsigned* Q3 = CTL + 64 + (rep_ ? 8 : 0);
            int qx = (int)xcc;
            __syncthreads();
            if (tid == 0) ibox[0] = (int)atomicAdd(&Q3[qx], 1u);
            __syncthreads();
            for (;;) {
                int k = __builtin_amdgcn_readfirstlane(ibox[0]);
                if (k >= 64) {
                    __syncthreads();
                    if (wave == 0) {
                        unsigned v = 64u;
                        if (lane < 8) v = __hip_atomic_load(&Q3[(xcc + (unsigned)lane) & 7u], __ATOMIC_RELAXED, __HIP_MEMORY_SCOPE_AGENT);
                        const unsigned long long m = __ballot(v < 64u);
                        int nq = -1; unsigned nk = 64u;
                        if (m != 0ull) { nq = (int)((xcc + (unsigned)__builtin_ctzll(m)) & 7u); if (lane == 0) nk = atomicAdd(&Q3[nq], 1u); }
                        if (lane == 0) { ibox[0] = (int)nk; ibox[1] = nq; }
                    }
                    __syncthreads();
                    const int nq = __builtin_amdgcn_readfirstlane(ibox[1]);
                    if (nq < 0) break;
                    qx = nq;
                    continue;
                }
                const int oi = k >> 1;
                const int og = p3_order(oi), bh = 2 * qx + (k & 1);
                moba_group(lds, QK, KF, VT, KSUM, OA, bh >> 3, bh & 7, og, true, &Q3[qx]);
            }
        }
    }
    SEAM(3);

    for (int rep_ = 0; rep_ < (IN(4) ? 1 : 0); ++rep_) {
        pg8::Gemm gm{OA, WOA, T, DM, 2 * WA}; pg8::StaticOrder S; S.init(T, DM, G, bid);
        EpiMix E{GATES, MIXED};
        pg8::gemm_phase<EpiMix, pg8::StaticOrder, true, true, true>((PG8_LAS unsigned char*)lds, gm, S, E);
    }
    SEAM(4);

    for (int rep_ = 0; rep_ < (IN(5) ? (PROBE_REP == 5 ? 2 : 1) : 0); ++rep_) {
        pg8::Gemm gm{MIXED, WMIX, T, DM, DM}; pg8::StaticOrder S; S.init(T, DM, G, bid);
        EpiResid E{p.x, HB};
        pg8::gemm_phase<EpiResid, pg8::StaticOrder, true, true>((PG8_LAS unsigned char*)lds, gm, S, E);
    }
    SEAM(5);

    for (int rep_ = 0; rep_ < (IN(7) ? 1 : 0); ++rep_) {
        pg8::Gemm gm{HB, WQ, T, PQW, DM}; pg8::StaticOrder S; S.init(T, PQW, G, bid);
        EpiPeerQ E{Q2};
        pg8::gemm_phase<EpiPeerQ, pg8::StaticOrder, true, true>((PG8_LAS unsigned char*)lds, gm, S, E);
    }
    SEAM(7);

    for (int rep_ = 0; rep_ < (IN(8) ? (PROBE_REP == 8 ? 2 : 1) : 0); ++rep_) {
        bf16_t* Qs = (bf16_t*)lds;
        bf16_t* Ks = Qs + 128 * 264;
        unsigned* LST = (unsigned*)(lds + 128 * 264 * 2 + 2 * 128 * 136 * 2);
        int h_loaded = -1;
        __syncthreads();
        if (bid < (T / 128) * 8) {
            const int h0 = bid & 7, t00 = (bid >> 3) * 128;
#pragma unroll
            for (int i = 0; i < 8; ++i) { const int c = tid + i * NTHREADS, r = c >> 5, ch = c & 31; *(u32x4*)(Qs + r * 264 + ch * 8) = *(const u32x4*)(Q2 + (size_t)(t00 + r) * PQW + h0 * 256 + ch * 8); }
        }
        for (int it = bid; it < (T / 128) * 8; it += G) {
            const int h = it & 7, t0 = (it >> 3) * 128;
            if (h != h_loaded) {
#pragma unroll
                for (int i = 0; i < 8; ++i) {
                    const int c = tid + i * NTHREADS, r = c >> 4, ch = c & 15;
                    *(u32x4*)(Ks + r * 136 + ch * 8) = *(const u32x4*)(SK + (size_t)(2 * h * 128 + r) * 128 + ch * 8);
                }
                h_loaded = h;
            }
            __syncthreads();
#pragma unroll 1
            for (int ph = 0; ph < 2; ++ph) {
                f32x4 acc[8];
#pragma unroll
                for (int ni = 0; ni < 8; ++ni) acc[ni] = (f32x4){0.f, 0.f, 0.f, 0.f};
#pragma unroll
                for (int ks = 0; ks < 4; ++ks) {
                    const bf16x8 qf = *(const bf16x8*)(Qs + (wave * 16 + (lane & 15)) * 264 + ph * 128 + ks * 32 + (lane >> 4) * 8);
#pragma unroll
                    for (int ni = 0; ni < 8; ++ni) {
                        const bf16x8 kf = *(const bf16x8*)(Ks + (ph * 128 + ni * 16 + (lane & 15)) * 136 + ks * 32 + (lane >> 4) * 8);
                        acc[ni] = __builtin_amdgcn_mfma_f32_16x16x32_bf16(kf, qf, acc[ni], 0, 0, 0);
                    }
                }
                unsigned tk[16];
                top16_of_128(acc, lane >> 4, tk);
                if (lane < 16) {
                    unsigned* dst = LST + ((wave * 16 + lane) * 2 + ph) * 16;
#pragma unroll
                    for (int i = 0; i < 4; ++i) { u32x4 w; w.x = tk[15 - 4 * i]; w.y = tk[14 - 4 * i]; w.z = tk[13 - 4 * i]; w.w = tk[12 - 4 * i]; *(u32x4*)(dst + 4 * i) = w; }
                }
            }
            __syncthreads();
            if (tid >= 128 && it + G < (T / 128) * 8) {
                const int itn = it + G, hn = itn & 7, tn0 = (itn >> 3) * 128;
                for (int c = tid - 128; c < 128 * 32; c += NTHREADS - 128) { const int r = c >> 5, ch = c & 31; *(u32x4*)(Qs + r * 264 + ch * 8) = *(const u32x4*)(Q2 + (size_t)(tn0 + r) * PQW + hn * 256 + ch * 8); }
            }
            if (wave >= 6) quant_rows<8>(p.pu, p.pv, p.g2, U8, V8, SU, SV, it * 32 + 16 + (wave - 6) * 8, 1, lane);
            else if (wave >= 2) quant_rows<4>(p.pu, p.pv, p.g2, U8, V8, SU, SV, it * 32 + (wave - 2) * 4, 1, lane);
            if (tid >= 128 && tid < 384) h_rows4(HB, RS2, SH, H8, it * 16 + (wave - 2) * 4, 1, lane);
            if (tid < 128) {
                const unsigned* La = LST + (tid * 2) * 16; const unsigned* Lb = La + 16;
                float cand[16];
                const float b0 = fkey_val(Lb[0]);
#pragma unroll
                for (int i = 0; i < 4; ++i) { const u32x4 w = *(const u32x4*)(La + 4 * i); cand[4 * i] = fkey_val(w.x) + b0; cand[4 * i + 1] = fkey_val(w.y) + b0; cand[4 * i + 2] = fkey_val(w.z) + b0; cand[4 * i + 3] = fkey_val(w.w) + b0; }
                unsigned long long ptrs = 0ull;
                float selv[16]; unsigned sele[16];
#pragma unroll
                for (int r = 0; r < 16; ++r) {
                    float best = cand[0];
#pragma unroll
                    for (int i = 1; i < 16; ++i) best = fmaxf(best, cand[i]);
                    int istar = 15;
#pragma unroll
                    for (int i = 14; i >= 0; --i) istar = (cand[i] == best) ? i : istar;
                    const int j = (int)((ptrs >> (4 * istar)) & 15ull);
                    const unsigned ka = La[istar], kb = Lb[j];
                    selv[r] = best; sele[r] = (ka & 127u) * PNK + (kb & 127u);
                    const bool more = j < 15;
                    const float nc = more ? fkey_val(ka) + fkey_val(Lb[more ? j + 1 : j]) : -INFINITY;
                    if (more) ptrs += 1ull << (4 * istar);
#pragma unroll
                    for (int i = 0; i < 16; ++i) cand[i] = (i == istar) ? nc : cand[i];
                }
                float* go = GW + (size_t)(t0 + tid) * 128 + h * 16;
#pragma unroll
                for (int r = 0; r < 8; ++r) *(unsigned*)(EIDX + (size_t)(t0 + tid) * 128 + r * 16 + 2 * h) = sele[r] | (sele[r + 8] << 16);
#pragma unroll
                for (int i = 0; i < 4; ++i) *(f32x4*)(go + 4 * i) = (f32x4){selv[4 * i], selv[4 * i + 1], selv[4 * i + 2], selv[4 * i + 3]};
            }
        }
    }
    SEAM(8);

#define PEER_ID(ia, ib, i) ((((i) < 8 ? (ia) : (ib))[((i) & 7) >> 1] >> (((i) & 1) * 16)) & 0xffffu)
#define PEER_ROWS4(dst, base, ia, ib, m) do { _Pragma("unroll") for (int q_ = 0; q_ < 4; ++q_) dst[4 * (m) + q_] = *(const u32x4*)((base) + (unsigned)(PEER_ID(ia, ib, 4 * (m) + q_) * 128u + jp16)); } while (0)
#define PEER_IDS(ia, ib, t) do { const unsigned short* ep_ = EIDX + (size_t)(t) * 128; ia = *(const u32x4*)(ep_ + (unsigned)(g * 16)); ib = *(const u32x4*)(ep_ + (unsigned)(g * 16 + 8)); } while (0)
    for (int rep_ = 0; rep_ < (IN(9) ? (PROBE_REP == 9 ? 2 : 1) : 0); ++rep_) {
        volatile int* ubox = (volatile int*)lds;
        const unsigned xcc = (unsigned)__builtin_amdgcn_s_getreg((3 << 11) | 20) & 7u;
        int ln = lane; asm volatile("" : "+v"(ln));
        const int g = ln >> 3, jp = ln & 7;
        const bool b2 = (ln & 4) != 0, b1 = (ln & 2) != 0, b0 = (ln & 1) != 0;
        const int wv = __builtin_amdgcn_readfirstlane(wave); const unsigned jp16 = (unsigned)jp * 16u;
        constexpr int NTW = 32;
        int live = 0xff;
        for (int k8 = 0; k8 < 8; ++k8) {
            const int sl = (int)((xcc + k8) & 7u);
            if (k8 == 1) {
                __syncthreads();
                if (wave == 0) { unsigned v = 0xffffffffu; if (lane < 8) v = __hip_atomic_load(&CTL[(rep_ ? 32 : 0) + lane], __ATOMIC_RELAXED, __HIP_MEMORY_SCOPE_AGENT);
                    const unsigned long long m = __ballot(v < (unsigned)(T / (8 * NTW))); if (lane == 0) ubox[1] = (int)m; }
                __syncthreads();
                live = __builtin_amdgcn_readfirstlane(ubox[1]);
            }
            if (!((live >> sl) & 1)) continue;
            const unsigned char* U8s = U8 + (size_t)sl * NEXP * 128;
            __syncthreads();
            if (tid == 0) ubox[0] = (int)atomicAdd(&CTL[(rep_ ? 32 : 0) + sl], 1u);
            __syncthreads();
            for (;;) {
                const int u = __builtin_amdgcn_readfirstlane(ubox[0]);
                if (u >= T / (8 * NTW)) break;
                unsigned nxt = 0u;
                if (tid == 0) nxt = atomicAdd(&CTL[(rep_ ? 32 : 0) + sl], 1u);
                const int tb = u * (8 * NTW) + wv;
#define P1_HQ(hq, t) hq = *(const u32x4*)(H8 + (size_t)(t) * DM + sl * 128 + jp16)
#define P1_DOT4(d, rw, hq, m) do { _Pragma("unroll") for (int q_ = 0; q_ < 4; ++q_) { int x_ = __builtin_amdgcn_sdot4((int)hq.x, (int)rw[4 * (m) + q_].x, 0, false); x_ = __builtin_amdgcn_sdot4((int)hq.y, (int)rw[4 * (m) + q_].y, x_, false); \
        x_ = __builtin_amdgcn_sdot4((int)hq.z, (int)rw[4 * (m) + q_].z, x_, false); d[4 * (m) + q_] = __builtin_amdgcn_sdot4((int)hq.w, (int)rw[4 * (m) + q_].w, x_, false); } } while (0)
#define P1_FINISH(d_, t) do { int v8_[8], v4_[4]; \
    _Pragma("unroll") for (int i_ = 0; i_ < 8; ++i_) v8_[i_] = (b2 ? d_[8 + i_] : d_[i_]) + __shfl_xor(b2 ? d_[i_] : d_[8 + i_], 4); \
    _Pragma("unroll") for (int i_ = 0; i_ < 4; ++i_) v4_[i_] = (b1 ? v8_[4 + i_] : v8_[i_]) + __shfl_xor(b1 ? v8_[i_] : v8_[4 + i_], 2); \
    const int k0_ = (b0 ? v4_[2] : v4_[0]) + __shfl_xor(b0 ? v4_[0] : v4_[2], 1), k1_ = (b0 ? v4_[3] : v4_[1]) + __shfl_xor(b0 ? v4_[1] : v4_[3], 1); \
    int* ap_ = AP + ((size_t)sl * T + (t)) * 128 + 16 * jp + g; ap_[0] = k0_; ap_[8] = k1_; } while (0)
#define P1_STEP(rw, hq, ea, eb, i, REISSUE) do { int d_[16]; \
    _Pragma("unroll") for (int m_ = 0; m_ < 4; ++m_) { P1_DOT4(d_, rw, hq, m_); __builtin_amdgcn_sched_barrier(0); if (REISSUE) { PEER_ROWS4(rw, U8s, ea, eb, m_); __builtin_amdgcn_sched_barrier(0); } } \
    P1_FINISH(d_, tb + 8 * (i)); } while (0)
                u32x4 e0a, e0b, e1a, e1b, h0, h1, rwA[16], rwB[16];
                PEER_IDS(e0a, e0b, tb); PEER_IDS(e1a, e1b, tb + 8); P1_HQ(h0, tb);
#pragma unroll
                for (int m_ = 0; m_ < 4; ++m_) PEER_ROWS4(rwA, U8s, e0a, e0b, m_);
#pragma unroll
                for (int m_ = 0; m_ < 4; ++m_) PEER_ROWS4(rwB, U8s, e1a, e1b, m_);
                PEER_IDS(e0a, e0b, tb + 16);
#pragma unroll 1
                for (int i = 0; i < NTW - 2; i += 2) {
                    PEER_IDS(e1a, e1b, tb + 8 * (i + 3));
                    P1_HQ(h1, tb + 8 * (i + 1));
                    P1_STEP(rwA, h0, e0a, e0b, i, true);
                    { const int tn = tb + 8 * (i + 4 < NTW ? i + 4 : NTW - 1); PEER_IDS(e0a, e0b, tn); }
                    P1_HQ(h0, tb + 8 * (i + 2));
                    P1_STEP(rwB, h1, e1a, e1b, i + 1, true);
                }
                P1_HQ(h1, tb + 8 * (NTW - 1));
                P1_STEP(rwA, h0, e0a, e0b, NTW - 2, false);
                P1_STEP(rwB, h1, e1a, e1b, NTW - 1, false);
                __syncthreads();
                if (tid == 0) ubox[0] = (int)nxt;
                __syncthreads();
            }
        }
    }
    SEAM(9);

    for (int rep_ = 0; rep_ < (IN(10) ? (PROBE_REP == 10 ? 2 : 1) : 0); ++rep_) {
        for (int t = gwave; t < T; t += ngw) {
            int s0 = 0, s1 = 0;
#pragma unroll
            for (int q = 0; q < 8; ++q) { const int* ap = AP + ((size_t)q * T + t) * 128; s0 += ap[lane]; s1 += ap[64 + lane]; }
            const int p0 = (lane & 7) * 16 + (lane >> 3), p1 = p0 + 8;
            const int e0 = EIDX[(size_t)t * 128 + p0], e1 = EIDX[(size_t)t * 128 + p1];
            const float sc = SH[t] * RS2[t];
            const float a0 = (float)s0 * (sc * SU[e0]), a1 = (float)s1 * (sc * SU[e1]);
            const float rs2t = RS2[t];
            const float c0 = GW[(size_t)t * 128 + lane] * rs2t, c1 = GW[(size_t)t * 128 + 64 + lane] * rs2t;
            float m0 = c0, m1 = c1;
#pragma unroll
            for (int o = 8; o >= 1; o >>= 1) { m0 = fmaxf(m0, __shfl_xor(m0, o)); m1 = fmaxf(m1, __shfl_xor(m1, o)); }
            const float x0e = __expf(c0 - m0), x1e = __expf(c1 - m1);
            float z0 = x0e, z1 = x1e;
#pragma unroll
            for (int o = 8; o >= 1; o >>= 1) { z0 += __shfl_xor(z0, o); z1 += __shfl_xor(z1, o); }
            const float w0 = (x0e * __builtin_amdgcn_rcpf(z0)) * (0.5f * a0 * (1.f + erff(a0 * 0.70710678118654752f))) * SV[e0];
            const float w1 = (x1e * __builtin_amdgcn_rcpf(z1)) * (0.5f * a1 * (1.f + erff(a1 * 0.70710678118654752f))) * SV[e1];
            float wm = fmaxf(fabsf(w0), fabsf(w1));
#pragma unroll
            for (int o = 32; o >= 1; o >>= 1) wm = fmaxf(wm, __shfl_xor(wm, o));
            const float wsc = wm > 0.f ? wm * (1.f / 127.f) : 1.f, iw = 1.f / wsc;
            const float x0 = w0 * iw, x1 = w1 * iw;
            int h0 = (int)rintf(x0), h1 = (int)rintf(x1);
            h0 = h0 < -127 ? -127 : (h0 > 127 ? 127 : h0); h1 = h1 < -127 ? -127 : (h1 > 127 ? 127 : h1);
            WH[(size_t)t * 128 + p0] = (signed char)h0; WH[(size_t)t * 128 + p1] = (signed char)h1;
            if (lane == 0) WSC[t] = wsc;
        }
    }
    SEAM(10);

    for (int rep_ = 0; rep_ < (IN(11) ? (PROBE_REP == 11 ? 2 : 1) : 0); ++rep_) {
        const bool dry_ = (PROBE_REP == 11) && rep_ == 0;
        volatile int* ubox = (volatile int*)lds;
        const unsigned xcc = (unsigned)__builtin_amdgcn_s_getreg((3 << 11) | 20) & 7u;
        int ln = lane; asm volatile("" : "+v"(ln));
        const int g = ln >> 3, jp = ln & 7;
        const bool b5 = (ln & 32) != 0, b4 = (ln & 16) != 0, b3 = (ln & 8) != 0;
        const int wv = __builtin_amdgcn_readfirstlane(wave); const unsigned jp16 = (unsigned)jp * 16u;
        constexpr int NTW = 32;
        int live = 0xff;
        for (int k8 = 0; k8 < 8; ++k8) {
            const int sl = (int)((xcc + k8) & 7u);
            if (k8 == 1) {
                __syncthreads();
                if (wave == 0) { unsigned v = 0xffffffffu; if (lane < 8) v = __hip_atomic_load(&CTL[(dry_ ? 48 : 16) + lane], __ATOMIC_RELAXED, __HIP_MEMORY_SCOPE_AGENT);
                    const unsigned long long m = __ballot(v < (unsigned)(T / (8 * NTW))); if (lane == 0) ubox[1] = (int)m; }
                __syncthreads();
                live = __builtin_amdgcn_readfirstlane(ubox[1]);
            }
            if (!((live >> sl) & 1)) continue;
            const unsigned char* V8s = V8 + (size_t)sl * NEXP * 128;
            __syncthreads();
            if (tid == 0) ubox[0] = (int)atomicAdd(&CTL[(dry_ ? 48 : 16) + sl], 1u);
            __syncthreads();
            for (;;) {
                const int u = __builtin_amdgcn_readfirstlane(ubox[0]);
                if (u >= T / (8 * NTW)) break;
                unsigned nxt = 0u;
                if (tid == 0) nxt = atomicAdd(&CTL[(dry_ ? 48 : 16) + sl], 1u);
                const int tb = u * (8 * NTW) + wv;
#define P2_WM(wh, hv, wsc, t) do { wh = *(const u32x4*)(WH + (size_t)(t) * 128 + (unsigned)(g * 16)); { const unsigned hw_ = *(const unsigned*)(HB + (size_t)(t) * DM + sl * 128 + (unsigned)(jp * 16 + 2 * g)); hv = (f32x2_t){bflo(hw_), bfhi(hw_)}; } wsc = WSC[t]; } while (0)
#define P2_COL(rw, wh, ah, c, cb, m) do { const unsigned t0_ = __builtin_amdgcn_perm(rw[4 * (m) + 1].c, rw[4 * (m)].c, 0x05010400u), t1_ = __builtin_amdgcn_perm(rw[4 * (m) + 3].c, rw[4 * (m) + 2].c, 0x05010400u); \
    const unsigned t2_ = __builtin_amdgcn_perm(rw[4 * (m) + 1].c, rw[4 * (m)].c, 0x07030602u), t3_ = __builtin_amdgcn_perm(rw[4 * (m) + 3].c, rw[4 * (m) + 2].c, 0x07030602u); \
    ah[(cb) + 0] = __builtin_amdgcn_sdot4((int)__builtin_amdgcn_perm(t1_, t0_, 0x05040100u), (int)wh[m], ah[(cb) + 0], false); ah[(cb) + 1] = __builtin_amdgcn_sdot4((int)__builtin_amdgcn_perm(t1_, t0_, 0x07060302u), (int)wh[m], ah[(cb) + 1], false); \
    ah[(cb) + 2] = __builtin_amdgcn_sdot4((int)__builtin_amdgcn_perm(t3_, t2_, 0x05040100u), (int)wh[m], ah[(cb) + 2], false); ah[(cb) + 3] = __builtin_amdgcn_sdot4((int)__builtin_amdgcn_perm(t3_, t2_, 0x07060302u), (int)wh[m], ah[(cb) + 3], false); } while (0)
#define P2_FINISH(d_, hv, wsc, t) do { int v8_[8], v4_[4]; \
    _Pragma("unroll") for (int i_ = 0; i_ < 8; ++i_) v8_[i_] = (b5 ? d_[8 + i_] : d_[i_]) + __shfl_xor(b5 ? d_[i_] : d_[8 + i_], 32); \
    _Pragma("unroll") for (int i_ = 0; i_ < 4; ++i_) v4_[i_] = (b4 ? v8_[4 + i_] : v8_[i_]) + __shfl_xor(b4 ? v8_[i_] : v8_[4 + i_], 16); \
    const int k0_ = (b3 ? v4_[2] : v4_[0]) + __shfl_xor(b3 ? v4_[0] : v4_[2], 8), k1_ = (b3 ? v4_[3] : v4_[1]) + __shfl_xor(b3 ? v4_[1] : v4_[3], 8); \
    bf16_t* orow_ = MIXED + (size_t)(t) * DM + sl * 128 + jp * 16 + 2 * g;     \
    const unsigned ob_ = cvtpk((hv).x + (float)k0_ * (wsc), (hv).y + (float)k1_ * (wsc)); const float o0_ = bflo(ob_), o1_ = bfhi(ob_); \
    if (!dry_) *(unsigned*)orow_ = ob_; \
    const float ss_ = wave_sum(o0_ * o0_ + o1_ * o1_); if (ln == 0 && !dry_) SSP[(size_t)(t) * 8 + sl] = ss_; asm volatile("" :: "v"(ss_)); } while (0)
#define P2_STEP(rw, wh, hv, wsc, ea, eb, i, REISSUE) do { int d_[16]; _Pragma("unroll") for (int i_ = 0; i_ < 16; ++i_) d_[i_] = 0; \
    _Pragma("unroll") for (int m_ = 0; m_ < 4; ++m_) { P2_COL(rw, wh, d_, x, 0, m_); P2_COL(rw, wh, d_, y, 4, m_); P2_COL(rw, wh, d_, z, 8, m_); P2_COL(rw, wh, d_, w, 12, m_); __builtin_amdgcn_sched_barrier(0); \
        if (REISSUE) { PEER_ROWS4(rw, V8s, ea, eb, m_); __builtin_amdgcn_sched_barrier(0); } } \
    P2_FINISH(d_, hv, wsc, tb + 8 * (i)); } while (0)
                u32x4 e0a, e0b, e1a, e1b, w0, w1, rwA[16], rwB[16]; f32x2_t hv0, hv1; float ws0, ws1;
                PEER_IDS(e0a, e0b, tb); PEER_IDS(e1a, e1b, tb + 8); P2_WM(w0, hv0, ws0, tb);
#pragma unroll
                for (int m_ = 0; m_ < 4; ++m_) PEER_ROWS4(rwA, V8s, e0a, e0b, m_);
#pragma unroll
                for (int m_ = 0; m_ < 4; ++m_) PEER_ROWS4(rwB, V8s, e1a, e1b, m_);
                PEER_IDS(e0a, e0b, tb + 16);
#pragma unroll 1
                for (int i = 0; i < NTW - 2; i += 2) {
                    PEER_IDS(e1a, e1b, tb + 8 * (i + 3));
                    P2_WM(w1, hv1, ws1, tb + 8 * (i + 1));
                    P2_STEP(rwA, w0, hv0, ws0, e0a, e0b, i, true);
                    { const int tn = tb + 8 * (i + 4 < NTW ? i + 4 : NTW - 1); PEER_IDS(e0a, e0b, tn); }
                    P2_WM(w0, hv0, ws0, tb + 8 * (i + 2));
                    P2_STEP(rwB, w1, hv1, ws1, e1a, e1b, i + 1, true);
                }
                P2_WM(w1, hv1, ws1, tb + 8 * (NTW - 1));
                P2_STEP(rwA, w0, hv0, ws0, e0a, e0b, NTW - 2, false);
                P2_STEP(rwB, w1, hv1, ws1, e1a, e1b, NTW - 1, false);
                __syncthreads();
                if (tid == 0) ubox[0] = (int)nxt;
                __syncthreads();
            }
        }
    }
    SEAM(11);

    for (int rep_ = 0; rep_ < (IN(12) ? 1 : 0); ++rep_) {
        for (int row = gwave; row < T; row += ngw) {
            float tot = 0.f;
#pragma unroll
            for (int q = 0; q < 8; ++q) tot += SSP[(size_t)row * 8 + q];
            const float rs = rsqrtf(tot * (1.f / DM) + RMS_EPS);
            f32x4* orow = (f32x4*)(p.out + (size_t)row * DM) + lane; const u32x2* ob = (const u32x2*)(MIXED + (size_t)row * DM) + lane;
#pragma unroll
            for (int j = 0; j < 4; ++j) { const f32x4 gv = ((const f32x4*)p.gf)[lane + 64 * j]; const u32x2 w = ob[64 * j]; orow[64 * j] = (f32x4){bflo(w.x), bfhi(w.x), bflo(w.y), bfhi(w.y)} * rs * gv; }
        }
    }
#undef IN
#undef SEAM
}

extern "C" void kernel_launch(void* const* d_in, const int* in_sizes, int n_in, void* d_out, int out_size, void* d_ws, size_t ws_size, hipStream_t stream) {
    static int grid = 0;
    if (grid == 0) {
        int dev = 0, cus = 0, per_cu = 0;
        (void)hipGetDevice(&dev);
        (void)hipDeviceGetAttribute(&cus, hipDeviceAttributeMultiprocessorCount, dev);
        (void)hipFuncSetAttribute((const void*)fwd_kernel, hipFuncAttributeMaxDynamicSharedMemorySize, LDS_BYTES);
        (void)hipOccupancyMaxActiveBlocksPerMultiprocessor(&per_cu, (const void*)fwd_kernel, NTHREADS, LDS_BYTES);
        if (per_cu < 1) { fprintf(stderr, "kernel_launch: occupancy query says %d blocks per CU\n", per_cu); per_cu = 1; }
        grid = cus * 1;
        if (ws_size < WS_END) { fprintf(stderr, "kernel_launch: workspace too small: %zu < %zu\n", ws_size, (size_t)WS_END); grid = -1; }
    }
    if (grid < 0) return;
    Params p{};
    p.x = (const float*)d_in[0]; p.g1 = (const float*)d_in[1]; p.w_in = (const float*)d_in[2]; p.w_oa = (const float*)d_in[3]; p.w_ob = (const float*)d_in[4];
    p.w_mix = (const float*)d_in[5]; p.g2 = (const float*)d_in[6]; p.w_q = (const float*)d_in[7]; p.skeys = (const float*)d_in[8]; p.pu = (const float*)d_in[9];
    p.pv = (const float*)d_in[10]; p.gf = (const float*)d_in[11]; p.out = (float*)d_out; p.ws = (unsigned char*)d_ws;
    p.ph_lo = 0; p.ph_hi = 13;
    if (hipMemsetAsync((char*)d_ws + WS_CTL, 0, 65536 + 131072 + 32768, stream) != hipSuccess) { fprintf(stderr, "kernel_launch: hipMemsetAsync failed\n"); return; }
    hipLaunchKernelGGL(fwd_kernel, dim3(grid), dim3(NTHREADS), LDS_BYTES, stream, p);
}
```

```cpp
#include <hip/hip_runtime.h>
#include <cstdio>
#include <cstdint>

#define DI __device__ __forceinline__
typedef unsigned short bf16_t;
typedef short bf16x8 __attribute__((ext_vector_type(8)));
typedef float f32x4 __attribute__((ext_vector_type(4)));
typedef unsigned u32x4 __attribute__((ext_vector_type(4)));
typedef unsigned u32x2 __attribute__((ext_vector_type(2)));

constexpr int NBATCH = 2, SEQ = 8192, T = NBATCH * SEQ, DM = 1024;
constexpr int NH = 8, HD = 64, WA = 512;
constexpr int INW = 5120, QKVW = 3072, GATEW = 2048;
constexpr int MBLK = 256, NBLK = SEQ / MBLK;
constexpr int PNK = 128, PTOPK = 16, NEXP = 16384, PQW = 2048;
constexpr float RMS_EPS = 1e-6f;
constexpr int NTHREADS = 512, NWAVES = 8;
static_assert((T / 128) * 8 * 32 == 2 * NEXP && (T / 128) * 8 * 16 == T, "P8 side work: 32 expert rows and 16 h rows per item cover all rows");
constexpr int LDS_BYTES = 163840;
#ifndef PROBE_REP
#define PROBE_REP -1
#endif

constexpr size_t MiB = 1u << 20;
constexpr size_t WS_CTL = 0;
constexpr size_t WS_KSUM = 65536;
constexpr size_t WS_SWMAX = 196608;
constexpr size_t WS_WIN = 1 * MiB;
constexpr size_t WS_WOA = 11 * MiB;
constexpr size_t WS_WMIX = 13 * MiB;
constexpr size_t WS_WQ = 15 * MiB;
constexpr size_t WS_SK = 19 * MiB;
constexpr size_t WS_RS1 = 19 * MiB + 512 * 1024;
constexpr size_t WS_RS2 = WS_RS1 + 65536;
constexpr size_t WS_XB = 24 * MiB;
constexpr size_t WS_OA = 24 * MiB;
constexpr size_t WS_EIDX = 24 * MiB;
constexpr size_t WS_GW = 28 * MiB;
constexpr size_t WS_QK = 56 * MiB;
constexpr size_t WS_KF = 88 * MiB;
constexpr size_t WS_VT = 120 * MiB;
constexpr size_t WS_MIXED = 56 * MiB;
constexpr size_t WS_HB = 88 * MiB;
constexpr size_t WS_GATES = 152 * MiB;
constexpr size_t WS_Q2 = 152 * MiB;
constexpr size_t WS_SU = 20 * MiB;
constexpr size_t WS_SV = WS_SU + 65536;
constexpr size_t WS_SSP = 36 * MiB;
constexpr size_t WS_SH = WS_SSP + 524288;
constexpr size_t WS_WSC = WS_SH + 65536;
constexpr size_t WS_WH = 37 * MiB;
constexpr size_t WS_WL = 39 * MiB;
constexpr size_t WS_H8 = 40 * MiB;
constexpr size_t WS_AP = 152 * MiB;
constexpr size_t WS_U8 = 216 * MiB;
constexpr size_t WS_V8 = 232 * MiB;
constexpr size_t WS_END = 248 * MiB;

struct Params {
    const float *x, *g1, *w_in, *w_oa, *w_ob, *w_mix, *g2, *w_q, *skeys, *pu, *pv, *gf;
    float* out; unsigned char* ws; int ph_lo, ph_hi;
};

DI unsigned f2bf(float f) { unsigned u = __float_as_uint(f); return (u + 0x7fffu + ((u >> 16) & 1u)) >> 16; }
DI float bf2f(unsigned h) { return __uint_as_float(h << 16); }
DI float bflo(unsigned w) { return __uint_as_float(w << 16); }
DI float bfhi(unsigned w) { return __uint_as_float(w & 0xffff0000u); }
typedef __bf16 bf16x2_t __attribute__((ext_vector_type(2)));
typedef float f32x2_t __attribute__((ext_vector_type(2)));
DI unsigned cvtpk(float lo, float hi) { f32x2_t v = {lo, hi}; bf16x2_t b = __builtin_convertvector(v, bf16x2_t); return __builtin_bit_cast(unsigned, b); }
DI unsigned pk2(float lo, float hi) { return cvtpk(lo, hi); }
DI unsigned q8x4(float a, float b, float c, float d, float isc) {
    const float M = 12582912.f;
    const unsigned fa = __float_as_uint(fmaf(a, isc, M)), fb = __float_as_uint(fmaf(b, isc, M)), fc = __float_as_uint(fmaf(c, isc, M)), fd = __float_as_uint(fmaf(d, isc, M));
    return __builtin_amdgcn_perm(fb, fa, 0x0c0c0400u) | __builtin_amdgcn_perm(fd, fc, 0x04000c0cu);
}
DI float wave_sum(float v) {
#pragma unroll
    for (int o = 32; o >= 1; o >>= 1) v += __shfl_xor(v, o);
    return v;
}
DI void load_row64(const bf16_t* p, float* o) {
#pragma unroll
    for (int i = 0; i < 8; ++i) {
        u32x4 w = *(const u32x4*)(p + 8 * i);
        o[8 * i + 0] = bflo(w.x); o[8 * i + 1] = bfhi(w.x); o[8 * i + 2] = bflo(w.y); o[8 * i + 3] = bfhi(w.y);
        o[8 * i + 4] = bflo(w.z); o[8 * i + 5] = bfhi(w.z); o[8 * i + 6] = bflo(w.w); o[8 * i + 7] = bfhi(w.w);
    }
}
DI float sigmoidf_(float x) { return __builtin_amdgcn_rcpf(1.f + __builtin_amdgcn_exp2f(x * -1.4426950408889634f)); }

DI void transpose_item(const float* W, int K, int N, bf16_t* WT, int ldk, int koff, const float* ks, float* scr, int item, int lane) {
    const int nblk = N / 32, kb = item / nblk, nb = item % nblk, k0 = 64 * kb, n0 = 32 * nb;
    float tv[32];
#pragma unroll
    for (int i = 0; i < 32; ++i) tv[i] = W[(size_t)(k0 + 2 * i + (lane >> 5)) * N + n0 + (lane & 31)];
    if (ks) {
#pragma unroll
        for (int i = 0; i < 32; ++i) tv[i] *= ks[k0 + 2 * i + (lane >> 5)];
    }
#pragma unroll
    for (int i = 0; i < 32; ++i) scr[(2 * i + (lane >> 5)) * 33 + (lane & 31)] = tv[i];
    asm volatile("s_waitcnt lgkmcnt(0)" ::: "memory");
    const int c = lane & 7;
#pragma unroll
    for (int j = 0; j < 4; ++j) { const int n = (lane >> 3) + 8 * j; const float* sp = scr + (8 * c) * 33 + n;
        u32x4 o; o.x = pk2(sp[0 * 33], sp[1 * 33]); o.y = pk2(sp[2 * 33], sp[3 * 33]); o.z = pk2(sp[4 * 33], sp[5 * 33]); o.w = pk2(sp[6 * 33], sp[7 * 33]);
        *(u32x4*)(WT + (size_t)(n0 + n) * ldk + koff + k0 + 8 * c) = o; }
    asm volatile("s_waitcnt lgkmcnt(0)" ::: "memory");
}

namespace pg8 {
#define PG8_LAS __attribute__((address_space(3)))
typedef unsigned short bf16_t;
typedef short bf16x8 __attribute__((ext_vector_type(8)));
typedef float f32x4 __attribute__((ext_vector_type(4)));
typedef int i32x4 __attribute__((ext_vector_type(4)));
typedef unsigned u32x4 __attribute__((ext_vector_type(4)));
template <bool I8> struct AccT { typedef f32x4 type; };
template <> struct AccT<true> { typedef i32x4 type; };
constexpr int BM = 256, BK = 64, HALF = 128, HTB = HALF * BK * 2  , STAGE_BYTES = 8 * HTB, NXCD = 8, WGM = 8;

__host__ __device__ __forceinline__ int lds_byte(int r, int c) { const int st = (r >> 4) * 2 + (c >> 5), rr = r & 15, cc = c & 31, ob = rr * 64 + cc * 2; return st * 1024 + (ob ^ (((ob >> 9) & 1) << 5)); }
__host__ __device__ __forceinline__ void stage_rc(int b, int& R, int& C) { const int st = b / 1024, sb = b % 1024, swz = sb ^ (((sb >> 9) & 1) << 5); R = (st >> 1) * 16 + swz / 64; C = (st & 1) * 32 + (swz % 64) / 2; }
__host__ __device__ __forceinline__ int perm32(int rho) { const int n = rho >> 4, i = rho & 15; return 8 * (i >> 2) + 4 * n + (i & 3); }

struct Unit { int pm, pn; };
struct Gemm { const bf16_t* A; const bf16_t* Bt; int M, N, K; };

struct StaticOrder {
    int nM, nN, nwg, G, c;
    __host__ __device__ void init(int M, int N, int G_, int c_) { nM = M / BM; nN = N / BM; nwg = nM * nN; G = G_; c = c_; }
    __host__ __device__ bool next(int i, Unit& u) const {
        const long L = (long)i * G + c; if (L >= nwg) return false;
        int wgid = (int)L; { const int q = nwg / NXCD, r = nwg % NXCD, xcd = wgid % NXCD, off = wgid / NXCD; wgid = (xcd < r ? xcd * (q + 1) : r * (q + 1) + (xcd - r) * q) + off; }
        const int nig = WGM * nN, gid = wgid / nig, fm = gid * WGM, gsz = (nM - fm) < WGM ? (nM - fm) : WGM;
        u.pm = fm + ((wgid % nig) % gsz); u.pn = (wgid % nig) / gsz; return true;
    }
    __device__ __forceinline__ void a_ready(const Unit&) const {}
    __device__ __forceinline__ void done(const Unit&) const {}
};
__device__ __forceinline__ unsigned cvt_pk_bf16(float lo, float hi) { unsigned r; asm volatile("v_cvt_pk_bf16_f32 %0, %1, %2" : "=v"(r) : "v"(lo), "v"(hi)); return r; }
template <class Epi, class Sched, bool ALIGN_EPI = false, bool SP2 = false, bool MIDK = false>
__device__ __forceinline__ void gemm_phase(PG8_LAS unsigned char* lds, const Gemm g, const Sched& S, const Epi& E) {
    const int tid = threadIdx.x, wid = __builtin_amdgcn_readfirstlane(tid >> 6), lane = tid & 63, wr = wid >> 2, wc = wid & 3, fr = lane & 15, fq = lane >> 4;
    const int K = g.K, nt = K / BK;
    unsigned voffA[2], voffB[2];
#pragma unroll
    for (int i = 0; i < 2; ++i) { int R, C; stage_rc(tid * 16 + i * 8192, R, C); const int Rb = Epi::PERM ? ((R & ~31) + perm32(R & 31)) : R;
        voffA[i] = (unsigned)(R * K + C) * 2u; voffB[i] = (unsigned)(Rb * K + C) * 2u; }
    const size_t kstep = (size_t)(BK * 2);
    const size_t hstep = (size_t)HALF * K * 2;
    const size_t tstep = 2 * hstep;
    const unsigned ldsw = (unsigned)wid * 1024u;
    const int aoff = lds_byte(wr * 64 + fr, fq * 8), boff = lds_byte(wc * 32 + fr, fq * 8);
#define PG8_SA(b, h) (((b) * 2 + (h)) * HTB)
#define PG8_SB(b, h) ((4 + (b) * 2 + (h)) * HTB)
#define PG8_STAGE(bufoff, gbase, voff) do { _Pragma("unroll") for (int _i = 0; _i < 2; ++_i) \
        __builtin_amdgcn_global_load_lds((const unsigned*)((const char*)(gbase) + (voff)[_i]), (PG8_LAS unsigned*)(lds + (bufoff) + ldsw + _i * 8192), 16, 0, 0); } while (0)
#define PG8_LDA(dst, b, h) do { _Pragma("unroll") for (int m = 0; m < 4; ++m) _Pragma("unroll") for (int k = 0; k < 2; ++k) dst[m][k] = *(const PG8_LAS bf16x8*)(lds + PG8_SA(b, h) + aoff + m * 2048 + k * 1024); } while (0)
#define PG8_LDB(dst, b, h) do { _Pragma("unroll") for (int n = 0; n < 2; ++n) _Pragma("unroll") for (int k = 0; k < 2; ++k) dst[n][k] = *(const PG8_LAS bf16x8*)(lds + PG8_SB(b, h) + boff + n * 2048 + k * 1024); } while (0)
#define PG8_MMA(ai, bj, At, Bt) do { __builtin_amdgcn_s_setprio(1); _Pragma("unroll") for (int m = 0; m < 4; ++m) _Pragma("unroll") for (int n = 0; n < 2; ++n) _Pragma("unroll") for (int k = 0; k < 2; ++k) \
        { if constexpr (Epi::I8) acc[ai][bj][m][n] = __builtin_amdgcn_mfma_i32_16x16x64_i8(__builtin_bit_cast(i32x4, Bt[n][k]), __builtin_bit_cast(i32x4, At[m][k]), acc[ai][bj][m][n], 0, 0, 0); \
          else acc[ai][bj][m][n] = __builtin_amdgcn_mfma_f32_16x16x32_bf16(Bt[n][k], At[m][k], acc[ai][bj][m][n], 0, 0, 0); } __builtin_amdgcn_s_setprio(0); } while (0)
#define PG8_WAIT_V(n) asm volatile("s_waitcnt vmcnt(" #n ")" ::: "memory")
#define PG8_WAIT_L(n) asm volatile("s_waitcnt lgkmcnt(" #n ")" ::: "memory")
#define PG8_BAR __builtin_amdgcn_s_barrier()
#define PG8_SCHED __builtin_amdgcn_sched_barrier(0)
    Unit cur, nxt; int ui = 0;
    if (!S.next(0, cur)) return;
    typedef typename AccT<Epi::I8>::type acc_t;
    acc_t acc[2][2][4][2];
    if constexpr (Epi::HAS_INIT) E.init(acc, cur, wr, wc, fr, fq);
    else {
#pragma unroll
    for (int a = 0; a < 2; ++a)
#pragma unroll
        for (int b = 0; b < 2; ++b)
#pragma unroll
            for (int m = 0; m < 4; ++m)
#pragma unroll
                for (int n = 0; n < 2; ++n) acc[a][b][m][n] = acc_t{};
    }
    bf16x8 At[4][2], B0[2][2], B1[2][2];
    const char* cA = (const char*)g.A + (size_t)cur.pm * tstep; const char* cB = (const char*)g.Bt + (size_t)cur.pn * tstep;
    S.a_ready(cur);
    if constexpr (SP2) {
        PG8_STAGE(PG8_SB(0, 0), cB, voffB); PG8_STAGE(PG8_SB(0, 1), cB + hstep, voffB); PG8_STAGE(PG8_SA(0, 0), cA, voffA); PG8_STAGE(PG8_SA(0, 1), cA + hstep, voffA);
        if (wr == 1) PG8_BAR;
        PG8_WAIT_V(2); PG8_BAR;
        PG8_STAGE(PG8_SB(1, 0), cB + kstep, voffB); PG8_STAGE(PG8_SA(1, 0), cA + kstep, voffA); PG8_STAGE(PG8_SB(1, 1), cB + hstep + kstep, voffB);
        PG8_WAIT_V(6); PG8_BAR;
    } else {
        PG8_STAGE(PG8_SB(0, 0), cB, voffB); PG8_STAGE(PG8_SA(0, 0), cA, voffA); PG8_STAGE(PG8_SB(0, 1), cB + hstep, voffB); PG8_STAGE(PG8_SA(0, 1), cA + hstep, voffA);
        if (wr == 1) PG8_BAR;
        PG8_WAIT_V(4); PG8_BAR;
        PG8_STAGE(PG8_SB(1, 0), cB + kstep, voffB); PG8_STAGE(PG8_SA(1, 0), cA + kstep, voffA); PG8_STAGE(PG8_SB(1, 1), cB + hstep + kstep, voffB);
        PG8_WAIT_V(6); PG8_BAR;
    }
    for (;;) {
        const bool has_next = S.next(ui + 1, nxt);
        const char* nA = has_next ? (const char*)g.A + (size_t)nxt.pm * tstep : cA; const char* nB = has_next ? (const char*)g.Bt + (size_t)nxt.pn * tstep : cB;
        for (int t = 0; t < nt; t += 2) {
            if constexpr (MIDK) { if (t == nt / 2) E.mid(acc, cur, wr, wc, fr, fq); }
            const bool last = (t == nt - 2);
            const char* a1 = cA + (size_t)(t + 1) * kstep;
            const char* a2 = last ? nA : cA + (size_t)(t + 2) * kstep; const char* b2 = last ? nB : cB + (size_t)(t + 2) * kstep;
            const char* a3 = a2 + kstep; const char* b3 = b2 + kstep;
            if (last && has_next) S.a_ready(nxt);
            if constexpr (SP2) {
            PG8_LDB(B0, 0, 0); PG8_LDB(B1, 0, 1); PG8_SCHED; PG8_LDA(At, 0, 0); PG8_STAGE(PG8_SA(1, 1), a1 + hstep, voffA);
            PG8_WAIT_V(8); PG8_WAIT_L(0); PG8_BAR; PG8_MMA(0, 0, At, B0); PG8_MMA(0, 1, At, B1); PG8_BAR; PG8_SCHED;
            PG8_LDA(At, 0, 1); PG8_STAGE(PG8_SB(0, 0), b2, voffB); PG8_STAGE(PG8_SB(0, 1), b2 + hstep, voffB); PG8_STAGE(PG8_SA(0, 0), a2, voffA);
            PG8_WAIT_V(8); PG8_WAIT_L(0); PG8_BAR; PG8_MMA(1, 0, At, B0); PG8_MMA(1, 1, At, B1); PG8_BAR; PG8_SCHED;
            PG8_LDB(B0, 1, 0); PG8_LDB(B1, 1, 1); PG8_SCHED; PG8_LDA(At, 1, 0); PG8_STAGE(PG8_SA(0, 1), a2 + hstep, voffA);
            PG8_WAIT_V(8); PG8_WAIT_L(0); PG8_BAR; PG8_MMA(0, 0, At, B0); PG8_MMA(0, 1, At, B1); PG8_BAR; PG8_SCHED;
            PG8_LDA(At, 1, 1); PG8_STAGE(PG8_SB(1, 0), b3, voffB); PG8_STAGE(PG8_SB(1, 1), b3 + hstep, voffB); PG8_STAGE(PG8_SA(1, 0), a3, voffA);
            PG8_WAIT_V(8); PG8_WAIT_L(0); PG8_BAR; PG8_MMA(1, 0, At, B0); PG8_MMA(1, 1, At, B1); PG8_BAR; PG8_SCHED;
            } else {
            PG8_LDB(B0, 0, 0); PG8_SCHED; PG8_LDA(At, 0, 0); PG8_STAGE(PG8_SA(1, 1), a1 + hstep, voffA);
            PG8_WAIT_L(8); PG8_BAR; PG8_WAIT_L(0); PG8_MMA(0, 0, At, B0); PG8_BAR; PG8_SCHED;
            PG8_LDB(B1, 0, 1); PG8_STAGE(PG8_SB(0, 0), b2, voffB);
            PG8_BAR; PG8_WAIT_L(0); PG8_MMA(0, 1, At, B1); PG8_BAR;
            PG8_LDA(At, 0, 1); PG8_STAGE(PG8_SA(0, 0), a2, voffA);
            PG8_BAR; PG8_WAIT_L(0); PG8_MMA(1, 0, At, B0); PG8_BAR; PG8_SCHED;
            PG8_STAGE(PG8_SB(0, 1), b2 + hstep, voffB);
            PG8_WAIT_V(6); PG8_BAR; PG8_MMA(1, 1, At, B1); PG8_BAR;
            PG8_LDB(B0, 1, 0); PG8_SCHED; PG8_LDA(At, 1, 0); PG8_STAGE(PG8_SA(0, 1), a2 + hstep, voffA);
            PG8_WAIT_L(8); PG8_BAR; PG8_WAIT_L(0); PG8_MMA(0, 0, At, B0); PG8_BAR; PG8_SCHED;
            PG8_LDB(B1, 1, 1); PG8_STAGE(PG8_SB(1, 0), b3, voffB);
            PG8_BAR; PG8_WAIT_L(0); PG8_MMA(0, 1, At, B1); PG8_BAR;
            PG8_LDA(At, 1, 1); PG8_STAGE(PG8_SA(1, 0), a3, voffA);
            PG8_BAR; PG8_WAIT_L(0); PG8_MMA(1, 0, At, B0); PG8_BAR; PG8_SCHED;
            PG8_STAGE(PG8_SB(1, 1), b3 + hstep, voffB);
            PG8_WAIT_V(6); PG8_BAR; PG8_MMA(1, 1, At, B1); PG8_BAR;
            }
        }
        if constexpr (ALIGN_EPI) { if (wr == 0) PG8_BAR; }
        if constexpr (!Epi::AFTER_DRAIN) { E(acc, cur, wr, wc, fr, fq); S.done(cur); }
        if (!has_next) break;
        if constexpr (Epi::HAS_INIT) E.init(acc, nxt, wr, wc, fr, fq);
        else {
#pragma unroll
        for (int a = 0; a < 2; ++a)
#pragma unroll
            for (int b = 0; b < 2; ++b)
#pragma unroll
                for (int m = 0; m < 4; ++m)
#pragma unroll
                    for (int n = 0; n < 2; ++n) acc[a][b][m][n] = acc_t{};
        }
        cur = nxt; cA = nA; cB = nB; ++ui;
        if constexpr (ALIGN_EPI) { if (wr == 1) PG8_BAR; }
    }
    PG8_WAIT_V(0);
    if constexpr (!ALIGN_EPI) { if (wr == 0) PG8_BAR; }
    PG8_BAR;
    if constexpr (Epi::AFTER_DRAIN) { E.fused(acc, cur, wr, wc, fr, fq, lds, wid, lane); S.done(cur); }
#undef PG8_SA
#undef PG8_SB
#undef PG8_STAGE
#undef PG8_LDA
#undef PG8_LDB
#undef PG8_MMA
#undef PG8_WAIT_V
#undef PG8_WAIT_L
#undef PG8_BAR
#undef PG8_SCHED
}
}

#define EPI_FOR(...) _Pragma("unroll") for (int ai = 0; ai < 2; ++ai) _Pragma("unroll") for (int m = 0; m < 4; ++m) { const int row = u.pm * 256 + ai * 128 + wr * 64 + m * 16 + fr; \
    _Pragma("unroll") for (int bj = 0; bj < 2; ++bj) { const int col = u.pn * 256 + bj * 128 + wc * 32 + 8 * fq; const f32x4 a0 = acc[ai][bj][m][0], a1 = acc[ai][bj][m][1]; __VA_ARGS__ } }
DI u32x4 pack8bf(f32x4 a, f32x4 b) { u32x4 w; w.x = pk2(a.x, a.y); w.y = pk2(a.z, a.w); w.z = pk2(b.x, b.y); w.w = pk2(b.z, b.w); return w; }
constexpr float C2 = 0.125f * 1.4426950408889634f;
struct EpiInProj {
    static constexpr bool PERM = true, AFTER_DRAIN = false, HAS_INIT = false, I8 = true;
    bf16_t* QK; bf16_t* KF; bf16_t* VT; bf16_t* GATES; const float* RS1  ; const float* SW  ; float* KSUM; bool ksum_on;
    DI void operator()(const pg8::i32x4 (&iacc)[2][2][4][2], const pg8::Unit& u, int wr, int wc, int fr, int fq) const {
        f32x4 acc[2][2][4][2];
#pragma unroll
        for (int bj = 0; bj < 2; ++bj) {
            const float* swp = SW + u.pn * 256 + bj * 128 + wc * 32 + 8 * fq;
            const f32x4 c0 = *(const f32x4*)swp * (1.f / 127.f), c1 = *(const f32x4*)(swp + 4) * (1.f / 127.f);
#pragma unroll
            for (int ai = 0; ai < 2; ++ai)
#pragma unroll
                for (int m = 0; m < 4; ++m) { acc[ai][bj][m][0] = __builtin_convertvector(iacc[ai][bj][m][0], f32x4) * c0; acc[ai][bj][m][1] = __builtin_convertvector(iacc[ai][bj][m][1], f32x4) * c1; }
        }
        const int seg = (u.pn * 256) >> 9;
        if (seg == 2 || seg == 5) {
            const int kind = seg == 5;
            EPI_FOR({
                const float rs = RS1[row]; const int bb = row >> 13, key = row & (SEQ - 1), kp = key & 15;
                const int nn = col - (kind ? 2560 : 1024), dim = nn & 63;
                bf16_t* vt = VT + (((size_t)((kind * 2 + bb) * NH + (nn >> 6)) * 256 + (key >> 5)) * 4 + ((dim >> 5) * 2 + ((key >> 4) & 1))) * 512 + (((kp >> 2) & 1) * 32 + (dim & 31)) * 8 + 4 * (kp >> 3) + (kp & 3);
                vt[0] = (bf16_t)f2bf(a0.x * rs); vt[8] = (bf16_t)f2bf(a0.y * rs); vt[16] = (bf16_t)f2bf(a0.z * rs); vt[24] = (bf16_t)f2bf(a0.w * rs);
                vt[32] = (bf16_t)f2bf(a1.x * rs); vt[40] = (bf16_t)f2bf(a1.y * rs); vt[48] = (bf16_t)f2bf(a1.z * rs); vt[56] = (bf16_t)f2bf(a1.w * rs);
            })
        } else if (seg == 1 || seg == 4) {
            const int kind = seg == 4;
            float cs[16];
#pragma unroll
            for (int i = 0; i < 16; ++i) cs[i] = 0.f;
            EPI_FOR({
                const float rs = RS1[row]; const f32x4 v0 = a0 * rs, v1 = a1 * rs;
                const int bb = row >> 13, key = row & (SEQ - 1), nn = col - (kind ? 2048 : 512), dim = nn & 63;
                *(u32x4*)(KF + (((size_t)((kind * 2 + bb) * NH + (nn >> 6)) * 256 + (key >> 5)) * 4 + (dim >> 4)) * 512 + (((dim >> 3) & 1) * 32 + (key & 31)) * 8) = pack8bf(v0, v1);
                if (seg == 1) { cs[bj * 8 + 0] += v0.x; cs[bj * 8 + 1] += v0.y; cs[bj * 8 + 2] += v0.z; cs[bj * 8 + 3] += v0.w; cs[bj * 8 + 4] += v1.x; cs[bj * 8 + 5] += v1.y; cs[bj * 8 + 6] += v1.z; cs[bj * 8 + 7] += v1.w; }
            })
            if (seg == 1 && ksum_on) {
                const bool b3 = (fr & 8) != 0, b2 = (fr & 4) != 0, b1 = (fr & 2) != 0, b0 = (fr & 1) != 0;
                float v8[8], v4[4];
#pragma unroll
                for (int i = 0; i < 8; ++i) v8[i] = (b3 ? cs[8 + i] : cs[i]) + __shfl_xor(b3 ? cs[i] : cs[8 + i], 8);
#pragma unroll
                for (int i = 0; i < 4; ++i) v4[i] = (b2 ? v8[4 + i] : v8[i]) + __shfl_xor(b2 ? v8[i] : v8[4 + i], 4);
                const float v20 = (b1 ? v4[2] : v4[0]) + __shfl_xor(b1 ? v4[0] : v4[2], 2), v21 = (b1 ? v4[3] : v4[1]) + __shfl_xor(b1 ? v4[1] : v4[3], 2);
                const float v1_ = (b0 ? v21 : v20) + __shfl_xor(b0 ? v20 : v21, 1);
                const int c = u.pn * 256 + (fr >> 3) * 128 + wc * 32 + 8 * fq + (fr & 7) - 512, row0 = u.pm * 256;
                atomicAdd(KSUM + ((size_t)(((row0 >> 13) * NH + (c >> 6)) * NBLK + ((row0 & (SEQ - 1)) >> 8))) * HD + (c & 63), v1_);
            }
        } else if (seg < 6) {
            const int cshift = seg == 3 ? -1024 : 0;
            EPI_FOR({ const float rs = RS1[row] * C2; *(u32x4*)(QK + (size_t)row * 1024 + col + cshift) = pack8bf(a0 * rs, a1 * rs); })
        } else {
            EPI_FOR({
                const float rs = RS1[row]; const f32x4 v0 = a0 * rs, v1 = a1 * rs;
                const f32x4 s0 = {sigmoidf_(v0.x), sigmoidf_(v0.y), sigmoidf_(v0.z), sigmoidf_(v0.w)}, s1 = {sigmoidf_(v1.x), sigmoidf_(v1.y), sigmoidf_(v1.z), sigmoidf_(v1.w)};
                *(u32x4*)(GATES + (size_t)row * GATEW + col - QKVW) = pack8bf(s0, s1);
            })
        }
    }
};
struct EpiMix {
    static constexpr bool PERM = true, AFTER_DRAIN = false, HAS_INIT = false, I8 = false;
    const bf16_t* GATES; bf16_t* MIXED;
    DI void mid(f32x4 (&acc)[2][2][4][2], const pg8::Unit& u, int wr, int wc, int fr_in, int fq_in) const {
        int fr = fr_in, fq = fq_in; asm volatile("" : "+v"(fr), "+v"(fq));
#pragma unroll
        for (int ai = 0; ai < 2; ++ai)
#pragma unroll
            for (int m = 0; m < 4; ++m) { const int row = u.pm * 256 + ai * 128 + wr * 64 + m * 16 + fr;
#pragma unroll
                for (int bj = 0; bj < 2; ++bj) { const int col = u.pn * 256 + bj * 128 + wc * 32 + 8 * fq;
                    const u32x4 ga = *(const u32x4*)(GATES + (size_t)row * GATEW + col), gb = *(const u32x4*)(GATES + (size_t)row * GATEW + 1024 + col);
                    const float r0 = bflo(ga.x) * __builtin_amdgcn_rcpf(fmaxf(bflo(gb.x), 1e-30f)), r1 = bfhi(ga.x) * __builtin_amdgcn_rcpf(fmaxf(bfhi(gb.x), 1e-30f));
                    const float r2 = bflo(ga.y) * __builtin_amdgcn_rcpf(fmaxf(bflo(gb.y), 1e-30f)), r3 = bfhi(ga.y) * __builtin_amdgcn_rcpf(fmaxf(bfhi(gb.y), 1e-30f));
                    const float r4 = bflo(ga.z) * __builtin_amdgcn_rcpf(fmaxf(bflo(gb.z), 1e-30f)), r5 = bfhi(ga.z) * __builtin_amdgcn_rcpf(fmaxf(bfhi(gb.z), 1e-30f));
                    const float r6 = bflo(ga.w) * __builtin_amdgcn_rcpf(fmaxf(bflo(gb.w), 1e-30f)), r7 = bfhi(ga.w) * __builtin_amdgcn_rcpf(fmaxf(bfhi(gb.w), 1e-30f));
                    acc[ai][bj][m][0] = acc[ai][bj][m][0] * (f32x4){r0, r1, r2, r3}; acc[ai][bj][m][1] = acc[ai][bj][m][1] * (f32x4){r4, r5, r6, r7}; }
                __builtin_amdgcn_sched_barrier(0); }
    }
    DI void operator()(const f32x4 (&acc)[2][2][4][2], const pg8::Unit& u, int wr, int wc, int fr, int fq) const {
        EPI_FOR({
            const u32x4 gb = *(const u32x4*)(GATES + (size_t)row * GATEW + 1024 + col);
            const f32x4 s0 = {fmaxf(bflo(gb.x), 1e-30f), fmaxf(bfhi(gb.x), 1e-30f), fmaxf(bflo(gb.y), 1e-30f), fmaxf(bfhi(gb.y), 1e-30f)};
            const f32x4 s1 = {fmaxf(bflo(gb.z), 1e-30f), fmaxf(bfhi(gb.z), 1e-30f), fmaxf(bflo(gb.w), 1e-30f), fmaxf(bfhi(gb.w), 1e-30f)};
            *(u32x4*)(MIXED + (size_t)row * DM + col) = pack8bf(a0 * s0, a1 * s1);
        })
    }
};
struct EpiResid {
    static constexpr bool PERM = true, AFTER_DRAIN = false, HAS_INIT = true, I8 = false;
    const float* X; bf16_t* HB;
    DI void init(f32x4 (&acc)[2][2][4][2], const pg8::Unit& u, int wr, int wc, int fr, int fq) const {
#pragma unroll
        for (int ai = 0; ai < 2; ++ai)
#pragma unroll
            for (int m = 0; m < 4; ++m) { const int row = u.pm * 256 + ai * 128 + wr * 64 + m * 16 + fr;
#pragma unroll
                for (int bj = 0; bj < 2; ++bj) { const float* xp = X + (size_t)row * DM + u.pn * 256 + bj * 128 + wc * 32 + 8 * fq; acc[ai][bj][m][0] = *(const f32x4*)xp; acc[ai][bj][m][1] = *(const f32x4*)(xp + 4); } }
    }
    DI void operator()(const f32x4 (&acc)[2][2][4][2], const pg8::Unit& u, int wr, int wc, int fr, int fq) const {
        EPI_FOR({ *(u32x4*)(HB + (size_t)row * DM + col) = pack8bf(a0, a1); })
    }
};
struct EpiPeerQ {
    static constexpr bool PERM = true, AFTER_DRAIN = false, HAS_INIT = false, I8 = false;
    bf16_t* Q2;
    DI void operator()(const f32x4 (&acc)[2][2][4][2], const pg8::Unit& u, int wr, int wc, int fr, int fq) const {
        EPI_FOR({ *(u32x4*)(Q2 + (size_t)row * PQW + col) = pack8bf(a0, a1); })
    }
};


DI void h_rows4(const bf16_t* H, float* RS2, float* SH, signed char* H8, int row0, int stride, int lane) {
    u32x4 a[4][2];
#pragma unroll
    for (int k = 0; k < 4; ++k)
#pragma unroll
        for (int j = 0; j < 2; ++j) a[k][j] = *(const u32x4*)(H + (size_t)(row0 + k * stride) * DM + lane * 16 + 8 * j);
#pragma unroll
    for (int k = 0; k < 4; ++k) {
        const int row = row0 + k * stride;
        float v[16];
#pragma unroll
        for (int j = 0; j < 2; ++j) { v[8 * j] = bflo(a[k][j].x); v[8 * j + 1] = bfhi(a[k][j].x); v[8 * j + 2] = bflo(a[k][j].y); v[8 * j + 3] = bfhi(a[k][j].y);
            v[8 * j + 4] = bflo(a[k][j].z); v[8 * j + 5] = bfhi(a[k][j].z); v[8 * j + 6] = bflo(a[k][j].w); v[8 * j + 7] = bfhi(a[k][j].w); }
        float ss = 0.f, am = 0.f;
#pragma unroll
        for (int j = 0; j < 16; ++j) { ss += v[j] * v[j]; am = fmaxf(am, fabsf(v[j])); }
        ss = wave_sum(ss);
#pragma unroll
        for (int o = 32; o >= 1; o >>= 1) am = fmaxf(am, __shfl_xor(am, o));
        const float sc = am > 0.f ? am * (1.f / 127.f) : 1.f, isc = 1.f / sc;
        unsigned w[4];
#pragma unroll
        for (int j = 0; j < 4; ++j) w[j] = q8x4(v[4 * j], v[4 * j + 1], v[4 * j + 2], v[4 * j + 3], isc);
        *(u32x4*)(H8 + (size_t)row * DM + lane * 16) = (u32x4){w[0], w[1], w[2], w[3]};
        if (lane == 0) { RS2[row] = rsqrtf(ss * (1.f / DM) + RMS_EPS); SH[row] = sc; }
    }
}

template <int NR>
DI void quant_rows(const float* pu, const float* pv, const float* g2, unsigned char* U8, unsigned char* V8, float* SU, float* SV, int row0, int stride, int lane) {
    f32x4 a[NR][4];
#pragma unroll
    for (int k = 0; k < NR; ++k) { const int row = row0 + k * stride, isv = row >= NEXP, e = row - (isv ? NEXP : 0); const float* src = (isv ? pv : pu) + (size_t)e * DM + lane * 16;
#pragma unroll
        for (int j = 0; j < 4; ++j) a[k][j] = *(const f32x4*)(src + 4 * j); }
    f32x4 gq[4];
#pragma unroll
    for (int j = 0; j < 4; ++j) gq[j] = *(const f32x4*)(g2 + lane * 16 + 4 * j);
#pragma unroll
    for (int k = 0; k < NR; ++k) {
        const int row = row0 + k * stride, isv = row >= NEXP, e = row - (isv ? NEXP : 0);
        float v[16];
#pragma unroll
        for (int j = 0; j < 4; ++j) { const f32x4 x = isv ? a[k][j] : a[k][j] * gq[j]; v[4 * j] = x.x; v[4 * j + 1] = x.y; v[4 * j + 2] = x.z; v[4 * j + 3] = x.w; }
        float am = 0.f;
#pragma unroll
        for (int j = 0; j < 16; ++j) am = fmaxf(am, fabsf(v[j]));
#pragma unroll
        for (int o = 32; o >= 1; o >>= 1) am = fmaxf(am, __shfl_xor(am, o));
        const float sc = am > 0.f ? am * (1.f / 127.f) : 1.f, isc = 1.f / sc;
        unsigned w[4];
#pragma unroll
        for (int j = 0; j < 4; ++j) w[j] = q8x4(v[4 * j], v[4 * j + 1], v[4 * j + 2], v[4 * j + 3], isc);
        unsigned char* dst = (isv ? V8 : U8) + ((size_t)((lane >> 3) * NEXP + e)) * 128 + (lane & 7) * 16;
        *(u32x4*)dst = (u32x4){w[0], w[1], w[2], w[3]};
        if (lane == 0) (isv ? SV : SU)[e] = sc;
    }
}

typedef float f32x16 __attribute__((ext_vector_type(16)));
#define MFMA32(a, b, c) __builtin_amdgcn_mfma_f32_32x32x16_bf16((a), (b), (c), 0, 0, 0)
constexpr float FLT_MIN_ = 1.17549435e-38f;

struct KV { bf16x8 k[4], v[4]; };
DI void load_kv(KV& f, const bf16_t* kp, const bf16_t* vp) {
#pragma unroll
    for (int i = 0; i < 4; ++i) { f.k[i] = *(const bf16x8*)(kp + 512 * i); f.v[i] = *(const bf16x8*)(vp + 512 * i); }
}
DI void load_kv_async(KV& f, const bf16_t* kp, const bf16_t* vp) {
    asm volatile("global_load_dwordx4 %0, %4, off\n\tglobal_load_dwordx4 %1, %4, off offset:1024\n\tglobal_load_dwordx4 %2, %4, off offset:2048\n\tglobal_load_dwordx4 %3, %4, off offset:3072"
                 : "=&v"(f.k[0]), "=&v"(f.k[1]), "=&v"(f.k[2]), "=&v"(f.k[3]) : "v"(kp) : "memory");
    asm volatile("global_load_dwordx4 %0, %4, off\n\tglobal_load_dwordx4 %1, %4, off offset:1024\n\tglobal_load_dwordx4 %2, %4, off offset:2048\n\tglobal_load_dwordx4 %3, %4, off offset:3072"
                 : "=&v"(f.v[0]), "=&v"(f.v[1]), "=&v"(f.v[2]), "=&v"(f.v[3]) : "v"(vp) : "memory");
}
#define KV_WAIT_K(f, N) asm volatile("s_waitcnt vmcnt(" #N ")" : "+v"(f.k[0]), "+v"(f.k[1]), "+v"(f.k[2]), "+v"(f.k[3]) :: "memory")
#define KV_WAIT_V(f, N) asm volatile("s_waitcnt vmcnt(" #N ")" : "+v"(f.v[0]), "+v"(f.v[1]), "+v"(f.v[2]), "+v"(f.v[3]) :: "memory")
DI bf16x8 pack8(const f32x16& p, int s) {
    u32x4 w;
    if (s == 0) { w.x = cvtpk(p[0], p[1]); w.y = cvtpk(p[2], p[3]); w.z = cvtpk(p[4], p[5]); w.w = cvtpk(p[6], p[7]); }
    else { w.x = cvtpk(p[8], p[9]); w.y = cvtpk(p[10], p[11]); w.z = cvtpk(p[12], p[13]); w.w = cvtpk(p[14], p[15]); }
    return __builtin_bit_cast(bf16x8, w);
}
struct SmState { float m, l; f32x16 o0, o1; };
typedef float f32x2 __attribute__((ext_vector_type(2)));
DI float sum16(const f32x16& p) {
    const f32x2 s0 = (f32x2){p[0], p[1]} + (f32x2){p[2], p[3]}, s1 = (f32x2){p[4], p[5]} + (f32x2){p[6], p[7]};
    const f32x2 s2 = (f32x2){p[8], p[9]} + (f32x2){p[10], p[11]}, s3 = (f32x2){p[12], p[13]} + (f32x2){p[14], p[15]};
    const f32x2 t0 = s0 + s1, t1 = s2 + s3, u = t0 + t1;
    return u.x + u.y;
}
constexpr float LAZY_THR = 1.0995116e12f;
template <int WK = -1, int WV = -1>
DI void moba_tile_first(SmState& st, KV& f, const bf16x8 (&qf)[4], float bias0, float slopeL, int maskrow, int hh) {
    f32x16 acc;
#pragma unroll
    for (int r = 0; r < 16; ++r) acc[r] = bias0 + slopeL * (float)((r & 3) + 8 * (r >> 2));
    if constexpr (WK == 12) KV_WAIT_K(f, 12); else if constexpr (WK == 4) KV_WAIT_K(f, 4);
#pragma unroll
    for (int ks = 0; ks < 4; ++ks) acc = MFMA32(f.k[ks], qf[ks], acc);
    if (maskrow < 32) {
#pragma unroll
        for (int r = 0; r < 16; ++r) if ((r & 3) + 8 * (r >> 2) + 4 * hh > maskrow) acc[r] = -1e30f;
    }
    float tm = acc[0];
#pragma unroll
    for (int r = 1; r < 16; ++r) tm = fmaxf(tm, acc[r]);
    tm = fmaxf(tm, __shfl_xor(tm, 32));
    f32x16 pw;
#pragma unroll
    for (int r = 0; r < 16; ++r) pw[r] = __builtin_amdgcn_exp2f(acc[r] - tm);
    st.m = tm; st.l = sum16(pw);
    const bf16x8 p0 = pack8(pw, 0), p1 = pack8(pw, 1);
    if constexpr (WV == 8) KV_WAIT_V(f, 8); else if constexpr (WV == 0) KV_WAIT_V(f, 0);
    f32x16 z;
#pragma unroll
    for (int r = 0; r < 16; ++r) z[r] = 0.f;
    st.o0 = MFMA32(f.v[0], p0, z); st.o0 = MFMA32(f.v[1], p1, st.o0);
    st.o1 = MFMA32(f.v[2], p0, z); st.o1 = MFMA32(f.v[3], p1, st.o1);
}
template <int WK = -1, int WV = -1>
DI void moba_tile_lazy(SmState& st, KV& f, const bf16x8 (&qf)[4], float bias0, float slopeL, int hh) {
    f32x16 acc;
    const float b0 = bias0 - st.m;
#pragma unroll
    for (int r = 0; r < 16; ++r) acc[r] = b0 + slopeL * (float)((r & 3) + 8 * (r >> 2));
    if constexpr (WK == 12) KV_WAIT_K(f, 12); else if constexpr (WK == 4) KV_WAIT_K(f, 4);
#pragma unroll
    for (int ks = 0; ks < 4; ++ks) acc = MFMA32(f.k[ks], qf[ks], acc);
    f32x16 pw;
#pragma unroll
    for (int r = 0; r < 16; ++r) pw[r] = __builtin_amdgcn_exp2f(acc[r]);
    float ps = sum16(pw);
    if (__builtin_expect(__any(!(ps <= LAZY_THR)), 0)) {
        const int nl = !(ps <= LAZY_THR);
        const bool need = (nl | __shfl_xor(nl, 32)) != 0;
        float tm = acc[0];
#pragma unroll
        for (int r = 1; r < 16; ++r) tm = fmaxf(tm, acc[r]);
        tm = fmaxf(tm, __shfl_xor(tm, 32));
        const float d = need ? tm : 0.f, al = __builtin_amdgcn_exp2f(-d);
        st.m += d; st.l *= al; st.o0 = st.o0 * al; st.o1 = st.o1 * al;
#pragma unroll
        for (int r = 0; r < 16; ++r) pw[r] = __builtin_amdgcn_exp2f(acc[r] - d);
        ps = sum16(pw);
    }
    st.l += ps;
    const bf16x8 p0 = pack8(pw, 0), p1 = pack8(pw, 1);
    if constexpr (WV == 8) KV_WAIT_V(f, 8); else if constexpr (WV == 0) KV_WAIT_V(f, 0);
    st.o0 = MFMA32(f.v[0], p0, st.o0); st.o0 = MFMA32(f.v[1], p1, st.o0);
    st.o1 = MFMA32(f.v[2], p0, st.o1); st.o1 = MFMA32(f.v[3], p1, st.o1);
}
DI void moba_pass_own(SmState& st, const bf16x8 (&qf)[4], const bf16_t* kt0, const bf16_t* vt0, int w, int maskrow, float bb, float slopeL, int hh) {
    KV fa, fb;
    const float bs = slopeL * 32.f;
    load_kv(fa, kt0 + (size_t)w * 2048, vt0 + (size_t)w * 2048);
    if (w >= 1) load_kv(fb, kt0 + (size_t)(w - 1) * 2048, vt0 + (size_t)(w - 1) * 2048);
    moba_tile_first(st, fa, qf, bb + (float)w * bs, slopeL, maskrow, hh);
#pragma unroll 1
    for (int kt = w - 1; kt >= 0; kt -= 2) {
        if (kt >= 1) load_kv(fa, kt0 + (size_t)(kt - 1) * 2048, vt0 + (size_t)(kt - 1) * 2048);
        moba_tile_lazy(st, fb, qf, bb + (float)kt * bs, slopeL, hh);
        if (kt >= 1) {
            if (kt >= 2) load_kv(fb, kt0 + (size_t)(kt - 2) * 2048, vt0 + (size_t)(kt - 2) * 2048);
            moba_tile_lazy(st, fa, qf, bb + (float)(kt - 1) * bs, slopeL, hh);
        }
    }
}
template <bool MASKED>
DI void sb_tile(f32x16& o0, f32x16& o1, float& carry, const KV& f, const bf16x8 (&qf)[4], int maskrow, int hh) {
    f32x16 acc;
#pragma unroll
    for (int r = 0; r < 16; ++r) acc[r] = 0.f;
#pragma unroll
    for (int ks = 0; ks < 4; ++ks) acc = MFMA32(f.k[ks], qf[ks], acc);
    float bt[16], fc[16];
#pragma unroll
    for (int r = 0; r < 16; ++r) {
        const float z = acc[r];
        const float e = __builtin_amdgcn_exp2f(-fabsf(z)), rr = __builtin_amdgcn_rcpf(1.f + e), er = e * rr;
        const bool pos = z >= 0.f, msk = MASKED && ((r & 3) + 8 * (r >> 2) + 4 * hh) >= maskrow;
        bt[r] = msk ? 0.f : (pos ? rr : er);
        fc[r] = msk ? 1.f : (pos ? er : rr);
    }
    float G[4], Gp[4], wf[16];
#pragma unroll
    for (int g = 0; g < 4; ++g) {
        const float s3 = fc[4 * g + 3], s2 = s3 * fc[4 * g + 2], s1 = s2 * fc[4 * g + 1];
        G[g] = s1 * fc[4 * g];
        wf[4 * g + 3] = bt[4 * g + 3]; wf[4 * g + 2] = bt[4 * g + 2] * s3; wf[4 * g + 1] = bt[4 * g + 1] * s2; wf[4 * g] = bt[4 * g] * s1;
    }
#pragma unroll
    for (int g = 0; g < 4; ++g) Gp[g] = __shfl_xor(G[g], 32);
    const float T0 = G[0] * Gp[0], T1 = G[1] * Gp[1], T2 = G[2] * Gp[2], T3 = G[3] * Gp[3];
    const float RR2 = T3, RR1 = T3 * T2, RR0 = RR1 * T1, total = RR0 * T0;
    float base[4];
    base[3] = carry * (hh == 0 ? Gp[3] : 1.f);
    base[2] = carry * RR2 * (hh == 0 ? Gp[2] : 1.f);
    base[1] = carry * RR1 * (hh == 0 ? Gp[1] : 1.f);
    base[0] = carry * RR0 * (hh == 0 ? Gp[0] : 1.f);
    f32x16 pw;
#pragma unroll
    for (int r = 0; r < 16; ++r) pw[r] = wf[r] * base[r >> 2];
    carry *= total;
    const bf16x8 p0 = pack8(pw, 0), p1 = pack8(pw, 1);
    o0 = MFMA32(f.v[0], p0, o0); o0 = MFMA32(f.v[1], p1, o0);
    o1 = MFMA32(f.v[2], p0, o1); o1 = MFMA32(f.v[3], p1, o1);
}
DI void store_o(bf16_t* orow  , const f32x16& o0, const f32x16& o1, float sc) {
#pragma unroll
    for (int g = 0; g < 4; ++g) {
        u32x2 a; a.x = cvtpk(o0[4 * g] * sc, o0[4 * g + 1] * sc); a.y = cvtpk(o0[4 * g + 2] * sc, o0[4 * g + 3] * sc); *(u32x2*)(orow + 8 * g) = a;
        u32x2 c; c.x = cvtpk(o1[4 * g] * sc, o1[4 * g + 1] * sc); c.y = cvtpk(o1[4 * g + 2] * sc, o1[4 * g + 3] * sc); *(u32x2*)(orow + 32 + 8 * g) = c;
    }
}
constexpr int ML_OPART = 0;
constexpr int ML_ML = 4 * 256 * 68 * 2;
constexpr int ML_LISTS = ML_ML + 4 * 256 * 2 * 4;
constexpr int ML_SELS = ML_LISTS + 32 * 256;
constexpr int ML_CNT = ML_SELS + 1024;
constexpr int ML_UST = ML_CNT + 128;
constexpr int ML_QCTR = ML_UST + 144;
constexpr int ML_ITEM = ML_QCTR + 16;
constexpr int ML_UJ = ML_ITEM + 16;
static_assert(ML_UJ + 64 <= LDS_BYTES - 16, "MoBA LDS map");
DI void top3_insert(float s, int b, float& v0, float& v1, float& v2, int& i0, int& i1, int& i2) {
    const bool g0 = s > v0, g1 = s > v1, g2 = s > v2;
    v2 = g1 ? v1 : (g2 ? s : v2); i2 = g1 ? i1 : (g2 ? b : i2);
    v1 = g0 ? v0 : (g1 ? s : v1); i1 = g0 ? i0 : (g1 ? b : i1);
    v0 = g0 ? s : v0; i0 = g0 ? b : i0;
}
DI int p3_order(int i) {
    constexpr unsigned long long W0 = 0x1918171612151413ull, W1 = 0x1d1c1e1b0b1f1a11ull, W2 = 0x08070d0e0f0c0a10ull, W3 = 0x0001020403050906ull;
    const unsigned long long w = (i >> 3) == 0 ? W0 : ((i >> 3) == 1 ? W1 : ((i >> 3) == 2 ? W2 : W3));
    return (int)((w >> (8 * (i & 7))) & 255ull);
}
DI void sb_group(const bf16_t* QK, const bf16_t* KF, const bf16_t* VT, bf16_t* OB, int b, int head, int qt) {
    const int tid = threadIdx.x, wave = tid >> 6; int lane = tid & 63;
    asm volatile("" : "+v"(lane));
    const int r = lane & 31, hh = lane >> 5;
    const bf16_t* kp = KF + (size_t)((1 * 2 + b) * NH + head) * 256 * 2048 + lane * 8;
    const bf16_t* vp = VT + (size_t)((1 * 2 + b) * NH + head) * 256 * 2048 + lane * 8;
    const int kt0 = 8 * qt + wave, t = 32 * kt0 + r;
    const bf16_t* qp = QK + (size_t)(b * SEQ + t) * 1024 + 512 + head * HD + 8 * hh;
    bf16x8 qf[4];
#pragma unroll
    for (int ks = 0; ks < 4; ++ks) qf[ks] = *(const bf16x8*)(qp + 16 * ks);
    f32x16 o0, o1;
#pragma unroll
    for (int x = 0; x < 16; ++x) { o0[x] = 0.f; o1[x] = 0.f; }
    float carry = 1.f;
    KV fa, fb;
    int kt = kt0;
    load_kv(fa, kp + (size_t)kt * 2048, vp + (size_t)kt * 2048);
    if (kt >= 1) load_kv(fb, kp + (size_t)(kt - 1) * 2048, vp + (size_t)(kt - 1) * 2048);
    asm volatile("" ::: "memory");
    sb_tile<true>(o0, o1, carry, fa, qf, r, hh);
    if (!(kt < 1 || __all(carry < FLT_MIN_))) {
        for (;;) {
            if (kt >= 2) load_kv(fa, kp + (size_t)(kt - 2) * 2048, vp + (size_t)(kt - 2) * 2048);
            asm volatile("" ::: "memory");
            sb_tile<false>(o0, o1, carry, fb, qf, 32, hh);
            if (kt < 2 || __all(carry < FLT_MIN_)) break;
            if (kt >= 3) load_kv(fb, kp + (size_t)(kt - 3) * 2048, vp + (size_t)(kt - 3) * 2048);
            asm volatile("" ::: "memory");
            sb_tile<false>(o0, o1, carry, fa, qf, 32, hh);
            if (kt < 3 || __all(carry < FLT_MIN_)) break;
            kt -= 2;
        }
    }
    store_o(OB + (size_t)(b * SEQ + t) * (2 * WA) + WA + head * HD + 4 * hh, o0, o1, 1.f);
}
DI void moba_group(unsigned char* lds, const bf16_t* QK, const bf16_t* KF, const bf16_t* VT, const float* KSUM, bf16_t* OA, int b, int head, int og, bool with_sb, unsigned* nextctr) {
    const int tid = threadIdx.x, wave = tid >> 6; int lane = tid & 63;
    asm volatile("" : "+v"(lane));
    const int r = lane & 31, hh = lane >> 5;
    bf16_t* OPART = (bf16_t*)(lds + ML_OPART); float* MLS = (float*)(lds + ML_ML); unsigned char* LISTS = lds + ML_LISTS; unsigned char* SELS = lds + ML_SELS;
    int* CNT = (int*)(lds + ML_CNT); int* UST = (int*)(lds + ML_UST);
    const float slopeL = 1.4426950408889634f * exp2f(-(float)(head + 1));
    const bf16_t* kp = KF + (size_t)((0 * 2 + b) * NH + head) * 256 * 2048 + lane * 8;
    const bf16_t* vp = VT + (size_t)((0 * 2 + b) * NH + head) * 256 * 2048 + lane * 8;
    const bf16_t* qbase = QK + (size_t)(b * SEQ) * 1024 + head * HD + 8 * hh;
    __syncthreads();
    unsigned nk = 0;
    if (tid == 0) nk = atomicAdd(nextctr, 1u);
    if (tid < 32) CNT[tid] = 0;
    __syncthreads();
    {
        const int c = 32 * wave + r;
        const bf16_t* qp = qbase + (size_t)(256 * og + c) * 1024;
        bf16x8 qf[4];
#pragma unroll
        for (int ks = 0; ks < 4; ++ks) qf[ks] = *(const bf16x8*)(qp + 16 * ks);
        f32x16 acc;
#pragma unroll
        for (int i = 0; i < 16; ++i) acc[i] = 0.f;
        const float* km = KSUM + ((size_t)(b * NH + head) * NBLK + r) * HD + 8 * hh;
#pragma unroll
        for (int ks = 0; ks < 4; ++ks) {
            const f32x4 s0 = *(const f32x4*)(km + 16 * ks) * (1.f / MBLK), s1 = *(const f32x4*)(km + 16 * ks + 4) * (1.f / MBLK);
            const float mv[8] = {s0.x, s0.y, s0.z, s0.w, s1.x, s1.y, s1.z, s1.w};
            unsigned hb[8], lb[8];
#pragma unroll
            for (int e = 0; e < 8; ++e) { hb[e] = f2bf(mv[e]); lb[e] = f2bf(mv[e] - bf2f(hb[e])); }
            const u32x4 hw = {hb[0] | (hb[1] << 16), hb[2] | (hb[3] << 16), hb[4] | (hb[5] << 16), hb[6] | (hb[7] << 16)};
            const u32x4 lw = {lb[0] | (lb[1] << 16), lb[2] | (lb[3] << 16), lb[4] | (lb[5] << 16), lb[6] | (lb[7] << 16)};
            acc = MFMA32(__builtin_bit_cast(bf16x8, hw), qf[ks], acc); acc = MFMA32(__builtin_bit_cast(bf16x8, lw), qf[ks], acc);
        }
        float v0 = -INFINITY, v1 = -INFINITY, v2 = -INFINITY; int i0 = -1, i1 = -1, i2 = -1;
#pragma unroll
        for (int i = 0; i < 16; ++i) { const int blk = (i & 3) + 8 * (i >> 2) + 4 * hh; const float sv = blk < og ? acc[i] : -INFINITY; top3_insert(sv, blk, v0, v1, v2, i0, i1, i2); }
        const float pv0 = __shfl_xor(v0, 32), pv1 = __shfl_xor(v1, 32), pv2 = __shfl_xor(v2, 32);
        const int pi0 = __shfl_xor(i0, 32), pi1 = __shfl_xor(i1, 32), pi2 = __shfl_xor(i2, 32);
        top3_insert(pv0, pi0, v0, v1, v2, i0, i1, i2); top3_insert(pv1, pi1, v0, v1, v2, i0, i1, i2); top3_insert(pv2, pi2, v0, v1, v2, i0, i1, i2);
        if (hh == 0) {
            SELS[c * 4 + 0] = (unsigned char)(i0 < 0 ? 255 : i0); SELS[c * 4 + 1] = (unsigned char)(i1 < 0 ? 255 : i1); SELS[c * 4 + 2] = (unsigned char)(i2 < 0 ? 255 : i2);
            if (i0 >= 0) { const int ps = atomicAdd(&CNT[i0], 1); LISTS[i0 * 256 + ps] = (unsigned char)c; }
            if (i1 >= 0) { const int ps = atomicAdd(&CNT[i1], 1); LISTS[i1 * 256 + ps] = (unsigned char)c; }
            if (i2 >= 0) { const int ps = atomicAdd(&CNT[i2], 1); LISTS[i2 * 256 + ps] = (unsigned char)c; }
        }
    }
    __syncthreads();
    if (wave == 0) {
        const int jx = lane & 31, n = (CNT[jx] + 31) >> 5;
        int inc = n;
#pragma unroll
        for (int o = 1; o < 32; o <<= 1) { const int v = __shfl_up(inc, o, 32); if (jx >= o) inc += v; }
        const int st0 = inc - n;
        if (lane < 32) {
            UST[jx] = st0;
            unsigned char* UJ = lds + ML_UJ;
            for (int q = 0; q < n; ++q) UJ[st0 + q] = (unsigned char)jx;
            if (jx == 31) UST[32] = inc;
        }
        if (lane == 0) { *(volatile int*)(lds + ML_QCTR) = 0; *(volatile int*)(lds + ML_ITEM) = (int)nk; }
    }
    __syncthreads();
    {
        const int Usel = UST[32], Utot = Usel + 8;
        int* qctr = (int*)(lds + ML_QCTR);
        int u = 0;
        if (lane == 0) u = atomicAdd(qctr, 1);
        u = __builtin_amdgcn_readfirstlane(u);
        const int sb_after = __builtin_amdgcn_readfirstlane(wave) >> 1;
        bool sb_done = !with_sb; int nun = 0;
        for (;;) {
            const bool have = u < Utot;
            if (!sb_done && (nun == sb_after || !have)) { sb_group(QK, KF, VT, OA, b, head, og); sb_done = true; }
            if (!have) break;
            ++nun;
            int un = 0;
            if (lane == 0) un = atomicAdd(qctr, 1);
            int j, slot, qi; bool valid;
            SmState st;
            if (u < Usel) {
                j = __builtin_amdgcn_readfirstlane((int)(lds + ML_UJ)[u]);
                const bf16_t* kt0 = kp + (size_t)(8 * j) * 2048; const bf16_t* vt0 = vp + (size_t)(8 * j) * 2048;
                KV fa, fb;
                load_kv_async(fa, kt0 + 7 * 2048, vt0 + 7 * 2048); load_kv_async(fb, kt0 + 6 * 2048, vt0 + 6 * 2048);
                const int i = u - UST[j], idx = 32 * i + r;
                valid = idx < CNT[j];
                qi = LISTS[j * 256 + (valid ? idx : 32 * i)];
                slot = (SELS[qi * 4] == j) ? 0 : ((SELS[qi * 4 + 1] == j) ? 1 : 2);
                const int t = 256 * og + qi;
                const bf16_t* qp = qbase + (size_t)t * 1024;
                bf16x8 qf[4];
#pragma unroll
                for (int ks = 0; ks < 4; ++ks) qf[ks] = *(const bf16x8*)(qp + 16 * ks);
                const float bb = slopeL * (float)(256 * j + 4 * hh - t), bs = slopeL * 32.f;
                moba_tile_first<12, 8>(st, fa, qf, bb + 7.f * bs, slopeL, 64, hh);   load_kv_async(fa, kt0 + 5 * 2048, vt0 + 5 * 2048);
                moba_tile_lazy<12, 8>(st, fb, qf, bb + 6.f * bs, slopeL, hh);        load_kv_async(fb, kt0 + 4 * 2048, vt0 + 4 * 2048);
                moba_tile_lazy<12, 8>(st, fa, qf, bb + 5.f * bs, slopeL, hh);        load_kv_async(fa, kt0 + 3 * 2048, vt0 + 3 * 2048);
                moba_tile_lazy<12, 8>(st, fb, qf, bb + 4.f * bs, slopeL, hh);        load_kv_async(fb, kt0 + 2 * 2048, vt0 + 2 * 2048);
                moba_tile_lazy<12, 8>(st, fa, qf, bb + 3.f * bs, slopeL, hh);        load_kv_async(fa, kt0 + 1 * 2048, vt0 + 1 * 2048);
                moba_tile_lazy<12, 8>(st, fb, qf, bb + 2.f * bs, slopeL, hh);        load_kv_async(fb, kt0, vt0);
                moba_tile_lazy<12, 8>(st, fa, qf, bb + bs, slopeL, hh);
                moba_tile_lazy<4, 0>(st, fb, qf, bb, slopeL, hh);
            } else {
                const int w = 7 - (u - Usel);
                j = og; qi = 32 * w + r; valid = true; slot = 3;
                const int t = 256 * og + qi;
                const bf16_t* qp = qbase + (size_t)t * 1024;
                bf16x8 qf[4];
#pragma unroll
                for (int ks = 0; ks < 4; ++ks) qf[ks] = *(const bf16x8*)(qp + 16 * ks);
                moba_pass_own(st, qf, kp + (size_t)(8 * og) * 2048, vp + (size_t)(8 * og) * 2048, w, r, slopeL * (float)(256 * og + 4 * hh - t), slopeL, hh);
            }
            const float lt = st.l + __shfl_xor(st.l, 32), inv = 1.f / lt;
            if (valid) {
                bf16_t* op = OPART + (size_t)(slot * 256 + qi) * 68 + 4 * hh;
#pragma unroll
                for (int g = 0; g < 4; ++g) {
                    u32x2 a; a.x = cvtpk(st.o0[4 * g] * inv, st.o0[4 * g + 1] * inv); a.y = cvtpk(st.o0[4 * g + 2] * inv, st.o0[4 * g + 3] * inv); *(u32x2*)(op + 8 * g) = a;
                    u32x2 c; c.x = cvtpk(st.o1[4 * g] * inv, st.o1[4 * g + 1] * inv); c.y = cvtpk(st.o1[4 * g + 2] * inv, st.o1[4 * g + 3] * inv); *(u32x2*)(op + 32 + 8 * g) = c;
                }
                if (hh == 0) { MLS[(slot * 256 + qi) * 2] = st.m; MLS[(slot * 256 + qi) * 2 + 1] = lt; }
            }
            u = __builtin_amdgcn_readfirstlane(un);
        }
    }
    __syncthreads();
    {
        const int c = 32 * wave + r, t = 256 * og + c;
        float M = -1e30f, ms[4], ls[4];
#pragma unroll
        for (int sl = 0; sl < 4; ++sl) {
            const bool v = sl == 3 || SELS[c * 4 + sl] != 255;
            ms[sl] = v ? MLS[(sl * 256 + c) * 2] : -1e30f; ls[sl] = v ? MLS[(sl * 256 + c) * 2 + 1] : 0.f;
            M = fmaxf(M, ms[sl]);
        }
        float L = 0.f; f32x16 o0, o1;
#pragma unroll
        for (int x = 0; x < 16; ++x) { o0[x] = 0.f; o1[x] = 0.f; }
#pragma unroll
        for (int sl = 0; sl < 4; ++sl) {
            const float w = ls[sl] * __builtin_amdgcn_exp2f(ms[sl] - M);
            L += w;
            const bf16_t* op = OPART + (size_t)(sl * 256 + c) * 68 + 4 * hh;
            if (ls[sl] > 0.f) {
#pragma unroll
                for (int g = 0; g < 4; ++g) {
                    const u32x2 a = *(const u32x2*)(op + 8 * g), cc = *(const u32x2*)(op + 32 + 8 * g);
                    o0[4 * g] += w * bflo(a.x); o0[4 * g + 1] += w * bfhi(a.x); o0[4 * g + 2] += w * bflo(a.y); o0[4 * g + 3] += w * bfhi(a.y);
                    o1[4 * g] += w * bflo(cc.x); o1[4 * g + 1] += w * bfhi(cc.x); o1[4 * g + 2] += w * bflo(cc.y); o1[4 * g + 3] += w * bfhi(cc.y);
                }
            }
        }
        store_o(OA + (size_t)(b * SEQ + t) * (2 * WA) + head * HD + 4 * hh, o0, o1, 1.f / L);
    }
}


#define CE(a, b) do { const unsigned lo_ = min(a, b), hi_ = max(a, b); a = lo_; b = hi_; } while (0)
DI void sort16_asc(unsigned (&k)[16]) {
    CE(k[0], k[1]); CE(k[2], k[3]); CE(k[0], k[2]); CE(k[1], k[3]); CE(k[1], k[2]); CE(k[4], k[5]); CE(k[6], k[7]); CE(k[4], k[6]); CE(k[5], k[7]); CE(k[5], k[6]);
    CE(k[0], k[4]); CE(k[2], k[6]); CE(k[2], k[4]); CE(k[1], k[5]); CE(k[3], k[7]); CE(k[3], k[5]); CE(k[1], k[2]); CE(k[3], k[4]); CE(k[5], k[6]); CE(k[8], k[9]);
    CE(k[10], k[11]); CE(k[8], k[10]); CE(k[9], k[11]); CE(k[9], k[10]); CE(k[12], k[13]); CE(k[14], k[15]); CE(k[12], k[14]); CE(k[13], k[15]); CE(k[13], k[14]);
    CE(k[8], k[12]); CE(k[10], k[14]); CE(k[10], k[12]); CE(k[9], k[13]); CE(k[11], k[15]); CE(k[11], k[13]); CE(k[9], k[10]); CE(k[11], k[12]); CE(k[13], k[14]);
    CE(k[0], k[8]); CE(k[4], k[12]); CE(k[4], k[8]); CE(k[2], k[10]); CE(k[6], k[14]); CE(k[6], k[10]); CE(k[2], k[4]); CE(k[6], k[8]); CE(k[10], k[12]);
    CE(k[1], k[9]); CE(k[5], k[13]); CE(k[5], k[9]); CE(k[3], k[11]); CE(k[7], k[15]); CE(k[7], k[11]); CE(k[3], k[5]); CE(k[7], k[9]); CE(k[11], k[13]);
    CE(k[1], k[2]); CE(k[3], k[4]); CE(k[5], k[6]); CE(k[7], k[8]); CE(k[9], k[10]); CE(k[11], k[12]); CE(k[13], k[14]);
}
DI void bitonic16_asc(unsigned (&k)[16]) {
    CE(k[0], k[8]); CE(k[1], k[9]); CE(k[2], k[10]); CE(k[3], k[11]); CE(k[4], k[12]); CE(k[5], k[13]); CE(k[6], k[14]); CE(k[7], k[15]); CE(k[0], k[4]);
    CE(k[1], k[5]); CE(k[2], k[6]); CE(k[3], k[7]); CE(k[8], k[12]); CE(k[9], k[13]); CE(k[10], k[14]); CE(k[11], k[15]); CE(k[0], k[2]); CE(k[1], k[3]);
    CE(k[4], k[6]); CE(k[5], k[7]); CE(k[8], k[10]); CE(k[9], k[11]); CE(k[12], k[14]); CE(k[13], k[15]); CE(k[0], k[1]); CE(k[2], k[3]); CE(k[4], k[5]);
    CE(k[6], k[7]); CE(k[8], k[9]); CE(k[10], k[11]); CE(k[12], k[13]); CE(k[14], k[15]);
}

DI unsigned fkey(float v, unsigned idx) { unsigned b = __float_as_uint(v); b = (b & 0x80000000u) ? ~b : (b | 0x80000000u); return (b & ~127u) | idx; }
DI float fkey_val(unsigned k) { unsigned b = k & ~127u; b = (b & 0x80000000u) ? (b & 0x7fffffffu) : ~b; return __uint_as_float(b); }
DI void top16_of_128(const f32x4 (&acc)[8], int g, unsigned (&t)[16]) {
    unsigned ka[16], kb[16];
#pragma unroll
    for (int ni = 0; ni < 4; ++ni)
#pragma unroll
        for (int j = 0; j < 4; ++j) { ka[4 * ni + j] = fkey(acc[ni][j], 16 * ni + 4 * g + j); kb[4 * ni + j] = fkey(acc[ni + 4][j], 16 * (ni + 4) + 4 * g + j); }
    sort16_asc(ka); sort16_asc(kb);
#pragma unroll
    for (int i = 0; i < 16; ++i) t[i] = max(ka[i], kb[15 - i]);
    bitonic16_asc(t);
#pragma unroll
    for (int xo = 16; xo <= 32; xo <<= 1) {
        unsigned pp[16];
#pragma unroll
        for (int i = 0; i < 16; ++i) pp[i] = (unsigned)__shfl_xor((int)t[i], xo);
#pragma unroll
        for (int i = 0; i < 16; ++i) t[i] = max(t[i], pp[15 - i]);
        bitonic16_asc(t);
    }
}

#define LAS __attribute__((address_space(3)))
#define XB_TMO      128
#define XB_XCNT(j)  (256  + 64 * (j))
#define XB_XSUB(j)  (1280 + 64 * (j))
#define XB_XGEN(j)  (2304 + 64 * (j))
#define XB_TOP      3328
#define XB_TOPGEN   3392
#define XCD_BAR_WORDS 3456
#define XB_SPIN_CAP (1u << 18)

__device__ __forceinline__ unsigned xb_ld(unsigned* p)              { return __hip_atomic_load(p, __ATOMIC_RELAXED, __HIP_MEMORY_SCOPE_AGENT); }
__device__ __forceinline__ unsigned xb_add(unsigned* p, unsigned v) { return __hip_atomic_fetch_add(p, v, __ATOMIC_RELAXED, __HIP_MEMORY_SCOPE_AGENT); }
__device__ __forceinline__ unsigned xb_xcc_id() { return (unsigned)__builtin_amdgcn_s_getreg((3 << 11) | 20) & 0xFu; }
#define XB_SPIN(cond, bar) do { unsigned _sp = 0; while (cond) { __builtin_amdgcn_s_sleep(1); \
    if ((++_sp & 255u) == 0u) { if (xb_ld(&(bar)[XB_TMO])) break; if (_sp > XB_SPIN_CAP) { atomicAdd(&(bar)[XB_TMO], 1u); break; } } } } while (0)

struct XcdBarrier {
    unsigned* bar; unsigned x;
    volatile LAS unsigned* st;
};

__device__ __forceinline__ XcdBarrier xcd_barrier_post(unsigned* bar, volatile LAS unsigned* st, unsigned& rank) {
    XcdBarrier b; b.bar = bar; b.x = xb_xcc_id(); b.st = st;
    rank = 0u;
    if (threadIdx.x == 0) rank = xb_add(&bar[XB_XCNT(b.x)], 1u);
    return b;
}
__device__ __forceinline__ void xcd_barrier_complete(unsigned* bar, unsigned x, unsigned& nloc, unsigned& nx) {
    const unsigned G = gridDim.x * gridDim.y * gridDim.z;
    unsigned sum, cnt, mine, sp = 0u;
    for (;;) {
        sum = 0u; cnt = 0u; mine = 0u;
#pragma unroll
        for (unsigned j = 0; j < 16; ++j) { const unsigned c = xb_ld(&bar[XB_XCNT(j)]); sum += c; cnt += (c > 0u) ? 1u : 0u; mine = (j == x) ? c : mine; }
        if (sum == G) break;
        __builtin_amdgcn_s_sleep(1);
        if ((++sp & 255u) == 0u) { if (xb_ld(&bar[XB_TMO])) break; if (sp > XB_SPIN_CAP) { atomicAdd(&bar[XB_TMO], 1u); break; } }
    }
    nloc = mine > 0u ? mine : 1u; nx = cnt > 0u ? cnt : 1u;
}

__device__ __forceinline__ void xcd_barrier(const XcdBarrier& b) {
    asm volatile("s_waitcnt vmcnt(0)" ::: "memory");
    __syncthreads();
    if (threadIdx.x == 0) {
        unsigned* bar = b.bar;
        __builtin_amdgcn_s_waitcnt(0);
        unsigned nloc = b.st[0], nx = b.st[1];
        if (nloc == 0u) { xcd_barrier_complete(bar, b.x, nloc, nx); b.st[0] = nloc; b.st[1] = nx; }
        const unsigned old = xb_add(&bar[XB_XSUB(b.x)], 1u);
        const unsigned gen = old / nloc;
        if (old + 1u == (gen + 1u) * nloc) {
            __builtin_amdgcn_fence(__ATOMIC_RELEASE, "agent");
            asm volatile("s_waitcnt vmcnt(0)" ::: "memory");
            const unsigned og = xb_add(&bar[XB_TOP], 1u);
            const unsigned tg = og / nx;
            if (og + 1u == (tg + 1u) * nx) xb_add(&bar[XB_TOPGEN], 1u);
            else XB_SPIN(xb_ld(&bar[XB_TOPGEN]) == tg, bar);
            __builtin_amdgcn_fence(__ATOMIC_ACQUIRE, "agent");
            xb_add(&bar[XB_XGEN(b.x)], 1u);
            asm volatile("s_waitcnt vmcnt(0)" ::: "memory");
        } else {
            XB_SPIN(xb_ld(&bar[XB_XGEN(b.x)]) == gen, bar);
            __builtin_amdgcn_fence(__ATOMIC_ACQUIRE, "agent");
            asm volatile("s_waitcnt vmcnt(0)" ::: "memory");
        }
    }
    __syncthreads();
}


__global__ void __launch_bounds__(NTHREADS, 2) fwd_kernel(Params p) {
    extern __shared__ __attribute__((aligned(16))) unsigned char lds[];
    const int tid = threadIdx.x, lane = tid & 63, wave = tid >> 6;
    const int G = gridDim.x, bid = blockIdx.x;
    const long gtid = (long)bid * NTHREADS + tid, gth = (long)G * NTHREADS;
    const int gwave = bid * NWAVES + wave, ngw = G * NWAVES;
    unsigned char* ws = p.ws;
    bf16_t* WIN = (bf16_t*)(ws + WS_WIN); bf16_t* WOA = (bf16_t*)(ws + WS_WOA);
    bf16_t* WMIX = (bf16_t*)(ws + WS_WMIX); bf16_t* WQ = (bf16_t*)(ws + WS_WQ); bf16_t* SK = (bf16_t*)(ws + WS_SK);
    float* RS1 = (float*)(ws + WS_RS1); float* RS2 = (float*)(ws + WS_RS2);
    bf16_t* XB = (bf16_t*)(ws + WS_XB); bf16_t* OA = (bf16_t*)(ws + WS_OA);
    unsigned short* EIDX = (unsigned short*)(ws + WS_EIDX); float* GW = (float*)(ws + WS_GW);
    bf16_t* QK = (bf16_t*)(ws + WS_QK); bf16_t* KF = (bf16_t*)(ws + WS_KF); bf16_t* VT = (bf16_t*)(ws + WS_VT); bf16_t* MIXED = (bf16_t*)(ws + WS_MIXED); bf16_t* HB = (bf16_t*)(ws + WS_HB);
    bf16_t* GATES = (bf16_t*)(ws + WS_GATES); bf16_t* Q2 = (bf16_t*)(ws + WS_Q2);
    float* SU = (float*)(ws + WS_SU); float* SV = (float*)(ws + WS_SV); float* SSP = (float*)(ws + WS_SSP); float* SH = (float*)(ws + WS_SH);
    signed char* H8 = (signed char*)(ws + WS_H8); int* AP = (int*)(ws + WS_AP); unsigned char* U8 = ws + WS_U8; unsigned char* V8 = ws + WS_V8;
    unsigned* CTL = (unsigned*)(ws + WS_CTL); float* KSUM = (float*)(ws + WS_KSUM); float* SWMAX = (float*)(ws + WS_SWMAX); float* WSC = (float*)(ws + WS_WSC); signed char* WH = (signed char*)(ws + WS_WH); signed char* WL = (signed char*)(ws + WS_WL);
    volatile LAS unsigned* bst = (volatile LAS unsigned*)((LAS unsigned char*)lds + (LDS_BYTES - 16));
    if (tid < 4) bst[tid] = 0u;
    __syncthreads();
    unsigned xrank;
    const XcdBarrier xbar = xcd_barrier_post((unsigned*)(ws + WS_CTL) + 1024, bst, xrank);
    volatile unsigned* rankw = (volatile unsigned*)(lds + (LDS_BYTES - 32));
    const int lo = p.ph_lo, hi = p.ph_hi;
#ifdef ONLY_PHASE
#define IN(k) ((k) == ONLY_PHASE && lo <= (k) && (k) < hi)
#else
#define IN(k) (lo <= (k) && (k) < hi)
#endif
#define SEAM(k) do { if (IN(k) && IN((k) + 1)) xcd_barrier(xbar); } while (0)

    for (int rep_ = 0; rep_ < (IN(0) ? 1 : 0); ++rep_) {
        for (int nb = bid; nb < INW / 32; nb += G) {
            float* scr = (float*)(lds + wave * (128 * 33 * 4));
            float* AMX = (float*)(lds + 8 * (128 * 33 * 4));
            const int n0 = 32 * nb, kw = 128 * wave;
            float am = 0.f;
            __syncthreads();
            {
#pragma unroll
                for (int hf = 0; hf < 2; ++hf) {
                    float wv[32], gv[32];
#pragma unroll
                    for (int i = 0; i < 32; ++i) { const int kk = 64 * hf + 2 * i + (lane >> 5); wv[i] = p.w_in[(size_t)(kw + kk) * INW + n0 + (lane & 31)]; gv[i] = p.g1[kw + kk]; }
#pragma unroll
                    for (int i = 0; i < 32; ++i) { const int kk = 64 * hf + 2 * i + (lane >> 5); const float v = wv[i] * gv[i]; scr[kk * 33 + (lane & 31)] = v; am = fmaxf(am, fabsf(v)); }
                }
            }
            am = fmaxf(am, __shfl_xor(am, 32));
            if (lane < 32) AMX[wave * 32 + lane] = am;
            __syncthreads();
            const int kc = lane & 15;
#pragma unroll
            for (int j = 0; j < 8; ++j) {
                const int n = (lane >> 4) + 4 * j;
                float cm = AMX[n];
#pragma unroll
                for (int w2 = 1; w2 < 8; ++w2) cm = fmaxf(cm, AMX[w2 * 32 + n]);
                const float isc = cm > 0.f ? 127.f / cm : 0.f;
                const float* sp = scr + (8 * kc) * 33 + n;
                unsigned lo, hi;
                lo = q8x4(sp[0], sp[33], sp[66], sp[99], isc); hi = q8x4(sp[4 * 33], sp[5 * 33], sp[6 * 33], sp[7 * 33], isc);
                *(u32x2*)((signed char*)WIN + (size_t)(n0 + n) * DM + kw + 8 * kc) = (u32x2){lo, hi};
                if (wave == 0 && kc == 0) SWMAX[n0 + n] = cm;
            }
        }
        __syncthreads();
        {
            float* scr = (float*)(lds + wave * 16384);
            constexpr int I_OA = (WA / 64) * (DM / 32), I_MIX = (DM / 64) * (DM / 32), I_Q = (DM / 64) * (PQW / 32);
            for (int it = gwave; it < 2 * I_OA + I_MIX + I_Q; it += ngw) {
                int r = it;
                if (r < I_OA) { transpose_item(p.w_oa, WA, DM, WOA, 2 * WA, 0, nullptr, scr, r, lane); continue; } r -= I_OA;
                if (r < I_OA) { transpose_item(p.w_ob, WA, DM, WOA, 2 * WA, WA, nullptr, scr, r, lane); continue; } r -= I_OA;
                if (r < I_MIX) { transpose_item(p.w_mix, DM, DM, WMIX, DM, 0, nullptr, scr, r, lane); continue; } r -= I_MIX;
                transpose_item(p.w_q, DM, PQW, WQ, DM, 0, p.g2, scr, r, lane);
            }
            for (long i = gtid; i < 16L * 128 * 128; i += gth) SK[i] = (bf16_t)f2bf(p.skeys[i]);
        }
        for (int row0 = gwave; row0 < T; row0 += 8 * ngw) {
            f32x4 xv[8][4];
#pragma unroll
            for (int k = 0; k < 8; ++k) {
                const int row = row0 + k * ngw;
                if (row < T) {
#pragma unroll
                    for (int j = 0; j < 4; ++j) xv[k][j] = ((const f32x4*)(p.x + (size_t)row * DM) + lane)[64 * j];
                }
            }
#pragma unroll
            for (int k = 0; k < 8; ++k) {
                const int row = row0 + k * ngw;
                if (row < T) {
                    float sq = 0.f, am = 0.f;
#pragma unroll
                    for (int j = 0; j < 4; ++j) { const f32x4 v = xv[k][j]; sq += v.x * v.x + v.y * v.y + v.z * v.z + v.w * v.w; am = fmaxf(fmaxf(am, fmaxf(fabsf(v.x), fabsf(v.y))), fmaxf(fabsf(v.z), fabsf(v.w))); }
                    sq = wave_sum(sq);
#pragma unroll
                    for (int o = 32; o >= 1; o >>= 1) am = fmaxf(am, __shfl_xor(am, o));
                    const float sc = am > 0.f ? am * (1.f / 127.f) : 1.f, isc = 1.f / sc;
                    unsigned* ob = (unsigned*)(XB + (size_t)row * (DM / 2)) + lane;
#pragma unroll
                    for (int j = 0; j < 4; ++j) { const f32x4 v = xv[k][j]; ob[64 * j] = q8x4(v.x, v.y, v.z, v.w, isc); }
                    if (lane == 0) RS1[row] = sc * rsqrtf(sq * (1.f / DM) + RMS_EPS);
                }
            }
        }
    }
    if (tid == 0) rankw[0] = xrank;
    SEAM(0);

    for (int rep_ = 0; rep_ < (IN(1) ? (PROBE_REP == 1 ? 2 : 1) : 0); ++rep_) {
        pg8::Gemm gm{XB, WIN, T, INW, DM / 2}; pg8::StaticOrder S; S.init(T, INW, G, bid);
        EpiInProj E{QK, KF, VT, GATES, RS1, SWMAX, KSUM, rep_ == 0};
        pg8::gemm_phase<EpiInProj, pg8::StaticOrder, true, true>((PG8_LAS unsigned char*)lds, gm, S, E);
    }
    SEAM(1);

    for (int rep_ = 0; rep_ < (IN(3) ? (PROBE_REP == 3 ? 2 : 1) : 0); ++rep_) {
        {
            volatile int* ibox = (volatile int*)(lds + ML_ITEM);
            const unsigned xcc = (unsigned)__builtin_amdgcn_s_getreg((3 << 11) | 20) & 7u;
            unsigned* Q3 = CTL + 64 + (rep_ ? 8 : 0);
            int qx = (int)xcc;
            __syncthreads();
            if (tid == 0) ibox[0] = (int)atomicAdd(&Q3[qx], 1u);
            __syncthreads();
            for (;;) {
                int k = __builtin_amdgcn_readfirstlane(ibox[0]);
                if (k >= 64) {
                    __syncthreads();
                    if (wave == 0) {
                        unsigned v = 64u;
                        if (lane < 8) v = __hip_atomic_load(&Q3[(xcc + (unsigned)lane) & 7u], __ATOMIC_RELAXED, __HIP_MEMORY_SCOPE_AGENT);
                        const unsigned long long m = __ballot(v < 64u);
                        int nq = -1; unsigned nk = 64u;
                        if (m != 0ull) { nq = (int)((xcc + (unsigned)__builtin_ctzll(m)) & 7u); if (lane == 0) nk = atomicAdd(&Q3[nq], 1u); }
                        if (lane == 0) { ibox[0] = (int)nk; ibox[1] = nq; }
                    }
                    __syncthreads();
                    const int nq = __builtin_amdgcn_readfirstlane(ibox[1]);
                    if (nq < 0) break;
                    qx = nq;
                    continue;
                }
                const int oi = k >> 1;
                const int og = p3_order(oi), bh = 2 * qx + (k & 1);
                moba_group(lds, QK, KF, VT, KSUM, OA, bh >> 3, bh & 7, og, true, &Q3[qx]);
            }
        }
    }
    SEAM(3);

    for (int rep_ = 0; rep_ < (IN(4) ? 1 : 0); ++rep_) {
        pg8::Gemm gm{OA, WOA, T, DM, 2 * WA}; pg8::StaticOrder S; S.init(T, DM, G, bid);
        EpiMix E{GATES, MIXED};
        pg8::gemm_phase<EpiMix, pg8::StaticOrder, true, true, true>((PG8_LAS unsigned char*)lds, gm, S, E);
    }
    SEAM(4);

    for (int rep_ = 0; rep_ < (IN(5) ? (PROBE_REP == 5 ? 2 : 1) : 0); ++rep_) {
        pg8::Gemm gm{MIXED, WMIX, T, DM, DM}; pg8::StaticOrder S; S.init(T, DM, G, bid);
        EpiResid E{p.x, HB};
        pg8::gemm_phase<EpiResid, pg8::StaticOrder, true, true>((PG8_LAS unsigned char*)lds, gm, S, E);
    }
    SEAM(5);

    for (int rep_ = 0; rep_ < (IN(7) ? 1 : 0); ++rep_) {
        pg8::Gemm gm{HB, WQ, T, PQW, DM}; pg8::StaticOrder S; S.init(T, PQW, G, bid);
        EpiPeerQ E{Q2};
        pg8::gemm_phase<EpiPeerQ, pg8::StaticOrder, true, true>((PG8_LAS unsigned char*)lds, gm, S, E);
    }
    SEAM(7);

    for (int rep_ = 0; rep_ < (IN(8) ? (PROBE_REP == 8 ? 2 : 1) : 0); ++rep_) {
        bf16_t* Qs = (bf16_t*)lds;
        bf16_t* Ks = Qs + 128 * 264;
        unsigned* LST = (unsigned*)(lds + 128 * 264 * 2 + 2 * 128 * 136 * 2);
        int h_loaded = -1;
        __syncthreads();
        if (bid < (T / 128) * 8) {
            const int h0 = bid & 7, t00 = (bid >> 3) * 128;
#pragma unroll
            for (int i = 0; i < 8; ++i) { const int c = tid + i * NTHREADS, r = c >> 5, ch = c & 31; *(u32x4*)(Qs + r * 264 + ch * 8) = *(const u32x4*)(Q2 + (size_t)(t00 + r) * PQW + h0 * 256 + ch * 8); }
        }
        for (int it = bid; it < (T / 128) * 8; it += G) {
            const int h = it & 7, t0 = (it >> 3) * 128;
            if (h != h_loaded) {
#pragma unroll
                for (int i = 0; i < 8; ++i) {
                    const int c = tid + i * NTHREADS, r = c >> 4, ch = c & 15;
                    *(u32x4*)(Ks + r * 136 + ch * 8) = *(const u32x4*)(SK + (size_t)(2 * h * 128 + r) * 128 + ch * 8);
                }
                h_loaded = h;
            }
            __syncthreads();
#pragma unroll 1
            for (int ph = 0; ph < 2; ++ph) {
                f32x4 acc[8];
#pragma unroll
                for (int ni = 0; ni < 8; ++ni) acc[ni] = (f32x4){0.f, 0.f, 0.f, 0.f};
#pragma unroll
                for (int ks = 0; ks < 4; ++ks) {
                    const bf16x8 qf = *(const bf16x8*)(Qs + (wave * 16 + (lane & 15)) * 264 + ph * 128 + ks * 32 + (lane >> 4) * 8);
#pragma unroll
                    for (int ni = 0; ni < 8; ++ni) {
                        const bf16x8 kf = *(const bf16x8*)(Ks + (ph * 128 + ni * 16 + (lane & 15)) * 136 + ks * 32 + (lane >> 4) * 8);
                        acc[ni] = __builtin_amdgcn_mfma_f32_16x16x32_bf16(kf, qf, acc[ni], 0, 0, 0);
                    }
                }
                unsigned tk[16];
                top16_of_128(acc, lane >> 4, tk);
                if (lane < 16) {
                    unsigned* dst = LST + ((wave * 16 + lane) * 2 + ph) * 16;
#pragma unroll
                    for (int i = 0; i < 4; ++i) { u32x4 w; w.x = tk[15 - 4 * i]; w.y = tk[14 - 4 * i]; w.z = tk[13 - 4 * i]; w.w = tk[12 - 4 * i]; *(u32x4*)(dst + 4 * i) = w; }
                }
            }
            __syncthreads();
            if (tid >= 128 && it + G < (T / 128) * 8) {
                const int itn = it + G, hn = itn & 7, tn0 = (itn >> 3) * 128;
                for (int c = tid - 128; c < 128 * 32; c += NTHREADS - 128) { const int r = c >> 5, ch = c & 31; *(u32x4*)(Qs + r * 264 + ch * 8) = *(const u32x4*)(Q2 + (size_t)(tn0 + r) * PQW + hn * 256 + ch * 8); }
            }
            if (wave >= 6) quant_rows<8>(p.pu, p.pv, p.g2, U8, V8, SU, SV, it * 32 + 16 + (wave - 6) * 8, 1, lane);
            else if (wave >= 2) quant_rows<4>(p.pu, p.pv, p.g2, U8, V8, SU, SV, it * 32 + (wave - 2) * 4, 1, lane);
            if (tid >= 128 && tid < 384) h_rows4(HB, RS2, SH, H8, it * 16 + (wave - 2) * 4, 1, lane);
            if (tid < 128) {
                const unsigned* La = LST + (tid * 2) * 16; const unsigned* Lb = La + 16;
                float cand[16];
                const float b0 = fkey_val(Lb[0]);
#pragma unroll
                for (int i = 0; i < 4; ++i) { const u32x4 w = *(const u32x4*)(La + 4 * i); cand[4 * i] = fkey_val(w.x) + b0; cand[4 * i + 1] = fkey_val(w.y) + b0; cand[4 * i + 2] = fkey_val(w.z) + b0; cand[4 * i + 3] = fkey_val(w.w) + b0; }
                unsigned long long ptrs = 0ull;
                float selv[16]; unsigned sele[16];
#pragma unroll
                for (int r = 0; r < 16; ++r) {
                    float best = cand[0];
#pragma unroll
                    for (int i = 1; i < 16; ++i) best = fmaxf(best, cand[i]);
                    int istar = 15;
#pragma unroll
                    for (int i = 14; i >= 0; --i) istar = (cand[i] == best) ? i : istar;
                    const int j = (int)((ptrs >> (4 * istar)) & 15ull);
                    const unsigned ka = La[istar], kb = Lb[j];
                    selv[r] = best; sele[r] = (ka & 127u) * PNK + (kb & 127u);
                    const bool more = j < 15;
                    const float nc = more ? fkey_val(ka) + fkey_val(Lb[more ? j + 1 : j]) : -INFINITY;
                    if (more) ptrs += 1ull << (4 * istar);
#pragma unroll
                    for (int i = 0; i < 16; ++i) cand[i] = (i == istar) ? nc : cand[i];
                }
                float* go = GW + (size_t)(t0 + tid) * 128 + h * 16;
#pragma unroll
                for (int r = 0; r < 8; ++r) *(unsigned*)(EIDX + (size_t)(t0 + tid) * 128 + r * 16 + 2 * h) = sele[r] | (sele[r + 8] << 16);
#pragma unroll
                for (int i = 0; i < 4; ++i) *(f32x4*)(go + 4 * i) = (f32x4){selv[4 * i], selv[4 * i + 1], selv[4 * i + 2], selv[4 * i + 3]};
            }
        }
    }
    SEAM(8);

#define PEER_ID(ia, ib, i) ((((i) < 8 ? (ia) : (ib))[((i) & 7) >> 1] >> (((i) & 1) * 16)) & 0xffffu)
#define PEER_ROWS4(dst, base, ia, ib, m) do { _Pragma("unroll") for (int q_ = 0; q_ < 4; ++q_) dst[4 * (m) + q_] = *(const u32x4*)((base) + (unsigned)(PEER_ID(ia, ib, 4 * (m) + q_) * 128u + jp16)); } while (0)
#define PEER_IDS(ia, ib, t) do { const unsigned short* ep_ = EIDX + (size_t)(t) * 128; ia = *(const u32x4*)(ep_ + (unsigned)(g * 16)); ib = *(const u32x4*)(ep_ + (unsigned)(g * 16 + 8)); } while (0)
    for (int rep_ = 0; rep_ < (IN(9) ? (PROBE_REP == 9 ? 2 : 1) : 0); ++rep_) {
        volatile int* ubox = (volatile int*)lds;
        const unsigned xcc = (unsigned)__builtin_amdgcn_s_getreg((3 << 11) | 20) & 7u;
        int ln = lane; asm volatile("" : "+v"(ln));
        const int g = ln >> 3, jp = ln & 7;
        const bool b2 = (ln & 4) != 0, b1 = (ln & 2) != 0, b0 = (ln & 1) != 0;
        const int wv = __builtin_amdgcn_readfirstlane(wave); const unsigned jp16 = (unsigned)jp * 16u;
        constexpr int NTW = 32;
        constexpr int NU = T / (8 * NTW);
        const int rank = (int)rankw[0], nloc = (int)bst[0];
        int live = 0;
#define PEER_SCAN_LOAD(cj, nj, base) do { cj = 0xffffffffu; nj = 0u; if (wave == 0 && lane < 8) { cj = __hip_atomic_load(&CTL[(base) + lane], __ATOMIC_RELAXED, __HIP_MEMORY_SCOPE_AGENT); nj = xb_ld(&xbar.bar[XB_XCNT(lane)]); } } while (0)
#define PEER_SCAN_MASK(cj, nj) ((int)__ballot(lane < 8 && cj + nj < (unsigned)NU))
        for (int k8 = 0; k8 < 8; ++k8) {
            const int sl = (int)((xcc + k8) & 7u);
            if (k8 >= 1 && !((live >> sl) & 1)) continue;
            const unsigned char* U8s = U8 + (size_t)sl * NEXP * 128;
            const int cbase = rep_ ? 32 : 0;
            int uoff;
            __syncthreads();
            if (k8 == 0) {
                uoff = nloc;
                if (tid == 0) ubox[0] = rank;
                if (rank >= NU) { unsigned cj, nj; PEER_SCAN_LOAD(cj, nj, cbase); if (wave == 0) { const int m = PEER_SCAN_MASK(cj, nj); if (lane == 0) ubox[1] = m; } }
            } else {
                uoff = __builtin_amdgcn_readfirstlane((int)xb_ld(&xbar.bar[XB_XCNT(sl)]));
                if (tid == 0) ubox[0] = uoff + (int)atomicAdd(&CTL[cbase + sl], 1u);
            }
            __syncthreads();
            if (k8 == 0 && rank >= NU) live = __builtin_amdgcn_readfirstlane(ubox[1]);
            for (;;) {
                const int u = __builtin_amdgcn_readfirstlane(ubox[0]);
                if (u >= NU) break;
                unsigned nxt = 0u;
                if (tid == 0) nxt = atomicAdd(&CTL[cbase + sl], 1u);
                const int tb = u * (8 * NTW) + wv;
#define P1_HQ(hq, t) hq = *(const u32x4*)(H8 + (size_t)(t) * DM + sl * 128 + jp16)
#define P1_DOT4(d, rw, hq, m) do { _Pragma("unroll") for (int q_ = 0; q_ < 4; ++q_) { int x_ = __builtin_amdgcn_sdot4((int)hq.x, (int)rw[4 * (m) + q_].x, 0, false); x_ = __builtin_amdgcn_sdot4((int)hq.y, (int)rw[4 * (m) + q_].y, x_, false); \
        x_ = __builtin_amdgcn_sdot4((int)hq.z, (int)rw[4 * (m) + q_].z, x_, false); d[4 * (m) + q_] = __builtin_amdgcn_sdot4((int)hq.w, (int)rw[4 * (m) + q_].w, x_, false); } } while (0)
#define P1_FINISH(d_, t) do { int v8_[8], v4_[4]; \
    _Pragma("unroll") for (int i_ = 0; i_ < 8; ++i_) v8_[i_] = (b2 ? d_[8 + i_] : d_[i_]) + __shfl_xor(b2 ? d_[i_] : d_[8 + i_], 4); \
    _Pragma("unroll") for (int i_ = 0; i_ < 4; ++i_) v4_[i_] = (b1 ? v8_[4 + i_] : v8_[i_]) + __shfl_xor(b1 ? v8_[i_] : v8_[4 + i_], 2); \
    const int k0_ = (b0 ? v4_[2] : v4_[0]) + __shfl_xor(b0 ? v4_[0] : v4_[2], 1), k1_ = (b0 ? v4_[3] : v4_[1]) + __shfl_xor(b0 ? v4_[1] : v4_[3], 1); \
    int* ap_ = AP + ((size_t)sl * T + (t)) * 128 + 16 * jp + g; ap_[0] = k0_; ap_[8] = k1_; } while (0)
#define P1_STEP(rw, hq, ea, eb, i, REISSUE) do { int d_[16]; \
    _Pragma("unroll") for (int m_ = 0; m_ < 4; ++m_) { P1_DOT4(d_, rw, hq, m_); __builtin_amdgcn_sched_barrier(0); if (REISSUE) { PEER_ROWS4(rw, U8s, ea, eb, m_); __builtin_amdgcn_sched_barrier(0); } } \
    P1_FINISH(d_, tb + 8 * (i)); } while (0)
                u32x4 e0a, e0b, e1a, e1b, h0, h1, rwA[16], rwB[16];
                PEER_IDS(e0a, e0b, tb); PEER_IDS(e1a, e1b, tb + 8); P1_HQ(h0, tb);
#pragma unroll
                for (int m_ = 0; m_ < 4; ++m_) PEER_ROWS4(rwA, U8s, e0a, e0b, m_);
#pragma unroll
                for (int m_ = 0; m_ < 4; ++m_) PEER_ROWS4(rwB, U8s, e1a, e1b, m_);
                PEER_IDS(e0a, e0b, tb + 16);
#pragma unroll 1
                for (int i = 0; i < NTW - 2; i += 2) {
                    PEER_IDS(e1a, e1b, tb + 8 * (i + 3));
                    P1_HQ(h1, tb + 8 * (i + 1));
                    P1_STEP(rwA, h0, e0a, e0b, i, true);
                    { const int tn = tb + 8 * (i + 4 < NTW ? i + 4 : NTW - 1); PEER_IDS(e0a, e0b, tn); }
                    P1_HQ(h0, tb + 8 * (i + 2));
                    P1_STEP(rwB, h1, e1a, e1b, i + 1, true);
                }
                P1_HQ(h1, tb + 8 * (NTW - 1));
                P1_STEP(rwA, h0, e0a, e0b, NTW - 2, false);
                P1_STEP(rwB, h1, e1a, e1b, NTW - 1, false);
                __syncthreads();
                if (tid == 0) ubox[0] = uoff + (int)nxt;
                __syncthreads();
            }
            if (k8 == 0 && rank < NU) {
                __syncthreads();
                { unsigned cj, nj; PEER_SCAN_LOAD(cj, nj, cbase); if (wave == 0) { const int m = PEER_SCAN_MASK(cj, nj); if (lane == 0) ubox[1] = m; } }
                __syncthreads();
                live = __builtin_amdgcn_readfirstlane(ubox[1]);
            }
        }
    }
    SEAM(9);

    for (int rep_ = 0; rep_ < (IN(10) ? (PROBE_REP == 10 ? 2 : 1) : 0); ++rep_) {
        for (int t = gwave; t < T; t += ngw) {
            int s0 = 0, s1 = 0;
#pragma unroll
            for (int q = 0; q < 8; ++q) { const int* ap = AP + ((size_t)q * T + t) * 128; s0 += ap[lane]; s1 += ap[64 + lane]; }
            const int p0 = (lane & 7) * 16 + (lane >> 3), p1 = p0 + 8;
            const int e0 = EIDX[(size_t)t * 128 + p0], e1 = EIDX[(size_t)t * 128 + p1];
            const float sc = SH[t] * RS2[t];
            const float a0 = (float)s0 * (sc * SU[e0]), a1 = (float)s1 * (sc * SU[e1]);
            const float rs2t = RS2[t];
            const float c0 = GW[(size_t)t * 128 + lane] * rs2t, c1 = GW[(size_t)t * 128 + 64 + lane] * rs2t;
            float m0 = c0, m1 = c1;
#pragma unroll
            for (int o = 8; o >= 1; o >>= 1) { m0 = fmaxf(m0, __shfl_xor(m0, o)); m1 = fmaxf(m1, __shfl_xor(m1, o)); }
            const float x0e = __expf(c0 - m0), x1e = __expf(c1 - m1);
            float z0 = x0e, z1 = x1e;
#pragma unroll
            for (int o = 8; o >= 1; o >>= 1) { z0 += __shfl_xor(z0, o); z1 += __shfl_xor(z1, o); }
            const float w0 = (x0e * __builtin_amdgcn_rcpf(z0)) * (0.5f * a0 * (1.f + erff(a0 * 0.70710678118654752f))) * SV[e0];
            const float w1 = (x1e * __builtin_amdgcn_rcpf(z1)) * (0.5f * a1 * (1.f + erff(a1 * 0.70710678118654752f))) * SV[e1];
            float wm = fmaxf(fabsf(w0), fabsf(w1));
#pragma unroll
            for (int o = 32; o >= 1; o >>= 1) wm = fmaxf(wm, __shfl_xor(wm, o));
            const float wsc = wm > 0.f ? wm * (1.f / 127.f) : 1.f, iw = 1.f / wsc;
            const float x0 = w0 * iw, x1 = w1 * iw;
            int h0 = (int)rintf(x0), h1 = (int)rintf(x1);
            h0 = h0 < -127 ? -127 : (h0 > 127 ? 127 : h0); h1 = h1 < -127 ? -127 : (h1 > 127 ? 127 : h1);
            WH[(size_t)t * 128 + p0] = (signed char)h0; WH[(size_t)t * 128 + p1] = (signed char)h1;
            if (lane == 0) WSC[t] = wsc;
        }
    }
    SEAM(10);

    for (int rep_ = 0; rep_ < (IN(11) ? (PROBE_REP == 11 ? 2 : 1) : 0); ++rep_) {
        const bool dry_ = (PROBE_REP == 11) && rep_ == 0;
        volatile int* ubox = (volatile int*)lds;
        const unsigned xcc = (unsigned)__builtin_amdgcn_s_getreg((3 << 11) | 20) & 7u;
        int ln = lane; asm volatile("" : "+v"(ln));
        const int g = ln >> 3, jp = ln & 7;
        const bool b5 = (ln & 32) != 0, b4 = (ln & 16) != 0, b3 = (ln & 8) != 0;
        const int wv = __builtin_amdgcn_readfirstlane(wave); const unsigned jp16 = (unsigned)jp * 16u;
        constexpr int NTW = 32;
        constexpr int NU = T / (8 * NTW);
        const int rank = (int)rankw[0], nloc = (int)bst[0];
        int live = 0;
        for (int k8 = 0; k8 < 8; ++k8) {
            const int sl = (int)((xcc + k8) & 7u);
            if (k8 >= 1 && !((live >> sl) & 1)) continue;
            const unsigned char* V8s = V8 + (size_t)sl * NEXP * 128;
            const int cbase = dry_ ? 48 : 16;
            int uoff;
            __syncthreads();
            if (k8 == 0) {
                uoff = nloc;
                if (tid == 0) ubox[0] = rank;
                if (rank >= NU) { unsigned cj, nj; PEER_SCAN_LOAD(cj, nj, cbase); if (wave == 0) { const int m = PEER_SCAN_MASK(cj, nj); if (lane == 0) ubox[1] = m; } }
            } else {
                uoff = __builtin_amdgcn_readfirstlane((int)xb_ld(&xbar.bar[XB_XCNT(sl)]));
                if (tid == 0) ubox[0] = uoff + (int)atomicAdd(&CTL[cbase + sl], 1u);
            }
            __syncthreads();
            if (k8 == 0 && rank >= NU) live = __builtin_amdgcn_readfirstlane(ubox[1]);
            for (;;) {
                const int u = __builtin_amdgcn_readfirstlane(ubox[0]);
                if (u >= NU) break;
                unsigned nxt = 0u;
                if (tid == 0) nxt = atomicAdd(&CTL[cbase + sl], 1u);
                const int tb = u * (8 * NTW) + wv;
#define P2_WM(wh, hv, wsc, t) do { wh = *(const u32x4*)(WH + (size_t)(t) * 128 + (unsigned)(g * 16)); { const unsigned hw_ = *(const unsigned*)(HB + (size_t)(t) * DM + sl * 128 + (unsigned)(jp * 16 + 2 * g)); hv = (f32x2_t){bflo(hw_), bfhi(hw_)}; } wsc = WSC[t]; } while (0)
#define P2_COL(rw, wh, ah, c, cb, m) do { const unsigned t0_ = __builtin_amdgcn_perm(rw[4 * (m) + 1].c, rw[4 * (m)].c, 0x05010400u), t1_ = __builtin_amdgcn_perm(rw[4 * (m) + 3].c, rw[4 * (m) + 2].c, 0x05010400u); \
    const unsigned t2_ = __builtin_amdgcn_perm(rw[4 * (m) + 1].c, rw[4 * (m)].c, 0x07030602u), t3_ = __builtin_amdgcn_perm(rw[4 * (m) + 3].c, rw[4 * (m) + 2].c, 0x07030602u); \
    ah[(cb) + 0] = __builtin_amdgcn_sdot4((int)__builtin_amdgcn_perm(t1_, t0_, 0x05040100u), (int)wh[m], ah[(cb) + 0], false); ah[(cb) + 1] = __builtin_amdgcn_sdot4((int)__builtin_amdgcn_perm(t1_, t0_, 0x07060302u), (int)wh[m], ah[(cb) + 1], false); \
    ah[(cb) + 2] = __builtin_amdgcn_sdot4((int)__builtin_amdgcn_perm(t3_, t2_, 0x05040100u), (int)wh[m], ah[(cb) + 2], false); ah[(cb) + 3] = __builtin_amdgcn_sdot4((int)__builtin_amdgcn_perm(t3_, t2_, 0x07060302u), (int)wh[m], ah[(cb) + 3], false); } while (0)
#define P2_FINISH(d_, hv, wsc, t) do { int v8_[8], v4_[4]; \
    _Pragma("unroll") for (int i_ = 0; i_ < 8; ++i_) v8_[i_] = (b5 ? d_[8 + i_] : d_[i_]) + __shfl_xor(b5 ? d_[i_] : d_[8 + i_], 32); \
    _Pragma("unroll") for (int i_ = 0; i_ < 4; ++i_) v4_[i_] = (b4 ? v8_[4 + i_] : v8_[i_]) + __shfl_xor(b4 ? v8_[i_] : v8_[4 + i_], 16); \
    const int k0_ = (b3 ? v4_[2] : v4_[0]) + __shfl_xor(b3 ? v4_[0] : v4_[2], 8), k1_ = (b3 ? v4_[3] : v4_[1]) + __shfl_xor(b3 ? v4_[1] : v4_[3], 8); \
    bf16_t* orow_ = MIXED + (size_t)(t) * DM + sl * 128 + jp * 16 + 2 * g;     \
    const unsigned ob_ = cvtpk((hv).x + (float)k0_ * (wsc), (hv).y + (float)k1_ * (wsc)); const float o0_ = bflo(ob_), o1_ = bfhi(ob_); \
    if (!dry_) *(unsigned*)orow_ = ob_; \
    const float ss_ = wave_sum(o0_ * o0_ + o1_ * o1_); if (ln == 0 && !dry_) SSP[(size_t)(t) * 8 + sl] = ss_; asm volatile("" :: "v"(ss_)); } while (0)
#define P2_STEP(rw, wh, hv, wsc, ea, eb, i, REISSUE) do { int d_[16]; _Pragma("unroll") for (int i_ = 0; i_ < 16; ++i_) d_[i_] = 0; \
    _Pragma("unroll") for (int m_ = 0; m_ < 4; ++m_) { P2_COL(rw, wh, d_, x, 0, m_); P2_COL(rw, wh, d_, y, 4, m_); P2_COL(rw, wh, d_, z, 8, m_); P2_COL(rw, wh, d_, w, 12, m_); __builtin_amdgcn_sched_barrier(0); \
        if (REISSUE) { PEER_ROWS4(rw, V8s, ea, eb, m_); __builtin_amdgcn_sched_barrier(0); } } \
    P2_FINISH(d_, hv, wsc, tb + 8 * (i)); } while (0)
                u32x4 e0a, e0b, e1a, e1b, w0, w1, rwA[16], rwB[16]; f32x2_t hv0, hv1; float ws0, ws1;
                PEER_IDS(e0a, e0b, tb); PEER_IDS(e1a, e1b, tb + 8); P2_WM(w0, hv0, ws0, tb);
#pragma unroll
                for (int m_ = 0; m_ < 4; ++m_) PEER_ROWS4(rwA, V8s, e0a, e0b, m_);
#pragma unroll
                for (int m_ = 0; m_ < 4; ++m_) PEER_ROWS4(rwB, V8s, e1a, e1b, m_);
                PEER_IDS(e0a, e0b, tb + 16);
#pragma unroll 1
                for (int i = 0; i < NTW - 2; i += 2) {
                    PEER_IDS(e1a, e1b, tb + 8 * (i + 3));
                    P2_WM(w1, hv1, ws1, tb + 8 * (i + 1));
                    P2_STEP(rwA, w0, hv0, ws0, e0a, e0b, i, true);
                    { const int tn = tb + 8 * (i + 4 < NTW ? i + 4 : NTW - 1); PEER_IDS(e0a, e0b, tn); }
                    P2_WM(w0, hv0, ws0, tb + 8 * (i + 2));
                    P2_STEP(rwB, w1, hv1, ws1, e1a, e1b, i + 1, true);
                }
                P2_WM(w1, hv1, ws1, tb + 8 * (NTW - 1));
                P2_STEP(rwA, w0, hv0, ws0, e0a, e0b, NTW - 2, false);
                P2_STEP(rwB, w1, hv1, ws1, e1a, e1b, NTW - 1, false);
                __syncthreads();
                if (tid == 0) ubox[0] = uoff + (int)nxt;
                __syncthreads();
            }
            if (k8 == 0 && rank < NU) {
                __syncthreads();
                { unsigned cj, nj; PEER_SCAN_LOAD(cj, nj, cbase); if (wave == 0) { const int m = PEER_SCAN_MASK(cj, nj); if (lane == 0) ubox[1] = m; } }
                __syncthreads();
                live = __builtin_amdgcn_readfirstlane(ubox[1]);
            }
        }
    }
    SEAM(11);

    for (int rep_ = 0; rep_ < (IN(12) ? 1 : 0); ++rep_) {
        for (int row = gwave; row < T; row += ngw) {
            float tot = 0.f;
#pragma unroll
            for (int q = 0; q < 8; ++q) tot += SSP[(size_t)row * 8 + q];
            const float rs = rsqrtf(tot * (1.f / DM) + RMS_EPS);
            f32x4* orow = (f32x4*)(p.out + (size_t)row * DM) + lane; const u32x2* ob = (const u32x2*)(MIXED + (size_t)row * DM) + lane;
#pragma unroll
            for (int j = 0; j < 4; ++j) { const f32x4 gv = ((const f32x4*)p.gf)[lane + 64 * j]; const u32x2 w = ob[64 * j]; orow[64 * j] = (f32x4){bflo(w.x), bfhi(w.x), bflo(w.y), bfhi(w.y)} * rs * gv; }
        }
    }
#undef IN
#undef SEAM
}

extern "C" void kernel_launch(void* const* d_in, const int* in_sizes, int n_in, void* d_out, int out_size, void* d_ws, size_t ws_size, hipStream_t stream) {
    static int grid = 0;
    if (grid == 0) {
        int dev = 0, cus = 0, per_cu = 0;
        (void)hipGetDevice(&dev);
        (void)hipDeviceGetAttribute(&cus, hipDeviceAttributeMultiprocessorCount, dev);
        (void)hipFuncSetAttribute((const void*)fwd_kernel, hipFuncAttributeMaxDynamicSharedMemorySize, LDS_BYTES);
        (void)hipOccupancyMaxActiveBlocksPerMultiprocessor(&per_cu, (const void*)fwd_kernel, NTHREADS, LDS_BYTES);
        if (per_cu < 1) { fprintf(stderr, "kernel_launch: occupancy query says %d blocks per CU\n", per_cu); per_cu = 1; }
        grid = cus * 1;
        if (ws_size < WS_END) { fprintf(stderr, "kernel_launch: workspace too small: %zu < %zu\n", ws_size, (size_t)WS_END); grid = -1; }
    }
    if (grid < 0) return;
    Params p{};
    p.x = (const float*)d_in[0]; p.g1 = (const float*)d_in[1]; p.w_in = (const float*)d_in[2]; p.w_oa = (const float*)d_in[3]; p.w_ob = (const float*)d_in[4];
    p.w_mix = (const float*)d_in[5]; p.g2 = (const float*)d_in[6]; p.w_q = (const float*)d_in[7]; p.skeys = (const float*)d_in[8]; p.pu = (const float*)d_in[9];
    p.pv = (const float*)d_in[10]; p.gf = (const float*)d_in[11]; p.out = (float*)d_out; p.ws = (unsigned char*)d_ws;
    p.ph_lo = 0; p.ph_hi = 13;
    if (hipMemsetAsync((char*)d_ws + WS_CTL, 0, 65536 + 131072 + 32768, stream) != hipSuccess) { fprintf(stderr, "kernel_launch: hipMemsetAsync failed\n"); return; }
    hipLaunchKernelGGL(fwd_kernel, dim3(grid), dim3(NTHREADS), LDS_BYTES, stream, p);
}
```

```cpp
#include <hip/hip_runtime.h>
#include <cstdio>
#include <cstdint>

#define DI __device__ __forceinline__
typedef unsigned short bf16_t;
typedef short bf16x8 __attribute__((ext_vector_type(8)));
typedef float f32x4 __attribute__((ext_vector_type(4)));
typedef unsigned u32x4 __attribute__((ext_vector_type(4)));
typedef unsigned u32x2 __attribute__((ext_vector_type(2)));

constexpr int NBATCH = 2, SEQ = 8192, T = NBATCH * SEQ, DM = 1024;
constexpr int NH = 8, HD = 64, WA = 512;
constexpr int INW = 5120, QKVW = 3072, GATEW = 2048;
constexpr int MBLK = 256, NBLK = SEQ / MBLK;
constexpr int PNK = 128, PTOPK = 16, NEXP = 16384, PQW = 2048;
constexpr float RMS_EPS = 1e-6f;
constexpr int NTHREADS = 512, NWAVES = 8;
static_assert((T / 128) * 8 * 32 == 2 * NEXP && (T / 128) * 8 * 16 == T, "P8 side work: 32 expert rows and 16 h rows per item cover all rows");
constexpr int LDS_BYTES = 163840;
#ifndef PROBE_REP
#define PROBE_REP -1
#endif

constexpr size_t MiB = 1u << 20;
constexpr size_t WS_CTL = 0;
constexpr size_t WS_KSUM = 65536;
constexpr size_t WS_SWMAX = 196608;
constexpr size_t WS_WIN = 1 * MiB;
constexpr size_t WS_WOA = 11 * MiB;
constexpr size_t WS_WMIX = 13 * MiB;
constexpr size_t WS_WQ = 15 * MiB;
constexpr size_t WS_SK = 19 * MiB;
constexpr size_t WS_RS1 = 19 * MiB + 512 * 1024;
constexpr size_t WS_RS2 = WS_RS1 + 65536;
constexpr size_t WS_XB = 24 * MiB;
constexpr size_t WS_OA = 24 * MiB;
constexpr size_t WS_EIDX = 24 * MiB;
constexpr size_t WS_GW = 28 * MiB;
constexpr size_t WS_QK = 56 * MiB;
constexpr size_t WS_KF = 88 * MiB;
constexpr size_t WS_VT = 120 * MiB;
constexpr size_t WS_MIXED = 56 * MiB;
constexpr size_t WS_HB = 88 * MiB;
constexpr size_t WS_GATES = 152 * MiB;
constexpr size_t WS_Q2 = 152 * MiB;
constexpr size_t WS_SU = 20 * MiB;
constexpr size_t WS_SV = WS_SU + 65536;
constexpr size_t WS_SSP = 36 * MiB;
constexpr size_t WS_SH = WS_SSP + 524288;
constexpr size_t WS_WSC = WS_SH + 65536;
constexpr size_t WS_WH = 37 * MiB;
constexpr size_t WS_WL = 39 * MiB;
constexpr size_t WS_H8 = 40 * MiB;
constexpr size_t WS_AP = 152 * MiB;
constexpr size_t WS_U8 = 216 * MiB;
constexpr size_t WS_V8 = 232 * MiB;
constexpr size_t WS_END = 248 * MiB;

struct Params {
    const float *x, *g1, *w_in, *w_oa, *w_ob, *w_mix, *g2, *w_q, *skeys, *pu, *pv, *gf;
    float* out; unsigned char* ws; int ph_lo, ph_hi;
};

DI unsigned f2bf(float f) { unsigned u = __float_as_uint(f); return (u + 0x7fffu + ((u >> 16) & 1u)) >> 16; }
DI float bf2f(unsigned h) { return __uint_as_float(h << 16); }
DI float bflo(unsigned w) { return __uint_as_float(w << 16); }
DI float bfhi(unsigned w) { return __uint_as_float(w & 0xffff0000u); }
typedef __bf16 bf16x2_t __attribute__((ext_vector_type(2)));
typedef float f32x2_t __attribute__((ext_vector_type(2)));
DI unsigned cvtpk(float lo, float hi) { f32x2_t v = {lo, hi}; bf16x2_t b = __builtin_convertvector(v, bf16x2_t); return __builtin_bit_cast(unsigned, b); }
DI unsigned pk2(float lo, float hi) { return cvtpk(lo, hi); }
DI unsigned q8x4(float a, float b, float c, float d, float isc) {
    const float M = 12582912.f;
    const unsigned fa = __float_as_uint(fmaf(a, isc, M)), fb = __float_as_uint(fmaf(b, isc, M)), fc = __float_as_uint(fmaf(c, isc, M)), fd = __float_as_uint(fmaf(d, isc, M));
    return __builtin_amdgcn_perm(fb, fa, 0x0c0c0400u) | __builtin_amdgcn_perm(fd, fc, 0x04000c0cu);
}
DI float wave_sum(float v) {
#pragma unroll
    for (int o = 32; o >= 1; o >>= 1) v += __shfl_xor(v, o);
    return v;
}
DI void load_row64(const bf16_t* p, float* o) {
#pragma unroll
    for (int i = 0; i < 8; ++i) {
        u32x4 w = *(const u32x4*)(p + 8 * i);
        o[8 * i + 0] = bflo(w.x); o[8 * i + 1] = bfhi(w.x); o[8 * i + 2] = bflo(w.y); o[8 * i + 3] = bfhi(w.y);
        o[8 * i + 4] = bflo(w.z); o[8 * i + 5] = bfhi(w.z); o[8 * i + 6] = bflo(w.w); o[8 * i + 7] = bfhi(w.w);
    }
}
DI float sigmoidf_(float x) { return __builtin_amdgcn_rcpf(1.f + __builtin_amdgcn_exp2f(x * -1.4426950408889634f)); }

DI void transpose_item(const float* W, int K, int N, bf16_t* WT, int ldk, int koff, const float* ks, float* scr, int item, int lane) {
    const int nblk = N / 32, kb = item / nblk, nb = item % nblk, k0 = 64 * kb, n0 = 32 * nb;
    float tv[32];
#pragma unroll
    for (int i = 0; i < 32; ++i) tv[i] = W[(size_t)(k0 + 2 * i + (lane >> 5)) * N + n0 + (lane & 31)];
    if (ks) {
#pragma unroll
        for (int i = 0; i < 32; ++i) tv[i] *= ks[k0 + 2 * i + (lane >> 5)];
    }
#pragma unroll
    for (int i = 0; i < 32; ++i) scr[(2 * i + (lane >> 5)) * 33 + (lane & 31)] = tv[i];
    asm volatile("s_waitcnt lgkmcnt(0)" ::: "memory");
    const int c = lane & 7;
#pragma unroll
    for (int j = 0; j < 4; ++j) { const int n = (lane >> 3) + 8 * j; const float* sp = scr + (8 * c) * 33 + n;
        u32x4 o; o.x = pk2(sp[0 * 33], sp[1 * 33]); o.y = pk2(sp[2 * 33], sp[3 * 33]); o.z = pk2(sp[4 * 33], sp[5 * 33]); o.w = pk2(sp[6 * 33], sp[7 * 33]);
        *(u32x4*)(WT + (size_t)(n0 + n) * ldk + koff + k0 + 8 * c) = o; }
    asm volatile("s_waitcnt lgkmcnt(0)" ::: "memory");
}

namespace pg8 {
#define PG8_LAS __attribute__((address_space(3)))
typedef unsigned short bf16_t;
typedef short bf16x8 __attribute__((ext_vector_type(8)));
typedef float f32x4 __attribute__((ext_vector_type(4)));
typedef int i32x4 __attribute__((ext_vector_type(4)));
typedef unsigned u32x4 __attribute__((ext_vector_type(4)));
template <bool I8> struct AccT { typedef f32x4 type; };
template <> struct AccT<true> { typedef i32x4 type; };
constexpr int BM = 256, BK = 64, HALF = 128, HTB = HALF * BK * 2  , STAGE_BYTES = 8 * HTB, NXCD = 8, WGM = 8;

__host__ __device__ __forceinline__ int lds_byte(int r, int c) { const int st = (r >> 4) * 2 + (c >> 5), rr = r & 15, cc = c & 31, ob = rr * 64 + cc * 2; return st * 1024 + (ob ^ (((ob >> 9) & 1) << 5)); }
__host__ __device__ __forceinline__ void stage_rc(int b, int& R, int& C) { const int st = b / 1024, sb = b % 1024, swz = sb ^ (((sb >> 9) & 1) << 5); R = (st >> 1) * 16 + swz / 64; C = (st & 1) * 32 + (swz % 64) / 2; }
__host__ __device__ __forceinline__ int perm32(int rho) { const int n = rho >> 4, i = rho & 15; return 8 * (i >> 2) + 4 * n + (i & 3); }

struct Unit { int pm, pn; };
struct Gemm { const bf16_t* A; const bf16_t* Bt; int M, N, K; };

struct StaticOrder {
    int nM, nN, nwg, G, c;
    __host__ __device__ void init(int M, int N, int G_, int c_) { nM = M / BM; nN = N / BM; nwg = nM * nN; G = G_; c = c_; }
    __host__ __device__ bool next(int i, Unit& u) const {
        const long L = (long)i * G + c; if (L >= nwg) return false;
        int wgid = (int)L; { const int q = nwg / NXCD, r = nwg % NXCD, xcd = wgid % NXCD, off = wgid / NXCD; wgid = (xcd < r ? xcd * (q + 1) : r * (q + 1) + (xcd - r) * q) + off; }
        const int nig = WGM * nN, gid = wgid / nig, fm = gid * WGM, gsz = (nM - fm) < WGM ? (nM - fm) : WGM;
        u.pm = fm + ((wgid % nig) % gsz); u.pn = (wgid % nig) / gsz; return true;
    }
    __device__ __forceinline__ void a_ready(const Unit&) const {}
    __device__ __forceinline__ void done(const Unit&) const {}
};
__device__ __forceinline__ unsigned cvt_pk_bf16(float lo, float hi) { unsigned r; asm volatile("v_cvt_pk_bf16_f32 %0, %1, %2" : "=v"(r) : "v"(lo), "v"(hi)); return r; }
template <class Epi, class Sched, bool ALIGN_EPI = false, bool SP2 = false, bool MIDK = false>
__device__ __forceinline__ void gemm_phase(PG8_LAS unsigned char* lds, const Gemm g, const Sched& S, const Epi& E) {
    const int tid = threadIdx.x, wid = __builtin_amdgcn_readfirstlane(tid >> 6), lane = tid & 63, wr = wid >> 2, wc = wid & 3, fr = lane & 15, fq = lane >> 4;
    const int K = g.K, nt = K / BK;
    unsigned voffA[2], voffB[2];
#pragma unroll
    for (int i = 0; i < 2; ++i) { int R, C; stage_rc(tid * 16 + i * 8192, R, C); const int Rb = Epi::PERM ? ((R & ~31) + perm32(R & 31)) : R;
        voffA[i] = (unsigned)(R * K + C) * 2u; voffB[i] = (unsigned)(Rb * K + C) * 2u; }
    const size_t kstep = (size_t)(BK * 2);
    const size_t hstep = (size_t)HALF * K * 2;
    const size_t tstep = 2 * hstep;
    const unsigned ldsw = (unsigned)wid * 1024u;
    const int aoff = lds_byte(wr * 64 + fr, fq * 8), boff = lds_byte(wc * 32 + fr, fq * 8);
#define PG8_SA(b, h) (((b) * 2 + (h)) * HTB)
#define PG8_SB(b, h) ((4 + (b) * 2 + (h)) * HTB)
#define PG8_STAGE(bufoff, gbase, voff) do { _Pragma("unroll") for (int _i = 0; _i < 2; ++_i) \
        __builtin_amdgcn_global_load_lds((const unsigned*)((const char*)(gbase) + (voff)[_i]), (PG8_LAS unsigned*)(lds + (bufoff) + ldsw + _i * 8192), 16, 0, 0); } while (0)
#define PG8_LDA(dst, b, h) do { _Pragma("unroll") for (int m = 0; m < 4; ++m) _Pragma("unroll") for (int k = 0; k < 2; ++k) dst[m][k] = *(const PG8_LAS bf16x8*)(lds + PG8_SA(b, h) + aoff + m * 2048 + k * 1024); } while (0)
#define PG8_LDB(dst, b, h) do { _Pragma("unroll") for (int n = 0; n < 2; ++n) _Pragma("unroll") for (int k = 0; k < 2; ++k) dst[n][k] = *(const PG8_LAS bf16x8*)(lds + PG8_SB(b, h) + boff + n * 2048 + k * 1024); } while (0)
#define PG8_MMA(ai, bj, At, Bt) do { __builtin_amdgcn_s_setprio(1); _Pragma("unroll") for (int m = 0; m < 4; ++m) _Pragma("unroll") for (int n = 0; n < 2; ++n) _Pragma("unroll") for (int k = 0; k < 2; ++k) \
        { if constexpr (Epi::I8) acc[ai][bj][m][n] = __builtin_amdgcn_mfma_i32_16x16x64_i8(__builtin_bit_cast(i32x4, Bt[n][k]), __builtin_bit_cast(i32x4, At[m][k]), acc[ai][bj][m][n], 0, 0, 0); \
          else acc[ai][bj][m][n] = __builtin_amdgcn_mfma_f32_16x16x32_bf16(Bt[n][k], At[m][k], acc[ai][bj][m][n], 0, 0, 0); } __builtin_amdgcn_s_setprio(0); } while (0)
#define PG8_WAIT_V(n) asm volatile("s_waitcnt vmcnt(" #n ")" ::: "memory")
#define PG8_WAIT_L(n) asm volatile("s_waitcnt lgkmcnt(" #n ")" ::: "memory")
#define PG8_BAR __builtin_amdgcn_s_barrier()
#define PG8_SCHED __builtin_amdgcn_sched_barrier(0)
    Unit cur, nxt; int ui = 0;
    if (!S.next(0, cur)) return;
    typedef typename AccT<Epi::I8>::type acc_t;
    acc_t acc[2][2][4][2];
    if constexpr (Epi::HAS_INIT) E.init(acc, cur, wr, wc, fr, fq);
    else {
#pragma unroll
    for (int a = 0; a < 2; ++a)
#pragma unroll
        for (int b = 0; b < 2; ++b)
#pragma unroll
            for (int m = 0; m < 4; ++m)
#pragma unroll
                for (int n = 0; n < 2; ++n) acc[a][b][m][n] = acc_t{};
    }
    bf16x8 At[4][2], B0[2][2], B1[2][2];
    const char* cA = (const char*)g.A + (size_t)cur.pm * tstep; const char* cB = (const char*)g.Bt + (size_t)cur.pn * tstep;
    S.a_ready(cur);
    if constexpr (SP2) {
        PG8_STAGE(PG8_SB(0, 0), cB, voffB); PG8_STAGE(PG8_SB(0, 1), cB + hstep, voffB); PG8_STAGE(PG8_SA(0, 0), cA, voffA); PG8_STAGE(PG8_SA(0, 1), cA + hstep, voffA);
        if (wr == 1) PG8_BAR;
        PG8_WAIT_V(2); PG8_BAR;
        PG8_STAGE(PG8_SB(1, 0), cB + kstep, voffB); PG8_STAGE(PG8_SA(1, 0), cA + kstep, voffA); PG8_STAGE(PG8_SB(1, 1), cB + hstep + kstep, voffB);
        PG8_WAIT_V(6); PG8_BAR;
    } else {
        PG8_STAGE(PG8_SB(0, 0), cB, voffB); PG8_STAGE(PG8_SA(0, 0), cA, voffA); PG8_STAGE(PG8_SB(0, 1), cB + hstep, voffB); PG8_STAGE(PG8_SA(0, 1), cA + hstep, voffA);
        if (wr == 1) PG8_BAR;
        PG8_WAIT_V(4); PG8_BAR;
        PG8_STAGE(PG8_SB(1, 0), cB + kstep, voffB); PG8_STAGE(PG8_SA(1, 0), cA + kstep, voffA); PG8_STAGE(PG8_SB(1, 1), cB + hstep + kstep, voffB);
        PG8_WAIT_V(6); PG8_BAR;
    }
    for (;;) {
        const bool has_next = S.next(ui + 1, nxt);
        const char* nA = has_next ? (const char*)g.A + (size_t)nxt.pm * tstep : cA; const char* nB = has_next ? (const char*)g.Bt + (size_t)nxt.pn * tstep : cB;
        for (int t = 0; t < nt; t += 2) {
            if constexpr (MIDK) { if (t == nt / 2) E.mid(acc, cur, wr, wc, fr, fq); }
            const bool last = (t == nt - 2);
            const char* a1 = cA + (size_t)(t + 1) * kstep;
            const char* a2 = last ? nA : cA + (size_t)(t + 2) * kstep; const char* b2 = last ? nB : cB + (size_t)(t + 2) * kstep;
            const char* a3 = a2 + kstep; const char* b3 = b2 + kstep;
            if (last && has_next) S.a_ready(nxt);
            if constexpr (SP2) {
            PG8_LDB(B0, 0, 0); PG8_LDB(B1, 0, 1); PG8_SCHED; PG8_LDA(At, 0, 0); PG8_STAGE(PG8_SA(1, 1), a1 + hstep, voffA);
            PG8_WAIT_V(8); PG8_WAIT_L(0); PG8_BAR; PG8_MMA(0, 0, At, B0); PG8_MMA(0, 1, At, B1); PG8_BAR; PG8_SCHED;
            PG8_LDA(At, 0, 1); PG8_STAGE(PG8_SB(0, 0), b2, voffB); PG8_STAGE(PG8_SB(0, 1), b2 + hstep, voffB); PG8_STAGE(PG8_SA(0, 0), a2, voffA);
            PG8_WAIT_V(8); PG8_WAIT_L(0); PG8_BAR; PG8_MMA(1, 0, At, B0); PG8_MMA(1, 1, At, B1); PG8_BAR; PG8_SCHED;
            PG8_LDB(B0, 1, 0); PG8_LDB(B1, 1, 1); PG8_SCHED; PG8_LDA(At, 1, 0); PG8_STAGE(PG8_SA(0, 1), a2 + hstep, voffA);
            PG8_WAIT_V(8); PG8_WAIT_L(0); PG8_BAR; PG8_MMA(0, 0, At, B0); PG8_MMA(0, 1, At, B1); PG8_BAR; PG8_SCHED;
            PG8_LDA(At, 1, 1); PG8_STAGE(PG8_SB(1, 0), b3, voffB); PG8_STAGE(PG8_SB(1, 1), b3 + hstep, voffB); PG8_STAGE(PG8_SA(1, 0), a3, voffA);
            PG8_WAIT_V(8); PG8_WAIT_L(0); PG8_BAR; PG8_MMA(1, 0, At, B0); PG8_MMA(1, 1, At, B1); PG8_BAR; PG8_SCHED;
            } else {
            PG8_LDB(B0, 0, 0); PG8_SCHED; PG8_LDA(At, 0, 0); PG8_STAGE(PG8_SA(1, 1), a1 + hstep, voffA);
            PG8_WAIT_L(8); PG8_BAR; PG8_WAIT_L(0); PG8_MMA(0, 0, At, B0); PG8_BAR; PG8_SCHED;
            PG8_LDB(B1, 0, 1); PG8_STAGE(PG8_SB(0, 0), b2, voffB);
            PG8_BAR; PG8_WAIT_L(0); PG8_MMA(0, 1, At, B1); PG8_BAR;
            PG8_LDA(At, 0, 1); PG8_STAGE(PG8_SA(0, 0), a2, voffA);
            PG8_BAR; PG8_WAIT_L(0); PG8_MMA(1, 0, At, B0); PG8_BAR; PG8_SCHED;
            PG8_STAGE(PG8_SB(0, 1), b2 + hstep, voffB);
            PG8_WAIT_V(6); PG8_BAR; PG8_MMA(1, 1, At, B1); PG8_BAR;
            PG8_LDB(B0, 1, 0); PG8_SCHED; PG8_LDA(At, 1, 0); PG8_STAGE(PG8_SA(0, 1), a2 + hstep, voffA);
            PG8_WAIT_L(8); PG8_BAR; PG8_WAIT_L(0); PG8_MMA(0, 0, At, B0); PG8_BAR; PG8_SCHED;
            PG8_LDB(B1, 1, 1); PG8_STAGE(PG8_SB(1, 0), b3, voffB);
            PG8_BAR; PG8_WAIT_L(0); PG8_MMA(0, 1, At, B1); PG8_BAR;
            PG8_LDA(At, 1, 1); PG8_STAGE(PG8_SA(1, 0), a3, voffA);
            PG8_BAR; PG8_WAIT_L(0); PG8_MMA(1, 0, At, B0); PG8_BAR; PG8_SCHED;
            PG8_STAGE(PG8_SB(1, 1), b3 + hstep, voffB);
            PG8_WAIT_V(6); PG8_BAR; PG8_MMA(1, 1, At, B1); PG8_BAR;
            }
        }
        if constexpr (ALIGN_EPI) { if (wr == 0) PG8_BAR; }
        if constexpr (!Epi::AFTER_DRAIN) { E(acc, cur, wr, wc, fr, fq); S.done(cur); }
        if (!has_next) break;
        if constexpr (Epi::HAS_INIT) E.init(acc, nxt, wr, wc, fr, fq);
        else {
#pragma unroll
        for (int a = 0; a < 2; ++a)
#pragma unroll
            for (int b = 0; b < 2; ++b)
#pragma unroll
                for (int m = 0; m < 4; ++m)
#pragma unroll
                    for (int n = 0; n < 2; ++n) acc[a][b][m][n] = acc_t{};
        }
        cur = nxt; cA = nA; cB = nB; ++ui;
        if constexpr (ALIGN_EPI) { if (wr == 1) PG8_BAR; }
    }
    PG8_WAIT_V(0);
    if constexpr (!ALIGN_EPI) { if (wr == 0) PG8_BAR; }
    PG8_BAR;
    if constexpr (Epi::AFTER_DRAIN) { E.fused(acc, cur, wr, wc, fr, fq, lds, wid, lane); S.done(cur); }
#undef PG8_SA
#undef PG8_SB
#undef PG8_STAGE
#undef PG8_LDA
#undef PG8_LDB
#undef PG8_MMA
#undef PG8_WAIT_V
#undef PG8_WAIT_L
#undef PG8_BAR
#undef PG8_SCHED
}
}

#define EPI_FOR(...) _Pragma("unroll") for (int ai = 0; ai < 2; ++ai) _Pragma("unroll") for (int m = 0; m < 4; ++m) { const int row = u.pm * 256 + ai * 128 + wr * 64 + m * 16 + fr; \
    _Pragma("unroll") for (int bj = 0; bj < 2; ++bj) { const int col = u.pn * 256 + bj * 128 + wc * 32 + 8 * fq; const f32x4 a0 = acc[ai][bj][m][0], a1 = acc[ai][bj][m][1]; __VA_ARGS__ } }
DI u32x4 pack8bf(f32x4 a, f32x4 b) { u32x4 w; w.x = pk2(a.x, a.y); w.y = pk2(a.z, a.w); w.z = pk2(b.x, b.y); w.w = pk2(b.z, b.w); return w; }
constexpr float C2 = 0.125f * 1.4426950408889634f;
struct EpiInProj {
    static constexpr bool PERM = true, AFTER_DRAIN = false, HAS_INIT = false, I8 = true;
    bf16_t* QK; bf16_t* KF; bf16_t* VT; bf16_t* GATES; const float* RS1  ; const float* SW  ; float* KSUM; bool ksum_on;
    DI void operator()(const pg8::i32x4 (&iacc)[2][2][4][2], const pg8::Unit& u, int wr, int wc, int fr, int fq) const {
        f32x4 acc[2][2][4][2];
#pragma unroll
        for (int bj = 0; bj < 2; ++bj) {
            const float* swp = SW + u.pn * 256 + bj * 128 + wc * 32 + 8 * fq;
            const f32x4 c0 = *(const f32x4*)swp * (1.f / 127.f), c1 = *(const f32x4*)(swp + 4) * (1.f / 127.f);
#pragma unroll
            for (int ai = 0; ai < 2; ++ai)
#pragma unroll
                for (int m = 0; m < 4; ++m) { acc[ai][bj][m][0] = __builtin_convertvector(iacc[ai][bj][m][0], f32x4) * c0; acc[ai][bj][m][1] = __builtin_convertvector(iacc[ai][bj][m][1], f32x4) * c1; }
        }
        const int seg = (u.pn * 256) >> 9;
        if (seg == 2 || seg == 5) {
            const int kind = seg == 5;
            EPI_FOR({
                const float rs = RS1[row]; const int bb = row >> 13, key = row & (SEQ - 1), kp = key & 15;
                const int nn = col - (kind ? 2560 : 1024), dim = nn & 63;
                bf16_t* vt = VT + (((size_t)((kind * 2 + bb) * NH + (nn >> 6)) * 256 + (key >> 5)) * 4 + ((dim >> 5) * 2 + ((key >> 4) & 1))) * 512 + (((kp >> 2) & 1) * 32 + (dim & 31)) * 8 + 4 * (kp >> 3) + (kp & 3);
                vt[0] = (bf16_t)f2bf(a0.x * rs); vt[8] = (bf16_t)f2bf(a0.y * rs); vt[16] = (bf16_t)f2bf(a0.z * rs); vt[24] = (bf16_t)f2bf(a0.w * rs);
                vt[32] = (bf16_t)f2bf(a1.x * rs); vt[40] = (bf16_t)f2bf(a1.y * rs); vt[48] = (bf16_t)f2bf(a1.z * rs); vt[56] = (bf16_t)f2bf(a1.w * rs);
            })
        } else if (seg == 1 || seg == 4) {
            const int kind = seg == 4;
            float cs[16];
#pragma unroll
            for (int i = 0; i < 16; ++i) cs[i] = 0.f;
            EPI_FOR({
                const float rs = RS1[row]; const f32x4 v0 = a0 * rs, v1 = a1 * rs;
                const int bb = row >> 13, key = row & (SEQ - 1), nn = col - (kind ? 2048 : 512), dim = nn & 63;
                *(u32x4*)(KF + (((size_t)((kind * 2 + bb) * NH + (nn >> 6)) * 256 + (key >> 5)) * 4 + (dim >> 4)) * 512 + (((dim >> 3) & 1) * 32 + (key & 31)) * 8) = pack8bf(v0, v1);
                if (seg == 1) { cs[bj * 8 + 0] += v0.x; cs[bj * 8 + 1] += v0.y; cs[bj * 8 + 2] += v0.z; cs[bj * 8 + 3] += v0.w; cs[bj * 8 + 4] += v1.x; cs[bj * 8 + 5] += v1.y; cs[bj * 8 + 6] += v1.z; cs[bj * 8 + 7] += v1.w; }
            })
            if (seg == 1 && ksum_on) {
                const bool b3 = (fr & 8) != 0, b2 = (fr & 4) != 0, b1 = (fr & 2) != 0, b0 = (fr & 1) != 0;
                float v8[8], v4[4];
#pragma unroll
                for (int i = 0; i < 8; ++i) v8[i] = (b3 ? cs[8 + i] : cs[i]) + __shfl_xor(b3 ? cs[i] : cs[8 + i], 8);
#pragma unroll
                for (int i = 0; i < 4; ++i) v4[i] = (b2 ? v8[4 + i] : v8[i]) + __shfl_xor(b2 ? v8[i] : v8[4 + i], 4);
                const float v20 = (b1 ? v4[2] : v4[0]) + __shfl_xor(b1 ? v4[0] : v4[2], 2), v21 = (b1 ? v4[3] : v4[1]) + __shfl_xor(b1 ? v4[1] : v4[3], 2);
                const float v1_ = (b0 ? v21 : v20) + __shfl_xor(b0 ? v20 : v21, 1);
                const int c = u.pn * 256 + (fr >> 3) * 128 + wc * 32 + 8 * fq + (fr & 7) - 512, row0 = u.pm * 256;
                atomicAdd(KSUM + ((size_t)(((row0 >> 13) * NH + (c >> 6)) * NBLK + ((row0 & (SEQ - 1)) >> 8))) * HD + (c & 63), v1_);
            }
        } else if (seg < 6) {
            const int cshift = seg == 3 ? -1024 : 0;
            EPI_FOR({ const float rs = RS1[row] * C2; *(u32x4*)(QK + (size_t)row * 1024 + col + cshift) = pack8bf(a0 * rs, a1 * rs); })
        } else {
            EPI_FOR({
                const float rs = RS1[row]; const f32x4 v0 = a0 * rs, v1 = a1 * rs;
                const f32x4 s0 = {sigmoidf_(v0.x), sigmoidf_(v0.y), sigmoidf_(v0.z), sigmoidf_(v0.w)}, s1 = {sigmoidf_(v1.x), sigmoidf_(v1.y), sigmoidf_(v1.z), sigmoidf_(v1.w)};
                *(u32x4*)(GATES + (size_t)row * GATEW + col - QKVW) = pack8bf(s0, s1);
            })
        }
    }
};
struct EpiMix {
    static constexpr bool PERM = true, AFTER_DRAIN = false, HAS_INIT = false, I8 = false;
    const bf16_t* GATES; bf16_t* MIXED;
    DI void mid(f32x4 (&acc)[2][2][4][2], const pg8::Unit& u, int wr, int wc, int fr_in, int fq_in) const {
        int fr = fr_in, fq = fq_in; asm volatile("" : "+v"(fr), "+v"(fq));
#pragma unroll
        for (int ai = 0; ai < 2; ++ai)
#pragma unroll
            for (int m = 0; m < 4; ++m) { const int row = u.pm * 256 + ai * 128 + wr * 64 + m * 16 + fr;
#pragma unroll
                for (int bj = 0; bj < 2; ++bj) { const int col = u.pn * 256 + bj * 128 + wc * 32 + 8 * fq;
                    const u32x4 ga = *(const u32x4*)(GATES + (size_t)row * GATEW + col), gb = *(const u32x4*)(GATES + (size_t)row * GATEW + 1024 + col);
                    const float r0 = bflo(ga.x) * __builtin_amdgcn_rcpf(fmaxf(bflo(gb.x), 1e-30f)), r1 = bfhi(ga.x) * __builtin_amdgcn_rcpf(fmaxf(bfhi(gb.x), 1e-30f));
                    const float r2 = bflo(ga.y) * __builtin_amdgcn_rcpf(fmaxf(bflo(gb.y), 1e-30f)), r3 = bfhi(ga.y) * __builtin_amdgcn_rcpf(fmaxf(bfhi(gb.y), 1e-30f));
                    const float r4 = bflo(ga.z) * __builtin_amdgcn_rcpf(fmaxf(bflo(gb.z), 1e-30f)), r5 = bfhi(ga.z) * __builtin_amdgcn_rcpf(fmaxf(bfhi(gb.z), 1e-30f));
                    const float r6 = bflo(ga.w) * __builtin_amdgcn_rcpf(fmaxf(bflo(gb.w), 1e-30f)), r7 = bfhi(ga.w) * __builtin_amdgcn_rcpf(fmaxf(bfhi(gb.w), 1e-30f));
                    acc[ai][bj][m][0] = acc[ai][bj][m][0] * (f32x4){r0, r1, r2, r3}; acc[ai][bj][m][1] = acc[ai][bj][m][1] * (f32x4){r4, r5, r6, r7}; }
                __builtin_amdgcn_sched_barrier(0); }
    }
    DI void operator()(const f32x4 (&acc)[2][2][4][2], const pg8::Unit& u, int wr, int wc, int fr, int fq) const {
        EPI_FOR({
            const u32x4 gb = *(const u32x4*)(GATES + (size_t)row * GATEW + 1024 + col);
            const f32x4 s0 = {fmaxf(bflo(gb.x), 1e-30f), fmaxf(bfhi(gb.x), 1e-30f), fmaxf(bflo(gb.y), 1e-30f), fmaxf(bfhi(gb.y), 1e-30f)};
            const f32x4 s1 = {fmaxf(bflo(gb.z), 1e-30f), fmaxf(bfhi(gb.z), 1e-30f), fmaxf(bflo(gb.w), 1e-30f), fmaxf(bfhi(gb.w), 1e-30f)};
            *(u32x4*)(MIXED + (size_t)row * DM + col) = pack8bf(a0 * s0, a1 * s1);
        })
    }
};
struct EpiResid {
    static constexpr bool PERM = true, AFTER_DRAIN = false, HAS_INIT = true, I8 = false;
    const float* X; bf16_t* HB;
    DI void init(f32x4 (&acc)[2][2][4][2], const pg8::Unit& u, int wr, int wc, int fr, int fq) const {
#pragma unroll
        for (int ai = 0; ai < 2; ++ai)
#pragma unroll
            for (int m = 0; m < 4; ++m) { const int row = u.pm * 256 + ai * 128 + wr * 64 + m * 16 + fr;
#pragma unroll
                for (int bj = 0; bj < 2; ++bj) { const float* xp = X + (size_t)row * DM + u.pn * 256 + bj * 128 + wc * 32 + 8 * fq; acc[ai][bj][m][0] = *(const f32x4*)xp; acc[ai][bj][m][1] = *(const f32x4*)(xp + 4); } }
    }
    DI void operator()(const f32x4 (&acc)[2][2][4][2], const pg8::Unit& u, int wr, int wc, int fr, int fq) const {
        EPI_FOR({ *(u32x4*)(HB + (size_t)row * DM + col) = pack8bf(a0, a1); })
    }
};
struct EpiPeerQ {
    static constexpr bool PERM = true, AFTER_DRAIN = false, HAS_INIT = false, I8 = false;
    bf16_t* Q2;
    DI void operator()(const f32x4 (&acc)[2][2][4][2], const pg8::Unit& u, int wr, int wc, int fr, int fq) const {
        EPI_FOR({ *(u32x4*)(Q2 + (size_t)row * PQW + col) = pack8bf(a0, a1); })
    }
};


DI void h_rows4(const bf16_t* H, float* RS2, float* SH, signed char* H8, int row0, int stride, int lane) {
    u32x4 a[4][2];
#pragma unroll
    for (int k = 0; k < 4; ++k)
#pragma unroll
        for (int j = 0; j < 2; ++j) a[k][j] = *(const u32x4*)(H + (size_t)(row0 + k * stride) * DM + lane * 16 + 8 * j);
#pragma unroll
    for (int k = 0; k < 4; ++k) {
        const int row = row0 + k * stride;
        float v[16];
#pragma unroll
        for (int j = 0; j < 2; ++j) { v[8 * j] = bflo(a[k][j].x); v[8 * j + 1] = bfhi(a[k][j].x); v[8 * j + 2] = bflo(a[k][j].y); v[8 * j + 3] = bfhi(a[k][j].y);
            v[8 * j + 4] = bflo(a[k][j].z); v[8 * j + 5] = bfhi(a[k][j].z); v[8 * j + 6] = bflo(a[k][j].w); v[8 * j + 7] = bfhi(a[k][j].w); }
        float ss = 0.f, am = 0.f;
#pragma unroll
        for (int j = 0; j < 16; ++j) { ss += v[j] * v[j]; am = fmaxf(am, fabsf(v[j])); }
        ss = wave_sum(ss);
#pragma unroll
        for (int o = 32; o >= 1; o >>= 1) am = fmaxf(am, __shfl_xor(am, o));
        const float sc = am > 0.f ? am * (1.f / 127.f) : 1.f, isc = 1.f / sc;
        unsigned w[4];
#pragma unroll
        for (int j = 0; j < 4; ++j) w[j] = q8x4(v[4 * j], v[4 * j + 1], v[4 * j + 2], v[4 * j + 3], isc);
        *(u32x4*)(H8 + (size_t)row * DM + lane * 16) = (u32x4){w[0], w[1], w[2], w[3]};
        if (lane == 0) { RS2[row] = rsqrtf(ss * (1.f / DM) + RMS_EPS); SH[row] = sc; }
    }
}

template <int NR>
DI void quant_rows(const float* pu, const float* pv, const float* g2, unsigned char* U8, unsigned char* V8, float* SU, float* SV, int row0, int stride, int lane) {
    f32x4 a[NR][4];
#pragma unroll
    for (int k = 0; k < NR; ++k) { const int row = row0 + k * stride, isv = row >= NEXP, e = row - (isv ? NEXP : 0); const float* src = (isv ? pv : pu) + (size_t)e * DM + lane * 16;
#pragma unroll
        for (int j = 0; j < 4; ++j) a[k][j] = *(const f32x4*)(src + 4 * j); }
    f32x4 gq[4];
#pragma unroll
    for (int j = 0; j < 4; ++j) gq[j] = *(const f32x4*)(g2 + lane * 16 + 4 * j);
#pragma unroll
    for (int k = 0; k < NR; ++k) {
        const int row = row0 + k * stride, isv = row >= NEXP, e = row - (isv ? NEXP : 0);
        float v[16];
#pragma unroll
        for (int j = 0; j < 4; ++j) { const f32x4 x = isv ? a[k][j] : a[k][j] * gq[j]; v[4 * j] = x.x; v[4 * j + 1] = x.y; v[4 * j + 2] = x.z; v[4 * j + 3] = x.w; }
        float am = 0.f;
#pragma unroll
        for (int j = 0; j < 16; ++j) am = fmaxf(am, fabsf(v[j]));
#pragma unroll
        for (int o = 32; o >= 1; o >>= 1) am = fmaxf(am, __shfl_xor(am, o));
        const float sc = am > 0.f ? am * (1.f / 127.f) : 1.f, isc = 1.f / sc;
        unsigned w[4];
#pragma unroll
        for (int j = 0; j < 4; ++j) w[j] = q8x4(v[4 * j], v[4 * j + 1], v[4 * j + 2], v[4 * j + 3], isc);
        unsigned char* dst = (isv ? V8 : U8) + ((size_t)((lane >> 3) * NEXP + e)) * 128 + (lane & 7) * 16;
        *(u32x4*)dst = (u32x4){w[0], w[1], w[2], w[3]};
        if (lane == 0) (isv ? SV : SU)[e] = sc;
    }
}

typedef float f32x16 __attribute__((ext_vector_type(16)));
#define MFMA32(a, b, c) __builtin_amdgcn_mfma_f32_32x32x16_bf16((a), (b), (c), 0, 0, 0)
constexpr float FLT_MIN_ = 1.17549435e-38f;

struct KV { bf16x8 k[4], v[4]; };
DI void load_kv(KV& f, const bf16_t* kp, const bf16_t* vp) {
#pragma unroll
    for (int i = 0; i < 4; ++i) { f.k[i] = *(const bf16x8*)(kp + 512 * i); f.v[i] = *(const bf16x8*)(vp + 512 * i); }
}
DI void load_kv_async(KV& f, const bf16_t* kp, const bf16_t* vp) {
    asm volatile("global_load_dwordx4 %0, %4, off\n\tglobal_load_dwordx4 %1, %4, off offset:1024\n\tglobal_load_dwordx4 %2, %4, off offset:2048\n\tglobal_load_dwordx4 %3, %4, off offset:3072"
                 : "=&v"(f.k[0]), "=&v"(f.k[1]), "=&v"(f.k[2]), "=&v"(f.k[3]) : "v"(kp) : "memory");
    asm volatile("global_load_dwordx4 %0, %4, off\n\tglobal_load_dwordx4 %1, %4, off offset:1024\n\tglobal_load_dwordx4 %2, %4, off offset:2048\n\tglobal_load_dwordx4 %3, %4, off offset:3072"
                 : "=&v"(f.v[0]), "=&v"(f.v[1]), "=&v"(f.v[2]), "=&v"(f.v[3]) : "v"(vp) : "memory");
}
#define KV_WAIT_K(f, N) asm volatile("s_waitcnt vmcnt(" #N ")" : "+v"(f.k[0]), "+v"(f.k[1]), "+v"(f.k[2]), "+v"(f.k[3]) :: "memory")
#define KV_WAIT_V(f, N) asm volatile("s_waitcnt vmcnt(" #N ")" : "+v"(f.v[0]), "+v"(f.v[1]), "+v"(f.v[2]), "+v"(f.v[3]) :: "memory")
DI bf16x8 pack8(const f32x16& p, int s) {
    u32x4 w;
    if (s == 0) { w.x = cvtpk(p[0], p[1]); w.y = cvtpk(p[2], p[3]); w.z = cvtpk(p[4], p[5]); w.w = cvtpk(p[6], p[7]); }
    else { w.x = cvtpk(p[8], p[9]); w.y = cvtpk(p[10], p[11]); w.z = cvtpk(p[12], p[13]); w.w = cvtpk(p[14], p[15]); }
    return __builtin_bit_cast(bf16x8, w);
}
struct SmState { float m, l; f32x16 o0, o1; };
typedef float f32x2 __attribute__((ext_vector_type(2)));
DI float sum16(const f32x16& p) {
    const f32x2 s0 = (f32x2){p[0], p[1]} + (f32x2){p[2], p[3]}, s1 = (f32x2){p[4], p[5]} + (f32x2){p[6], p[7]};
    const f32x2 s2 = (f32x2){p[8], p[9]} + (f32x2){p[10], p[11]}, s3 = (f32x2){p[12], p[13]} + (f32x2){p[14], p[15]};
    const f32x2 t0 = s0 + s1, t1 = s2 + s3, u = t0 + t1;
    return u.x + u.y;
}
constexpr float LAZY_THR = 1.0995116e12f;
template <int WK = -1, int WV = -1>
DI void moba_tile_first(SmState& st, KV& f, const bf16x8 (&qf)[4], float bias0, float slopeL, int maskrow, int hh) {
    f32x16 acc;
#pragma unroll
    for (int r = 0; r < 16; ++r) acc[r] = bias0 + slopeL * (float)((r & 3) + 8 * (r >> 2));
    if constexpr (WK == 12) KV_WAIT_K(f, 12); else if constexpr (WK == 4) KV_WAIT_K(f, 4);
#pragma unroll
    for (int ks = 0; ks < 4; ++ks) acc = MFMA32(f.k[ks], qf[ks], acc);
    if (maskrow < 32) {
#pragma unroll
        for (int r = 0; r < 16; ++r) if ((r & 3) + 8 * (r >> 2) + 4 * hh > maskrow) acc[r] = -1e30f;
    }
    float tm = acc[0];
#pragma unroll
    for (int r = 1; r < 16; ++r) tm = fmaxf(tm, acc[r]);
    tm = fmaxf(tm, __shfl_xor(tm, 32));
    f32x16 pw;
#pragma unroll
    for (int r = 0; r < 16; ++r) pw[r] = __builtin_amdgcn_exp2f(acc[r] - tm);
    st.m = tm; st.l = sum16(pw);
    const bf16x8 p0 = pack8(pw, 0), p1 = pack8(pw, 1);
    if constexpr (WV == 8) KV_WAIT_V(f, 8); else if constexpr (WV == 0) KV_WAIT_V(f, 0);
    f32x16 z;
#pragma unroll
    for (int r = 0; r < 16; ++r) z[r] = 0.f;
    st.o0 = MFMA32(f.v[0], p0, z); st.o0 = MFMA32(f.v[1], p1, st.o0);
    st.o1 = MFMA32(f.v[2], p0, z); st.o1 = MFMA32(f.v[3], p1, st.o1);
}
template <int WK = -1, int WV = -1>
DI void moba_tile_lazy(SmState& st, KV& f, const bf16x8 (&qf)[4], float bias0, float slopeL, int hh) {
    f32x16 acc;
    const float b0 = bias0 - st.m;
#pragma unroll
    for (int r = 0; r < 16; ++r) acc[r] = b0 + slopeL * (float)((r & 3) + 8 * (r >> 2));
    if constexpr (WK == 12) KV_WAIT_K(f, 12); else if constexpr (WK == 4) KV_WAIT_K(f, 4);
#pragma unroll
    for (int ks = 0; ks < 4; ++ks) acc = MFMA32(f.k[ks], qf[ks], acc);
    f32x16 pw;
#pragma unroll
    for (int r = 0; r < 16; ++r) pw[r] = __builtin_amdgcn_exp2f(acc[r]);
    float ps = sum16(pw);
    if (__builtin_expect(__any(!(ps <= LAZY_THR)), 0)) {
        const int nl = !(ps <= LAZY_THR);
        const bool need = (nl | __shfl_xor(nl, 32)) != 0;
        float tm = acc[0];
#pragma unroll
        for (int r = 1; r < 16; ++r) tm = fmaxf(tm, acc[r]);
        tm = fmaxf(tm, __shfl_xor(tm, 32));
        const float d = need ? tm : 0.f, al = __builtin_amdgcn_exp2f(-d);
        st.m += d; st.l *= al; st.o0 = st.o0 * al; st.o1 = st.o1 * al;
#pragma unroll
        for (int r = 0; r < 16; ++r) pw[r] = __builtin_amdgcn_exp2f(acc[r] - d);
        ps = sum16(pw);
    }
    st.l += ps;
    const bf16x8 p0 = pack8(pw, 0), p1 = pack8(pw, 1);
    if constexpr (WV == 8) KV_WAIT_V(f, 8); else if constexpr (WV == 0) KV_WAIT_V(f, 0);
    st.o0 = MFMA32(f.v[0], p0, st.o0); st.o0 = MFMA32(f.v[1], p1, st.o0);
    st.o1 = MFMA32(f.v[2], p0, st.o1); st.o1 = MFMA32(f.v[3], p1, st.o1);
}
DI void moba_pass_own(SmState& st, const bf16x8 (&qf)[4], const bf16_t* kt0, const bf16_t* vt0, int w, int maskrow, float bb, float slopeL, int hh) {
    KV fa, fb;
    const float bs = slopeL * 32.f;
    load_kv(fa, kt0 + (size_t)w * 2048, vt0 + (size_t)w * 2048);
    if (w >= 1) load_kv(fb, kt0 + (size_t)(w - 1) * 2048, vt0 + (size_t)(w - 1) * 2048);
    moba_tile_first(st, fa, qf, bb + (float)w * bs, slopeL, maskrow, hh);
#pragma unroll 1
    for (int kt = w - 1; kt >= 0; kt -= 2) {
        if (kt >= 1) load_kv(fa, kt0 + (size_t)(kt - 1) * 2048, vt0 + (size_t)(kt - 1) * 2048);
        moba_tile_lazy(st, fb, qf, bb + (float)kt * bs, slopeL, hh);
        if (kt >= 1) {
            if (kt >= 2) load_kv(fb, kt0 + (size_t)(kt - 2) * 2048, vt0 + (size_t)(kt - 2) * 2048);
            moba_tile_lazy(st, fa, qf, bb + (float)(kt - 1) * bs, slopeL, hh);
        }
    }
}
template <bool MASKED>
DI void sb_tile(f32x16& o0, f32x16& o1, float& carry, const KV& f, const bf16x8 (&qf)[4], int maskrow, int hh) {
    f32x16 acc;
#pragma unroll
    for (int r = 0; r < 16; ++r) acc[r] = 0.f;
#pragma unroll
    for (int ks = 0; ks < 4; ++ks) acc = MFMA32(f.k[ks], qf[ks], acc);
    float bt[16], fc[16];
#pragma unroll
    for (int r = 0; r < 16; ++r) {
        const float z = acc[r];
        const float e = __builtin_amdgcn_exp2f(-fabsf(z)), rr = __builtin_amdgcn_rcpf(1.f + e), er = e * rr;
        const bool pos = z >= 0.f, msk = MASKED && ((r & 3) + 8 * (r >> 2) + 4 * hh) >= maskrow;
        bt[r] = msk ? 0.f : (pos ? rr : er);
        fc[r] = msk ? 1.f : (pos ? er : rr);
    }
    float G[4], Gp[4], wf[16];
#pragma unroll
    for (int g = 0; g < 4; ++g) {
        const float s3 = fc[4 * g + 3], s2 = s3 * fc[4 * g + 2], s1 = s2 * fc[4 * g + 1];
        G[g] = s1 * fc[4 * g];
        wf[4 * g + 3] = bt[4 * g + 3]; wf[4 * g + 2] = bt[4 * g + 2] * s3; wf[4 * g + 1] = bt[4 * g + 1] * s2; wf[4 * g] = bt[4 * g] * s1;
    }
#pragma unroll
    for (int g = 0; g < 4; ++g) Gp[g] = __shfl_xor(G[g], 32);
    const float T0 = G[0] * Gp[0], T1 = G[1] * Gp[1], T2 = G[2] * Gp[2], T3 = G[3] * Gp[3];
    const float RR2 = T3, RR1 = T3 * T2, RR0 = RR1 * T1, total = RR0 * T0;
    float base[4];
    base[3] = carry * (hh == 0 ? Gp[3] : 1.f);
    base[2] = carry * RR2 * (hh == 0 ? Gp[2] : 1.f);
    base[1] = carry * RR1 * (hh == 0 ? Gp[1] : 1.f);
    base[0] = carry * RR0 * (hh == 0 ? Gp[0] : 1.f);
    f32x16 pw;
#pragma unroll
    for (int r = 0; r < 16; ++r) pw[r] = wf[r] * base[r >> 2];
    carry *= total;
    const bf16x8 p0 = pack8(pw, 0), p1 = pack8(pw, 1);
    o0 = MFMA32(f.v[0], p0, o0); o0 = MFMA32(f.v[1], p1, o0);
    o1 = MFMA32(f.v[2], p0, o1); o1 = MFMA32(f.v[3], p1, o1);
}
DI void store_o(bf16_t* orow  , const f32x16& o0, const f32x16& o1, float sc) {
#pragma unroll
    for (int g = 0; g < 4; ++g) {
        u32x2 a; a.x = cvtpk(o0[4 * g] * sc, o0[4 * g + 1] * sc); a.y = cvtpk(o0[4 * g + 2] * sc, o0[4 * g + 3] * sc); *(u32x2*)(orow + 8 * g) = a;
        u32x2 c; c.x = cvtpk(o1[4 * g] * sc, o1[4 * g + 1] * sc); c.y = cvtpk(o1[4 * g + 2] * sc, o1[4 * g + 3] * sc); *(u32x2*)(orow + 32 + 8 * g) = c;
    }
}
constexpr int ML_OPART = 0;
constexpr int ML_ML = 4 * 256 * 68 * 2;
constexpr int ML_LISTS = ML_ML + 4 * 256 * 2 * 4;
constexpr int ML_SELS = ML_LISTS + 32 * 256;
constexpr int ML_CNT = ML_SELS + 1024;
constexpr int ML_UST = ML_CNT + 128;
constexpr int ML_QCTR = ML_UST + 144;
constexpr int ML_ITEM = ML_QCTR + 16;
constexpr int ML_UJ = ML_ITEM + 16;
static_assert(ML_UJ + 64 <= LDS_BYTES - 16, "MoBA LDS map");
DI void top3_insert(float s, int b, float& v0, float& v1, float& v2, int& i0, int& i1, int& i2) {
    const bool g0 = s > v0, g1 = s > v1, g2 = s > v2;
    v2 = g1 ? v1 : (g2 ? s : v2); i2 = g1 ? i1 : (g2 ? b : i2);
    v1 = g0 ? v0 : (g1 ? s : v1); i1 = g0 ? i0 : (g1 ? b : i1);
    v0 = g0 ? s : v0; i0 = g0 ? b : i0;
}
DI int p3_order(int i) {
    constexpr unsigned long long W0 = 0x1918171612151413ull, W1 = 0x1d1c1e1b0b1f1a11ull, W2 = 0x08070d0e0f0c0a10ull, W3 = 0x0001020403050906ull;
    const unsigned long long w = (i >> 3) == 0 ? W0 : ((i >> 3) == 1 ? W1 : ((i >> 3) == 2 ? W2 : W3));
    return (int)((w >> (8 * (i & 7))) & 255ull);
}
DI void sb_group(const bf16_t* QK, const bf16_t* KF, const bf16_t* VT, bf16_t* OB, int b, int head, int qt) {
    const int tid = threadIdx.x, wave = tid >> 6; int lane = tid & 63;
    asm volatile("" : "+v"(lane));
    const int r = lane & 31, hh = lane >> 5;
    const bf16_t* kp = KF + (size_t)((1 * 2 + b) * NH + head) * 256 * 2048 + lane * 8;
    const bf16_t* vp = VT + (size_t)((1 * 2 + b) * NH + head) * 256 * 2048 + lane * 8;
    const int kt0 = 8 * qt + wave, t = 32 * kt0 + r;
    const bf16_t* qp = QK + (size_t)(b * SEQ + t) * 1024 + 512 + head * HD + 8 * hh;
    bf16x8 qf[4];
#pragma unroll
    for (int ks = 0; ks < 4; ++ks) qf[ks] = *(const bf16x8*)(qp + 16 * ks);
    f32x16 o0, o1;
#pragma unroll
    for (int x = 0; x < 16; ++x) { o0[x] = 0.f; o1[x] = 0.f; }
    float carry = 1.f;
    KV fa, fb;
    int kt = kt0;
    load_kv(fa, kp + (size_t)kt * 2048, vp + (size_t)kt * 2048);
    if (kt >= 1) load_kv(fb, kp + (size_t)(kt - 1) * 2048, vp + (size_t)(kt - 1) * 2048);
    asm volatile("" ::: "memory");
    sb_tile<true>(o0, o1, carry, fa, qf, r, hh);
    if (!(kt < 1 || __all(carry < FLT_MIN_))) {
        for (;;) {
            if (kt >= 2) load_kv(fa, kp + (size_t)(kt - 2) * 2048, vp + (size_t)(kt - 2) * 2048);
            asm volatile("" ::: "memory");
            sb_tile<false>(o0, o1, carry, fb, qf, 32, hh);
            if (kt < 2 || __all(carry < FLT_MIN_)) break;
            if (kt >= 3) load_kv(fb, kp + (size_t)(kt - 3) * 2048, vp + (size_t)(kt - 3) * 2048);
            asm volatile("" ::: "memory");
            sb_tile<false>(o0, o1, carry, fa, qf, 32, hh);
            if (kt < 3 || __all(carry < FLT_MIN_)) break;
            kt -= 2;
        }
    }
    store_o(OB + (size_t)(b * SEQ + t) * (2 * WA) + WA + head * HD + 4 * hh, o0, o1, 1.f);
}
DI void moba_group(unsigned char* lds, const bf16_t* QK, const bf16_t* KF, const bf16_t* VT, const float* KSUM, bf16_t* OA, int b, int head, int og, bool with_sb, unsigned* nextctr, int qoff) {
    const int tid = threadIdx.x, wave = tid >> 6; int lane = tid & 63;
    asm volatile("" : "+v"(lane));
    const int r = lane & 31, hh = lane >> 5;
    bf16_t* OPART = (bf16_t*)(lds + ML_OPART); float* MLS = (float*)(lds + ML_ML); unsigned char* LISTS = lds + ML_LISTS; unsigned char* SELS = lds + ML_SELS;
    int* CNT = (int*)(lds + ML_CNT); int* UST = (int*)(lds + ML_UST);
    const float slopeL = 1.4426950408889634f * exp2f(-(float)(head + 1));
    const bf16_t* kp = KF + (size_t)((0 * 2 + b) * NH + head) * 256 * 2048 + lane * 8;
    const bf16_t* vp = VT + (size_t)((0 * 2 + b) * NH + head) * 256 * 2048 + lane * 8;
    const bf16_t* qbase = QK + (size_t)(b * SEQ) * 1024 + head * HD + 8 * hh;
    __syncthreads();
    unsigned nk = 0;
    if (tid == 0) nk = atomicAdd(nextctr, 1u);
    if (tid < 32) CNT[tid] = 0;
    __syncthreads();
    {
        const int c = 32 * wave + r;
        const bf16_t* qp = qbase + (size_t)(256 * og + c) * 1024;
        bf16x8 qf[4];
#pragma unroll
        for (int ks = 0; ks < 4; ++ks) qf[ks] = *(const bf16x8*)(qp + 16 * ks);
        f32x16 acc;
#pragma unroll
        for (int i = 0; i < 16; ++i) acc[i] = 0.f;
        const float* km = KSUM + ((size_t)(b * NH + head) * NBLK + r) * HD + 8 * hh;
#pragma unroll
        for (int ks = 0; ks < 4; ++ks) {
            const f32x4 s0 = *(const f32x4*)(km + 16 * ks) * (1.f / MBLK), s1 = *(const f32x4*)(km + 16 * ks + 4) * (1.f / MBLK);
            const float mv[8] = {s0.x, s0.y, s0.z, s0.w, s1.x, s1.y, s1.z, s1.w};
            unsigned hb[8], lb[8];
#pragma unroll
            for (int e = 0; e < 8; ++e) { hb[e] = f2bf(mv[e]); lb[e] = f2bf(mv[e] - bf2f(hb[e])); }
            const u32x4 hw = {hb[0] | (hb[1] << 16), hb[2] | (hb[3] << 16), hb[4] | (hb[5] << 16), hb[6] | (hb[7] << 16)};
            const u32x4 lw = {lb[0] | (lb[1] << 16), lb[2] | (lb[3] << 16), lb[4] | (lb[5] << 16), lb[6] | (lb[7] << 16)};
            acc = MFMA32(__builtin_bit_cast(bf16x8, hw), qf[ks], acc); acc = MFMA32(__builtin_bit_cast(bf16x8, lw), qf[ks], acc);
        }
        float v0 = -INFINITY, v1 = -INFINITY, v2 = -INFINITY; int i0 = -1, i1 = -1, i2 = -1;
#pragma unroll
        for (int i = 0; i < 16; ++i) { const int blk = (i & 3) + 8 * (i >> 2) + 4 * hh; const float sv = blk < og ? acc[i] : -INFINITY; top3_insert(sv, blk, v0, v1, v2, i0, i1, i2); }
        const float pv0 = __shfl_xor(v0, 32), pv1 = __shfl_xor(v1, 32), pv2 = __shfl_xor(v2, 32);
        const int pi0 = __shfl_xor(i0, 32), pi1 = __shfl_xor(i1, 32), pi2 = __shfl_xor(i2, 32);
        top3_insert(pv0, pi0, v0, v1, v2, i0, i1, i2); top3_insert(pv1, pi1, v0, v1, v2, i0, i1, i2); top3_insert(pv2, pi2, v0, v1, v2, i0, i1, i2);
        if (hh == 0) {
            SELS[c * 4 + 0] = (unsigned char)(i0 < 0 ? 255 : i0); SELS[c * 4 + 1] = (unsigned char)(i1 < 0 ? 255 : i1); SELS[c * 4 + 2] = (unsigned char)(i2 < 0 ? 255 : i2);
            if (i0 >= 0) { const int ps = atomicAdd(&CNT[i0], 1); LISTS[i0 * 256 + ps] = (unsigned char)c; }
            if (i1 >= 0) { const int ps = atomicAdd(&CNT[i1], 1); LISTS[i1 * 256 + ps] = (unsigned char)c; }
            if (i2 >= 0) { const int ps = atomicAdd(&CNT[i2], 1); LISTS[i2 * 256 + ps] = (unsigned char)c; }
        }
    }
    __syncthreads();
    if (wave == 0) {
        const int jx = lane & 31, n = (CNT[jx] + 31) >> 5;
        int inc = n;
#pragma unroll
        for (int o = 1; o < 32; o <<= 1) { const int v = __shfl_up(inc, o, 32); if (jx >= o) inc += v; }
        const int st0 = inc - n;
        if (lane < 32) {
            UST[jx] = st0;
            unsigned char* UJ = lds + ML_UJ;
            for (int q = 0; q < n; ++q) UJ[st0 + q] = (unsigned char)jx;
            if (jx == 31) UST[32] = inc;
        }
        if (lane == 0) { *(volatile int*)(lds + ML_QCTR) = 0; *(volatile int*)(lds + ML_ITEM) = (int)nk + qoff; }
    }
    __syncthreads();
    {
        const int Usel = UST[32], Utot = Usel + 8;
        int* qctr = (int*)(lds + ML_QCTR);
        int u = 0;
        if (lane == 0) u = atomicAdd(qctr, 1);
        u = __builtin_amdgcn_readfirstlane(u);
        const int sb_after = __builtin_amdgcn_readfirstlane(wave) >> 1;
        bool sb_done = !with_sb; int nun = 0;
        for (;;) {
            const bool have = u < Utot;
            if (!sb_done && (nun == sb_after || !have)) { sb_group(QK, KF, VT, OA, b, head, og); sb_done = true; }
            if (!have) break;
            ++nun;
            int un = 0;
            if (lane == 0) un = atomicAdd(qctr, 1);
            int j, slot, qi; bool valid;
            SmState st;
            if (u < Usel) {
                j = __builtin_amdgcn_readfirstlane((int)(lds + ML_UJ)[u]);
                const bf16_t* kt0 = kp + (size_t)(8 * j) * 2048; const bf16_t* vt0 = vp + (size_t)(8 * j) * 2048;
                KV fa, fb;
                load_kv_async(fa, kt0 + 7 * 2048, vt0 + 7 * 2048); load_kv_async(fb, kt0 + 6 * 2048, vt0 + 6 * 2048);
                const int i = u - UST[j], idx = 32 * i + r;
                valid = idx < CNT[j];
                qi = LISTS[j * 256 + (valid ? idx : 32 * i)];
                slot = (SELS[qi * 4] == j) ? 0 : ((SELS[qi * 4 + 1] == j) ? 1 : 2);
                const int t = 256 * og + qi;
                const bf16_t* qp = qbase + (size_t)t * 1024;
                bf16x8 qf[4];
#pragma unroll
                for (int ks = 0; ks < 4; ++ks) qf[ks] = *(const bf16x8*)(qp + 16 * ks);
                const float bb = slopeL * (float)(256 * j + 4 * hh - t), bs = slopeL * 32.f;
                moba_tile_first<12, 8>(st, fa, qf, bb + 7.f * bs, slopeL, 64, hh);   load_kv_async(fa, kt0 + 5 * 2048, vt0 + 5 * 2048);
                moba_tile_lazy<12, 8>(st, fb, qf, bb + 6.f * bs, slopeL, hh);        load_kv_async(fb, kt0 + 4 * 2048, vt0 + 4 * 2048);
                moba_tile_lazy<12, 8>(st, fa, qf, bb + 5.f * bs, slopeL, hh);        load_kv_async(fa, kt0 + 3 * 2048, vt0 + 3 * 2048);
                moba_tile_lazy<12, 8>(st, fb, qf, bb + 4.f * bs, slopeL, hh);        load_kv_async(fb, kt0 + 2 * 2048, vt0 + 2 * 2048);
                moba_tile_lazy<12, 8>(st, fa, qf, bb + 3.f * bs, slopeL, hh);        load_kv_async(fa, kt0 + 1 * 2048, vt0 + 1 * 2048);
                moba_tile_lazy<12, 8>(st, fb, qf, bb + 2.f * bs, slopeL, hh);        load_kv_async(fb, kt0, vt0);
                moba_tile_lazy<12, 8>(st, fa, qf, bb + bs, slopeL, hh);
                moba_tile_lazy<4, 0>(st, fb, qf, bb, slopeL, hh);
            } else {
                const int w = 7 - (u - Usel);
                j = og; qi = 32 * w + r; valid = true; slot = 3;
                const int t = 256 * og + qi;
                const bf16_t* qp = qbase + (size_t)t * 1024;
                bf16x8 qf[4];
#pragma unroll
                for (int ks = 0; ks < 4; ++ks) qf[ks] = *(const bf16x8*)(qp + 16 * ks);
                moba_pass_own(st, qf, kp + (size_t)(8 * og) * 2048, vp + (size_t)(8 * og) * 2048, w, r, slopeL * (float)(256 * og + 4 * hh - t), slopeL, hh);
            }
            const float lt = st.l + __shfl_xor(st.l, 32), inv = 1.f / lt;
            if (valid) {
                bf16_t* op = OPART + (size_t)(slot * 256 + qi) * 68 + 4 * hh;
#pragma unroll
                for (int g = 0; g < 4; ++g) {
                    u32x2 a; a.x = cvtpk(st.o0[4 * g] * inv, st.o0[4 * g + 1] * inv); a.y = cvtpk(st.o0[4 * g + 2] * inv, st.o0[4 * g + 3] * inv); *(u32x2*)(op + 8 * g) = a;
                    u32x2 c; c.x = cvtpk(st.o1[4 * g] * inv, st.o1[4 * g + 1] * inv); c.y = cvtpk(st.o1[4 * g + 2] * inv, st.o1[4 * g + 3] * inv); *(u32x2*)(op + 32 + 8 * g) = c;
                }
                if (hh == 0) { MLS[(slot * 256 + qi) * 2] = st.m; MLS[(slot * 256 + qi) * 2 + 1] = lt; }
            }
            u = __builtin_amdgcn_readfirstlane(un);
        }
    }
    __syncthreads();
    {
        const int c = 32 * wave + r, t = 256 * og + c;
        float M = -1e30f, ms[4], ls[4];
#pragma unroll
        for (int sl = 0; sl < 4; ++sl) {
            const bool v = sl == 3 || SELS[c * 4 + sl] != 255;
            ms[sl] = v ? MLS[(sl * 256 + c) * 2] : -1e30f; ls[sl] = v ? MLS[(sl * 256 + c) * 2 + 1] : 0.f;
            M = fmaxf(M, ms[sl]);
        }
        float L = 0.f; f32x16 o0, o1;
#pragma unroll
        for (int x = 0; x < 16; ++x) { o0[x] = 0.f; o1[x] = 0.f; }
#pragma unroll
        for (int sl = 0; sl < 4; ++sl) {
            const float w = ls[sl] * __builtin_amdgcn_exp2f(ms[sl] - M);
            L += w;
            const bf16_t* op = OPART + (size_t)(sl * 256 + c) * 68 + 4 * hh;
            if (ls[sl] > 0.f) {
#pragma unroll
                for (int g = 0; g < 4; ++g) {
                    const u32x2 a = *(const u32x2*)(op + 8 * g), cc = *(const u32x2*)(op + 32 + 8 * g);
                    o0[4 * g] += w * bflo(a.x); o0[4 * g + 1] += w * bfhi(a.x); o0[4 * g + 2] += w * bflo(a.y); o0[4 * g + 3] += w * bfhi(a.y);
                    o1[4 * g] += w * bflo(cc.x); o1[4 * g + 1] += w * bfhi(cc.x); o1[4 * g + 2] += w * bflo(cc.y); o1[4 * g + 3] += w * bfhi(cc.y);
                }
            }
        }
        store_o(OA + (size_t)(b * SEQ + t) * (2 * WA) + head * HD + 4 * hh, o0, o1, 1.f / L);
    }
}


#define CE(a, b) do { const unsigned lo_ = min(a, b), hi_ = max(a, b); a = lo_; b = hi_; } while (0)
DI void sort16_asc(unsigned (&k)[16]) {
    CE(k[0], k[1]); CE(k[2], k[3]); CE(k[0], k[2]); CE(k[1], k[3]); CE(k[1], k[2]); CE(k[4], k[5]); CE(k[6], k[7]); CE(k[4], k[6]); CE(k[5], k[7]); CE(k[5], k[6]);
    CE(k[0], k[4]); CE(k[2], k[6]); CE(k[2], k[4]); CE(k[1], k[5]); CE(k[3], k[7]); CE(k[3], k[5]); CE(k[1], k[2]); CE(k[3], k[4]); CE(k[5], k[6]); CE(k[8], k[9]);
    CE(k[10], k[11]); CE(k[8], k[10]); CE(k[9], k[11]); CE(k[9], k[10]); CE(k[12], k[13]); CE(k[14], k[15]); CE(k[12], k[14]); CE(k[13], k[15]); CE(k[13], k[14]);
    CE(k[8], k[12]); CE(k[10], k[14]); CE(k[10], k[12]); CE(k[9], k[13]); CE(k[11], k[15]); CE(k[11], k[13]); CE(k[9], k[10]); CE(k[11], k[12]); CE(k[13], k[14]);
    CE(k[0], k[8]); CE(k[4], k[12]); CE(k[4], k[8]); CE(k[2], k[10]); CE(k[6], k[14]); CE(k[6], k[10]); CE(k[2], k[4]); CE(k[6], k[8]); CE(k[10], k[12]);
    CE(k[1], k[9]); CE(k[5], k[13]); CE(k[5], k[9]); CE(k[3], k[11]); CE(k[7], k[15]); CE(k[7], k[11]); CE(k[3], k[5]); CE(k[7], k[9]); CE(k[11], k[13]);
    CE(k[1], k[2]); CE(k[3], k[4]); CE(k[5], k[6]); CE(k[7], k[8]); CE(k[9], k[10]); CE(k[11], k[12]); CE(k[13], k[14]);
}
DI void bitonic16_asc(unsigned (&k)[16]) {
    CE(k[0], k[8]); CE(k[1], k[9]); CE(k[2], k[10]); CE(k[3], k[11]); CE(k[4], k[12]); CE(k[5], k[13]); CE(k[6], k[14]); CE(k[7], k[15]); CE(k[0], k[4]);
    CE(k[1], k[5]); CE(k[2], k[6]); CE(k[3], k[7]); CE(k[8], k[12]); CE(k[9], k[13]); CE(k[10], k[14]); CE(k[11], k[15]); CE(k[0], k[2]); CE(k[1], k[3]);
    CE(k[4], k[6]); CE(k[5], k[7]); CE(k[8], k[10]); CE(k[9], k[11]); CE(k[12], k[14]); CE(k[13], k[15]); CE(k[0], k[1]); CE(k[2], k[3]); CE(k[4], k[5]);
    CE(k[6], k[7]); CE(k[8], k[9]); CE(k[10], k[11]); CE(k[12], k[13]); CE(k[14], k[15]);
}

DI unsigned fkey(float v, unsigned idx) { unsigned b = __float_as_uint(v); b = (b & 0x80000000u) ? ~b : (b | 0x80000000u); return (b & ~127u) | idx; }
DI float fkey_val(unsigned k) { unsigned b = k & ~127u; b = (b & 0x80000000u) ? (b & 0x7fffffffu) : ~b; return __uint_as_float(b); }
DI void top16_of_128(const f32x4 (&acc)[8], int g, unsigned (&t)[16]) {
    unsigned ka[16], kb[16];
#pragma unroll
    for (int ni = 0; ni < 4; ++ni)
#pragma unroll
        for (int j = 0; j < 4; ++j) { ka[4 * ni + j] = fkey(acc[ni][j], 16 * ni + 4 * g + j); kb[4 * ni + j] = fkey(acc[ni + 4][j], 16 * (ni + 4) + 4 * g + j); }
    sort16_asc(ka); sort16_asc(kb);
#pragma unroll
    for (int i = 0; i < 16; ++i) t[i] = max(ka[i], kb[15 - i]);
    bitonic16_asc(t);
#pragma unroll
    for (int xo = 16; xo <= 32; xo <<= 1) {
        unsigned pp[16];
#pragma unroll
        for (int i = 0; i < 16; ++i) pp[i] = (unsigned)__shfl_xor((int)t[i], xo);
#pragma unroll
        for (int i = 0; i < 16; ++i) t[i] = max(t[i], pp[15 - i]);
        bitonic16_asc(t);
    }
}

#define LAS __attribute__((address_space(3)))
#define XB_TMO      128
#define XB_XCNT(j)  (256  + 64 * (j))
#define XB_XSUB(j)  (1280 + 64 * (j))
#define XB_XGEN(j)  (2304 + 64 * (j))
#define XB_TOP      3328
#define XB_TOPGEN   3392
#define XCD_BAR_WORDS 3456
#define XB_SPIN_CAP (1u << 18)

__device__ __forceinline__ unsigned xb_ld(unsigned* p)              { return __hip_atomic_load(p, __ATOMIC_RELAXED, __HIP_MEMORY_SCOPE_AGENT); }
__device__ __forceinline__ unsigned xb_add(unsigned* p, unsigned v) { return __hip_atomic_fetch_add(p, v, __ATOMIC_RELAXED, __HIP_MEMORY_SCOPE_AGENT); }
__device__ __forceinline__ unsigned xb_xcc_id() { return (unsigned)__builtin_amdgcn_s_getreg((3 << 11) | 20) & 0xFu; }
#define XB_SPIN(cond, bar) do { unsigned _sp = 0; while (cond) { __builtin_amdgcn_s_sleep(1); \
    if ((++_sp & 255u) == 0u) { if (xb_ld(&(bar)[XB_TMO])) break; if (_sp > XB_SPIN_CAP) { atomicAdd(&(bar)[XB_TMO], 1u); break; } } } } while (0)

struct XcdBarrier {
    unsigned* bar; unsigned x;
    volatile LAS unsigned* st;
};

__device__ __forceinline__ XcdBarrier xcd_barrier_post(unsigned* bar, volatile LAS unsigned* st, unsigned& rank) {
    XcdBarrier b; b.bar = bar; b.x = xb_xcc_id(); b.st = st;
    rank = 0u;
    if (threadIdx.x == 0) rank = xb_add(&bar[XB_XCNT(b.x)], 1u);
    return b;
}
__device__ __forceinline__ void xcd_barrier_complete(unsigned* bar, unsigned x, unsigned& nloc, unsigned& nx) {
    const unsigned G = gridDim.x * gridDim.y * gridDim.z;
    unsigned sum, cnt, mine, sp = 0u;
    for (;;) {
        sum = 0u; cnt = 0u; mine = 0u;
#pragma unroll
        for (unsigned j = 0; j < 16; ++j) { const unsigned c = xb_ld(&bar[XB_XCNT(j)]); sum += c; cnt += (c > 0u) ? 1u : 0u; mine = (j == x) ? c : mine; }
        if (sum == G) break;
        __builtin_amdgcn_s_sleep(1);
        if ((++sp & 255u) == 0u) { if (xb_ld(&bar[XB_TMO])) break; if (sp > XB_SPIN_CAP) { atomicAdd(&bar[XB_TMO], 1u); break; } }
    }
    nloc = mine > 0u ? mine : 1u; nx = cnt > 0u ? cnt : 1u;
}

__device__ __forceinline__ void xcd_barrier(const XcdBarrier& b) {
    asm volatile("s_waitcnt vmcnt(0)" ::: "memory");
    __syncthreads();
    if (threadIdx.x == 0) {
        unsigned* bar = b.bar;
        __builtin_amdgcn_s_waitcnt(0);
        unsigned nloc = b.st[0], nx = b.st[1];
        if (nloc == 0u) { xcd_barrier_complete(bar, b.x, nloc, nx); b.st[0] = nloc; b.st[1] = nx; }
        const unsigned old = xb_add(&bar[XB_XSUB(b.x)], 1u);
        const unsigned gen = old / nloc;
        if (old + 1u == (gen + 1u) * nloc) {
            __builtin_amdgcn_fence(__ATOMIC_RELEASE, "agent");
            asm volatile("s_waitcnt vmcnt(0)" ::: "memory");
            const unsigned og = xb_add(&bar[XB_TOP], 1u);
            const unsigned tg = og / nx;
            if (og + 1u == (tg + 1u) * nx) xb_add(&bar[XB_TOPGEN], 1u);
            else XB_SPIN(xb_ld(&bar[XB_TOPGEN]) == tg, bar);
            __builtin_amdgcn_fence(__ATOMIC_ACQUIRE, "agent");
            xb_add(&bar[XB_XGEN(b.x)], 1u);
            asm volatile("s_waitcnt vmcnt(0)" ::: "memory");
        } else {
            XB_SPIN(xb_ld(&bar[XB_XGEN(b.x)]) == gen, bar);
            __builtin_amdgcn_fence(__ATOMIC_ACQUIRE, "agent");
            asm volatile("s_waitcnt vmcnt(0)" ::: "memory");
        }
    }
    __syncthreads();
}


__global__ void __launch_bounds__(NTHREADS, 2) fwd_kernel(Params p) {
    extern __shared__ __attribute__((aligned(16))) unsigned char lds[];
    const int tid = threadIdx.x, lane = tid & 63, wave = tid >> 6;
    const int G = gridDim.x, bid = blockIdx.x;
    const long gtid = (long)bid * NTHREADS + tid, gth = (long)G * NTHREADS;
    const int gwave = bid * NWAVES + wave, ngw = G * NWAVES;
    unsigned char* ws = p.ws;
    bf16_t* WIN = (bf16_t*)(ws + WS_WIN); bf16_t* WOA = (bf16_t*)(ws + WS_WOA);
    bf16_t* WMIX = (bf16_t*)(ws + WS_WMIX); bf16_t* WQ = (bf16_t*)(ws + WS_WQ); bf16_t* SK = (bf16_t*)(ws + WS_SK);
    float* RS1 = (float*)(ws + WS_RS1); float* RS2 = (float*)(ws + WS_RS2);
    bf16_t* XB = (bf16_t*)(ws + WS_XB); bf16_t* OA = (bf16_t*)(ws + WS_OA);
    unsigned short* EIDX = (unsigned short*)(ws + WS_EIDX); float* GW = (float*)(ws + WS_GW);
    bf16_t* QK = (bf16_t*)(ws + WS_QK); bf16_t* KF = (bf16_t*)(ws + WS_KF); bf16_t* VT = (bf16_t*)(ws + WS_VT); bf16_t* MIXED = (bf16_t*)(ws + WS_MIXED); bf16_t* HB = (bf16_t*)(ws + WS_HB);
    bf16_t* GATES = (bf16_t*)(ws + WS_GATES); bf16_t* Q2 = (bf16_t*)(ws + WS_Q2);
    float* SU = (float*)(ws + WS_SU); float* SV = (float*)(ws + WS_SV); float* SSP = (float*)(ws + WS_SSP); float* SH = (float*)(ws + WS_SH);
    signed char* H8 = (signed char*)(ws + WS_H8); int* AP = (int*)(ws + WS_AP); unsigned char* U8 = ws + WS_U8; unsigned char* V8 = ws + WS_V8;
    unsigned* CTL = (unsigned*)(ws + WS_CTL); float* KSUM = (float*)(ws + WS_KSUM); float* SWMAX = (float*)(ws + WS_SWMAX); float* WSC = (float*)(ws + WS_WSC); signed char* WH = (signed char*)(ws + WS_WH); signed char* WL = (signed char*)(ws + WS_WL);
    volatile LAS unsigned* bst = (volatile LAS unsigned*)((LAS unsigned char*)lds + (LDS_BYTES - 16));
    if (tid < 4) bst[tid] = 0u;
    __syncthreads();
    unsigned xrank;
    const XcdBarrier xbar = xcd_barrier_post((unsigned*)(ws + WS_CTL) + 1024, bst, xrank);
    volatile unsigned* rankw = (volatile unsigned*)(lds + (LDS_BYTES - 32));
    const int lo = p.ph_lo, hi = p.ph_hi;
#ifdef ONLY_PHASE
#define IN(k) ((k) == ONLY_PHASE && lo <= (k) && (k) < hi)
#else
#define IN(k) (lo <= (k) && (k) < hi)
#endif
#define SEAM(k) do { if (IN(k) && IN((k) + 1)) xcd_barrier(xbar); } while (0)

    for (int rep_ = 0; rep_ < (IN(0) ? 1 : 0); ++rep_) {
        for (int nb = bid; nb < INW / 32; nb += G) {
            float* scr = (float*)(lds + wave * (128 * 33 * 4));
            float* AMX = (float*)(lds + 8 * (128 * 33 * 4));
            const int n0 = 32 * nb, kw = 128 * wave;
            float am = 0.f;
            __syncthreads();
            {
#pragma unroll
                for (int hf = 0; hf < 2; ++hf) {
                    float wv[32], gv[32];
#pragma unroll
                    for (int i = 0; i < 32; ++i) { const int kk = 64 * hf + 2 * i + (lane >> 5); wv[i] = p.w_in[(size_t)(kw + kk) * INW + n0 + (lane & 31)]; gv[i] = p.g1[kw + kk]; }
#pragma unroll
                    for (int i = 0; i < 32; ++i) { const int kk = 64 * hf + 2 * i + (lane >> 5); const float v = wv[i] * gv[i]; scr[kk * 33 + (lane & 31)] = v; am = fmaxf(am, fabsf(v)); }
                }
            }
            am = fmaxf(am, __shfl_xor(am, 32));
            if (lane < 32) AMX[wave * 32 + lane] = am;
            __syncthreads();
            const int kc = lane & 15;
#pragma unroll
            for (int j = 0; j < 8; ++j) {
                const int n = (lane >> 4) + 4 * j;
                float cm = AMX[n];
#pragma unroll
                for (int w2 = 1; w2 < 8; ++w2) cm = fmaxf(cm, AMX[w2 * 32 + n]);
                const float isc = cm > 0.f ? 127.f / cm : 0.f;
                const float* sp = scr + (8 * kc) * 33 + n;
                unsigned lo, hi;
                lo = q8x4(sp[0], sp[33], sp[66], sp[99], isc); hi = q8x4(sp[4 * 33], sp[5 * 33], sp[6 * 33], sp[7 * 33], isc);
                *(u32x2*)((signed char*)WIN + (size_t)(n0 + n) * DM + kw + 8 * kc) = (u32x2){lo, hi};
                if (wave == 0 && kc == 0) SWMAX[n0 + n] = cm;
            }
        }
        __syncthreads();
        {
            float* scr = (float*)(lds + wave * 16384);
            constexpr int I_OA = (WA / 64) * (DM / 32), I_MIX = (DM / 64) * (DM / 32), I_Q = (DM / 64) * (PQW / 32);
            for (int it = gwave; it < 2 * I_OA + I_MIX + I_Q; it += ngw) {
                int r = it;
                if (r < I_OA) { transpose_item(p.w_oa, WA, DM, WOA, 2 * WA, 0, nullptr, scr, r, lane); continue; } r -= I_OA;
                if (r < I_OA) { transpose_item(p.w_ob, WA, DM, WOA, 2 * WA, WA, nullptr, scr, r, lane); continue; } r -= I_OA;
                if (r < I_MIX) { transpose_item(p.w_mix, DM, DM, WMIX, DM, 0, nullptr, scr, r, lane); continue; } r -= I_MIX;
                transpose_item(p.w_q, DM, PQW, WQ, DM, 0, p.g2, scr, r, lane);
            }
            for (long i = gtid; i < 16L * 128 * 128; i += gth) SK[i] = (bf16_t)f2bf(p.skeys[i]);
        }
        for (int row0 = gwave; row0 < T; row0 += 8 * ngw) {
            f32x4 xv[8][4];
#pragma unroll
            for (int k = 0; k < 8; ++k) {
                const int row = row0 + k * ngw;
                if (row < T) {
#pragma unroll
                    for (int j = 0; j < 4; ++j) xv[k][j] = ((const f32x4*)(p.x + (size_t)row * DM) + lane)[64 * j];
                }
            }
#pragma unroll
            for (int k = 0; k < 8; ++k) {
                const int row = row0 + k * ngw;
                if (row < T) {
                    float sq = 0.f, am = 0.f;
#pragma unroll
                    for (int j = 0; j < 4; ++j) { const f32x4 v = xv[k][j]; sq += v.x * v.x + v.y * v.y + v.z * v.z + v.w * v.w; am = fmaxf(fmaxf(am, fmaxf(fabsf(v.x), fabsf(v.y))), fmaxf(fabsf(v.z), fabsf(v.w))); }
                    sq = wave_sum(sq);
#pragma unroll
                    for (int o = 32; o >= 1; o >>= 1) am = fmaxf(am, __shfl_xor(am, o));
                    const float sc = am > 0.f ? am * (1.f / 127.f) : 1.f, isc = 1.f / sc;
                    unsigned* ob = (unsigned*)(XB + (size_t)row * (DM / 2)) + lane;
#pragma unroll
                    for (int j = 0; j < 4; ++j) { const f32x4 v = xv[k][j]; ob[64 * j] = q8x4(v.x, v.y, v.z, v.w, isc); }
                    if (lane == 0) RS1[row] = sc * rsqrtf(sq * (1.f / DM) + RMS_EPS);
                }
            }
        }
    }
    if (tid == 0) rankw[0] = xrank;
    SEAM(0);

    for (int rep_ = 0; rep_ < (IN(1) ? (PROBE_REP == 1 ? 2 : 1) : 0); ++rep_) {
        pg8::Gemm gm{XB, WIN, T, INW, DM / 2}; pg8::StaticOrder S; S.init(T, INW, G, bid);
        EpiInProj E{QK, KF, VT, GATES, RS1, SWMAX, KSUM, rep_ == 0};
        pg8::gemm_phase<EpiInProj, pg8::StaticOrder, true, true>((PG8_LAS unsigned char*)lds, gm, S, E);
    }
    SEAM(1);

    for (int rep_ = 0; rep_ < (IN(3) ? (PROBE_REP == 3 ? 2 : 1) : 0); ++rep_) {
        {
            volatile int* ibox = (volatile int*)(lds + ML_ITEM);
            const unsigned xcc = (unsigned)__builtin_amdgcn_s_getreg((3 << 11) | 20) & 7u;
            unsigned* Q3 = CTL + 64 + (rep_ ? 8 : 0);
            int qx = (int)xcc, qoff = (int)bst[0];
            __syncthreads();
            if (tid == 0) { const int rk = (int)rankw[0]; ibox[0] = rk < 64 ? rk : 64; }
            __syncthreads();
            for (;;) {
                int k = __builtin_amdgcn_readfirstlane(ibox[0]);
                if (k >= 64) {
                    __syncthreads();
                    if (wave == 0) {
                        unsigned v = 64u, n = 0u;
                        if (lane < 8) { v = __hip_atomic_load(&Q3[(xcc + (unsigned)lane) & 7u], __ATOMIC_RELAXED, __HIP_MEMORY_SCOPE_AGENT); n = xb_ld(&xbar.bar[XB_XCNT((xcc + (unsigned)lane) & 7u)]); }
                        const unsigned long long m = __ballot(v + n < 64u);
                        int nq = -1, nn = 0; unsigned nk = 64u;
                        if (m != 0ull) { const int sel = __builtin_ctzll(m); nq = (int)((xcc + (unsigned)sel) & 7u); nn = __builtin_amdgcn_readlane((int)n, sel); if (lane == 0) nk = atomicAdd(&Q3[nq], 1u); }
                        if (lane == 0) { ibox[0] = nn + (int)nk; ibox[1] = nq; ibox[2] = nn; }
                    }
                    __syncthreads();
                    const int nq = __builtin_amdgcn_readfirstlane(ibox[1]);
                    if (nq < 0) break;
                    qx = nq; qoff = __builtin_amdgcn_readfirstlane(ibox[2]);
                    continue;
                }
                const int oi = k >> 1;
                const int og = p3_order(oi), bh = 2 * qx + (k & 1);
                moba_group(lds, QK, KF, VT, KSUM, OA, bh >> 3, bh & 7, og, true, &Q3[qx], qoff);
            }
        }
    }
    SEAM(3);

    for (int rep_ = 0; rep_ < (IN(4) ? 1 : 0); ++rep_) {
        pg8::Gemm gm{OA, WOA, T, DM, 2 * WA}; pg8::StaticOrder S; S.init(T, DM, G, bid);
        EpiMix E{GATES, MIXED};
        pg8::gemm_phase<EpiMix, pg8::StaticOrder, true, true, true>((PG8_LAS unsigned char*)lds, gm, S, E);
    }
    SEAM(4);

    for (int rep_ = 0; rep_ < (IN(5) ? (PROBE_REP == 5 ? 2 : 1) : 0); ++rep_) {
        pg8::Gemm gm{MIXED, WMIX, T, DM, DM}; pg8::StaticOrder S; S.init(T, DM, G, bid);
        EpiResid E{p.x, HB};
        pg8::gemm_phase<EpiResid, pg8::StaticOrder, true, true>((PG8_LAS unsigned char*)lds, gm, S, E);
    }
    SEAM(5);

    for (int rep_ = 0; rep_ < (IN(7) ? 1 : 0); ++rep_) {
        pg8::Gemm gm{HB, WQ, T, PQW, DM}; pg8::StaticOrder S; S.init(T, PQW, G, bid);
        EpiPeerQ E{Q2};
        pg8::gemm_phase<EpiPeerQ, pg8::StaticOrder, true, true>((PG8_LAS unsigned char*)lds, gm, S, E);
    }
    SEAM(7);

    for (int rep_ = 0; rep_ < (IN(8) ? (PROBE_REP == 8 ? 2 : 1) : 0); ++rep_) {
        bf16_t* Qs = (bf16_t*)lds;
        bf16_t* Ks = Qs + 128 * 264;
        unsigned* LST = (unsigned*)(lds + 128 * 264 * 2 + 2 * 128 * 136 * 2);
        int h_loaded = -1;
        __syncthreads();
        if (bid < (T / 128) * 8) {
            const int h0 = bid & 7, t00 = (bid >> 3) * 128;
#pragma unroll
            for (int i = 0; i < 8; ++i) { const int c = tid + i * NTHREADS, r = c >> 5, ch = c & 31; *(u32x4*)(Qs + r * 264 + ch * 8) = *(const u32x4*)(Q2 + (size_t)(t00 + r) * PQW + h0 * 256 + ch * 8); }
        }
        for (int it = bid; it < (T / 128) * 8; it += G) {
            const int h = it & 7, t0 = (it >> 3) * 128;
            if (h != h_loaded) {
#pragma unroll
                for (int i = 0; i < 8; ++i) {
                    const int c = tid + i * NTHREADS, r = c >> 4, ch = c & 15;
                    *(u32x4*)(Ks + r * 136 + ch * 8) = *(const u32x4*)(SK + (size_t)(2 * h * 128 + r) * 128 + ch * 8);
                }
                h_loaded = h;
            }
            __syncthreads();
#pragma unroll 1
            for (int ph = 0; ph < 2; ++ph) {
                f32x4 acc[8];
#pragma unroll
                for (int ni = 0; ni < 8; ++ni) acc[ni] = (f32x4){0.f, 0.f, 0.f, 0.f};
#pragma unroll
                for (int ks = 0; ks < 4; ++ks) {
                    const bf16x8 qf = *(const bf16x8*)(Qs + (wave * 16 + (lane & 15)) * 264 + ph * 128 + ks * 32 + (lane >> 4) * 8);
#pragma unroll
                    for (int ni = 0; ni < 8; ++ni) {
                        const bf16x8 kf = *(const bf16x8*)(Ks + (ph * 128 + ni * 16 + (lane & 15)) * 136 + ks * 32 + (lane >> 4) * 8);
                        acc[ni] = __builtin_amdgcn_mfma_f32_16x16x32_bf16(kf, qf, acc[ni], 0, 0, 0);
                    }
                }
                unsigned tk[16];
                top16_of_128(acc, lane >> 4, tk);
                if (lane < 16) {
                    unsigned* dst = LST + ((wave * 16 + lane) * 2 + ph) * 16;
#pragma unroll
                    for (int i = 0; i < 4; ++i) { u32x4 w; w.x = tk[15 - 4 * i]; w.y = tk[14 - 4 * i]; w.z = tk[13 - 4 * i]; w.w = tk[12 - 4 * i]; *(u32x4*)(dst + 4 * i) = w; }
                }
            }
            __syncthreads();
            if (tid >= 128 && it + G < (T / 128) * 8) {
                const int itn = it + G, hn = itn & 7, tn0 = (itn >> 3) * 128;
                for (int c = tid - 128; c < 128 * 32; c += NTHREADS - 128) { const int r = c >> 5, ch = c & 31; *(u32x4*)(Qs + r * 264 + ch * 8) = *(const u32x4*)(Q2 + (size_t)(tn0 + r) * PQW + hn * 256 + ch * 8); }
            }
            if (wave >= 6) quant_rows<8>(p.pu, p.pv, p.g2, U8, V8, SU, SV, it * 32 + 16 + (wave - 6) * 8, 1, lane);
            else if (wave >= 2) quant_rows<4>(p.pu, p.pv, p.g2, U8, V8, SU, SV, it * 32 + (wave - 2) * 4, 1, lane);
            if (tid >= 128 && tid < 384) h_rows4(HB, RS2, SH, H8, it * 16 + (wave - 2) * 4, 1, lane);
            if (tid < 128) {
                const unsigned* La = LST + (tid * 2) * 16; const unsigned* Lb = La + 16;
                float cand[16];
                const float b0 = fkey_val(Lb[0]);
#pragma unroll
                for (int i = 0; i < 4; ++i) { const u32x4 w = *(const u32x4*)(La + 4 * i); cand[4 * i] = fkey_val(w.x) + b0; cand[4 * i + 1] = fkey_val(w.y) + b0; cand[4 * i + 2] = fkey_val(w.z) + b0; cand[4 * i + 3] = fkey_val(w.w) + b0; }
                unsigned long long ptrs = 0ull;
                float selv[16]; unsigned sele[16];
#pragma unroll
                for (int r = 0; r < 16; ++r) {
                    float best = cand[0];
#pragma unroll
                    for (int i = 1; i < 16; ++i) best = fmaxf(best, cand[i]);
                    int istar = 15;
#pragma unroll
                    for (int i = 14; i >= 0; --i) istar = (cand[i] == best) ? i : istar;
                    const int j = (int)((ptrs >> (4 * istar)) & 15ull);
                    const unsigned ka = La[istar], kb = Lb[j];
                    selv[r] = best; sele[r] = (ka & 127u) * PNK + (kb & 127u);
                    const bool more = j < 15;
                    const float nc = more ? fkey_val(ka) + fkey_val(Lb[more ? j + 1 : j]) : -INFINITY;
                    if (more) ptrs += 1ull << (4 * istar);
#pragma unroll
                    for (int i = 0; i < 16; ++i) cand[i] = (i == istar) ? nc : cand[i];
                }
                float* go = GW + (size_t)(t0 + tid) * 128 + h * 16;
#pragma unroll
                for (int r = 0; r < 8; ++r) *(unsigned*)(EIDX + (size_t)(t0 + tid) * 128 + r * 16 + 2 * h) = sele[r] | (sele[r + 8] << 16);
#pragma unroll
                for (int i = 0; i < 4; ++i) *(f32x4*)(go + 4 * i) = (f32x4){selv[4 * i], selv[4 * i + 1], selv[4 * i + 2], selv[4 * i + 3]};
            }
        }
    }
    SEAM(8);

#define PEER_ID(ia, ib, i) ((((i) < 8 ? (ia) : (ib))[((i) & 7) >> 1] >> (((i) & 1) * 16)) & 0xffffu)
#define PEER_ROWS4(dst, base, ia, ib, m) do { _Pragma("unroll") for (int q_ = 0; q_ < 4; ++q_) dst[4 * (m) + q_] = *(const u32x4*)((base) + (unsigned)(PEER_ID(ia, ib, 4 * (m) + q_) * 128u + jp16)); } while (0)
#define PEER_IDS(ia, ib, t) do { const unsigned short* ep_ = EIDX + (size_t)(t) * 128; ia = *(const u32x4*)(ep_ + (unsigned)(g * 16)); ib = *(const u32x4*)(ep_ + (unsigned)(g * 16 + 8)); } while (0)
    for (int rep_ = 0; rep_ < (IN(9) ? (PROBE_REP == 9 ? 2 : 1) : 0); ++rep_) {
        volatile int* ubox = (volatile int*)lds;
        const unsigned xcc = (unsigned)__builtin_amdgcn_s_getreg((3 << 11) | 20) & 7u;
        int ln = lane; asm volatile("" : "+v"(ln));
        const int g = ln >> 3, jp = ln & 7;
        const bool b2 = (ln & 4) != 0, b1 = (ln & 2) != 0, b0 = (ln & 1) != 0;
        const int wv = __builtin_amdgcn_readfirstlane(wave); const unsigned jp16 = (unsigned)jp * 16u;
        constexpr int NTW = 32;
        constexpr int NU = T / (8 * NTW);
        const int rank = (int)rankw[0], nloc = (int)bst[0];
        int live = 0;
#define PEER_SCAN_LOAD(cj, nj, base) do { cj = 0xffffffffu; nj = 0u; if (wave == 0 && lane < 8) { cj = __hip_atomic_load(&CTL[(base) + lane], __ATOMIC_RELAXED, __HIP_MEMORY_SCOPE_AGENT); nj = xb_ld(&xbar.bar[XB_XCNT(lane)]); } } while (0)
#define PEER_SCAN_MASK(cj, nj) ((int)__ballot(lane < 8 && cj + nj < (unsigned)NU))
        for (int k8 = 0; k8 < 8; ++k8) {
            const int sl = (int)((xcc + k8) & 7u);
            if (k8 >= 1 && !((live >> sl) & 1)) continue;
            const unsigned char* U8s = U8 + (size_t)sl * NEXP * 128;
            const int cbase = rep_ ? 32 : 0;
            int uoff;
            __syncthreads();
            if (k8 == 0) {
                uoff = nloc;
                if (tid == 0) ubox[0] = rank;
                if (rank >= NU) { unsigned cj, nj; PEER_SCAN_LOAD(cj, nj, cbase); if (wave == 0) { const int m = PEER_SCAN_MASK(cj, nj); if (lane == 0) ubox[1] = m; } }
            } else {
                uoff = __builtin_amdgcn_readfirstlane((int)xb_ld(&xbar.bar[XB_XCNT(sl)]));
                if (tid == 0) ubox[0] = uoff + (int)atomicAdd(&CTL[cbase + sl], 1u);
            }
            __syncthreads();
            if (k8 == 0 && rank >= NU) live = __builtin_amdgcn_readfirstlane(ubox[1]);
            for (;;) {
                const int u = __builtin_amdgcn_readfirstlane(ubox[0]);
                if (u >= NU) break;
                unsigned nxt = 0u;
                if (tid == 0) nxt = atomicAdd(&CTL[cbase + sl], 1u);
                const int tb = u * (8 * NTW) + wv;
#define P1_HQ(hq, t) hq = *(const u32x4*)(H8 + (size_t)(t) * DM + sl * 128 + jp16)
#define P1_DOT4(d, rw, hq, m) do { _Pragma("unroll") for (int q_ = 0; q_ < 4; ++q_) { int x_ = __builtin_amdgcn_sdot4((int)hq.x, (int)rw[4 * (m) + q_].x, 0, false); x_ = __builtin_amdgcn_sdot4((int)hq.y, (int)rw[4 * (m) + q_].y, x_, false); \
        x_ = __builtin_amdgcn_sdot4((int)hq.z, (int)rw[4 * (m) + q_].z, x_, false); d[4 * (m) + q_] = __builtin_amdgcn_sdot4((int)hq.w, (int)rw[4 * (m) + q_].w, x_, false); } } while (0)
#define P1_FINISH(d_, t) do { int v8_[8], v4_[4]; \
    _Pragma("unroll") for (int i_ = 0; i_ < 8; ++i_) v8_[i_] = (b2 ? d_[8 + i_] : d_[i_]) + __shfl_xor(b2 ? d_[i_] : d_[8 + i_], 4); \
    _Pragma("unroll") for (int i_ = 0; i_ < 4; ++i_) v4_[i_] = (b1 ? v8_[4 + i_] : v8_[i_]) + __shfl_xor(b1 ? v8_[i_] : v8_[4 + i_], 2); \
    const int k0_ = (b0 ? v4_[2] : v4_[0]) + __shfl_xor(b0 ? v4_[0] : v4_[2], 1), k1_ = (b0 ? v4_[3] : v4_[1]) + __shfl_xor(b0 ? v4_[1] : v4_[3], 1); \
    int* ap_ = AP + ((size_t)sl * T + (t)) * 128 + 16 * jp + g; ap_[0] = k0_; ap_[8] = k1_; } while (0)
#define P1_STEP(rw, hq, ea, eb, i, REISSUE) do { int d_[16]; \
    _Pragma("unroll") for (int m_ = 0; m_ < 4; ++m_) { P1_DOT4(d_, rw, hq, m_); __builtin_amdgcn_sched_barrier(0); if (REISSUE) { PEER_ROWS4(rw, U8s, ea, eb, m_); __builtin_amdgcn_sched_barrier(0); } } \
    P1_FINISH(d_, tb + 8 * (i)); } while (0)
                u32x4 e0a, e0b, e1a, e1b, h0, h1, rwA[16], rwB[16];
                PEER_IDS(e0a, e0b, tb); PEER_IDS(e1a, e1b, tb + 8); P1_HQ(h0, tb);
#pragma unroll
                for (int m_ = 0; m_ < 4; ++m_) PEER_ROWS4(rwA, U8s, e0a, e0b, m_);
#pragma unroll
                for (int m_ = 0; m_ < 4; ++m_) PEER_ROWS4(rwB, U8s, e1a, e1b, m_);
                PEER_IDS(e0a, e0b, tb + 16);
#pragma unroll 1
                for (int i = 0; i < NTW - 2; i += 2) {
                    PEER_IDS(e1a, e1b, tb + 8 * (i + 3));
                    P1_HQ(h1, tb + 8 * (i + 1));
                    P1_STEP(rwA, h0, e0a, e0b, i, true);
                    { const int tn = tb + 8 * (i + 4 < NTW ? i + 4 : NTW - 1); PEER_IDS(e0a, e0b, tn); }
                    P1_HQ(h0, tb + 8 * (i + 2));
                    P1_STEP(rwB, h1, e1a, e1b, i + 1, true);
                }
                P1_HQ(h1, tb + 8 * (NTW - 1));
                P1_STEP(rwA, h0, e0a, e0b, NTW - 2, false);
                P1_STEP(rwB, h1, e1a, e1b, NTW - 1, false);
                __syncthreads();
                if (tid == 0) ubox[0] = uoff + (int)nxt;
                __syncthreads();
            }
            if (k8 == 0 && rank < NU) {
                __syncthreads();
                { unsigned cj, nj; PEER_SCAN_LOAD(cj, nj, cbase); if (wave == 0) { const int m = PEER_SCAN_MASK(cj, nj); if (lane == 0) ubox[1] = m; } }
                __syncthreads();
                live = __builtin_amdgcn_readfirstlane(ubox[1]);
            }
        }
    }
    SEAM(9);

    for (int rep_ = 0; rep_ < (IN(10) ? (PROBE_REP == 10 ? 2 : 1) : 0); ++rep_) {
        for (int t = gwave; t < T; t += ngw) {
            int s0 = 0, s1 = 0;
#pragma unroll
            for (int q = 0; q < 8; ++q) { const int* ap = AP + ((size_t)q * T + t) * 128; s0 += ap[lane]; s1 += ap[64 + lane]; }
            const int p0 = (lane & 7) * 16 + (lane >> 3), p1 = p0 + 8;
            const int e0 = EIDX[(size_t)t * 128 + p0], e1 = EIDX[(size_t)t * 128 + p1];
            const float sc = SH[t] * RS2[t];
            const float a0 = (float)s0 * (sc * SU[e0]), a1 = (float)s1 * (sc * SU[e1]);
            const float rs2t = RS2[t];
            const float c0 = GW[(size_t)t * 128 + lane] * rs2t, c1 = GW[(size_t)t * 128 + 64 + lane] * rs2t;
            float m0 = c0, m1 = c1;
#pragma unroll
            for (int o = 8; o >= 1; o >>= 1) { m0 = fmaxf(m0, __shfl_xor(m0, o)); m1 = fmaxf(m1, __shfl_xor(m1, o)); }
            const float x0e = __expf(c0 - m0), x1e = __expf(c1 - m1);
            float z0 = x0e, z1 = x1e;
#pragma unroll
            for (int o = 8; o >= 1; o >>= 1) { z0 += __shfl_xor(z0, o); z1 += __shfl_xor(z1, o); }
            const float w0 = (x0e * __builtin_amdgcn_rcpf(z0)) * (0.5f * a0 * (1.f + erff(a0 * 0.70710678118654752f))) * SV[e0];
            const float w1 = (x1e * __builtin_amdgcn_rcpf(z1)) * (0.5f * a1 * (1.f + erff(a1 * 0.70710678118654752f))) * SV[e1];
            float wm = fmaxf(fabsf(w0), fabsf(w1));
#pragma unroll
            for (int o = 32; o >= 1; o >>= 1) wm = fmaxf(wm, __shfl_xor(wm, o));
            const float wsc = wm > 0.f ? wm * (1.f / 127.f) : 1.f, iw = 1.f / wsc;
            const float x0 = w0 * iw, x1 = w1 * iw;
            int h0 = (int)rintf(x0), h1 = (int)rintf(x1);
            h0 = h0 < -127 ? -127 : (h0 > 127 ? 127 : h0); h1 = h1 < -127 ? -127 : (h1 > 127 ? 127 : h1);
            WH[(size_t)t * 128 + p0] = (signed char)h0; WH[(size_t)t * 128 + p1] = (signed char)h1;
            if (lane == 0) WSC[t] = wsc;
        }
    }
    SEAM(10);

    for (int rep_ = 0; rep_ < (IN(11) ? (PROBE_REP == 11 ? 2 : 1) : 0); ++rep_) {
        const bool dry_ = (PROBE_REP == 11) && rep_ == 0;
        volatile int* ubox = (volatile int*)lds;
        const unsigned xcc = (unsigned)__builtin_amdgcn_s_getreg((3 << 11) | 20) & 7u;
        int ln = lane; asm volatile("" : "+v"(ln));
        const int g = ln >> 3, jp = ln & 7;
        const bool b5 = (ln & 32) != 0, b4 = (ln & 16) != 0, b3 = (ln & 8) != 0;
        const int wv = __builtin_amdgcn_readfirstlane(wave); const unsigned jp16 = (unsigned)jp * 16u;
        constexpr int NTW = 32;
        constexpr int NU = T / (8 * NTW);
        const int rank = (int)rankw[0], nloc = (int)bst[0];
        int live = 0;
        for (int k8 = 0; k8 < 8; ++k8) {
            const int sl = (int)((xcc + k8) & 7u);
            if (k8 >= 1 && !((live >> sl) & 1)) continue;
            const unsigned char* V8s = V8 + (size_t)sl * NEXP * 128;
            const int cbase = dry_ ? 48 : 16;
            int uoff;
            __syncthreads();
            if (k8 == 0) {
                uoff = nloc;
                if (tid == 0) ubox[0] = rank;
                if (rank >= NU) { unsigned cj, nj; PEER_SCAN_LOAD(cj, nj, cbase); if (wave == 0) { const int m = PEER_SCAN_MASK(cj, nj); if (lane == 0) ubox[1] = m; } }
            } else {
                uoff = __builtin_amdgcn_readfirstlane((int)xb_ld(&xbar.bar[XB_XCNT(sl)]));
                if (tid == 0) ubox[0] = uoff + (int)atomicAdd(&CTL[cbase + sl], 1u);
            }
            __syncthreads();
            if (k8 == 0 && rank >= NU) live = __builtin_amdgcn_readfirstlane(ubox[1]);
            for (;;) {
                const int u = __builtin_amdgcn_readfirstlane(ubox[0]);
                if (u >= NU) break;
                unsigned nxt = 0u;
                if (tid == 0) nxt = atomicAdd(&CTL[cbase + sl], 1u);
                const int tb = u * (8 * NTW) + wv;
#define P2_WM(wh, hv, wsc, t) do { wh = *(const u32x4*)(WH + (size_t)(t) * 128 + (unsigned)(g * 16)); { const unsigned hw_ = *(const unsigned*)(HB + (size_t)(t) * DM + sl * 128 + (unsigned)(jp * 16 + 2 * g)); hv = (f32x2_t){bflo(hw_), bfhi(hw_)}; } wsc = WSC[t]; } while (0)
#define P2_COL(rw, wh, ah, c, cb, m) do { const unsigned t0_ = __builtin_amdgcn_perm(rw[4 * (m) + 1].c, rw[4 * (m)].c, 0x05010400u), t1_ = __builtin_amdgcn_perm(rw[4 * (m) + 3].c, rw[4 * (m) + 2].c, 0x05010400u); \
    const unsigned t2_ = __builtin_amdgcn_perm(rw[4 * (m) + 1].c, rw[4 * (m)].c, 0x07030602u), t3_ = __builtin_amdgcn_perm(rw[4 * (m) + 3].c, rw[4 * (m) + 2].c, 0x07030602u); \
    ah[(cb) + 0] = __builtin_amdgcn_sdot4((int)__builtin_amdgcn_perm(t1_, t0_, 0x05040100u), (int)wh[m], ah[(cb) + 0], false); ah[(cb) + 1] = __builtin_amdgcn_sdot4((int)__builtin_amdgcn_perm(t1_, t0_, 0x07060302u), (int)wh[m], ah[(cb) + 1], false); \
    ah[(cb) + 2] = __builtin_amdgcn_sdot4((int)__builtin_amdgcn_perm(t3_, t2_, 0x05040100u), (int)wh[m], ah[(cb) + 2], false); ah[(cb) + 3] = __builtin_amdgcn_sdot4((int)__builtin_amdgcn_perm(t3_, t2_, 0x07060302u), (int)wh[m], ah[(cb) + 3], false); } while (0)
#define P2_FINISH(d_, hv, wsc, t) do { int v8_[8], v4_[4]; \
    _Pragma("unroll") for (int i_ = 0; i_ < 8; ++i_) v8_[i_] = (b5 ? d_[8 + i_] : d_[i_]) + __shfl_xor(b5 ? d_[i_] : d_[8 + i_], 32); \
    _Pragma("unroll") for (int i_ = 0; i_ < 4; ++i_) v4_[i_] = (b4 ? v8_[4 + i_] : v8_[i_]) + __shfl_xor(b4 ? v8_[i_] : v8_[4 + i_], 16); \
    const int k0_ = (b3 ? v4_[2] : v4_[0]) + __shfl_xor(b3 ? v4_[0] : v4_[2], 8), k1_ = (b3 ? v4_[3] : v4_[1]) + __shfl_xor(b3 ? v4_[1] : v4_[3], 8); \
    bf16_t* orow_ = MIXED + (size_t)(t) * DM + sl * 128 + jp * 16 + 2 * g;     \
    const unsigned ob_ = cvtpk((hv).x + (float)k0_ * (wsc), (hv).y + (float)k1_ * (wsc)); const float o0_ = bflo(ob_), o1_ = bfhi(ob_); \
    if (!dry_) *(unsigned*)orow_ = ob_; \
    const float ss_ = wave_sum(o0_ * o0_ + o1_ * o1_); if (ln == 0 && !dry_) SSP[(size_t)(t) * 8 + sl] = ss_; asm volatile("" :: "v"(ss_)); } while (0)
#define P2_STEP(rw, wh, hv, wsc, ea, eb, i, REISSUE) do { int d_[16]; _Pragma("unroll") for (int i_ = 0; i_ < 16; ++i_) d_[i_] = 0; \
    _Pragma("unroll") for (int m_ = 0; m_ < 4; ++m_) { P2_COL(rw, wh, d_, x, 0, m_); P2_COL(rw, wh, d_, y, 4, m_); P2_COL(rw, wh, d_, z, 8, m_); P2_COL(rw, wh, d_, w, 12, m_); __builtin_amdgcn_sched_barrier(0); \
        if (REISSUE) { PEER_ROWS4(rw, V8s, ea, eb, m_); __builtin_amdgcn_sched_barrier(0); } } \
    P2_FINISH(d_, hv, wsc, tb + 8 * (i)); } while (0)
                u32x4 e0a, e0b, e1a, e1b, w0, w1, rwA[16], rwB[16]; f32x2_t hv0, hv1; float ws0, ws1;
                PEER_IDS(e0a, e0b, tb); PEER_IDS(e1a, e1b, tb + 8); P2_WM(w0, hv0, ws0, tb);
#pragma unroll
                for (int m_ = 0; m_ < 4; ++m_) PEER_ROWS4(rwA, V8s, e0a, e0b, m_);
#pragma unroll
                for (int m_ = 0; m_ < 4; ++m_) PEER_ROWS4(rwB, V8s, e1a, e1b, m_);
                PEER_IDS(e0a, e0b, tb + 16);
#pragma unroll 1
                for (int i = 0; i < NTW - 2; i += 2) {
                    PEER_IDS(e1a, e1b, tb + 8 * (i + 3));
                    P2_WM(w1, hv1, ws1, tb + 8 * (i + 1));
                    P2_STEP(rwA, w0, hv0, ws0, e0a, e0b, i, true);
                    { const int tn = tb + 8 * (i + 4 < NTW ? i + 4 : NTW - 1); PEER_IDS(e0a, e0b, tn); }
                    P2_WM(w0, hv0, ws0, tb + 8 * (i + 2));
                    P2_STEP(rwB, w1, hv1, ws1, e1a, e1b, i + 1, true);
                }
                P2_WM(w1, hv1, ws1, tb + 8 * (NTW - 1));
                P2_STEP(rwA, w0, hv0, ws0, e0a, e0b, NTW - 2, false);
                P2_STEP(rwB, w1, hv1, ws1, e1a, e1b, NTW - 1, false);
                __syncthreads();
                if (tid == 0) ubox[0] = uoff + (int)nxt;
                __syncthreads();
            }
            if (k8 == 0 && rank < NU) {
                __syncthreads();
                { unsigned cj, nj; PEER_SCAN_LOAD(cj, nj, cbase); if (wave == 0) { const int m = PEER_SCAN_MASK(cj, nj); if (lane == 0) ubox[1] = m; } }
                __syncthreads();
                live = __builtin_amdgcn_readfirstlane(ubox[1]);
            }
        }
    }
    SEAM(11);

    for (int rep_ = 0; rep_ < (IN(12) ? 1 : 0); ++rep_) {
        for (int row = gwave; row < T; row += ngw) {
            float tot = 0.f;
#pragma unroll
            for (int q = 0; q < 8; ++q) tot += SSP[(size_t)row * 8 + q];
            const float rs = rsqrtf(tot * (1.f / DM) + RMS_EPS);
            f32x4* orow = (f32x4*)(p.out + (size_t)row * DM) + lane; const u32x2* ob = (const u32x2*)(MIXED + (size_t)row * DM) + lane;
#pragma unroll
            for (int j = 0; j < 4; ++j) { const f32x4 gv = ((const f32x4*)p.gf)[lane + 64 * j]; const u32x2 w = ob[64 * j]; orow[64 * j] = (f32x4){bflo(w.x), bfhi(w.x), bflo(w.y), bfhi(w.y)} * rs * gv; }
        }
    }
#undef IN
#undef SEAM
}

extern "C" void kernel_launch(void* const* d_in, const int* in_sizes, int n_in, void* d_out, int out_size, void* d_ws, size_t ws_size, hipStream_t stream) {
    static int grid = 0;
    if (grid == 0) {
        int dev = 0, cus = 0, per_cu = 0;
        (void)hipGetDevice(&dev);
        (void)hipDeviceGetAttribute(&cus, hipDeviceAttributeMultiprocessorCount, dev);
        (void)hipFuncSetAttribute((const void*)fwd_kernel, hipFuncAttributeMaxDynamicSharedMemorySize, LDS_BYTES);
        (void)hipOccupancyMaxActiveBlocksPerMultiprocessor(&per_cu, (const void*)fwd_kernel, NTHREADS, LDS_BYTES);
        if (per_cu < 1) { fprintf(stderr, "kernel_launch: occupancy query says %d blocks per CU\n", per_cu); per_cu = 1; }
        grid = cus * 1;
        if (ws_size < WS_END) { fprintf(stderr, "kernel_launch: workspace too small: %zu < %zu\n", ws_size, (size_t)WS_END); grid = -1; }
    }
    if (grid < 0) return;
    Params p{};
    p.x = (const float*)d_in[0]; p.g1 = (const float*)d_in[1]; p.w_in = (const float*)d_in[2]; p.w_oa = (const float*)d_in[3]; p.w_ob = (const float*)d_in[4];
    p.w_mix = (const float*)d_in[5]; p.g2 = (const float*)d_in[6]; p.w_q = (const float*)d_in[7]; p.skeys = (const float*)d_in[8]; p.pu = (const float*)d_in[9];
    p.pv = (const float*)d_in[10]; p.gf = (const float*)d_in[11]; p.out = (float*)d_out; p.ws = (unsigned char*)d_ws;
    p.ph_lo = 0; p.ph_hi = 13;
    if (hipMemsetAsync((char*)d_ws + WS_CTL, 0, 65536 + 131072 + 32768, stream) != hipSuccess) { fprintf(stderr, "kernel_launch: hipMemsetAsync failed\n"); return; }
    hipLaunchKernelGGL(fwd_kernel, dim3(grid), dim3(NTHREADS), LDS_BYTES, stream, p);
}
```

```cpp
#include <hip/hip_runtime.h>
#include <cstdio>
#include <cstdint>

#define DI __device__ __forceinline__
typedef unsigned short bf16_t;
typedef short bf16x8 __attribute__((ext_vector_type(8)));
typedef float f32x4 __attribute__((ext_vector_type(4)));
typedef unsigned u32x4 __attribute__((ext_vector_type(4)));
typedef unsigned u32x2 __attribute__((ext_vector_type(2)));

constexpr int NBATCH = 2, SEQ = 8192, T = NBATCH * SEQ, DM = 1024;
constexpr int NH = 8, HD = 64, WA = 512;
constexpr int INW = 5120, QKVW = 3072, GATEW = 2048;
constexpr int MBLK = 256, NBLK = SEQ / MBLK;
constexpr int PNK = 128, PTOPK = 16, NEXP = 16384, PQW = 2048;
constexpr float RMS_EPS = 1e-6f;
constexpr int NTHREADS = 512, NWAVES = 8;
static_assert((T / 128) * 8 * 32 == 2 * NEXP && (T / 128) * 8 * 16 == T, "P8 side work: 32 expert rows and 16 h rows per item cover all rows");
constexpr int LDS_BYTES = 163840;
#ifndef PROBE_REP
#define PROBE_REP -1
#endif

constexpr size_t MiB = 1u << 20;
constexpr size_t WS_CTL = 0;
constexpr size_t WS_KSUM = 65536;
constexpr size_t WS_SWMAX = 196608;
constexpr size_t WS_WIN = 1 * MiB;
constexpr size_t WS_WOA = 11 * MiB;
constexpr size_t WS_WMIX = 13 * MiB;
constexpr size_t WS_WQ = 15 * MiB;
constexpr size_t WS_SK = 19 * MiB;
constexpr size_t WS_RS1 = 19 * MiB + 512 * 1024;
constexpr size_t WS_RS2 = WS_RS1 + 65536;
constexpr size_t WS_XB = 24 * MiB;
constexpr size_t WS_OA = 24 * MiB;
constexpr size_t WS_EIDX = 24 * MiB;
constexpr size_t WS_GW = 28 * MiB;
constexpr size_t WS_QK = 56 * MiB;
constexpr size_t WS_KF = 88 * MiB;
constexpr size_t WS_VT = 120 * MiB;
constexpr size_t WS_MIXED = 56 * MiB;
constexpr size_t WS_HB = 88 * MiB;
constexpr size_t WS_GATES = 152 * MiB;
constexpr size_t WS_Q2 = 152 * MiB;
constexpr size_t WS_SU = 20 * MiB;
constexpr size_t WS_SV = WS_SU + 65536;
constexpr size_t WS_SSP = 36 * MiB;
constexpr size_t WS_SH = WS_SSP + 524288;
constexpr size_t WS_WSC = WS_SH + 65536;
constexpr size_t WS_WH = 37 * MiB;
constexpr size_t WS_WL = 39 * MiB;
constexpr size_t WS_H8 = 40 * MiB;
constexpr size_t WS_AP = 152 * MiB;
constexpr size_t WS_U8 = 216 * MiB;
constexpr size_t WS_V8 = 232 * MiB;
constexpr size_t WS_END = 248 * MiB;

struct Params {
    const float *x, *g1, *w_in, *w_oa, *w_ob, *w_mix, *g2, *w_q, *skeys, *pu, *pv, *gf;
    float* out; unsigned char* ws; int ph_lo, ph_hi;
};

DI unsigned f2bf(float f) { unsigned u = __float_as_uint(f); return (u + 0x7fffu + ((u >> 16) & 1u)) >> 16; }
DI float bf2f(unsigned h) { return __uint_as_float(h << 16); }
DI float bflo(unsigned w) { return __uint_as_float(w << 16); }
DI float bfhi(unsigned w) { return __uint_as_float(w & 0xffff0000u); }
typedef __bf16 bf16x2_t __attribute__((ext_vector_type(2)));
typedef float f32x2_t __attribute__((ext_vector_type(2)));
DI unsigned cvtpk(float lo, float hi) { f32x2_t v = {lo, hi}; bf16x2_t b = __builtin_convertvector(v, bf16x2_t); return __builtin_bit_cast(unsigned, b); }
DI unsigned pk2(float lo, float hi) { return cvtpk(lo, hi); }
DI unsigned q8x4(float a, float b, float c, float d, float isc) {
    const float M = 12582912.f;
    const unsigned fa = __float_as_uint(fmaf(a, isc, M)), fb = __float_as_uint(fmaf(b, isc, M)), fc = __float_as_uint(fmaf(c, isc, M)), fd = __float_as_uint(fmaf(d, isc, M));
    return __builtin_amdgcn_perm(fb, fa, 0x0c0c0400u) | __builtin_amdgcn_perm(fd, fc, 0x04000c0cu);
}
DI float wave_sum(float v) {
#pragma unroll
    for (int o = 32; o >= 1; o >>= 1) v += __shfl_xor(v, o);
    return v;
}
DI void load_row64(const bf16_t* p, float* o) {
#pragma unroll
    for (int i = 0; i < 8; ++i) {
        u32x4 w = *(const u32x4*)(p + 8 * i);
        o[8 * i + 0] = bflo(w.x); o[8 * i + 1] = bfhi(w.x); o[8 * i + 2] = bflo(w.y); o[8 * i + 3] = bfhi(w.y);
        o[8 * i + 4] = bflo(w.z); o[8 * i + 5] = bfhi(w.z); o[8 * i + 6] = bflo(w.w); o[8 * i + 7] = bfhi(w.w);
    }
}
DI float sigmoidf_(float x) { return __builtin_amdgcn_rcpf(1.f + __builtin_amdgcn_exp2f(x * -1.4426950408889634f)); }

DI void transpose_item(const float* W, int K, int N, bf16_t* WT, int ldk, int koff, const float* ks, float* scr, int item, int lane) {
    const int nblk = N / 32, kb = item / nblk, nb = item % nblk, k0 = 64 * kb, n0 = 32 * nb;
    float tv[32];
#pragma unroll
    for (int i = 0; i < 32; ++i) tv[i] = W[(size_t)(k0 + 2 * i + (lane >> 5)) * N + n0 + (lane & 31)];
    if (ks) {
#pragma unroll
        for (int i = 0; i < 32; ++i) tv[i] *= ks[k0 + 2 * i + (lane >> 5)];
    }
#pragma unroll
    for (int i = 0; i < 32; ++i) scr[(2 * i + (lane >> 5)) * 33 + (lane & 31)] = tv[i];
    asm volatile("s_waitcnt lgkmcnt(0)" ::: "memory");
    const int c = lane & 7;
#pragma unroll
    for (int j = 0; j < 4; ++j) { const int n = (lane >> 3) + 8 * j; const float* sp = scr + (8 * c) * 33 + n;
        u32x4 o; o.x = pk2(sp[0 * 33], sp[1 * 33]); o.y = pk2(sp[2 * 33], sp[3 * 33]); o.z = pk2(sp[4 * 33], sp[5 * 33]); o.w = pk2(sp[6 * 33], sp[7 * 33]);
        *(u32x4*)(WT + (size_t)(n0 + n) * ldk + koff + k0 + 8 * c) = o; }
    asm volatile("s_waitcnt lgkmcnt(0)" ::: "memory");
}

namespace pg8 {
#define PG8_LAS __attribute__((address_space(3)))
typedef unsigned short bf16_t;
typedef short bf16x8 __attribute__((ext_vector_type(8)));
typedef float f32x4 __attribute__((ext_vector_type(4)));
typedef int i32x4 __attribute__((ext_vector_type(4)));
typedef unsigned u32x4 __attribute__((ext_vector_type(4)));
template <bool I8> struct AccT { typedef f32x4 type; };
template <> struct AccT<true> { typedef i32x4 type; };
constexpr int BM = 256, BK = 64, HALF = 128, HTB = HALF * BK * 2  , STAGE_BYTES = 8 * HTB, NXCD = 8, WGM = 8;

__host__ __device__ __forceinline__ int lds_byte(int r, int c) { const int st = (r >> 4) * 2 + (c >> 5), rr = r & 15, cc = c & 31, ob = rr * 64 + cc * 2; return st * 1024 + (ob ^ (((ob >> 9) & 1) << 5)); }
__host__ __device__ __forceinline__ void stage_rc(int b, int& R, int& C) { const int st = b / 1024, sb = b % 1024, swz = sb ^ (((sb >> 9) & 1) << 5); R = (st >> 1) * 16 + swz / 64; C = (st & 1) * 32 + (swz % 64) / 2; }
__host__ __device__ __forceinline__ int perm32(int rho) { const int n = rho >> 4, i = rho & 15; return 8 * (i >> 2) + 4 * n + (i & 3); }

struct Unit { int pm, pn; };
struct Gemm { const bf16_t* A; const bf16_t* Bt; int M, N, K; };

struct StaticOrder {
    int nM, nN, nwg, G, c;
    __host__ __device__ void init(int M, int N, int G_, int c_) { nM = M / BM; nN = N / BM; nwg = nM * nN; G = G_; c = c_; }
    __host__ __device__ bool next(int i, Unit& u) const {
        const long L = (long)i * G + c; if (L >= nwg) return false;
        int wgid = (int)L; { const int q = nwg / NXCD, r = nwg % NXCD, xcd = wgid % NXCD, off = wgid / NXCD; wgid = (xcd < r ? xcd * (q + 1) : r * (q + 1) + (xcd - r) * q) + off; }
        const int nig = WGM * nN, gid = wgid / nig, fm = gid * WGM, gsz = (nM - fm) < WGM ? (nM - fm) : WGM;
        u.pm = fm + ((wgid % nig) % gsz); u.pn = (wgid % nig) / gsz; return true;
    }
    __device__ __forceinline__ void a_ready(const Unit&) const {}
    __device__ __forceinline__ void done(const Unit&) const {}
};
__device__ __forceinline__ unsigned cvt_pk_bf16(float lo, float hi) { unsigned r; asm volatile("v_cvt_pk_bf16_f32 %0, %1, %2" : "=v"(r) : "v"(lo), "v"(hi)); return r; }
template <class Epi, class Sched, bool ALIGN_EPI = false, bool SP2 = false, bool MIDK = false>
__device__ __forceinline__ void gemm_phase(PG8_LAS unsigned char* lds, const Gemm g, const Sched& S, const Epi& E) {
    const int tid = threadIdx.x, wid = __builtin_amdgcn_readfirstlane(tid >> 6), lane = tid & 63, wr = wid >> 2, wc = wid & 3, fr = lane & 15, fq = lane >> 4;
    const int K = g.K, nt = K / BK;
    unsigned voffA[2], voffB[2];
#pragma unroll
    for (int i = 0; i < 2; ++i) { int R, C; stage_rc(tid * 16 + i * 8192, R, C); const int Rb = Epi::PERM ? ((R & ~31) + perm32(R & 31)) : R;
        voffA[i] = (unsigned)(R * K + C) * 2u; voffB[i] = (unsigned)(Rb * K + C) * 2u; }
    const size_t kstep = (size_t)(BK * 2);
    const size_t hstep = (size_t)HALF * K * 2;
    const size_t tstep = 2 * hstep;
    const unsigned ldsw = (unsigned)wid * 1024u;
    const int aoff = lds_byte(wr * 64 + fr, fq * 8), boff = lds_byte(wc * 32 + fr, fq * 8);
#define PG8_SA(b, h) (((b) * 2 + (h)) * HTB)
#define PG8_SB(b, h) ((4 + (b) * 2 + (h)) * HTB)
#define PG8_STAGE(bufoff, gbase, voff) do { _Pragma("unroll") for (int _i = 0; _i < 2; ++_i) \
        __builtin_amdgcn_global_load_lds((const unsigned*)((const char*)(gbase) + (voff)[_i]), (PG8_LAS unsigned*)(lds + (bufoff) + ldsw + _i * 8192), 16, 0, 0); } while (0)
#define PG8_LDA(dst, b, h) do { _Pragma("unroll") for (int m = 0; m < 4; ++m) _Pragma("unroll") for (int k = 0; k < 2; ++k) dst[m][k] = *(const PG8_LAS bf16x8*)(lds + PG8_SA(b, h) + aoff + m * 2048 + k * 1024); } while (0)
#define PG8_LDB(dst, b, h) do { _Pragma("unroll") for (int n = 0; n < 2; ++n) _Pragma("unroll") for (int k = 0; k < 2; ++k) dst[n][k] = *(const PG8_LAS bf16x8*)(lds + PG8_SB(b, h) + boff + n * 2048 + k * 1024); } while (0)
#define PG8_MMA(ai, bj, At, Bt) do { __builtin_amdgcn_s_setprio(1); _Pragma("unroll") for (int m = 0; m < 4; ++m) _Pragma("unroll") for (int n = 0; n < 2; ++n) _Pragma("unroll") for (int k = 0; k < 2; ++k) \
        { if constexpr (Epi::I8) acc[ai][bj][m][n] = __builtin_amdgcn_mfma_i32_16x16x64_i8(__builtin_bit_cast(i32x4, Bt[n][k]), __builtin_bit_cast(i32x4, At[m][k]), acc[ai][bj][m][n], 0, 0, 0); \
          else acc[ai][bj][m][n] = __builtin_amdgcn_mfma_f32_16x16x32_bf16(Bt[n][k], At[m][k], acc[ai][bj][m][n], 0, 0, 0); } __builtin_amdgcn_s_setprio(0); } while (0)
#define PG8_WAIT_V(n) asm volatile("s_waitcnt vmcnt(" #n ")" ::: "memory")
#define PG8_WAIT_L(n) asm volatile("s_waitcnt lgkmcnt(" #n ")" ::: "memory")
#define PG8_BAR __builtin_amdgcn_s_barrier()
#define PG8_SCHED __builtin_amdgcn_sched_barrier(0)
    Unit cur, nxt; int ui = 0;
    if (!S.next(0, cur)) return;
    typedef typename AccT<Epi::I8>::type acc_t;
    acc_t acc[2][2][4][2];
    if constexpr (Epi::HAS_INIT) E.init(acc, cur, wr, wc, fr, fq);
    else {
#pragma unroll
    for (int a = 0; a < 2; ++a)
#pragma unroll
        for (int b = 0; b < 2; ++b)
#pragma unroll
            for (int m = 0; m < 4; ++m)
#pragma unroll
                for (int n = 0; n < 2; ++n) acc[a][b][m][n] = acc_t{};
    }
    bf16x8 At[4][2], B0[2][2], B1[2][2];
    const char* cA = (const char*)g.A + (size_t)cur.pm * tstep; const char* cB = (const char*)g.Bt + (size_t)cur.pn * tstep;
    S.a_ready(cur);
    if constexpr (SP2) {
        PG8_STAGE(PG8_SB(0, 0), cB, voffB); PG8_STAGE(PG8_SB(0, 1), cB + hstep, voffB); PG8_STAGE(PG8_SA(0, 0), cA, voffA); PG8_STAGE(PG8_SA(0, 1), cA + hstep, voffA);
        if (wr == 1) PG8_BAR;
        PG8_WAIT_V(2); PG8_BAR;
        PG8_STAGE(PG8_SB(1, 0), cB + kstep, voffB); PG8_STAGE(PG8_SA(1, 0), cA + kstep, voffA); PG8_STAGE(PG8_SB(1, 1), cB + hstep + kstep, voffB);
        PG8_WAIT_V(6); PG8_BAR;
    } else {
        PG8_STAGE(PG8_SB(0, 0), cB, voffB); PG8_STAGE(PG8_SA(0, 0), cA, voffA); PG8_STAGE(PG8_SB(0, 1), cB + hstep, voffB); PG8_STAGE(PG8_SA(0, 1), cA + hstep, voffA);
        if (wr == 1) PG8_BAR;
        PG8_WAIT_V(4); PG8_BAR;
        PG8_STAGE(PG8_SB(1, 0), cB + kstep, voffB); PG8_STAGE(PG8_SA(1, 0), cA + kstep, voffA); PG8_STAGE(PG8_SB(1, 1), cB + hstep + kstep, voffB);
        PG8_WAIT_V(6); PG8_BAR;
    }
    for (;;) {
        const bool has_next = S.next(ui + 1, nxt);
        const char* nA = has_next ? (const char*)g.A + (size_t)nxt.pm * tstep : cA; const char* nB = has_next ? (const char*)g.Bt + (size_t)nxt.pn * tstep : cB;
        for (int t = 0; t < nt; t += 2) {
            if constexpr (MIDK) { if (t == nt / 2) E.mid(acc, cur, wr, wc, fr, fq); }
            const bool last = (t == nt - 2);
            const char* a1 = cA + (size_t)(t + 1) * kstep;
            const char* a2 = last ? nA : cA + (size_t)(t + 2) * kstep; const char* b2 = last ? nB : cB + (size_t)(t + 2) * kstep;
            const char* a3 = a2 + kstep; const char* b3 = b2 + kstep;
            if (last && has_next) S.a_ready(nxt);
            if constexpr (SP2) {
            PG8_LDB(B0, 0, 0); PG8_LDB(B1, 0, 1); PG8_SCHED; PG8_LDA(At, 0, 0); PG8_STAGE(PG8_SA(1, 1), a1 + hstep, voffA);
            PG8_WAIT_V(8); PG8_WAIT_L(0); PG8_BAR; PG8_MMA(0, 0, At, B0); PG8_MMA(0, 1, At, B1); PG8_BAR; PG8_SCHED;
            PG8_LDA(At, 0, 1); PG8_STAGE(PG8_SB(0, 0), b2, voffB); PG8_STAGE(PG8_SB(0, 1), b2 + hstep, voffB); PG8_STAGE(PG8_SA(0, 0), a2, voffA);
            PG8_WAIT_V(8); PG8_WAIT_L(0); PG8_BAR; PG8_MMA(1, 0, At, B0); PG8_MMA(1, 1, At, B1); PG8_BAR; PG8_SCHED;
            PG8_LDB(B0, 1, 0); PG8_LDB(B1, 1, 1); PG8_SCHED; PG8_LDA(At, 1, 0); PG8_STAGE(PG8_SA(0, 1), a2 + hstep, voffA);
            PG8_WAIT_V(8); PG8_WAIT_L(0); PG8_BAR; PG8_MMA(0, 0, At, B0); PG8_MMA(0, 1, At, B1); PG8_BAR; PG8_SCHED;
            PG8_LDA(At, 1, 1); PG8_STAGE(PG8_SB(1, 0), b3, voffB); PG8_STAGE(PG8_SB(1, 1), b3 + hstep, voffB); PG8_STAGE(PG8_SA(1, 0), a3, voffA);
            PG8_WAIT_V(8); PG8_WAIT_L(0); PG8_BAR; PG8_MMA(1, 0, At, B0); PG8_MMA(1, 1, At, B1); PG8_BAR; PG8_SCHED;
            } else {
            PG8_LDB(B0, 0, 0); PG8_SCHED; PG8_LDA(At, 0, 0); PG8_STAGE(PG8_SA(1, 1), a1 + hstep, voffA);
            PG8_WAIT_L(8); PG8_BAR; PG8_WAIT_L(0); PG8_MMA(0, 0, At, B0); PG8_BAR; PG8_SCHED;
            PG8_LDB(B1, 0, 1); PG8_STAGE(PG8_SB(0, 0), b2, voffB);
            PG8_BAR; PG8_WAIT_L(0); PG8_MMA(0, 1, At, B1); PG8_BAR;
            PG8_LDA(At, 0, 1); PG8_STAGE(PG8_SA(0, 0), a2, voffA);
            PG8_BAR; PG8_WAIT_L(0); PG8_MMA(1, 0, At, B0); PG8_BAR; PG8_SCHED;
            PG8_STAGE(PG8_SB(0, 1), b2 + hstep, voffB);
            PG8_WAIT_V(6); PG8_BAR; PG8_MMA(1, 1, At, B1); PG8_BAR;
            PG8_LDB(B0, 1, 0); PG8_SCHED; PG8_LDA(At, 1, 0); PG8_STAGE(PG8_SA(0, 1), a2 + hstep, voffA);
            PG8_WAIT_L(8); PG8_BAR; PG8_WAIT_L(0); PG8_MMA(0, 0, At, B0); PG8_BAR; PG8_SCHED;
            PG8_LDB(B1, 1, 1); PG8_STAGE(PG8_SB(1, 0), b3, voffB);
            PG8_BAR; PG8_WAIT_L(0); PG8_MMA(0, 1, At, B1); PG8_BAR;
            PG8_LDA(At, 1, 1); PG8_STAGE(PG8_SA(1, 0), a3, voffA);
            PG8_BAR; PG8_WAIT_L(0); PG8_MMA(1, 0, At, B0); PG8_BAR; PG8_SCHED;
            PG8_STAGE(PG8_SB(1, 1), b3 + hstep, voffB);
            PG8_WAIT_V(6); PG8_BAR; PG8_MMA(1, 1, At, B1); PG8_BAR;
            }
        }
        if constexpr (ALIGN_EPI) { if (wr == 0) PG8_BAR; }
        if constexpr (!Epi::AFTER_DRAIN) { E(acc, cur, wr, wc, fr, fq); S.done(cur); }
        if (!has_next) break;
        if constexpr (Epi::HAS_INIT) E.init(acc, nxt, wr, wc, fr, fq);
        else {
#pragma unroll
        for (int a = 0; a < 2; ++a)
#pragma unroll
            for (int b = 0; b < 2; ++b)
#pragma unroll
                for (int m = 0; m < 4; ++m)
#pragma unroll
                    for (int n = 0; n < 2; ++n) acc[a][b][m][n] = acc_t{};
        }
        cur = nxt; cA = nA; cB = nB; ++ui;
        if constexpr (ALIGN_EPI) { if (wr == 1) PG8_BAR; }
    }
    PG8_WAIT_V(0);
    if constexpr (!ALIGN_EPI) { if (wr == 0) PG8_BAR; }
    PG8_BAR;
    if constexpr (Epi::AFTER_DRAIN) { E.fused(acc, cur, wr, wc, fr, fq, lds, wid, lane); S.done(cur); }
#undef PG8_SA
#undef PG8_SB
#undef PG8_STAGE
#undef PG8_LDA
#undef PG8_LDB
#undef PG8_MMA
#undef PG8_WAIT_V
#undef PG8_WAIT_L
#undef PG8_BAR
#undef PG8_SCHED
}
}

#define EPI_FOR(...) _Pragma("unroll") for (int ai = 0; ai < 2; ++ai) _Pragma("unroll") for (int m = 0; m < 4; ++m) { const int row = u.pm * 256 + ai * 128 + wr * 64 + m * 16 + fr; \
    _Pragma("unroll") for (int bj = 0; bj < 2; ++bj) { const int col = u.pn * 256 + bj * 128 + wc * 32 + 8 * fq; const f32x4 a0 = acc[ai][bj][m][0], a1 = acc[ai][bj][m][1]; __VA_ARGS__ } }
DI u32x4 pack8bf(f32x4 a, f32x4 b) { u32x4 w; w.x = pk2(a.x, a.y); w.y = pk2(a.z, a.w); w.z = pk2(b.x, b.y); w.w = pk2(b.z, b.w); return w; }
constexpr float C2 = 0.125f * 1.4426950408889634f;
struct EpiInProj {
    static constexpr bool PERM = true, AFTER_DRAIN = false, HAS_INIT = false, I8 = true;
    bf16_t* QK; bf16_t* KF; bf16_t* VT; bf16_t* GATES; const float* RS1  ; const float* SW  ; float* KSUM; bool ksum_on;
    DI void operator()(const pg8::i32x4 (&iacc)[2][2][4][2], const pg8::Unit& u, int wr, int wc, int fr, int fq) const {
        f32x4 acc[2][2][4][2];
#pragma unroll
        for (int bj = 0; bj < 2; ++bj) {
            const float* swp = SW + u.pn * 256 + bj * 128 + wc * 32 + 8 * fq;
            const f32x4 c0 = *(const f32x4*)swp * (1.f / 127.f), c1 = *(const f32x4*)(swp + 4) * (1.f / 127.f);
#pragma unroll
            for (int ai = 0; ai < 2; ++ai)
#pragma unroll
                for (int m = 0; m < 4; ++m) { acc[ai][bj][m][0] = __builtin_convertvector(iacc[ai][bj][m][0], f32x4) * c0; acc[ai][bj][m][1] = __builtin_convertvector(iacc[ai][bj][m][1], f32x4) * c1; }
        }
        const int seg = (u.pn * 256) >> 9;
        if (seg == 2 || seg == 5) {
            const int kind = seg == 5;
            EPI_FOR({
                const float rs = RS1[row]; const int bb = row >> 13, key = row & (SEQ - 1), kp = key & 15;
                const int nn = col - (kind ? 2560 : 1024), dim = nn & 63;
                bf16_t* vt = VT + (((size_t)((kind * 2 + bb) * NH + (nn >> 6)) * 256 + (key >> 5)) * 4 + ((dim >> 5) * 2 + ((key >> 4) & 1))) * 512 + (((kp >> 2) & 1) * 32 + (dim & 31)) * 8 + 4 * (kp >> 3) + (kp & 3);
                vt[0] = (bf16_t)f2bf(a0.x * rs); vt[8] = (bf16_t)f2bf(a0.y * rs); vt[16] = (bf16_t)f2bf(a0.z * rs); vt[24] = (bf16_t)f2bf(a0.w * rs);
                vt[32] = (bf16_t)f2bf(a1.x * rs); vt[40] = (bf16_t)f2bf(a1.y * rs); vt[48] = (bf16_t)f2bf(a1.z * rs); vt[56] = (bf16_t)f2bf(a1.w * rs);
            })
        } else if (seg == 1 || seg == 4) {
            const int kind = seg == 4;
            float cs[16];
#pragma unroll
            for (int i = 0; i < 16; ++i) cs[i] = 0.f;
            EPI_FOR({
                const float rs = RS1[row]; const f32x4 v0 = a0 * rs, v1 = a1 * rs;
                const int bb = row >> 13, key = row & (SEQ - 1), nn = col - (kind ? 2048 : 512), dim = nn & 63;
                *(u32x4*)(KF + (((size_t)((kind * 2 + bb) * NH + (nn >> 6)) * 256 + (key >> 5)) * 4 + (dim >> 4)) * 512 + (((dim >> 3) & 1) * 32 + (key & 31)) * 8) = pack8bf(v0, v1);
                if (seg == 1) { cs[bj * 8 + 0] += v0.x; cs[bj * 8 + 1] += v0.y; cs[bj * 8 + 2] += v0.z; cs[bj * 8 + 3] += v0.w; cs[bj * 8 + 4] += v1.x; cs[bj * 8 + 5] += v1.y; cs[bj * 8 + 6] += v1.z; cs[bj * 8 + 7] += v1.w; }
            })
            if (seg == 1 && ksum_on) {
                const bool b3 = (fr & 8) != 0, b2 = (fr & 4) != 0, b1 = (fr & 2) != 0, b0 = (fr & 1) != 0;
                float v8[8], v4[4];
#pragma unroll
                for (int i = 0; i < 8; ++i) v8[i] = (b3 ? cs[8 + i] : cs[i]) + __shfl_xor(b3 ? cs[i] : cs[8 + i], 8);
#pragma unroll
                for (int i = 0; i < 4; ++i) v4[i] = (b2 ? v8[4 + i] : v8[i]) + __shfl_xor(b2 ? v8[i] : v8[4 + i], 4);
                const float v20 = (b1 ? v4[2] : v4[0]) + __shfl_xor(b1 ? v4[0] : v4[2], 2), v21 = (b1 ? v4[3] : v4[1]) + __shfl_xor(b1 ? v4[1] : v4[3], 2);
                const float v1_ = (b0 ? v21 : v20) + __shfl_xor(b0 ? v20 : v21, 1);
                const int c = u.pn * 256 + (fr >> 3) * 128 + wc * 32 + 8 * fq + (fr & 7) - 512, row0 = u.pm * 256;
                atomicAdd(KSUM + ((size_t)(((row0 >> 13) * NH + (c >> 6)) * NBLK + ((row0 & (SEQ - 1)) >> 8))) * HD + (c & 63), v1_);
            }
        } else if (seg < 6) {
            const int cshift = seg == 3 ? -1024 : 0;
            EPI_FOR({ const float rs = RS1[row] * C2; *(u32x4*)(QK + (size_t)row * 1024 + col + cshift) = pack8bf(a0 * rs, a1 * rs); })
        } else {
            EPI_FOR({
                const float rs = RS1[row]; const f32x4 v0 = a0 * rs, v1 = a1 * rs;
                const f32x4 s0 = {sigmoidf_(v0.x), sigmoidf_(v0.y), sigmoidf_(v0.z), sigmoidf_(v0.w)}, s1 = {sigmoidf_(v1.x), sigmoidf_(v1.y), sigmoidf_(v1.z), sigmoidf_(v1.w)};
                *(u32x4*)(GATES + (size_t)row * GATEW + col - QKVW) = pack8bf(s0, s1);
            })
        }
    }
};
struct EpiMix {
    static constexpr bool PERM = true, AFTER_DRAIN = false, HAS_INIT = false, I8 = false;
    const bf16_t* GATES; bf16_t* MIXED;
    DI void mid(f32x4 (&acc)[2][2][4][2], const pg8::Unit& u, int wr, int wc, int fr_in, int fq_in) const {
        int fr = fr_in, fq = fq_in; asm volatile("" : "+v"(fr), "+v"(fq));
#pragma unroll
        for (int ai = 0; ai < 2; ++ai)
#pragma unroll
            for (int m = 0; m < 4; ++m) { const int row = u.pm * 256 + ai * 128 + wr * 64 + m * 16 + fr;
#pragma unroll
                for (int bj = 0; bj < 2; ++bj) { const int col = u.pn * 256 + bj * 128 + wc * 32 + 8 * fq;
                    const u32x4 ga = *(const u32x4*)(GATES + (size_t)row * GATEW + col), gb = *(const u32x4*)(GATES + (size_t)row * GATEW + 1024 + col);
                    const float r0 = bflo(ga.x) * __builtin_amdgcn_rcpf(fmaxf(bflo(gb.x), 1e-30f)), r1 = bfhi(ga.x) * __builtin_amdgcn_rcpf(fmaxf(bfhi(gb.x), 1e-30f));
                    const float r2 = bflo(ga.y) * __builtin_amdgcn_rcpf(fmaxf(bflo(gb.y), 1e-30f)), r3 = bfhi(ga.y) * __builtin_amdgcn_rcpf(fmaxf(bfhi(gb.y), 1e-30f));
                    const float r4 = bflo(ga.z) * __builtin_amdgcn_rcpf(fmaxf(bflo(gb.z), 1e-30f)), r5 = bfhi(ga.z) * __builtin_amdgcn_rcpf(fmaxf(bfhi(gb.z), 1e-30f));
                    const float r6 = bflo(ga.w) * __builtin_amdgcn_rcpf(fmaxf(bflo(gb.w), 1e-30f)), r7 = bfhi(ga.w) * __builtin_amdgcn_rcpf(fmaxf(bfhi(gb.w), 1e-30f));
                    acc[ai][bj][m][0] = acc[ai][bj][m][0] * (f32x4){r0, r1, r2, r3}; acc[ai][bj][m][1] = acc[ai][bj][m][1] * (f32x4){r4, r5, r6, r7}; }
                __builtin_amdgcn_sched_barrier(0); }
    }
    DI void operator()(const f32x4 (&acc)[2][2][4][2], const pg8::Unit& u, int wr, int wc, int fr, int fq) const {
        EPI_FOR({
            const u32x4 gb = *(const u32x4*)(GATES + (size_t)row * GATEW + 1024 + col);
            const f32x4 s0 = {fmaxf(bflo(gb.x), 1e-30f), fmaxf(bfhi(gb.x), 1e-30f), fmaxf(bflo(gb.y), 1e-30f), fmaxf(bfhi(gb.y), 1e-30f)};
            const f32x4 s1 = {fmaxf(bflo(gb.z), 1e-30f), fmaxf(bfhi(gb.z), 1e-30f), fmaxf(bflo(gb.w), 1e-30f), fmaxf(bfhi(gb.w), 1e-30f)};
            *(u32x4*)(MIXED + (size_t)row * DM + col) = pack8bf(a0 * s0, a1 * s1);
        })
    }
};
struct EpiResid {
    static constexpr bool PERM = true, AFTER_DRAIN = false, HAS_INIT = true, I8 = false;
    const float* X; bf16_t* HB;
    DI void init(f32x4 (&acc)[2][2][4][2], const pg8::Unit& u, int wr, int wc, int fr, int fq) const {
#pragma unroll
        for (int ai = 0; ai < 2; ++ai)
#pragma unroll
            for (int m = 0; m < 4; ++m) { const int row = u.pm * 256 + ai * 128 + wr * 64 + m * 16 + fr;
#pragma unroll
                for (int bj = 0; bj < 2; ++bj) { const float* xp = X + (size_t)row * DM + u.pn * 256 + bj * 128 + wc * 32 + 8 * fq; acc[ai][bj][m][0] = *(const f32x4*)xp; acc[ai][bj][m][1] = *(const f32x4*)(xp + 4); } }
    }
    DI void operator()(const f32x4 (&acc)[2][2][4][2], const pg8::Unit& u, int wr, int wc, int fr, int fq) const {
        EPI_FOR({ *(u32x4*)(HB + (size_t)row * DM + col) = pack8bf(a0, a1); })
    }
};
struct EpiPeerQ {
    static constexpr bool PERM = true, AFTER_DRAIN = false, HAS_INIT = false, I8 = false;
    bf16_t* Q2;
    DI void operator()(const f32x4 (&acc)[2][2][4][2], const pg8::Unit& u, int wr, int wc, int fr, int fq) const {
        EPI_FOR({ *(u32x4*)(Q2 + (size_t)row * PQW + col) = pack8bf(a0, a1); })
    }
};


DI void h_rows4(const bf16_t* H, float* RS2, float* SH, signed char* H8, int row0, int stride, int lane) {
    u32x4 a[4][2];
#pragma unroll
    for (int k = 0; k < 4; ++k)
#pragma unroll
        for (int j = 0; j < 2; ++j) a[k][j] = *(const u32x4*)(H + (size_t)(row0 + k * stride) * DM + lane * 16 + 8 * j);
#pragma unroll
    for (int k = 0; k < 4; ++k) {
        const int row = row0 + k * stride;
        float v[16];
#pragma unroll
        for (int j = 0; j < 2; ++j) { v[8 * j] = bflo(a[k][j].x); v[8 * j + 1] = bfhi(a[k][j].x); v[8 * j + 2] = bflo(a[k][j].y); v[8 * j + 3] = bfhi(a[k][j].y);
            v[8 * j + 4] = bflo(a[k][j].z); v[8 * j + 5] = bfhi(a[k][j].z); v[8 * j + 6] = bflo(a[k][j].w); v[8 * j + 7] = bfhi(a[k][j].w); }
        float ss = 0.f, am = 0.f;
#pragma unroll
        for (int j = 0; j < 16; ++j) { ss += v[j] * v[j]; am = fmaxf(am, fabsf(v[j])); }
        ss = wave_sum(ss);
#pragma unroll
        for (int o = 32; o >= 1; o >>= 1) am = fmaxf(am, __shfl_xor(am, o));
        const float sc = am > 0.f ? am * (1.f / 127.f) : 1.f, isc = 1.f / sc;
        unsigned w[4];
#pragma unroll
        for (int j = 0; j < 4; ++j) w[j] = q8x4(v[4 * j], v[4 * j + 1], v[4 * j + 2], v[4 * j + 3], isc);
        *(u32x4*)(H8 + (size_t)row * DM + lane * 16) = (u32x4){w[0], w[1], w[2], w[3]};
        if (lane == 0) { RS2[row] = rsqrtf(ss * (1.f / DM) + RMS_EPS); SH[row] = sc; }
    }
}

template <int NR>
DI void quant_rows(const float* pu, const float* pv, const float* g2, unsigned char* U8, unsigned char* V8, float* SU, float* SV, int row0, int stride, int lane) {
    f32x4 a[NR][4];
#pragma unroll
    for (int k = 0; k < NR; ++k) { const int row = row0 + k * stride, isv = row >= NEXP, e = row - (isv ? NEXP : 0); const float* src = (isv ? pv : pu) + (size_t)e * DM + lane * 16;
#pragma unroll
        for (int j = 0; j < 4; ++j) a[k][j] = *(const f32x4*)(src + 4 * j); }
    f32x4 gq[4];
#pragma unroll
    for (int j = 0; j < 4; ++j) gq[j] = *(const f32x4*)(g2 + lane * 16 + 4 * j);
#pragma unroll
    for (int k = 0; k < NR; ++k) {
        const int row = row0 + k * stride, isv = row >= NEXP, e = row - (isv ? NEXP : 0);
        float v[16];
#pragma unroll
        for (int j = 0; j < 4; ++j) { const f32x4 x = isv ? a[k][j] : a[k][j] * gq[j]; v[4 * j] = x.x; v[4 * j + 1] = x.y; v[4 * j + 2] = x.z; v[4 * j + 3] = x.w; }
        float am = 0.f;
#pragma unroll
        for (int j = 0; j < 16; ++j) am = fmaxf(am, fabsf(v[j]));
#pragma unroll
        for (int o = 32; o >= 1; o >>= 1) am = fmaxf(am, __shfl_xor(am, o));
        const float sc = am > 0.f ? am * (1.f / 127.f) : 1.f, isc = 1.f / sc;
        unsigned w[4];
#pragma unroll
        for (int j = 0; j < 4; ++j) w[j] = q8x4(v[4 * j], v[4 * j + 1], v[4 * j + 2], v[4 * j + 3], isc);
        unsigned char* dst = (isv ? V8 : U8) + ((size_t)((lane >> 3) * NEXP + e)) * 128 + (lane & 7) * 16;
        *(u32x4*)dst = (u32x4){w[0], w[1], w[2], w[3]};
        if (lane == 0) (isv ? SV : SU)[e] = sc;
    }
}

typedef float f32x16 __attribute__((ext_vector_type(16)));
#define MFMA32(a, b, c) __builtin_amdgcn_mfma_f32_32x32x16_bf16((a), (b), (c), 0, 0, 0)
constexpr float FLT_MIN_ = 1.17549435e-38f;

struct KV { bf16x8 k[4], v[4]; };
DI void load_kv(KV& f, const bf16_t* kp, const bf16_t* vp) {
#pragma unroll
    for (int i = 0; i < 4; ++i) { f.k[i] = *(const bf16x8*)(kp + 512 * i); f.v[i] = *(const bf16x8*)(vp + 512 * i); }
}
DI void load_kv_async(KV& f, const bf16_t* kp, const bf16_t* vp) {
    asm volatile("global_load_dwordx4 %0, %4, off\n\tglobal_load_dwordx4 %1, %4, off offset:1024\n\tglobal_load_dwordx4 %2, %4, off offset:2048\n\tglobal_load_dwordx4 %3, %4, off offset:3072"
                 : "=&v"(f.k[0]), "=&v"(f.k[1]), "=&v"(f.k[2]), "=&v"(f.k[3]) : "v"(kp) : "memory");
    asm volatile("global_load_dwordx4 %0, %4, off\n\tglobal_load_dwordx4 %1, %4, off offset:1024\n\tglobal_load_dwordx4 %2, %4, off offset:2048\n\tglobal_load_dwordx4 %3, %4, off offset:3072"
                 : "=&v"(f.v[0]), "=&v"(f.v[1]), "=&v"(f.v[2]), "=&v"(f.v[3]) : "v"(vp) : "memory");
}
#define KV_WAIT_K(f, N) asm volatile("s_waitcnt vmcnt(" #N ")" : "+v"(f.k[0]), "+v"(f.k[1]), "+v"(f.k[2]), "+v"(f.k[3]) :: "memory")
#define KV_WAIT_V(f, N) asm volatile("s_waitcnt vmcnt(" #N ")" : "+v"(f.v[0]), "+v"(f.v[1]), "+v"(f.v[2]), "+v"(f.v[3]) :: "memory")
DI bf16x8 pack8(const f32x16& p, int s) {
    u32x4 w;
    if (s == 0) { w.x = cvtpk(p[0], p[1]); w.y = cvtpk(p[2], p[3]); w.z = cvtpk(p[4], p[5]); w.w = cvtpk(p[6], p[7]); }
    else { w.x = cvtpk(p[8], p[9]); w.y = cvtpk(p[10], p[11]); w.z = cvtpk(p[12], p[13]); w.w = cvtpk(p[14], p[15]); }
    return __builtin_bit_cast(bf16x8, w);
}
struct SmState { float m, l; f32x16 o0, o1; };
typedef float f32x2 __attribute__((ext_vector_type(2)));
DI float sum16(const f32x16& p) {
    const f32x2 s0 = (f32x2){p[0], p[1]} + (f32x2){p[2], p[3]}, s1 = (f32x2){p[4], p[5]} + (f32x2){p[6], p[7]};
    const f32x2 s2 = (f32x2){p[8], p[9]} + (f32x2){p[10], p[11]}, s3 = (f32x2){p[12], p[13]} + (f32x2){p[14], p[15]};
    const f32x2 t0 = s0 + s1, t1 = s2 + s3, u = t0 + t1;
    return u.x + u.y;
}
constexpr float LAZY_THR = 1.0995116e12f;
template <int WK = -1, int WV = -1>
DI void moba_tile_first(SmState& st, KV& f, const bf16x8 (&qf)[4], float bias0, float slopeL, int maskrow, int hh) {
    f32x16 acc;
#pragma unroll
    for (int r = 0; r < 16; ++r) acc[r] = bias0 + slopeL * (float)((r & 3) + 8 * (r >> 2));
    if constexpr (WK == 12) KV_WAIT_K(f, 12); else if constexpr (WK == 4) KV_WAIT_K(f, 4);
#pragma unroll
    for (int ks = 0; ks < 4; ++ks) acc = MFMA32(f.k[ks], qf[ks], acc);
    if (maskrow < 32) {
#pragma unroll
        for (int r = 0; r < 16; ++r) if ((r & 3) + 8 * (r >> 2) + 4 * hh > maskrow) acc[r] = -1e30f;
    }
    float tm = acc[0];
#pragma unroll
    for (int r = 1; r < 16; ++r) tm = fmaxf(tm, acc[r]);
    tm = fmaxf(tm, __shfl_xor(tm, 32));
    f32x16 pw;
#pragma unroll
    for (int r = 0; r < 16; ++r) pw[r] = __builtin_amdgcn_exp2f(acc[r] - tm);
    st.m = tm; st.l = sum16(pw);
    const bf16x8 p0 = pack8(pw, 0), p1 = pack8(pw, 1);
    if constexpr (WV == 8) KV_WAIT_V(f, 8); else if constexpr (WV == 0) KV_WAIT_V(f, 0);
    f32x16 z;
#pragma unroll
    for (int r = 0; r < 16; ++r) z[r] = 0.f;
    st.o0 = MFMA32(f.v[0], p0, z); st.o0 = MFMA32(f.v[1], p1, st.o0);
    st.o1 = MFMA32(f.v[2], p0, z); st.o1 = MFMA32(f.v[3], p1, st.o1);
}
template <int WK = -1, int WV = -1>
DI void moba_tile_lazy(SmState& st, KV& f, const bf16x8 (&qf)[4], float bias0, float slopeL, int hh) {
    f32x16 acc;
    const float b0 = bias0 - st.m;
#pragma unroll
    for (int r = 0; r < 16; ++r) acc[r] = b0 + slopeL * (float)((r & 3) + 8 * (r >> 2));
    if constexpr (WK == 12) KV_WAIT_K(f, 12); else if constexpr (WK == 4) KV_WAIT_K(f, 4);
#pragma unroll
    for (int ks = 0; ks < 4; ++ks) acc = MFMA32(f.k[ks], qf[ks], acc);
    f32x16 pw;
#pragma unroll
    for (int r = 0; r < 16; ++r) pw[r] = __builtin_amdgcn_exp2f(acc[r]);
    float ps = sum16(pw);
    if (__builtin_expect(__any(!(ps <= LAZY_THR)), 0)) {
        const int nl = !(ps <= LAZY_THR);
        const bool need = (nl | __shfl_xor(nl, 32)) != 0;
        float tm = acc[0];
#pragma unroll
        for (int r = 1; r < 16; ++r) tm = fmaxf(tm, acc[r]);
        tm = fmaxf(tm, __shfl_xor(tm, 32));
        const float d = need ? tm : 0.f, al = __builtin_amdgcn_exp2f(-d);
        st.m += d; st.l *= al; st.o0 = st.o0 * al; st.o1 = st.o1 * al;
#pragma unroll
        for (int r = 0; r < 16; ++r) pw[r] = __builtin_amdgcn_exp2f(acc[r] - d);
        ps = sum16(pw);
    }
    st.l += ps;
    const bf16x8 p0 = pack8(pw, 0), p1 = pack8(pw, 1);
    if constexpr (WV == 8) KV_WAIT_V(f, 8); else if constexpr (WV == 0) KV_WAIT_V(f, 0);
    st.o0 = MFMA32(f.v[0], p0, st.o0); st.o0 = MFMA32(f.v[1], p1, st.o0);
    st.o1 = MFMA32(f.v[2], p0, st.o1); st.o1 = MFMA32(f.v[3], p1, st.o1);
}
DI void moba_pass_own(SmState& st, const bf16x8 (&qf)[4], const bf16_t* kt0, const bf16_t* vt0, int w, int maskrow, float bb, float slopeL, int hh) {
    KV fa, fb;
    const float bs = slopeL * 32.f;
    load_kv(fa, kt0 + (size_t)w * 2048, vt0 + (size_t)w * 2048);
    if (w >= 1) load_kv(fb, kt0 + (size_t)(w - 1) * 2048, vt0 + (size_t)(w - 1) * 2048);
    moba_tile_first(st, fa, qf, bb + (float)w * bs, slopeL, maskrow, hh);
#pragma unroll 1
    for (int kt = w - 1; kt >= 0; kt -= 2) {
        if (kt >= 1) load_kv(fa, kt0 + (size_t)(kt - 1) * 2048, vt0 + (size_t)(kt - 1) * 2048);
        moba_tile_lazy(st, fb, qf, bb + (float)kt * bs, slopeL, hh);
        if (kt >= 1) {
            if (kt >= 2) load_kv(fb, kt0 + (size_t)(kt - 2) * 2048, vt0 + (size_t)(kt - 2) * 2048);
            moba_tile_lazy(st, fa, qf, bb + (float)(kt - 1) * bs, slopeL, hh);
        }
    }
}
template <bool MASKED>
DI void sb_tile(f32x16& o0, f32x16& o1, float& carry, const KV& f, const bf16x8 (&qf)[4], int maskrow, int hh) {
    f32x16 acc;
#pragma unroll
    for (int r = 0; r < 16; ++r) acc[r] = 0.f;
#pragma unroll
    for (int ks = 0; ks < 4; ++ks) acc = MFMA32(f.k[ks], qf[ks], acc);
    float bt[16], fc[16];
#pragma unroll
    for (int r = 0; r < 16; ++r) {
        const float z = acc[r];
        const float e = __builtin_amdgcn_exp2f(-fabsf(z)), rr = __builtin_amdgcn_rcpf(1.f + e), er = e * rr;
        const bool pos = z >= 0.f, msk = MASKED && ((r & 3) + 8 * (r >> 2) + 4 * hh) >= maskrow;
        bt[r] = msk ? 0.f : (pos ? rr : er);
        fc[r] = msk ? 1.f : (pos ? er : rr);
    }
    float G[4], Gp[4], wf[16];
#pragma unroll
    for (int g = 0; g < 4; ++g) {
        const float s3 = fc[4 * g + 3], s2 = s3 * fc[4 * g + 2], s1 = s2 * fc[4 * g + 1];
        G[g] = s1 * fc[4 * g];
        wf[4 * g + 3] = bt[4 * g + 3]; wf[4 * g + 2] = bt[4 * g + 2] * s3; wf[4 * g + 1] = bt[4 * g + 1] * s2; wf[4 * g] = bt[4 * g] * s1;
    }
#pragma unroll
    for (int g = 0; g < 4; ++g) Gp[g] = __shfl_xor(G[g], 32);
    const float T0 = G[0] * Gp[0], T1 = G[1] * Gp[1], T2 = G[2] * Gp[2], T3 = G[3] * Gp[3];
    const float RR2 = T3, RR1 = T3 * T2, RR0 = RR1 * T1, total = RR0 * T0;
    float base[4];
    base[3] = carry * (hh == 0 ? Gp[3] : 1.f);
    base[2] = carry * RR2 * (hh == 0 ? Gp[2] : 1.f);
    base[1] = carry * RR1 * (hh == 0 ? Gp[1] : 1.f);
    base[0] = carry * RR0 * (hh == 0 ? Gp[0] : 1.f);
    f32x16 pw;
#pragma unroll
    for (int r = 0; r < 16; ++r) pw[r] = wf[r] * base[r >> 2];
    carry *= total;
    const bf16x8 p0 = pack8(pw, 0), p1 = pack8(pw, 1);
    o0 = MFMA32(f.v[0], p0, o0); o0 = MFMA32(f.v[1], p1, o0);
    o1 = MFMA32(f.v[2], p0, o1); o1 = MFMA32(f.v[3], p1, o1);
}
DI void store_o(bf16_t* orow  , const f32x16& o0, const f32x16& o1, float sc) {
#pragma unroll
    for (int g = 0; g < 4; ++g) {
        u32x2 a; a.x = cvtpk(o0[4 * g] * sc, o0[4 * g + 1] * sc); a.y = cvtpk(o0[4 * g + 2] * sc, o0[4 * g + 3] * sc); *(u32x2*)(orow + 8 * g) = a;
        u32x2 c; c.x = cvtpk(o1[4 * g] * sc, o1[4 * g + 1] * sc); c.y = cvtpk(o1[4 * g + 2] * sc, o1[4 * g + 3] * sc); *(u32x2*)(orow + 32 + 8 * g) = c;
    }
}
constexpr int ML_OPART = 0;
constexpr int ML_ML = 4 * 256 * 68 * 2;
constexpr int ML_LISTS = ML_ML + 4 * 256 * 2 * 4;
constexpr int ML_SELS = ML_LISTS + 32 * 256;
constexpr int ML_CNT = ML_SELS + 1024;
constexpr int ML_UST = ML_CNT + 128;
constexpr int ML_QCTR = ML_UST + 144;
constexpr int ML_ITEM = ML_QCTR + 16;
constexpr int ML_UJ = ML_ITEM + 16;
static_assert(ML_UJ + 64 <= LDS_BYTES - 16, "MoBA LDS map");
DI void top3_insert(float s, int b, float& v0, float& v1, float& v2, int& i0, int& i1, int& i2) {
    const bool g0 = s > v0, g1 = s > v1, g2 = s > v2;
    v2 = g1 ? v1 : (g2 ? s : v2); i2 = g1 ? i1 : (g2 ? b : i2);
    v1 = g0 ? v0 : (g1 ? s : v1); i1 = g0 ? i0 : (g1 ? b : i1);
    v0 = g0 ? s : v0; i0 = g0 ? b : i0;
}
DI int p3_order(int i) {
    constexpr unsigned long long W0 = 0x1918171612151413ull, W1 = 0x1d1c1e1b0b1f1a11ull, W2 = 0x08070d0e0f0c0a10ull, W3 = 0x0001020403050906ull;
    const unsigned long long w = (i >> 3) == 0 ? W0 : ((i >> 3) == 1 ? W1 : ((i >> 3) == 2 ? W2 : W3));
    return (int)((w >> (8 * (i & 7))) & 255ull);
}
DI void sb_group(const bf16_t* QK, const bf16_t* KF, const bf16_t* VT, bf16_t* OB, int b, int head, int qt) {
    const int tid = threadIdx.x, wave = tid >> 6; int lane = tid & 63;
    asm volatile("" : "+v"(lane));
    const int r = lane & 31, hh = lane >> 5;
    const bf16_t* kp = KF + (size_t)((1 * 2 + b) * NH + head) * 256 * 2048 + lane * 8;
    const bf16_t* vp = VT + (size_t)((1 * 2 + b) * NH + head) * 256 * 2048 + lane * 8;
    const int kt0 = 8 * qt + wave, t = 32 * kt0 + r;
    const bf16_t* qp = QK + (size_t)(b * SEQ + t) * 1024 + 512 + head * HD + 8 * hh;
    bf16x8 qf[4];
#pragma unroll
    for (int ks = 0; ks < 4; ++ks) qf[ks] = *(const bf16x8*)(qp + 16 * ks);
    f32x16 o0, o1;
#pragma unroll
    for (int x = 0; x < 16; ++x) { o0[x] = 0.f; o1[x] = 0.f; }
    float carry = 1.f;
    KV fa, fb;
    int kt = kt0;
    load_kv(fa, kp + (size_t)kt * 2048, vp + (size_t)kt * 2048);
    if (kt >= 1) load_kv(fb, kp + (size_t)(kt - 1) * 2048, vp + (size_t)(kt - 1) * 2048);
    asm volatile("" ::: "memory");
    sb_tile<true>(o0, o1, carry, fa, qf, r, hh);
    if (!(kt < 1 || __all(carry < FLT_MIN_))) {
        for (;;) {
            if (kt >= 2) load_kv(fa, kp + (size_t)(kt - 2) * 2048, vp + (size_t)(kt - 2) * 2048);
            asm volatile("" ::: "memory");
            sb_tile<false>(o0, o1, carry, fb, qf, 32, hh);
            if (kt < 2 || __all(carry < FLT_MIN_)) break;
            if (kt >= 3) load_kv(fb, kp + (size_t)(kt - 3) * 2048, vp + (size_t)(kt - 3) * 2048);
            asm volatile("" ::: "memory");
            sb_tile<false>(o0, o1, carry, fa, qf, 32, hh);
            if (kt < 3 || __all(carry < FLT_MIN_)) break;
            kt -= 2;
        }
    }
    store_o(OB + (size_t)(b * SEQ + t) * (2 * WA) + WA + head * HD + 4 * hh, o0, o1, 1.f);
}
DI void moba_group(unsigned char* lds, const bf16_t* QK, const bf16_t* KF, const bf16_t* VT, const float* KSUM, bf16_t* OA, int b, int head, int og, bool with_sb) {
    const int tid = threadIdx.x, wave = tid >> 6; int lane = tid & 63;
    asm volatile("" : "+v"(lane));
    const int r = lane & 31, hh = lane >> 5;
    bf16_t* OPART = (bf16_t*)(lds + ML_OPART); float* MLS = (float*)(lds + ML_ML); unsigned char* LISTS = lds + ML_LISTS; unsigned char* SELS = lds + ML_SELS;
    int* CNT = (int*)(lds + ML_CNT); int* UST = (int*)(lds + ML_UST);
    const float slopeL = 1.4426950408889634f * exp2f(-(float)(head + 1));
    const bf16_t* kp = KF + (size_t)((0 * 2 + b) * NH + head) * 256 * 2048 + lane * 8;
    const bf16_t* vp = VT + (size_t)((0 * 2 + b) * NH + head) * 256 * 2048 + lane * 8;
    const bf16_t* qbase = QK + (size_t)(b * SEQ) * 1024 + head * HD + 8 * hh;
    __syncthreads();
    if (tid < 32) CNT[tid] = 0;
    __syncthreads();
    {
        const int c = 32 * wave + r;
        const bf16_t* qp = qbase + (size_t)(256 * og + c) * 1024;
        bf16x8 qf[4];
#pragma unroll
        for (int ks = 0; ks < 4; ++ks) qf[ks] = *(const bf16x8*)(qp + 16 * ks);
        f32x16 acc;
#pragma unroll
        for (int i = 0; i < 16; ++i) acc[i] = 0.f;
        const float* km = KSUM + ((size_t)(b * NH + head) * NBLK + r) * HD + 8 * hh;
#pragma unroll
        for (int ks = 0; ks < 4; ++ks) {
            const f32x4 s0 = *(const f32x4*)(km + 16 * ks) * (1.f / MBLK), s1 = *(const f32x4*)(km + 16 * ks + 4) * (1.f / MBLK);
            const float mv[8] = {s0.x, s0.y, s0.z, s0.w, s1.x, s1.y, s1.z, s1.w};
            unsigned hb[8], lb[8];
#pragma unroll
            for (int e = 0; e < 8; ++e) { hb[e] = f2bf(mv[e]); lb[e] = f2bf(mv[e] - bf2f(hb[e])); }
            const u32x4 hw = {hb[0] | (hb[1] << 16), hb[2] | (hb[3] << 16), hb[4] | (hb[5] << 16), hb[6] | (hb[7] << 16)};
            const u32x4 lw = {lb[0] | (lb[1] << 16), lb[2] | (lb[3] << 16), lb[4] | (lb[5] << 16), lb[6] | (lb[7] << 16)};
            acc = MFMA32(__builtin_bit_cast(bf16x8, hw), qf[ks], acc); acc = MFMA32(__builtin_bit_cast(bf16x8, lw), qf[ks], acc);
        }
        float v0 = -INFINITY, v1 = -INFINITY, v2 = -INFINITY; int i0 = -1, i1 = -1, i2 = -1;
#pragma unroll
        for (int i = 0; i < 16; ++i) { const int blk = (i & 3) + 8 * (i >> 2) + 4 * hh; const float sv = blk < og ? acc[i] : -INFINITY; top3_insert(sv, blk, v0, v1, v2, i0, i1, i2); }
        const float pv0 = __shfl_xor(v0, 32), pv1 = __shfl_xor(v1, 32), pv2 = __shfl_xor(v2, 32);
        const int pi0 = __shfl_xor(i0, 32), pi1 = __shfl_xor(i1, 32), pi2 = __shfl_xor(i2, 32);
        top3_insert(pv0, pi0, v0, v1, v2, i0, i1, i2); top3_insert(pv1, pi1, v0, v1, v2, i0, i1, i2); top3_insert(pv2, pi2, v0, v1, v2, i0, i1, i2);
        if (hh == 0) {
            SELS[c * 4 + 0] = (unsigned char)(i0 < 0 ? 255 : i0); SELS[c * 4 + 1] = (unsigned char)(i1 < 0 ? 255 : i1); SELS[c * 4 + 2] = (unsigned char)(i2 < 0 ? 255 : i2);
            if (i0 >= 0) { const int ps = atomicAdd(&CNT[i0], 1); LISTS[i0 * 256 + ps] = (unsigned char)c; }
            if (i1 >= 0) { const int ps = atomicAdd(&CNT[i1], 1); LISTS[i1 * 256 + ps] = (unsigned char)c; }
            if (i2 >= 0) { const int ps = atomicAdd(&CNT[i2], 1); LISTS[i2 * 256 + ps] = (unsigned char)c; }
        }
    }
    __syncthreads();
    if (wave == 0) {
        const int jx = lane & 31, n = (CNT[jx] + 31) >> 5;
        int inc = n;
#pragma unroll
        for (int o = 1; o < 32; o <<= 1) { const int v = __shfl_up(inc, o, 32); if (jx >= o) inc += v; }
        const int st0 = inc - n;
        if (lane < 32) {
            UST[jx] = st0;
            unsigned char* UJ = lds + ML_UJ;
            for (int q = 0; q < n; ++q) UJ[st0 + q] = (unsigned char)jx;
            if (jx == 31) UST[32] = inc;
        }
        if (lane == 0) { *(volatile int*)(lds + ML_QCTR) = 0; }
    }
    __syncthreads();
    {
        const int Usel = UST[32], Utot = Usel + 8;
        int* qctr = (int*)(lds + ML_QCTR);
        int u = 0;
        if (lane == 0) u = atomicAdd(qctr, 1);
        u = __builtin_amdgcn_readfirstlane(u);
        const int sb_after = __builtin_amdgcn_readfirstlane(wave) >> 1;
        bool sb_done = !with_sb; int nun = 0;
        for (;;) {
            const bool have = u < Utot;
            if (!sb_done && (nun == sb_after || !have)) { sb_group(QK, KF, VT, OA, b, head, og); sb_done = true; }
            if (!have) break;
            ++nun;
            int un = 0;
            if (lane == 0) un = atomicAdd(qctr, 1);
            int j, slot, qi; bool valid;
            SmState st;
            if (u < Usel) {
                j = __builtin_amdgcn_readfirstlane((int)(lds + ML_UJ)[u]);
                const bf16_t* kt0 = kp + (size_t)(8 * j) * 2048; const bf16_t* vt0 = vp + (size_t)(8 * j) * 2048;
                KV fa, fb;
                load_kv_async(fa, kt0 + 7 * 2048, vt0 + 7 * 2048); load_kv_async(fb, kt0 + 6 * 2048, vt0 + 6 * 2048);
                const int i = u - UST[j], idx = 32 * i + r;
                valid = idx < CNT[j];
                qi = LISTS[j * 256 + (valid ? idx : 32 * i)];
                slot = (SELS[qi * 4] == j) ? 0 : ((SELS[qi * 4 + 1] == j) ? 1 : 2);
                const int t = 256 * og + qi;
                const bf16_t* qp = qbase + (size_t)t * 1024;
                bf16x8 qf[4];
#pragma unroll
                for (int ks = 0; ks < 4; ++ks) qf[ks] = *(const bf16x8*)(qp + 16 * ks);
                const float bb = slopeL * (float)(256 * j + 4 * hh - t), bs = slopeL * 32.f;
                moba_tile_first<12, 8>(st, fa, qf, bb + 7.f * bs, slopeL, 64, hh);   load_kv_async(fa, kt0 + 5 * 2048, vt0 + 5 * 2048);
                moba_tile_lazy<12, 8>(st, fb, qf, bb + 6.f * bs, slopeL, hh);        load_kv_async(fb, kt0 + 4 * 2048, vt0 + 4 * 2048);
                moba_tile_lazy<12, 8>(st, fa, qf, bb + 5.f * bs, slopeL, hh);        load_kv_async(fa, kt0 + 3 * 2048, vt0 + 3 * 2048);
                moba_tile_lazy<12, 8>(st, fb, qf, bb + 4.f * bs, slopeL, hh);        load_kv_async(fb, kt0 + 2 * 2048, vt0 + 2 * 2048);
                moba_tile_lazy<12, 8>(st, fa, qf, bb + 3.f * bs, slopeL, hh);        load_kv_async(fa, kt0 + 1 * 2048, vt0 + 1 * 2048);
                moba_tile_lazy<12, 8>(st, fb, qf, bb + 2.f * bs, slopeL, hh);        load_kv_async(fb, kt0, vt0);
                moba_tile_lazy<12, 8>(st, fa, qf, bb + bs, slopeL, hh);
                moba_tile_lazy<4, 0>(st, fb, qf, bb, slopeL, hh);
            } else {
                const int w = 7 - (u - Usel);
                j = og; qi = 32 * w + r; valid = true; slot = 3;
                const int t = 256 * og + qi;
                const bf16_t* qp = qbase + (size_t)t * 1024;
                bf16x8 qf[4];
#pragma unroll
                for (int ks = 0; ks < 4; ++ks) qf[ks] = *(const bf16x8*)(qp + 16 * ks);
                moba_pass_own(st, qf, kp + (size_t)(8 * og) * 2048, vp + (size_t)(8 * og) * 2048, w, r, slopeL * (float)(256 * og + 4 * hh - t), slopeL, hh);
            }
            const float lt = st.l + __shfl_xor(st.l, 32), inv = 1.f / lt;
            if (valid) {
                bf16_t* op = OPART + (size_t)(slot * 256 + qi) * 68 + 4 * hh;
#pragma unroll
                for (int g = 0; g < 4; ++g) {
                    u32x2 a; a.x = cvtpk(st.o0[4 * g] * inv, st.o0[4 * g + 1] * inv); a.y = cvtpk(st.o0[4 * g + 2] * inv, st.o0[4 * g + 3] * inv); *(u32x2*)(op + 8 * g) = a;
                    u32x2 c; c.x = cvtpk(st.o1[4 * g] * inv, st.o1[4 * g + 1] * inv); c.y = cvtpk(st.o1[4 * g + 2] * inv, st.o1[4 * g + 3] * inv); *(u32x2*)(op + 32 + 8 * g) = c;
                }
                if (hh == 0) { MLS[(slot * 256 + qi) * 2] = st.m; MLS[(slot * 256 + qi) * 2 + 1] = lt; }
            }
            u = __builtin_amdgcn_readfirstlane(un);
        }
    }
    __syncthreads();
    {
        const int c = 32 * wave + r, t = 256 * og + c;
        float M = -1e30f, ms[4], ls[4];
#pragma unroll
        for (int sl = 0; sl < 4; ++sl) {
            const bool v = sl == 3 || SELS[c * 4 + sl] != 255;
            ms[sl] = v ? MLS[(sl * 256 + c) * 2] : -1e30f; ls[sl] = v ? MLS[(sl * 256 + c) * 2 + 1] : 0.f;
            M = fmaxf(M, ms[sl]);
        }
        float L = 0.f; f32x16 o0, o1;
#pragma unroll
        for (int x = 0; x < 16; ++x) { o0[x] = 0.f; o1[x] = 0.f; }
#pragma unroll
        for (int sl = 0; sl < 4; ++sl) {
            const float w = ls[sl] * __builtin_amdgcn_exp2f(ms[sl] - M);
            L += w;
            const bf16_t* op = OPART + (size_t)(sl * 256 + c) * 68 + 4 * hh;
            if (ls[sl] > 0.f) {
#pragma unroll
                for (int g = 0; g < 4; ++g) {
                    const u32x2 a = *(const u32x2*)(op + 8 * g), cc = *(const u32x2*)(op + 32 + 8 * g);
                    o0[4 * g] += w * bflo(a.x); o0[4 * g + 1] += w * bfhi(a.x); o0[4 * g + 2] += w * bflo(a.y); o0[4 * g + 3] += w * bfhi(a.y);
                    o1[4 * g] += w * bflo(cc.x); o1[4 * g + 1] += w * bfhi(cc.x); o1[4 * g + 2] += w * bflo(cc.y); o1[4 * g + 3] += w * bfhi(cc.y);
                }
            }
        }
        store_o(OA + (size_t)(b * SEQ + t) * (2 * WA) + head * HD + 4 * hh, o0, o1, 1.f / L);
    }
}


#define CE(a, b) do { const unsigned lo_ = min(a, b), hi_ = max(a, b); a = lo_; b = hi_; } while (0)
DI void sort16_asc(unsigned (&k)[16]) {
    CE(k[0], k[1]); CE(k[2], k[3]); CE(k[0], k[2]); CE(k[1], k[3]); CE(k[1], k[2]); CE(k[4], k[5]); CE(k[6], k[7]); CE(k[4], k[6]); CE(k[5], k[7]); CE(k[5], k[6]);
    CE(k[0], k[4]); CE(k[2], k[6]); CE(k[2], k[4]); CE(k[1], k[5]); CE(k[3], k[7]); CE(k[3], k[5]); CE(k[1], k[2]); CE(k[3], k[4]); CE(k[5], k[6]); CE(k[8], k[9]);
    CE(k[10], k[11]); CE(k[8], k[10]); CE(k[9], k[11]); CE(k[9], k[10]); CE(k[12], k[13]); CE(k[14], k[15]); CE(k[12], k[14]); CE(k[13], k[15]); CE(k[13], k[14]);
    CE(k[8], k[12]); CE(k[10], k[14]); CE(k[10], k[12]); CE(k[9], k[13]); CE(k[11], k[15]); CE(k[11], k[13]); CE(k[9], k[10]); CE(k[11], k[12]); CE(k[13], k[14]);
    CE(k[0], k[8]); CE(k[4], k[12]); CE(k[4], k[8]); CE(k[2], k[10]); CE(k[6], k[14]); CE(k[6], k[10]); CE(k[2], k[4]); CE(k[6], k[8]); CE(k[10], k[12]);
    CE(k[1], k[9]); CE(k[5], k[13]); CE(k[5], k[9]); CE(k[3], k[11]); CE(k[7], k[15]); CE(k[7], k[11]); CE(k[3], k[5]); CE(k[7], k[9]); CE(k[11], k[13]);
    CE(k[1], k[2]); CE(k[3], k[4]); CE(k[5], k[6]); CE(k[7], k[8]); CE(k[9], k[10]); CE(k[11], k[12]); CE(k[13], k[14]);
}
DI void bitonic16_asc(unsigned (&k)[16]) {
    CE(k[0], k[8]); CE(k[1], k[9]); CE(k[2], k[10]); CE(k[3], k[11]); CE(k[4], k[12]); CE(k[5], k[13]); CE(k[6], k[14]); CE(k[7], k[15]); CE(k[0], k[4]);
    CE(k[1], k[5]); CE(k[2], k[6]); CE(k[3], k[7]); CE(k[8], k[12]); CE(k[9], k[13]); CE(k[10], k[14]); CE(k[11], k[15]); CE(k[0], k[2]); CE(k[1], k[3]);
    CE(k[4], k[6]); CE(k[5], k[7]); CE(k[8], k[10]); CE(k[9], k[11]); CE(k[12], k[14]); CE(k[13], k[15]); CE(k[0], k[1]); CE(k[2], k[3]); CE(k[4], k[5]);
    CE(k[6], k[7]); CE(k[8], k[9]); CE(k[10], k[11]); CE(k[12], k[13]); CE(k[14], k[15]);
}

DI unsigned fkey(float v, unsigned idx) { unsigned b = __float_as_uint(v); b = (b & 0x80000000u) ? ~b : (b | 0x80000000u); return (b & ~127u) | idx; }
DI float fkey_val(unsigned k) { unsigned b = k & ~127u; b = (b & 0x80000000u) ? (b & 0x7fffffffu) : ~b; return __uint_as_float(b); }
DI void top16_of_128(const f32x4 (&acc)[8], int g, unsigned (&t)[16]) {
    unsigned ka[16], kb[16];
#pragma unroll
    for (int ni = 0; ni < 4; ++ni)
#pragma unroll
        for (int j = 0; j < 4; ++j) { ka[4 * ni + j] = fkey(acc[ni][j], 16 * ni + 4 * g + j); kb[4 * ni + j] = fkey(acc[ni + 4][j], 16 * (ni + 4) + 4 * g + j); }
    sort16_asc(ka); sort16_asc(kb);
#pragma unroll
    for (int i = 0; i < 16; ++i) t[i] = max(ka[i], kb[15 - i]);
    bitonic16_asc(t);
#pragma unroll
    for (int xo = 16; xo <= 32; xo <<= 1) {
        unsigned pp[16];
#pragma unroll
        for (int i = 0; i < 16; ++i) pp[i] = (unsigned)__shfl_xor((int)t[i], xo);
#pragma unroll
        for (int i = 0; i < 16; ++i) t[i] = max(t[i], pp[15 - i]);
        bitonic16_asc(t);
    }
}

#define LAS __attribute__((address_space(3)))
#define XB_TMO      128
#define XB_XCNT(j)  (256  + 64 * (j))
#define XB_XSUB(j)  (1280 + 64 * (j))
#define XB_XGEN(j)  (2304 + 64 * (j))
#define XB_TOP      3328
#define XB_TOPGEN   3392
#define XCD_BAR_WORDS 3456
#define XB_SPIN_CAP (1u << 18)

__device__ __forceinline__ unsigned xb_ld(unsigned* p)              { return __hip_atomic_load(p, __ATOMIC_RELAXED, __HIP_MEMORY_SCOPE_AGENT); }
__device__ __forceinline__ unsigned xb_add(unsigned* p, unsigned v) { return __hip_atomic_fetch_add(p, v, __ATOMIC_RELAXED, __HIP_MEMORY_SCOPE_AGENT); }
__device__ __forceinline__ unsigned xb_xcc_id() { return (unsigned)__builtin_amdgcn_s_getreg((3 << 11) | 20) & 0xFu; }
#define XB_SPIN(cond, bar) do { unsigned _sp = 0; while (cond) { __builtin_amdgcn_s_sleep(1); \
    if ((++_sp & 255u) == 0u) { if (xb_ld(&(bar)[XB_TMO])) break; if (_sp > XB_SPIN_CAP) { atomicAdd(&(bar)[XB_TMO], 1u); break; } } } } while (0)

struct XcdBarrier {
    unsigned* bar; unsigned x;
    volatile LAS unsigned* st;
};

__device__ __forceinline__ XcdBarrier xcd_barrier_post(unsigned* bar, volatile LAS unsigned* st, unsigned& rank) {
    XcdBarrier b; b.bar = bar; b.x = xb_xcc_id(); b.st = st;
    rank = 0u;
    if (threadIdx.x == 0) rank = xb_add(&bar[XB_XCNT(b.x)], 1u);
    return b;
}
__device__ __forceinline__ void xcd_barrier_complete(unsigned* bar, unsigned x, unsigned& nloc, unsigned& nx, unsigned& zmask) {
    const unsigned G = gridDim.x * gridDim.y * gridDim.z;
    unsigned sum, cnt, mine, zm, sp = 0u;
    for (;;) {
        sum = 0u; cnt = 0u; mine = 0u; zm = 0u;
#pragma unroll
        for (unsigned j = 0; j < 16; ++j) { const unsigned c = xb_ld(&bar[XB_XCNT(j)]); sum += c; cnt += (c > 0u) ? 1u : 0u; mine = (j == x) ? c : mine; zm |= (c == 0u && j < 8u) ? (1u << j) : 0u; }
        if (sum == G) break;
        __builtin_amdgcn_s_sleep(1);
        if ((++sp & 255u) == 0u) { if (xb_ld(&bar[XB_TMO])) break; if (sp > XB_SPIN_CAP) { atomicAdd(&bar[XB_TMO], 1u); break; } }
    }
    nloc = mine > 0u ? mine : 1u; nx = cnt > 0u ? cnt : 1u; zmask = zm;
}

__device__ __forceinline__ void xcd_barrier(const XcdBarrier& b) {
    asm volatile("s_waitcnt vmcnt(0)" ::: "memory");
    __syncthreads();
    if (threadIdx.x == 0) {
        unsigned* bar = b.bar;
        __builtin_amdgcn_s_waitcnt(0);
        unsigned nloc = b.st[0], nx = b.st[1];
        if (nloc == 0u) { unsigned zmask; xcd_barrier_complete(bar, b.x, nloc, nx, zmask); b.st[0] = nloc; b.st[1] = nx; b.st[2] = zmask; }
        const unsigned old = xb_add(&bar[XB_XSUB(b.x)], 1u);
        const unsigned gen = old / nloc;
        if (old + 1u == (gen + 1u) * nloc) {
            __builtin_amdgcn_fence(__ATOMIC_RELEASE, "agent");
            asm volatile("s_waitcnt vmcnt(0)" ::: "memory");
            const unsigned og = xb_add(&bar[XB_TOP], 1u);
            const unsigned tg = og / nx;
            if (og + 1u == (tg + 1u) * nx) xb_add(&bar[XB_TOPGEN], 1u);
            else XB_SPIN(xb_ld(&bar[XB_TOPGEN]) == tg, bar);
            __builtin_amdgcn_fence(__ATOMIC_ACQUIRE, "agent");
            xb_add(&bar[XB_XGEN(b.x)], 1u);
            asm volatile("s_waitcnt vmcnt(0)" ::: "memory");
        } else {
            XB_SPIN(xb_ld(&bar[XB_XGEN(b.x)]) == gen, bar);
            __builtin_amdgcn_fence(__ATOMIC_ACQUIRE, "agent");
            asm volatile("s_waitcnt vmcnt(0)" ::: "memory");
        }
    }
    __syncthreads();
}


__global__ void __launch_bounds__(NTHREADS, 2) fwd_kernel(Params p) {
    extern __shared__ __attribute__((aligned(16))) unsigned char lds[];
    const int tid = threadIdx.x, lane = tid & 63, wave = tid >> 6;
    const int G = gridDim.x, bid = blockIdx.x;
    const long gtid = (long)bid * NTHREADS + tid, gth = (long)G * NTHREADS;
    const int gwave = bid * NWAVES + wave, ngw = G * NWAVES;
    unsigned char* ws = p.ws;
    bf16_t* WIN = (bf16_t*)(ws + WS_WIN); bf16_t* WOA = (bf16_t*)(ws + WS_WOA);
    bf16_t* WMIX = (bf16_t*)(ws + WS_WMIX); bf16_t* WQ = (bf16_t*)(ws + WS_WQ); bf16_t* SK = (bf16_t*)(ws + WS_SK);
    float* RS1 = (float*)(ws + WS_RS1); float* RS2 = (float*)(ws + WS_RS2);
    bf16_t* XB = (bf16_t*)(ws + WS_XB); bf16_t* OA = (bf16_t*)(ws + WS_OA);
    unsigned short* EIDX = (unsigned short*)(ws + WS_EIDX); float* GW = (float*)(ws + WS_GW);
    bf16_t* QK = (bf16_t*)(ws + WS_QK); bf16_t* KF = (bf16_t*)(ws + WS_KF); bf16_t* VT = (bf16_t*)(ws + WS_VT); bf16_t* MIXED = (bf16_t*)(ws + WS_MIXED); bf16_t* HB = (bf16_t*)(ws + WS_HB);
    bf16_t* GATES = (bf16_t*)(ws + WS_GATES); bf16_t* Q2 = (bf16_t*)(ws + WS_Q2);
    float* SU = (float*)(ws + WS_SU); float* SV = (float*)(ws + WS_SV); float* SSP = (float*)(ws + WS_SSP); float* SH = (float*)(ws + WS_SH);
    signed char* H8 = (signed char*)(ws + WS_H8); int* AP = (int*)(ws + WS_AP); unsigned char* U8 = ws + WS_U8; unsigned char* V8 = ws + WS_V8;
    unsigned* CTL = (unsigned*)(ws + WS_CTL); float* KSUM = (float*)(ws + WS_KSUM); float* SWMAX = (float*)(ws + WS_SWMAX); float* WSC = (float*)(ws + WS_WSC); signed char* WH = (signed char*)(ws + WS_WH); signed char* WL = (signed char*)(ws + WS_WL);
    volatile LAS unsigned* bst = (volatile LAS unsigned*)((LAS unsigned char*)lds + (LDS_BYTES - 16));
    if (tid < 4) bst[tid] = 0u;
    __syncthreads();
    unsigned xrank;
    const XcdBarrier xbar = xcd_barrier_post((unsigned*)(ws + WS_CTL) + 1024, bst, xrank);
    volatile unsigned* rankw = (volatile unsigned*)(lds + (LDS_BYTES - 32));
    const int lo = p.ph_lo, hi = p.ph_hi;
#ifdef ONLY_PHASE
#define IN(k) ((k) == ONLY_PHASE && lo <= (k) && (k) < hi)
#else
#define IN(k) (lo <= (k) && (k) < hi)
#endif
#define SEAM(k) do { if (IN(k) && IN((k) + 1)) xcd_barrier(xbar); } while (0)

    for (int rep_ = 0; rep_ < (IN(0) ? 1 : 0); ++rep_) {
        for (int nb = bid; nb < INW / 32; nb += G) {
            float* scr = (float*)(lds + wave * (128 * 33 * 4));
            float* AMX = (float*)(lds + 8 * (128 * 33 * 4));
            const int n0 = 32 * nb, kw = 128 * wave;
            float am = 0.f;
            __syncthreads();
            {
#pragma unroll
                for (int hf = 0; hf < 2; ++hf) {
                    float wv[32], gv[32];
#pragma unroll
                    for (int i = 0; i < 32; ++i) { const int kk = 64 * hf + 2 * i + (lane >> 5); wv[i] = p.w_in[(size_t)(kw + kk) * INW + n0 + (lane & 31)]; gv[i] = p.g1[kw + kk]; }
#pragma unroll
                    for (int i = 0; i < 32; ++i) { const int kk = 64 * hf + 2 * i + (lane >> 5); const float v = wv[i] * gv[i]; scr[kk * 33 + (lane & 31)] = v; am = fmaxf(am, fabsf(v)); }
                }
            }
            am = fmaxf(am, __shfl_xor(am, 32));
            if (lane < 32) AMX[wave * 32 + lane] = am;
            __syncthreads();
            const int kc = lane & 15;
#pragma unroll
            for (int j = 0; j < 8; ++j) {
                const int n = (lane >> 4) + 4 * j;
                float cm = AMX[n];
#pragma unroll
                for (int w2 = 1; w2 < 8; ++w2) cm = fmaxf(cm, AMX[w2 * 32 + n]);
                const float isc = cm > 0.f ? 127.f / cm : 0.f;
                const float* sp = scr + (8 * kc) * 33 + n;
                unsigned lo, hi;
                lo = q8x4(sp[0], sp[33], sp[66], sp[99], isc); hi = q8x4(sp[4 * 33], sp[5 * 33], sp[6 * 33], sp[7 * 33], isc);
                *(u32x2*)((signed char*)WIN + (size_t)(n0 + n) * DM + kw + 8 * kc) = (u32x2){lo, hi};
                if (wave == 0 && kc == 0) SWMAX[n0 + n] = cm;
            }
        }
        __syncthreads();
        {
            float* scr = (float*)(lds + wave * 16384);
            constexpr int I_OA = (WA / 64) * (DM / 32), I_MIX = (DM / 64) * (DM / 32), I_Q = (DM / 64) * (PQW / 32);
            for (int it = gwave; it < 2 * I_OA + I_MIX + I_Q; it += ngw) {
                int r = it;
                if (r < I_OA) { transpose_item(p.w_oa, WA, DM, WOA, 2 * WA, 0, nullptr, scr, r, lane); continue; } r -= I_OA;
                if (r < I_OA) { transpose_item(p.w_ob, WA, DM, WOA, 2 * WA, WA, nullptr, scr, r, lane); continue; } r -= I_OA;
                if (r < I_MIX) { transpose_item(p.w_mix, DM, DM, WMIX, DM, 0, nullptr, scr, r, lane); continue; } r -= I_MIX;
                transpose_item(p.w_q, DM, PQW, WQ, DM, 0, p.g2, scr, r, lane);
            }
            for (long i = gtid; i < 16L * 128 * 128; i += gth) SK[i] = (bf16_t)f2bf(p.skeys[i]);
        }
        for (int row0 = gwave; row0 < T; row0 += 8 * ngw) {
            f32x4 xv[8][4];
#pragma unroll
            for (int k = 0; k < 8; ++k) {
                const int row = row0 + k * ngw;
                if (row < T) {
#pragma unroll
                    for (int j = 0; j < 4; ++j) xv[k][j] = ((const f32x4*)(p.x + (size_t)row * DM) + lane)[64 * j];
                }
            }
#pragma unroll
            for (int k = 0; k < 8; ++k) {
                const int row = row0 + k * ngw;
                if (row < T) {
                    float sq = 0.f, am = 0.f;
#pragma unroll
                    for (int j = 0; j < 4; ++j) { const f32x4 v = xv[k][j]; sq += v.x * v.x + v.y * v.y + v.z * v.z + v.w * v.w; am = fmaxf(fmaxf(am, fmaxf(fabsf(v.x), fabsf(v.y))), fmaxf(fabsf(v.z), fabsf(v.w))); }
                    sq = wave_sum(sq);
#pragma unroll
                    for (int o = 32; o >= 1; o >>= 1) am = fmaxf(am, __shfl_xor(am, o));
                    const float sc = am > 0.f ? am * (1.f / 127.f) : 1.f, isc = 1.f / sc;
                    unsigned* ob = (unsigned*)(XB + (size_t)row * (DM / 2)) + lane;
#pragma unroll
                    for (int j = 0; j < 4; ++j) { const f32x4 v = xv[k][j]; ob[64 * j] = q8x4(v.x, v.y, v.z, v.w, isc); }
                    if (lane == 0) RS1[row] = sc * rsqrtf(sq * (1.f / DM) + RMS_EPS);
                }
            }
        }
    }
    if (tid == 0) rankw[0] = xrank;
    SEAM(0);

    for (int rep_ = 0; rep_ < (IN(1) ? (PROBE_REP == 1 ? 2 : 1) : 0); ++rep_) {
        pg8::Gemm gm{XB, WIN, T, INW, DM / 2}; pg8::StaticOrder S; S.init(T, INW, G, bid);
        EpiInProj E{QK, KF, VT, GATES, RS1, SWMAX, KSUM, rep_ == 0};
        pg8::gemm_phase<EpiInProj, pg8::StaticOrder, true, true>((PG8_LAS unsigned char*)lds, gm, S, E);
    }
    SEAM(1);

    for (int rep_ = 0; rep_ < (IN(3) ? (PROBE_REP == 3 ? 2 : 1) : 0); ++rep_) {
        {
            const unsigned xcc = (unsigned)__builtin_amdgcn_s_getreg((3 << 11) | 20) & 7u;
            const int rank = __builtin_amdgcn_readfirstlane((int)rankw[0]), nloc = __builtin_amdgcn_readfirstlane((int)bst[0]), zmask = __builtin_amdgcn_readfirstlane((int)bst[2]);
            for (int pass = 0; pass < 9; ++pass) {
                int qx, r0, step;
                if (pass == 0) { qx = (int)xcc; r0 = rank; step = nloc; }
                else { qx = pass - 1; if (!((zmask >> qx) & 1)) continue; r0 = bid; step = G; }
                for (int t = 0; t * step < 64; ++t) {
                    const int k = t * step + ((t & 1) ? step - 1 - r0 : r0);
                    if (k >= 64) continue;
                    const int og = p3_order(k >> 1), bh = 2 * qx + (k & 1);
                    moba_group(lds, QK, KF, VT, KSUM, OA, bh >> 3, bh & 7, og, true);
                }
            }
        }
    }
    SEAM(3);

    for (int rep_ = 0; rep_ < (IN(4) ? 1 : 0); ++rep_) {
        pg8::Gemm gm{OA, WOA, T, DM, 2 * WA}; pg8::StaticOrder S; S.init(T, DM, G, bid);
        EpiMix E{GATES, MIXED};
        pg8::gemm_phase<EpiMix, pg8::StaticOrder, true, true, true>((PG8_LAS unsigned char*)lds, gm, S, E);
    }
    SEAM(4);

    for (int rep_ = 0; rep_ < (IN(5) ? (PROBE_REP == 5 ? 2 : 1) : 0); ++rep_) {
        pg8::Gemm gm{MIXED, WMIX, T, DM, DM}; pg8::StaticOrder S; S.init(T, DM, G, bid);
        EpiResid E{p.x, HB};
        pg8::gemm_phase<EpiResid, pg8::StaticOrder, true, true>((PG8_LAS unsigned char*)lds, gm, S, E);
    }
    SEAM(5);

    for (int rep_ = 0; rep_ < (IN(7) ? 1 : 0); ++rep_) {
        pg8::Gemm gm{HB, WQ, T, PQW, DM}; pg8::StaticOrder S; S.init(T, PQW, G, bid);
        EpiPeerQ E{Q2};
        pg8::gemm_phase<EpiPeerQ, pg8::StaticOrder, true, true>((PG8_LAS unsigned char*)lds, gm, S, E);
    }
    SEAM(7);

    for (int rep_ = 0; rep_ < (IN(8) ? (PROBE_REP == 8 ? 2 : 1) : 0); ++rep_) {
        bf16_t* Qs = (bf16_t*)lds;
        bf16_t* Ks = Qs + 128 * 264;
        unsigned* LST = (unsigned*)(lds + 128 * 264 * 2 + 2 * 128 * 136 * 2);
        int h_loaded = -1;
        __syncthreads();
        if (bid < (T / 128) * 8) {
            const int h0 = bid & 7, t00 = (bid >> 3) * 128;
#pragma unroll
            for (int i = 0; i < 8; ++i) { const int c = tid + i * NTHREADS, r = c >> 5, ch = c & 31; *(u32x4*)(Qs + r * 264 + ch * 8) = *(const u32x4*)(Q2 + (size_t)(t00 + r) * PQW + h0 * 256 + ch * 8); }
        }
        for (int it = bid; it < (T / 128) * 8; it += G) {
            const int h = it & 7, t0 = (it >> 3) * 128;
            if (h != h_loaded) {
#pragma unroll
                for (int i = 0; i < 8; ++i) {
                    const int c = tid + i * NTHREADS, r = c >> 4, ch = c & 15;
                    *(u32x4*)(Ks + r * 136 + ch * 8) = *(const u32x4*)(SK + (size_t)(2 * h * 128 + r) * 128 + ch * 8);
                }
                h_loaded = h;
            }
            __syncthreads();
#pragma unroll 1
            for (int ph = 0; ph < 2; ++ph) {
                f32x4 acc[8];
#pragma unroll
                for (int ni = 0; ni < 8; ++ni) acc[ni] = (f32x4){0.f, 0.f, 0.f, 0.f};
#pragma unroll
                for (int ks = 0; ks < 4; ++ks) {
                    const bf16x8 qf = *(const bf16x8*)(Qs + (wave * 16 + (lane & 15)) * 264 + ph * 128 + ks * 32 + (lane >> 4) * 8);
#pragma unroll
                    for (int ni = 0; ni < 8; ++ni) {
                        const bf16x8 kf = *(const bf16x8*)(Ks + (ph * 128 + ni * 16 + (lane & 15)) * 136 + ks * 32 + (lane >> 4) * 8);
                        acc[ni] = __builtin_amdgcn_mfma_f32_16x16x32_bf16(kf, qf, acc[ni], 0, 0, 0);
                    }
                }
                unsigned tk[16];
                top16_of_128(acc, lane >> 4, tk);
                if (lane < 16) {
                    unsigned* dst = LST + ((wave * 16 + lane) * 2 + ph) * 16;
#pragma unroll
                    for (int i = 0; i < 4; ++i) { u32x4 w; w.x = tk[15 - 4 * i]; w.y = tk[14 - 4 * i]; w.z = tk[13 - 4 * i]; w.w = tk[12 - 4 * i]; *(u32x4*)(dst + 4 * i) = w; }
                }
            }
            __syncthreads();
            if (tid >= 128 && it + G < (T / 128) * 8) {
                const int itn = it + G, hn = itn & 7, tn0 = (itn >> 3) * 128;
                for (int c = tid - 128; c < 128 * 32; c += NTHREADS - 128) { const int r = c >> 5, ch = c & 31; *(u32x4*)(Qs + r * 264 + ch * 8) = *(const u32x4*)(Q2 + (size_t)(tn0 + r) * PQW + hn * 256 + ch * 8); }
            }
            if (wave >= 6) quant_rows<8>(p.pu, p.pv, p.g2, U8, V8, SU, SV, it * 32 + 16 + (wave - 6) * 8, 1, lane);
            else if (wave >= 2) quant_rows<4>(p.pu, p.pv, p.g2, U8, V8, SU, SV, it * 32 + (wave - 2) * 4, 1, lane);
            if (tid >= 128 && tid < 384) h_rows4(HB, RS2, SH, H8, it * 16 + (wave - 2) * 4, 1, lane);
            if (tid < 128) {
                const unsigned* La = LST + (tid * 2) * 16; const unsigned* Lb = La + 16;
                float cand[16];
                const float b0 = fkey_val(Lb[0]);
#pragma unroll
                for (int i = 0; i < 4; ++i) { const u32x4 w = *(const u32x4*)(La + 4 * i); cand[4 * i] = fkey_val(w.x) + b0; cand[4 * i + 1] = fkey_val(w.y) + b0; cand[4 * i + 2] = fkey_val(w.z) + b0; cand[4 * i + 3] = fkey_val(w.w) + b0; }
                unsigned long long ptrs = 0ull;
                float selv[16]; unsigned sele[16];
#pragma unroll
                for (int r = 0; r < 16; ++r) {
                    float best = cand[0];
#pragma unroll
                    for (int i = 1; i < 16; ++i) best = fmaxf(best, cand[i]);
                    int istar = 15;
#pragma unroll
                    for (int i = 14; i >= 0; --i) istar = (cand[i] == best) ? i : istar;
                    const int j = (int)((ptrs >> (4 * istar)) & 15ull);
                    const unsigned ka = La[istar], kb = Lb[j];
                    selv[r] = best; sele[r] = (ka & 127u) * PNK + (kb & 127u);
                    const bool more = j < 15;
                    const float nc = more ? fkey_val(ka) + fkey_val(Lb[more ? j + 1 : j]) : -INFINITY;
                    if (more) ptrs += 1ull << (4 * istar);
#pragma unroll
                    for (int i = 0; i < 16; ++i) cand[i] = (i == istar) ? nc : cand[i];
                }
                float* go = GW + (size_t)(t0 + tid) * 128 + h * 16;
#pragma unroll
                for (int r = 0; r < 8; ++r) *(unsigned*)(EIDX + (size_t)(t0 + tid) * 128 + r * 16 + 2 * h) = sele[r] | (sele[r + 8] << 16);
#pragma unroll
                for (int i = 0; i < 4; ++i) *(f32x4*)(go + 4 * i) = (f32x4){selv[4 * i], selv[4 * i + 1], selv[4 * i + 2], selv[4 * i + 3]};
            }
        }
    }
    SEAM(8);

#define PEER_ID(ia, ib, i) ((((i) < 8 ? (ia) : (ib))[((i) & 7) >> 1] >> (((i) & 1) * 16)) & 0xffffu)
#define PEER_ROWS4(dst, base, ia, ib, m) do { _Pragma("unroll") for (int q_ = 0; q_ < 4; ++q_) dst[4 * (m) + q_] = *(const u32x4*)((base) + (unsigned)(PEER_ID(ia, ib, 4 * (m) + q_) * 128u + jp16)); } while (0)
#define PEER_IDS(ia, ib, t) do { const unsigned short* ep_ = EIDX + (size_t)(t) * 128; ia = *(const u32x4*)(ep_ + (unsigned)(g * 16)); ib = *(const u32x4*)(ep_ + (unsigned)(g * 16 + 8)); } while (0)
    for (int rep_ = 0; rep_ < (IN(9) ? (PROBE_REP == 9 ? 2 : 1) : 0); ++rep_) {
        volatile int* ubox = (volatile int*)lds;
        const unsigned xcc = (unsigned)__builtin_amdgcn_s_getreg((3 << 11) | 20) & 7u;
        int ln = lane; asm volatile("" : "+v"(ln));
        const int g = ln >> 3, jp = ln & 7;
        const bool b2 = (ln & 4) != 0, b1 = (ln & 2) != 0, b0 = (ln & 1) != 0;
        const int wv = __builtin_amdgcn_readfirstlane(wave); const unsigned jp16 = (unsigned)jp * 16u;
        constexpr int NTW = 32;
        constexpr int NU = T / (8 * NTW);
        const int rank = __builtin_amdgcn_readfirstlane((int)rankw[0]), nloc = __builtin_amdgcn_readfirstlane((int)bst[0]), zmask = __builtin_amdgcn_readfirstlane((int)bst[2]);
        for (int pass = 0; pass < 9; ++pass) {
            int sl, u0, ustep;
            if (pass == 0) { sl = (int)xcc; u0 = rank; ustep = nloc; }
            else { sl = pass - 1; if (!((zmask >> sl) & 1)) continue; u0 = bid; ustep = G; }
            const unsigned char* U8s = U8 + (size_t)sl * NEXP * 128;
            for (int u = u0; u < NU; u += ustep) {
                const int tb = u * (8 * NTW) + wv;
#define P1_HQ(hq, t) hq = *(const u32x4*)(H8 + (size_t)(t) * DM + sl * 128 + jp16)
#define P1_DOT4(d, rw, hq, m) do { _Pragma("unroll") for (int q_ = 0; q_ < 4; ++q_) { int x_ = __builtin_amdgcn_sdot4((int)hq.x, (int)rw[4 * (m) + q_].x, 0, false); x_ = __builtin_amdgcn_sdot4((int)hq.y, (int)rw[4 * (m) + q_].y, x_, false); \
        x_ = __builtin_amdgcn_sdot4((int)hq.z, (int)rw[4 * (m) + q_].z, x_, false); d[4 * (m) + q_] = __builtin_amdgcn_sdot4((int)hq.w, (int)rw[4 * (m) + q_].w, x_, false); } } while (0)
#define P1_FINISH(d_, t) do { int v8_[8], v4_[4]; \
    _Pragma("unroll") for (int i_ = 0; i_ < 8; ++i_) v8_[i_] = (b2 ? d_[8 + i_] : d_[i_]) + __shfl_xor(b2 ? d_[i_] : d_[8 + i_], 4); \
    _Pragma("unroll") for (int i_ = 0; i_ < 4; ++i_) v4_[i_] = (b1 ? v8_[4 + i_] : v8_[i_]) + __shfl_xor(b1 ? v8_[i_] : v8_[4 + i_], 2); \
    const int k0_ = (b0 ? v4_[2] : v4_[0]) + __shfl_xor(b0 ? v4_[0] : v4_[2], 1), k1_ = (b0 ? v4_[3] : v4_[1]) + __shfl_xor(b0 ? v4_[1] : v4_[3], 1); \
    int* ap_ = AP + ((size_t)sl * T + (t)) * 128 + 16 * jp + g; ap_[0] = k0_; ap_[8] = k1_; } while (0)
#define P1_STEP(rw, hq, ea, eb, i, REISSUE) do { int d_[16]; \
    _Pragma("unroll") for (int m_ = 0; m_ < 4; ++m_) { P1_DOT4(d_, rw, hq, m_); __builtin_amdgcn_sched_barrier(0); if (REISSUE) { PEER_ROWS4(rw, U8s, ea, eb, m_); __builtin_amdgcn_sched_barrier(0); } } \
    P1_FINISH(d_, tb + 8 * (i)); } while (0)
                u32x4 e0a, e0b, e1a, e1b, h0, h1, rwA[16], rwB[16];
                PEER_IDS(e0a, e0b, tb); PEER_IDS(e1a, e1b, tb + 8); P1_HQ(h0, tb);
#pragma unroll
                for (int m_ = 0; m_ < 4; ++m_) PEER_ROWS4(rwA, U8s, e0a, e0b, m_);
#pragma unroll
                for (int m_ = 0; m_ < 4; ++m_) PEER_ROWS4(rwB, U8s, e1a, e1b, m_);
                PEER_IDS(e0a, e0b, tb + 16);
#pragma unroll 1
                for (int i = 0; i < NTW - 2; i += 2) {
                    PEER_IDS(e1a, e1b, tb + 8 * (i + 3));
                    P1_HQ(h1, tb + 8 * (i + 1));
                    P1_STEP(rwA, h0, e0a, e0b, i, true);
                    { const int tn = tb + 8 * (i + 4 < NTW ? i + 4 : NTW - 1); PEER_IDS(e0a, e0b, tn); }
                    P1_HQ(h0, tb + 8 * (i + 2));
                    P1_STEP(rwB, h1, e1a, e1b, i + 1, true);
                }
                P1_HQ(h1, tb + 8 * (NTW - 1));
                P1_STEP(rwA, h0, e0a, e0b, NTW - 2, false);
                P1_STEP(rwB, h1, e1a, e1b, NTW - 1, false);
            }
        }
    }
    SEAM(9);

    for (int rep_ = 0; rep_ < (IN(10) ? (PROBE_REP == 10 ? 2 : 1) : 0); ++rep_) {
        for (int t = gwave; t < T; t += ngw) {
            int s0 = 0, s1 = 0;
#pragma unroll
            for (int q = 0; q < 8; ++q) { const int* ap = AP + ((size_t)q * T + t) * 128; s0 += ap[lane]; s1 += ap[64 + lane]; }
            const int p0 = (lane & 7) * 16 + (lane >> 3), p1 = p0 + 8;
            const int e0 = EIDX[(size_t)t * 128 + p0], e1 = EIDX[(size_t)t * 128 + p1];
            const float sc = SH[t] * RS2[t];
            const float a0 = (float)s0 * (sc * SU[e0]), a1 = (float)s1 * (sc * SU[e1]);
            const float rs2t = RS2[t];
            const float c0 = GW[(size_t)t * 128 + lane] * rs2t, c1 = GW[(size_t)t * 128 + 64 + lane] * rs2t;
            float m0 = c0, m1 = c1;
#pragma unroll
            for (int o = 8; o >= 1; o >>= 1) { m0 = fmaxf(m0, __shfl_xor(m0, o)); m1 = fmaxf(m1, __shfl_xor(m1, o)); }
            const float x0e = __expf(c0 - m0), x1e = __expf(c1 - m1);
            float z0 = x0e, z1 = x1e;
#pragma unroll
            for (int o = 8; o >= 1; o >>= 1) { z0 += __shfl_xor(z0, o); z1 += __shfl_xor(z1, o); }
            const float w0 = (x0e * __builtin_amdgcn_rcpf(z0)) * (0.5f * a0 * (1.f + erff(a0 * 0.70710678118654752f))) * SV[e0];
            const float w1 = (x1e * __builtin_amdgcn_rcpf(z1)) * (0.5f * a1 * (1.f + erff(a1 * 0.70710678118654752f))) * SV[e1];
            float wm = fmaxf(fabsf(w0), fabsf(w1));
#pragma unroll
            for (int o = 32; o >= 1; o >>= 1) wm = fmaxf(wm, __shfl_xor(wm, o));
            const float wsc = wm > 0.f ? wm * (1.f / 127.f) : 1.f, iw = 1.f / wsc;
            const float x0 = w0 * iw, x1 = w1 * iw;
            int h0 = (int)rintf(x0), h1 = (int)rintf(x1);
            h0 = h0 < -127 ? -127 : (h0 > 127 ? 127 : h0); h1 = h1 < -127 ? -127 : (h1 > 127 ? 127 : h1);
            WH[(size_t)t * 128 + p0] = (signed char)h0; WH[(size_t)t * 128 + p1] = (signed char)h1;
            if (lane == 0) WSC[t] = wsc;
        }
    }
    SEAM(10);

    for (int rep_ = 0; rep_ < (IN(11) ? (PROBE_REP == 11 ? 2 : 1) : 0); ++rep_) {
        const bool dry_ = (PROBE_REP == 11) && rep_ == 0;
        volatile int* ubox = (volatile int*)lds;
        const unsigned xcc = (unsigned)__builtin_amdgcn_s_getreg((3 << 11) | 20) & 7u;
        int ln = lane; asm volatile("" : "+v"(ln));
        const int g = ln >> 3, jp = ln & 7;
        const bool b5 = (ln & 32) != 0, b4 = (ln & 16) != 0, b3 = (ln & 8) != 0;
        const int wv = __builtin_amdgcn_readfirstlane(wave); const unsigned jp16 = (unsigned)jp * 16u;
        constexpr int NTW = 32;
        constexpr int NU = T / (8 * NTW);
        const int rank = __builtin_amdgcn_readfirstlane((int)rankw[0]), nloc = __builtin_amdgcn_readfirstlane((int)bst[0]), zmask = __builtin_amdgcn_readfirstlane((int)bst[2]);
        for (int pass = 0; pass < 9; ++pass) {
            int sl, u0, ustep;
            if (pass == 0) { sl = (int)xcc; u0 = rank; ustep = nloc; }
            else { sl = pass - 1; if (!((zmask >> sl) & 1)) continue; u0 = bid; ustep = G; }
            const unsigned char* V8s = V8 + (size_t)sl * NEXP * 128;
            for (int u = u0; u < NU; u += ustep) {
                const int tb = u * (8 * NTW) + wv;
#define P2_WM(wh, hv, wsc, t) do { wh = *(const u32x4*)(WH + (size_t)(t) * 128 + (unsigned)(g * 16)); { const unsigned hw_ = *(const unsigned*)(HB + (size_t)(t) * DM + sl * 128 + (unsigned)(jp * 16 + 2 * g)); hv = (f32x2_t){bflo(hw_), bfhi(hw_)}; } wsc = WSC[t]; } while (0)
#define P2_COL(rw, wh, ah, c, cb, m) do { const unsigned t0_ = __builtin_amdgcn_perm(rw[4 * (m) + 1].c, rw[4 * (m)].c, 0x05010400u), t1_ = __builtin_amdgcn_perm(rw[4 * (m) + 3].c, rw[4 * (m) + 2].c, 0x05010400u); \
    const unsigned t2_ = __builtin_amdgcn_perm(rw[4 * (m) + 1].c, rw[4 * (m)].c, 0x07030602u), t3_ = __builtin_amdgcn_perm(rw[4 * (m) + 3].c, rw[4 * (m) + 2].c, 0x07030602u); \
    ah[(cb) + 0] = __builtin_amdgcn_sdot4((int)__builtin_amdgcn_perm(t1_, t0_, 0x05040100u), (int)wh[m], ah[(cb) + 0], false); ah[(cb) + 1] = __builtin_amdgcn_sdot4((int)__builtin_amdgcn_perm(t1_, t0_, 0x07060302u), (int)wh[m], ah[(cb) + 1], false); \
    ah[(cb) + 2] = __builtin_amdgcn_sdot4((int)__builtin_amdgcn_perm(t3_, t2_, 0x05040100u), (int)wh[m], ah[(cb) + 2], false); ah[(cb) + 3] = __builtin_amdgcn_sdot4((int)__builtin_amdgcn_perm(t3_, t2_, 0x07060302u), (int)wh[m], ah[(cb) + 3], false); } while (0)
#define P2_FINISH(d_, hv, wsc, t) do { int v8_[8], v4_[4]; \
    _Pragma("unroll") for (int i_ = 0; i_ < 8; ++i_) v8_[i_] = (b5 ? d_[8 + i_] : d_[i_]) + __shfl_xor(b5 ? d_[i_] : d_[8 + i_], 32); \
    _Pragma("unroll") for (int i_ = 0; i_ < 4; ++i_) v4_[i_] = (b4 ? v8_[4 + i_] : v8_[i_]) + __shfl_xor(b4 ? v8_[i_] : v8_[4 + i_], 16); \
    const int k0_ = (b3 ? v4_[2] : v4_[0]) + __shfl_xor(b3 ? v4_[0] : v4_[2], 8), k1_ = (b3 ? v4_[3] : v4_[1]) + __shfl_xor(b3 ? v4_[1] : v4_[3], 8); \
    bf16_t* orow_ = MIXED + (size_t)(t) * DM + sl * 128 + jp * 16 + 2 * g;     \
    const unsigned ob_ = cvtpk((hv).x + (float)k0_ * (wsc), (hv).y + (float)k1_ * (wsc)); const float o0_ = bflo(ob_), o1_ = bfhi(ob_); \
    if (!dry_) *(unsigned*)orow_ = ob_; \
    const float ss_ = wave_sum(o0_ * o0_ + o1_ * o1_); if (ln == 0 && !dry_) SSP[(size_t)(t) * 8 + sl] = ss_; asm volatile("" :: "v"(ss_)); } while (0)
#define P2_STEP(rw, wh, hv, wsc, ea, eb, i, REISSUE) do { int d_[16]; _Pragma("unroll") for (int i_ = 0; i_ < 16; ++i_) d_[i_] = 0; \
    _Pragma("unroll") for (int m_ = 0; m_ < 4; ++m_) { P2_COL(rw, wh, d_, x, 0, m_); P2_COL(rw, wh, d_, y, 4, m_); P2_COL(rw, wh, d_, z, 8, m_); P2_COL(rw, wh, d_, w, 12, m_); __builtin_amdgcn_sched_barrier(0); \
        if (REISSUE) { PEER_ROWS4(rw, V8s, ea, eb, m_); __builtin_amdgcn_sched_barrier(0); } } \
    P2_FINISH(d_, hv, wsc, tb + 8 * (i)); } while (0)
                u32x4 e0a, e0b, e1a, e1b, w0, w1, rwA[16], rwB[16]; f32x2_t hv0, hv1; float ws0, ws1;
                PEER_IDS(e0a, e0b, tb); PEER_IDS(e1a, e1b, tb + 8); P2_WM(w0, hv0, ws0, tb);
#pragma unroll
                for (int m_ = 0; m_ < 4; ++m_) PEER_ROWS4(rwA, V8s, e0a, e0b, m_);
#pragma unroll
                for (int m_ = 0; m_ < 4; ++m_) PEER_ROWS4(rwB, V8s, e1a, e1b, m_);
                PEER_IDS(e0a, e0b, tb + 16);
#pragma unroll 1
                for (int i = 0; i < NTW - 2; i += 2) {
                    PEER_IDS(e1a, e1b, tb + 8 * (i + 3));
                    P2_WM(w1, hv1, ws1, tb + 8 * (i + 1));
                    P2_STEP(rwA, w0, hv0, ws0, e0a, e0b, i, true);
                    { const int tn = tb + 8 * (i + 4 < NTW ? i + 4 : NTW - 1); PEER_IDS(e0a, e0b, tn); }
                    P2_WM(w0, hv0, ws0, tb + 8 * (i + 2));
                    P2_STEP(rwB, w1, hv1, ws1, e1a, e1b, i + 1, true);
                }
                P2_WM(w1, hv1, ws1, tb + 8 * (NTW - 1));
                P2_STEP(rwA, w0, hv0, ws0, e0a, e0b, NTW - 2, false);
                P2_STEP(rwB, w1, hv1, ws1, e1a, e1b, NTW - 1, false);
            }
        }
    }
    SEAM(11);

    for (int rep_ = 0; rep_ < (IN(12) ? 1 : 0); ++rep_) {
        for (int row = gwave; row < T; row += ngw) {
            float tot = 0.f;
#pragma unroll
            for (int q = 0; q < 8; ++q) tot += SSP[(size_t)row * 8 + q];
            const float rs = rsqrtf(tot * (1.f / DM) + RMS_EPS);
            f32x4* orow = (f32x4*)(p.out + (size_t)row * DM) + lane; const u32x2* ob = (const u32x2*)(MIXED + (size_t)row * DM) + lane;
#pragma unroll
            for (int j = 0; j < 4; ++j) { const f32x4 gv = ((const f32x4*)p.gf)[lane + 64 * j]; const u32x2 w = ob[64 * j]; orow[64 * j] = (f32x4){bflo(w.x), bfhi(w.x), bflo(w.y), bfhi(w.y)} * rs * gv; }
        }
    }
#undef IN
#undef SEAM
}

extern "C" void kernel_launch(void* const* d_in, const int* in_sizes, int n_in, void* d_out, int out_size, void* d_ws, size_t ws_size, hipStream_t stream) {
    static int grid = 0;
    if (grid == 0) {
        int dev = 0, cus = 0, per_cu = 0;
        (void)hipGetDevice(&dev);
        (void)hipDeviceGetAttribute(&cus, hipDeviceAttributeMultiprocessorCount, dev);
        (void)hipFuncSetAttribute((const void*)fwd_kernel, hipFuncAttributeMaxDynamicSharedMemorySize, LDS_BYTES);
        (void)hipOccupancyMaxActiveBlocksPerMultiprocessor(&per_cu, (const void*)fwd_kernel, NTHREADS, LDS_BYTES);
        if (per_cu < 1) { fprintf(stderr, "kernel_launch: occupancy query says %d blocks per CU\n", per_cu); per_cu = 1; }
        grid = cus * 1;
        if (ws_size < WS_END) { fprintf(stderr, "kernel_launch: workspace too small: %zu < %zu\n", ws_size, (size_t)WS_END); grid = -1; }
    }
    if (grid < 0) return;
    Params p{};
    p.x = (const float*)d_in[0]; p.g1 = (const float*)d_in[1]; p.w_in = (const float*)d_in[2]; p.w_oa = (const float*)d_in[3]; p.w_ob = (const float*)d_in[4];
    p.w_mix = (const float*)d_in[5]; p.g2 = (const float*)d_in[6]; p.w_q = (const float*)d_in[7]; p.skeys = (const float*)d_in[8]; p.pu = (const float*)d_in[9];
    p.pv = (const float*)d_in[10]; p.gf = (const float*)d_in[11]; p.out = (float*)d_out; p.ws = (unsigned char*)d_ws;
    p.ph_lo = 0; p.ph_hi = 13;
    if (hipMemsetAsync((char*)d_ws + WS_CTL, 0, 65536 + 131072 + 32768, stream) != hipSuccess) { fprintf(stderr, "kernel_launch: hipMemsetAsync failed\n"); return; }
    hipLaunchKernelGGL(fwd_kernel, dim3(grid), dim3(NTHREADS), LDS_BYTES, stream, p);
}
```

```cpp
#include <hip/hip_runtime.h>
#include <cstdio>
#include <cstdint>

#define DI __device__ __forceinline__
typedef unsigned short bf16_t;
typedef short bf16x8 __attribute__((ext_vector_type(8)));
typedef float f32x4 __attribute__((ext_vector_type(4)));
typedef unsigned u32x4 __attribute__((ext_vector_type(4)));
typedef unsigned u32x2 __attribute__((ext_vector_type(2)));

constexpr int NBATCH = 2, SEQ = 8192, T = NBATCH * SEQ, DM = 1024;
constexpr int NH = 8, HD = 64, WA = 512;
constexpr int INW = 5120, QKVW = 3072, GATEW = 2048;
constexpr int MBLK = 256, NBLK = SEQ / MBLK;
constexpr int PNK = 128, PTOPK = 16, NEXP = 16384, PQW = 2048;
constexpr float RMS_EPS = 1e-6f;
constexpr int NTHREADS = 512, NWAVES = 8;
static_assert((T / 128) * 8 * 32 == 2 * NEXP && (T / 128) * 8 * 16 == T, "P8 side work: 32 expert rows and 16 h rows per item cover all rows");
constexpr int LDS_BYTES = 163840;
#ifndef PROBE_REP
#define PROBE_REP -1
#endif

constexpr size_t MiB = 1u << 20;
constexpr size_t WS_CTL = 0;
constexpr size_t WS_KSUM = 262144;
constexpr size_t WS_SWMAX = 196608;
constexpr size_t WS_WIN = 1 * MiB;
constexpr size_t WS_WOA = 11 * MiB;
constexpr size_t WS_WMIX = 13 * MiB;
constexpr size_t WS_WQ = 15 * MiB;
constexpr size_t WS_SK = 19 * MiB;
constexpr size_t WS_RS1 = 19 * MiB + 512 * 1024;
constexpr size_t WS_RS2 = WS_RS1 + 65536;
constexpr size_t WS_XB = 24 * MiB;
constexpr size_t WS_OA = 24 * MiB;
constexpr size_t WS_EIDX = 24 * MiB;
constexpr size_t WS_GW = 28 * MiB;
constexpr size_t WS_QK = 56 * MiB;
constexpr size_t WS_KF = 88 * MiB;
constexpr size_t WS_VT = 120 * MiB;
constexpr size_t WS_MIXED = 56 * MiB;
constexpr size_t WS_HB = 88 * MiB;
constexpr size_t WS_GATES = 152 * MiB;
constexpr size_t WS_Q2 = 152 * MiB;
constexpr size_t WS_SU = 20 * MiB;
constexpr size_t WS_SV = WS_SU + 65536;
constexpr size_t WS_SSP = 36 * MiB;
constexpr size_t WS_SH = WS_SSP + 524288;
constexpr size_t WS_WSC = WS_SH + 65536;
constexpr size_t WS_WH = 37 * MiB;
constexpr size_t WS_WL = 39 * MiB;
constexpr size_t WS_H8 = 40 * MiB;
constexpr size_t WS_AP = 152 * MiB;
constexpr size_t WS_U8 = 216 * MiB;
constexpr size_t WS_V8 = 232 * MiB;
constexpr size_t WS_END = 248 * MiB;

struct Params {
    const float *x, *g1, *w_in, *w_oa, *w_ob, *w_mix, *g2, *w_q, *skeys, *pu, *pv, *gf;
    float* out; unsigned char* ws; int ph_lo, ph_hi;
};

DI unsigned f2bf(float f) { unsigned u = __float_as_uint(f); return (u + 0x7fffu + ((u >> 16) & 1u)) >> 16; }
DI float bf2f(unsigned h) { return __uint_as_float(h << 16); }
DI float bflo(unsigned w) { return __uint_as_float(w << 16); }
DI float bfhi(unsigned w) { return __uint_as_float(w & 0xffff0000u); }
typedef __bf16 bf16x2_t __attribute__((ext_vector_type(2)));
typedef float f32x2_t __attribute__((ext_vector_type(2)));
DI unsigned cvtpk(float lo, float hi) { f32x2_t v = {lo, hi}; bf16x2_t b = __builtin_convertvector(v, bf16x2_t); return __builtin_bit_cast(unsigned, b); }
DI unsigned pk2(float lo, float hi) { return cvtpk(lo, hi); }
DI unsigned q8x4(float a, float b, float c, float d, float isc) {
    const float M = 12582912.f;
    const unsigned fa = __float_as_uint(fmaf(a, isc, M)), fb = __float_as_uint(fmaf(b, isc, M)), fc = __float_as_uint(fmaf(c, isc, M)), fd = __float_as_uint(fmaf(d, isc, M));
    return __builtin_amdgcn_perm(fb, fa, 0x0c0c0400u) | __builtin_amdgcn_perm(fd, fc, 0x04000c0cu);
}
DI float wave_sum(float v) {
#pragma unroll
    for (int o = 32; o >= 1; o >>= 1) v += __shfl_xor(v, o);
    return v;
}
DI void load_row64(const bf16_t* p, float* o) {
#pragma unroll
    for (int i = 0; i < 8; ++i) {
        u32x4 w = *(const u32x4*)(p + 8 * i);
        o[8 * i + 0] = bflo(w.x); o[8 * i + 1] = bfhi(w.x); o[8 * i + 2] = bflo(w.y); o[8 * i + 3] = bfhi(w.y);
        o[8 * i + 4] = bflo(w.z); o[8 * i + 5] = bfhi(w.z); o[8 * i + 6] = bflo(w.w); o[8 * i + 7] = bfhi(w.w);
    }
}
DI float sigmoidf_(float x) { return __builtin_amdgcn_rcpf(1.f + __builtin_amdgcn_exp2f(x * -1.4426950408889634f)); }

DI void transpose_item(const float* W, int K, int N, bf16_t* WT, int ldk, int koff, const float* ks, float* scr, int item, int lane) {
    const int nblk = N / 32, kb = item / nblk, nb = item % nblk, k0 = 64 * kb, n0 = 32 * nb;
    float tv[32];
#pragma unroll
    for (int i = 0; i < 32; ++i) tv[i] = W[(size_t)(k0 + 2 * i + (lane >> 5)) * N + n0 + (lane & 31)];
    if (ks) {
#pragma unroll
        for (int i = 0; i < 32; ++i) tv[i] *= ks[k0 + 2 * i + (lane >> 5)];
    }
#pragma unroll
    for (int i = 0; i < 32; ++i) scr[(2 * i + (lane >> 5)) * 33 + (lane & 31)] = tv[i];
    asm volatile("s_waitcnt lgkmcnt(0)" ::: "memory");
    const int c = lane & 7;
#pragma unroll
    for (int j = 0; j < 4; ++j) { const int n = (lane >> 3) + 8 * j; const float* sp = scr + (8 * c) * 33 + n;
        u32x4 o; o.x = pk2(sp[0 * 33], sp[1 * 33]); o.y = pk2(sp[2 * 33], sp[3 * 33]); o.z = pk2(sp[4 * 33], sp[5 * 33]); o.w = pk2(sp[6 * 33], sp[7 * 33]);
        *(u32x4*)(WT + (size_t)(n0 + n) * ldk + koff + k0 + 8 * c) = o; }
    asm volatile("s_waitcnt lgkmcnt(0)" ::: "memory");
}

namespace pg8 {
#define PG8_LAS __attribute__((address_space(3)))
typedef unsigned short bf16_t;
typedef short bf16x8 __attribute__((ext_vector_type(8)));
typedef float f32x4 __attribute__((ext_vector_type(4)));
typedef int i32x4 __attribute__((ext_vector_type(4)));
typedef unsigned u32x4 __attribute__((ext_vector_type(4)));
template <bool I8> struct AccT { typedef f32x4 type; };
template <> struct AccT<true> { typedef i32x4 type; };
constexpr int BM = 256, BK = 64, HALF = 128, HTB = HALF * BK * 2  , STAGE_BYTES = 8 * HTB, NXCD = 8, WGM = 8;

__host__ __device__ __forceinline__ int lds_byte(int r, int c) { const int st = (r >> 4) * 2 + (c >> 5), rr = r & 15, cc = c & 31, ob = rr * 64 + cc * 2; return st * 1024 + (ob ^ (((ob >> 9) & 1) << 5)); }
__host__ __device__ __forceinline__ void stage_rc(int b, int& R, int& C) { const int st = b / 1024, sb = b % 1024, swz = sb ^ (((sb >> 9) & 1) << 5); R = (st >> 1) * 16 + swz / 64; C = (st & 1) * 32 + (swz % 64) / 2; }
__host__ __device__ __forceinline__ int perm32(int rho) { const int n = rho >> 4, i = rho & 15; return 8 * (i >> 2) + 4 * n + (i & 3); }

struct Unit { int pm, pn; };
struct Gemm { const bf16_t* A; const bf16_t* Bt; int M, N, K; };

struct StaticOrder {
    int nM, nN, nwg, G, c;
    __host__ __device__ void init(int M, int N, int G_, int c_) { nM = M / BM; nN = N / BM; nwg = nM * nN; G = G_; c = c_; }
    __host__ __device__ bool next(int i, Unit& u) const {
        const long L = (long)i * G + c; if (L >= nwg) return false;
        int wgid = (int)L; { const int q = nwg / NXCD, r = nwg % NXCD, xcd = wgid % NXCD, off = wgid / NXCD; wgid = (xcd < r ? xcd * (q + 1) : r * (q + 1) + (xcd - r) * q) + off; }
        const int nig = WGM * nN, gid = wgid / nig, fm = gid * WGM, gsz = (nM - fm) < WGM ? (nM - fm) : WGM;
        u.pm = fm + ((wgid % nig) % gsz); u.pn = (wgid % nig) / gsz; return true;
    }
    __device__ __forceinline__ void a_ready(const Unit&) const {}
    __device__ __forceinline__ void done(const Unit&) const {}
};
__device__ __forceinline__ unsigned cvt_pk_bf16(float lo, float hi) { unsigned r; asm volatile("v_cvt_pk_bf16_f32 %0, %1, %2" : "=v"(r) : "v"(lo), "v"(hi)); return r; }
template <class Epi, class Sched, bool ALIGN_EPI = false, bool SP2 = false, bool MIDK = false>
__device__ __forceinline__ void gemm_phase(PG8_LAS unsigned char* lds, const Gemm g, const Sched& S, const Epi& E) {
    const int tid = threadIdx.x, wid = __builtin_amdgcn_readfirstlane(tid >> 6), lane = tid & 63, wr = wid >> 2, wc = wid & 3, fr = lane & 15, fq = lane >> 4;
    const int K = g.K, nt = K / BK;
    unsigned voffA[2], voffB[2];
#pragma unroll
    for (int i = 0; i < 2; ++i) { int R, C; stage_rc(tid * 16 + i * 8192, R, C); const int Rb = Epi::PERM ? ((R & ~31) + perm32(R & 31)) : R;
        voffA[i] = (unsigned)(R * K + C) * 2u; voffB[i] = (unsigned)(Rb * K + C) * 2u; }
    const size_t kstep = (size_t)(BK * 2);
    const size_t hstep = (size_t)HALF * K * 2;
    const size_t tstep = 2 * hstep;
    const unsigned ldsw = (unsigned)wid * 1024u;
    const int aoff = lds_byte(wr * 64 + fr, fq * 8), boff = lds_byte(wc * 32 + fr, fq * 8);
#define PG8_SA(b, h) (((b) * 2 + (h)) * HTB)
#define PG8_SB(b, h) ((4 + (b) * 2 + (h)) * HTB)
#define PG8_STAGE(bufoff, gbase, voff) do { _Pragma("unroll") for (int _i = 0; _i < 2; ++_i) \
        __builtin_amdgcn_global_load_lds((const unsigned*)((const char*)(gbase) + (voff)[_i]), (PG8_LAS unsigned*)(lds + (bufoff) + ldsw + _i * 8192), 16, 0, 0); } while (0)
#define PG8_LDA(dst, b, h) do { _Pragma("unroll") for (int m = 0; m < 4; ++m) _Pragma("unroll") for (int k = 0; k < 2; ++k) dst[m][k] = *(const PG8_LAS bf16x8*)(lds + PG8_SA(b, h) + aoff + m * 2048 + k * 1024); } while (0)
#define PG8_LDB(dst, b, h) do { _Pragma("unroll") for (int n = 0; n < 2; ++n) _Pragma("unroll") for (int k = 0; k < 2; ++k) dst[n][k] = *(const PG8_LAS bf16x8*)(lds + PG8_SB(b, h) + boff + n * 2048 + k * 1024); } while (0)
#define PG8_MMA(ai, bj, At, Bt) do { __builtin_amdgcn_s_setprio(1); _Pragma("unroll") for (int m = 0; m < 4; ++m) _Pragma("unroll") for (int n = 0; n < 2; ++n) _Pragma("unroll") for (int k = 0; k < 2; ++k) \
        { if constexpr (Epi::I8) acc[ai][bj][m][n] = __builtin_amdgcn_mfma_i32_16x16x64_i8(__builtin_bit_cast(i32x4, Bt[n][k]), __builtin_bit_cast(i32x4, At[m][k]), acc[ai][bj][m][n], 0, 0, 0); \
          else acc[ai][bj][m][n] = __builtin_amdgcn_mfma_f32_16x16x32_bf16(Bt[n][k], At[m][k], acc[ai][bj][m][n], 0, 0, 0); } __builtin_amdgcn_s_setprio(0); } while (0)
#define PG8_WAIT_V(n) asm volatile("s_waitcnt vmcnt(" #n ")" ::: "memory")
#define PG8_WAIT_L(n) asm volatile("s_waitcnt lgkmcnt(" #n ")" ::: "memory")
#define PG8_BAR __builtin_amdgcn_s_barrier()
#define PG8_SCHED __builtin_amdgcn_sched_barrier(0)
    Unit cur, nxt; int ui = 0;
    if (!S.next(0, cur)) return;
    typedef typename AccT<Epi::I8>::type acc_t;
    acc_t acc[2][2][4][2];
    if constexpr (Epi::HAS_INIT) E.init(acc, cur, wr, wc, fr, fq);
    else {
#pragma unroll
    for (int a = 0; a < 2; ++a)
#pragma unroll
        for (int b = 0; b < 2; ++b)
#pragma unroll
            for (int m = 0; m < 4; ++m)
#pragma unroll
                for (int n = 0; n < 2; ++n) acc[a][b][m][n] = acc_t{};
    }
    bf16x8 At[4][2], B0[2][2], B1[2][2];
    const char* cA = (const char*)g.A + (size_t)cur.pm * tstep; const char* cB = (const char*)g.Bt + (size_t)cur.pn * tstep;
    S.a_ready(cur);
    if constexpr (SP2) {
        PG8_STAGE(PG8_SB(0, 0), cB, voffB); PG8_STAGE(PG8_SB(0, 1), cB + hstep, voffB); PG8_STAGE(PG8_SA(0, 0), cA, voffA); PG8_STAGE(PG8_SA(0, 1), cA + hstep, voffA);
        if (wr == 1) PG8_BAR;
        PG8_WAIT_V(2); PG8_BAR;
        PG8_STAGE(PG8_SB(1, 0), cB + kstep, voffB); PG8_STAGE(PG8_SA(1, 0), cA + kstep, voffA); PG8_STAGE(PG8_SB(1, 1), cB + hstep + kstep, voffB);
        PG8_WAIT_V(6); PG8_BAR;
    } else {
        PG8_STAGE(PG8_SB(0, 0), cB, voffB); PG8_STAGE(PG8_SA(0, 0), cA, voffA); PG8_STAGE(PG8_SB(0, 1), cB + hstep, voffB); PG8_STAGE(PG8_SA(0, 1), cA + hstep, voffA);
        if (wr == 1) PG8_BAR;
        PG8_WAIT_V(4); PG8_BAR;
        PG8_STAGE(PG8_SB(1, 0), cB + kstep, voffB); PG8_STAGE(PG8_SA(1, 0), cA + kstep, voffA); PG8_STAGE(PG8_SB(1, 1), cB + hstep + kstep, voffB);
        PG8_WAIT_V(6); PG8_BAR;
    }
    for (;;) {
        const bool has_next = S.next(ui + 1, nxt);
        const char* nA = has_next ? (const char*)g.A + (size_t)nxt.pm * tstep : cA; const char* nB = has_next ? (const char*)g.Bt + (size_t)nxt.pn * tstep : cB;
        for (int t = 0; t < nt; t += 2) {
            if constexpr (MIDK) { if (t == nt / 2) E.mid(acc, cur, wr, wc, fr, fq); }
            const bool last = (t == nt - 2);
            const char* a1 = cA + (size_t)(t + 1) * kstep;
            const char* a2 = last ? nA : cA + (size_t)(t + 2) * kstep; const char* b2 = last ? nB : cB + (size_t)(t + 2) * kstep;
            const char* a3 = a2 + kstep; const char* b3 = b2 + kstep;
            if (last && has_next) S.a_ready(nxt);
            if constexpr (SP2) {
            PG8_LDB(B0, 0, 0); PG8_LDB(B1, 0, 1); PG8_SCHED; PG8_LDA(At, 0, 0); PG8_STAGE(PG8_SA(1, 1), a1 + hstep, voffA);
            PG8_WAIT_V(8); PG8_WAIT_L(0); PG8_BAR; PG8_MMA(0, 0, At, B0); PG8_MMA(0, 1, At, B1); PG8_BAR; PG8_SCHED;
            PG8_LDA(At, 0, 1); PG8_STAGE(PG8_SB(0, 0), b2, voffB); PG8_STAGE(PG8_SB(0, 1), b2 + hstep, voffB); PG8_STAGE(PG8_SA(0, 0), a2, voffA);
            PG8_WAIT_V(8); PG8_WAIT_L(0); PG8_BAR; PG8_MMA(1, 0, At, B0); PG8_MMA(1, 1, At, B1); PG8_BAR; PG8_SCHED;
            PG8_LDB(B0, 1, 0); PG8_LDB(B1, 1, 1); PG8_SCHED; PG8_LDA(At, 1, 0); PG8_STAGE(PG8_SA(0, 1), a2 + hstep, voffA);
            PG8_WAIT_V(8); PG8_WAIT_L(0); PG8_BAR; PG8_MMA(0, 0, At, B0); PG8_MMA(0, 1, At, B1); PG8_BAR; PG8_SCHED;
            PG8_LDA(At, 1, 1); PG8_STAGE(PG8_SB(1, 0), b3, voffB); PG8_STAGE(PG8_SB(1, 1), b3 + hstep, voffB); PG8_STAGE(PG8_SA(1, 0), a3, voffA);
            PG8_WAIT_V(8); PG8_WAIT_L(0); PG8_BAR; PG8_MMA(1, 0, At, B0); PG8_MMA(1, 1, At, B1); PG8_BAR; PG8_SCHED;
            } else {
            PG8_LDB(B0, 0, 0); PG8_SCHED; PG8_LDA(At, 0, 0); PG8_STAGE(PG8_SA(1, 1), a1 + hstep, voffA);
            PG8_WAIT_L(8); PG8_BAR; PG8_WAIT_L(0); PG8_MMA(0, 0, At, B0); PG8_BAR; PG8_SCHED;
            PG8_LDB(B1, 0, 1); PG8_STAGE(PG8_SB(0, 0), b2, voffB);
            PG8_BAR; PG8_WAIT_L(0); PG8_MMA(0, 1, At, B1); PG8_BAR;
            PG8_LDA(At, 0, 1); PG8_STAGE(PG8_SA(0, 0), a2, voffA);
            PG8_BAR; PG8_WAIT_L(0); PG8_MMA(1, 0, At, B0); PG8_BAR; PG8_SCHED;
            PG8_STAGE(PG8_SB(0, 1), b2 + hstep, voffB);
            PG8_WAIT_V(6); PG8_BAR; PG8_MMA(1, 1, At, B1); PG8_BAR;
            PG8_LDB(B0, 1, 0); PG8_SCHED; PG8_LDA(At, 1, 0); PG8_STAGE(PG8_SA(0, 1), a2 + hstep, voffA);
            PG8_WAIT_L(8); PG8_BAR; PG8_WAIT_L(0); PG8_MMA(0, 0, At, B0); PG8_BAR; PG8_SCHED;
            PG8_LDB(B1, 1, 1); PG8_STAGE(PG8_SB(1, 0), b3, voffB);
            PG8_BAR; PG8_WAIT_L(0); PG8_MMA(0, 1, At, B1); PG8_BAR;
            PG8_LDA(At, 1, 1); PG8_STAGE(PG8_SA(1, 0), a3, voffA);
            PG8_BAR; PG8_WAIT_L(0); PG8_MMA(1, 0, At, B0); PG8_BAR; PG8_SCHED;
            PG8_STAGE(PG8_SB(1, 1), b3 + hstep, voffB);
            PG8_WAIT_V(6); PG8_BAR; PG8_MMA(1, 1, At, B1); PG8_BAR;
            }
        }
        if constexpr (ALIGN_EPI) { if (wr == 0) PG8_BAR; }
        if constexpr (!Epi::AFTER_DRAIN) { E(acc, cur, wr, wc, fr, fq); S.done(cur); }
        if (!has_next) break;
        if constexpr (Epi::HAS_INIT) E.init(acc, nxt, wr, wc, fr, fq);
        else {
#pragma unroll
        for (int a = 0; a < 2; ++a)
#pragma unroll
            for (int b = 0; b < 2; ++b)
#pragma unroll
                for (int m = 0; m < 4; ++m)
#pragma unroll
                    for (int n = 0; n < 2; ++n) acc[a][b][m][n] = acc_t{};
        }
        cur = nxt; cA = nA; cB = nB; ++ui;
        if constexpr (ALIGN_EPI) { if (wr == 1) PG8_BAR; }
    }
    PG8_WAIT_V(0);
    if constexpr (!ALIGN_EPI) { if (wr == 0) PG8_BAR; }
    PG8_BAR;
    if constexpr (Epi::AFTER_DRAIN) { E.fused(acc, cur, wr, wc, fr, fq, lds, wid, lane); S.done(cur); }
#undef PG8_SA
#undef PG8_SB
#undef PG8_STAGE
#undef PG8_LDA
#undef PG8_LDB
#undef PG8_MMA
#undef PG8_WAIT_V
#undef PG8_WAIT_L
#undef PG8_BAR
#undef PG8_SCHED
}
}

#define EPI_FOR(...) _Pragma("unroll") for (int ai = 0; ai < 2; ++ai) _Pragma("unroll") for (int m = 0; m < 4; ++m) { const int row = u.pm * 256 + ai * 128 + wr * 64 + m * 16 + fr; \
    _Pragma("unroll") for (int bj = 0; bj < 2; ++bj) { const int col = u.pn * 256 + bj * 128 + wc * 32 + 8 * fq; const f32x4 a0 = acc[ai][bj][m][0], a1 = acc[ai][bj][m][1]; __VA_ARGS__ } }
DI u32x4 pack8bf(f32x4 a, f32x4 b) { u32x4 w; w.x = pk2(a.x, a.y); w.y = pk2(a.z, a.w); w.z = pk2(b.x, b.y); w.w = pk2(b.z, b.w); return w; }
constexpr float C2 = 0.125f * 1.4426950408889634f;
struct EpiInProj {
    static constexpr bool PERM = true, AFTER_DRAIN = false, HAS_INIT = false, I8 = true;
    bf16_t* QK; bf16_t* KF; bf16_t* VT; bf16_t* GATES; const float* RS1  ; const float* SW  ; float* KSUM; bool ksum_on;
    DI void operator()(const pg8::i32x4 (&iacc)[2][2][4][2], const pg8::Unit& u, int wr, int wc, int fr, int fq) const {
        f32x4 acc[2][2][4][2];
#pragma unroll
        for (int bj = 0; bj < 2; ++bj) {
            const float* swp = SW + u.pn * 256 + bj * 128 + wc * 32 + 8 * fq;
            const f32x4 c0 = *(const f32x4*)swp * (1.f / 127.f), c1 = *(const f32x4*)(swp + 4) * (1.f / 127.f);
#pragma unroll
            for (int ai = 0; ai < 2; ++ai)
#pragma unroll
                for (int m = 0; m < 4; ++m) { acc[ai][bj][m][0] = __builtin_convertvector(iacc[ai][bj][m][0], f32x4) * c0; acc[ai][bj][m][1] = __builtin_convertvector(iacc[ai][bj][m][1], f32x4) * c1; }
        }
        const int seg = (u.pn * 256) >> 9;
        if (seg == 2 || seg == 5) {
            const int kind = seg == 5;
            EPI_FOR({
                const float rs = RS1[row]; const int bb = row >> 13, key = row & (SEQ - 1), kp = key & 15;
                const int nn = col - (kind ? 2560 : 1024), dim = nn & 63;
                bf16_t* vt = VT + (((size_t)((kind * 2 + bb) * NH + (nn >> 6)) * 256 + (key >> 5)) * 4 + ((dim >> 5) * 2 + ((key >> 4) & 1))) * 512 + (((kp >> 2) & 1) * 32 + (dim & 31)) * 8 + 4 * (kp >> 3) + (kp & 3);
                vt[0] = (bf16_t)f2bf(a0.x * rs); vt[8] = (bf16_t)f2bf(a0.y * rs); vt[16] = (bf16_t)f2bf(a0.z * rs); vt[24] = (bf16_t)f2bf(a0.w * rs);
                vt[32] = (bf16_t)f2bf(a1.x * rs); vt[40] = (bf16_t)f2bf(a1.y * rs); vt[48] = (bf16_t)f2bf(a1.z * rs); vt[56] = (bf16_t)f2bf(a1.w * rs);
            })
        } else if (seg == 1 || seg == 4) {
            const int kind = seg == 4;
            float cs[16];
#pragma unroll
            for (int i = 0; i < 16; ++i) cs[i] = 0.f;
            EPI_FOR({
                const float rs = RS1[row]; const f32x4 v0 = a0 * rs, v1 = a1 * rs;
                const int bb = row >> 13, key = row & (SEQ - 1), nn = col - (kind ? 2048 : 512), dim = nn & 63;
                *(u32x4*)(KF + (((size_t)((kind * 2 + bb) * NH + (nn >> 6)) * 256 + (key >> 5)) * 4 + (dim >> 4)) * 512 + (((dim >> 3) & 1) * 32 + (key & 31)) * 8) = pack8bf(v0, v1);
                if (seg == 1) { cs[bj * 8 + 0] += v0.x; cs[bj * 8 + 1] += v0.y; cs[bj * 8 + 2] += v0.z; cs[bj * 8 + 3] += v0.w; cs[bj * 8 + 4] += v1.x; cs[bj * 8 + 5] += v1.y; cs[bj * 8 + 6] += v1.z; cs[bj * 8 + 7] += v1.w; }
            })
            if (seg == 1 && ksum_on) {
                const bool b3 = (fr & 8) != 0, b2 = (fr & 4) != 0, b1 = (fr & 2) != 0, b0 = (fr & 1) != 0;
                float v8[8], v4[4];
#pragma unroll
                for (int i = 0; i < 8; ++i) v8[i] = (b3 ? cs[8 + i] : cs[i]) + __shfl_xor(b3 ? cs[i] : cs[8 + i], 8);
#pragma unroll
                for (int i = 0; i < 4; ++i) v4[i] = (b2 ? v8[4 + i] : v8[i]) + __shfl_xor(b2 ? v8[i] : v8[4 + i], 4);
                const float v20 = (b1 ? v4[2] : v4[0]) + __shfl_xor(b1 ? v4[0] : v4[2], 2), v21 = (b1 ? v4[3] : v4[1]) + __shfl_xor(b1 ? v4[1] : v4[3], 2);
                const float v1_ = (b0 ? v21 : v20) + __shfl_xor(b0 ? v20 : v21, 1);
                const int c = u.pn * 256 + (fr >> 3) * 128 + wc * 32 + 8 * fq + (fr & 7) - 512, row0 = u.pm * 256;
                KSUM[(size_t)wr * (NBATCH * NH * NBLK * HD) + ((size_t)(((row0 >> 13) * NH + (c >> 6)) * NBLK + ((row0 & (SEQ - 1)) >> 8))) * HD + (c & 63)] = v1_;
            }
        } else if (seg < 6) {
            const int cshift = seg == 3 ? -1024 : 0;
            EPI_FOR({ const float rs = RS1[row] * C2; *(u32x4*)(QK + (size_t)row * 1024 + col + cshift) = pack8bf(a0 * rs, a1 * rs); })
        } else {
            EPI_FOR({
                const float rs = RS1[row]; const f32x4 v0 = a0 * rs, v1 = a1 * rs;
                const f32x4 s0 = {sigmoidf_(v0.x), sigmoidf_(v0.y), sigmoidf_(v0.z), sigmoidf_(v0.w)}, s1 = {sigmoidf_(v1.x), sigmoidf_(v1.y), sigmoidf_(v1.z), sigmoidf_(v1.w)};
                *(u32x4*)(GATES + (size_t)row * GATEW + col - QKVW) = pack8bf(s0, s1);
            })
        }
    }
};
struct EpiMix {
    static constexpr bool PERM = true, AFTER_DRAIN = false, HAS_INIT = false, I8 = false;
    const bf16_t* GATES; bf16_t* MIXED;
    DI void mid(f32x4 (&acc)[2][2][4][2], const pg8::Unit& u, int wr, int wc, int fr_in, int fq_in) const {
        int fr = fr_in, fq = fq_in; asm volatile("" : "+v"(fr), "+v"(fq));
#pragma unroll
        for (int ai = 0; ai < 2; ++ai)
#pragma unroll
            for (int m = 0; m < 4; ++m) { const int row = u.pm * 256 + ai * 128 + wr * 64 + m * 16 + fr;
#pragma unroll
                for (int bj = 0; bj < 2; ++bj) { const int col = u.pn * 256 + bj * 128 + wc * 32 + 8 * fq;
                    const u32x4 ga = *(const u32x4*)(GATES + (size_t)row * GATEW + col), gb = *(const u32x4*)(GATES + (size_t)row * GATEW + 1024 + col);
                    const float r0 = bflo(ga.x) * __builtin_amdgcn_rcpf(fmaxf(bflo(gb.x), 1e-30f)), r1 = bfhi(ga.x) * __builtin_amdgcn_rcpf(fmaxf(bfhi(gb.x), 1e-30f));
                    const float r2 = bflo(ga.y) * __builtin_amdgcn_rcpf(fmaxf(bflo(gb.y), 1e-30f)), r3 = bfhi(ga.y) * __builtin_amdgcn_rcpf(fmaxf(bfhi(gb.y), 1e-30f));
                    const float r4 = bflo(ga.z) * __builtin_amdgcn_rcpf(fmaxf(bflo(gb.z), 1e-30f)), r5 = bfhi(ga.z) * __builtin_amdgcn_rcpf(fmaxf(bfhi(gb.z), 1e-30f));
                    const float r6 = bflo(ga.w) * __builtin_amdgcn_rcpf(fmaxf(bflo(gb.w), 1e-30f)), r7 = bfhi(ga.w) * __builtin_amdgcn_rcpf(fmaxf(bfhi(gb.w), 1e-30f));
                    acc[ai][bj][m][0] = acc[ai][bj][m][0] * (f32x4){r0, r1, r2, r3}; acc[ai][bj][m][1] = acc[ai][bj][m][1] * (f32x4){r4, r5, r6, r7}; }
                __builtin_amdgcn_sched_barrier(0); }
    }
    DI void operator()(const f32x4 (&acc)[2][2][4][2], const pg8::Unit& u, int wr, int wc, int fr, int fq) const {
        EPI_FOR({
            const u32x4 gb = *(const u32x4*)(GATES + (size_t)row * GATEW + 1024 + col);
            const f32x4 s0 = {fmaxf(bflo(gb.x), 1e-30f), fmaxf(bfhi(gb.x), 1e-30f), fmaxf(bflo(gb.y), 1e-30f), fmaxf(bfhi(gb.y), 1e-30f)};
            const f32x4 s1 = {fmaxf(bflo(gb.z), 1e-30f), fmaxf(bfhi(gb.z), 1e-30f), fmaxf(bflo(gb.w), 1e-30f), fmaxf(bfhi(gb.w), 1e-30f)};
            *(u32x4*)(MIXED + (size_t)row * DM + col) = pack8bf(a0 * s0, a1 * s1);
        })
    }
};
struct EpiResid {
    static constexpr bool PERM = true, AFTER_DRAIN = false, HAS_INIT = true, I8 = false;
    const float* X; bf16_t* HB;
    DI void init(f32x4 (&acc)[2][2][4][2], const pg8::Unit& u, int wr, int wc, int fr, int fq) const {
#pragma unroll
        for (int ai = 0; ai < 2; ++ai)
#pragma unroll
            for (int m = 0; m < 4; ++m) { const int row = u.pm * 256 + ai * 128 + wr * 64 + m * 16 + fr;
#pragma unroll
                for (int bj = 0; bj < 2; ++bj) { const float* xp = X + (size_t)row * DM + u.pn * 256 + bj * 128 + wc * 32 + 8 * fq; acc[ai][bj][m][0] = *(const f32x4*)xp; acc[ai][bj][m][1] = *(const f32x4*)(xp + 4); } }
    }
    DI void operator()(const f32x4 (&acc)[2][2][4][2], const pg8::Unit& u, int wr, int wc, int fr, int fq) const {
        EPI_FOR({ *(u32x4*)(HB + (size_t)row * DM + col) = pack8bf(a0, a1); })
    }
};
struct EpiPeerQ {
    static constexpr bool PERM = true, AFTER_DRAIN = false, HAS_INIT = false, I8 = false;
    bf16_t* Q2;
    DI void operator()(const f32x4 (&acc)[2][2][4][2], const pg8::Unit& u, int wr, int wc, int fr, int fq) const {
        EPI_FOR({ *(u32x4*)(Q2 + (size_t)row * PQW + col) = pack8bf(a0, a1); })
    }
};


DI void h_rows4(const bf16_t* H, float* RS2, float* SH, signed char* H8, int row0, int stride, int lane) {
    u32x4 a[4][2];
#pragma unroll
    for (int k = 0; k < 4; ++k)
#pragma unroll
        for (int j = 0; j < 2; ++j) a[k][j] = *(const u32x4*)(H + (size_t)(row0 + k * stride) * DM + lane * 16 + 8 * j);
#pragma unroll
    for (int k = 0; k < 4; ++k) {
        const int row = row0 + k * stride;
        float v[16];
#pragma unroll
        for (int j = 0; j < 2; ++j) { v[8 * j] = bflo(a[k][j].x); v[8 * j + 1] = bfhi(a[k][j].x); v[8 * j + 2] = bflo(a[k][j].y); v[8 * j + 3] = bfhi(a[k][j].y);
            v[8 * j + 4] = bflo(a[k][j].z); v[8 * j + 5] = bfhi(a[k][j].z); v[8 * j + 6] = bflo(a[k][j].w); v[8 * j + 7] = bfhi(a[k][j].w); }
        float ss = 0.f, am = 0.f;
#pragma unroll
        for (int j = 0; j < 16; ++j) { ss += v[j] * v[j]; am = fmaxf(am, fabsf(v[j])); }
        ss = wave_sum(ss);
#pragma unroll
        for (int o = 32; o >= 1; o >>= 1) am = fmaxf(am, __shfl_xor(am, o));
        const float sc = am > 0.f ? am * (1.f / 127.f) : 1.f, isc = 1.f / sc;
        unsigned w[4];
#pragma unroll
        for (int j = 0; j < 4; ++j) w[j] = q8x4(v[4 * j], v[4 * j + 1], v[4 * j + 2], v[4 * j + 3], isc);
        *(u32x4*)(H8 + (size_t)row * DM + lane * 16) = (u32x4){w[0], w[1], w[2], w[3]};
        if (lane == 0) { RS2[row] = rsqrtf(ss * (1.f / DM) + RMS_EPS); SH[row] = sc; }
    }
}

template <int NR>
DI void quant_rows(const float* pu, const float* pv, const float* g2, unsigned char* U8, unsigned char* V8, float* SU, float* SV, int row0, int stride, int lane) {
    f32x4 a[NR][4];
#pragma unroll
    for (int k = 0; k < NR; ++k) { const int row = row0 + k * stride, isv = row >= NEXP, e = row - (isv ? NEXP : 0); const float* src = (isv ? pv : pu) + (size_t)e * DM + lane * 16;
#pragma unroll
        for (int j = 0; j < 4; ++j) a[k][j] = *(const f32x4*)(src + 4 * j); }
    f32x4 gq[4];
#pragma unroll
    for (int j = 0; j < 4; ++j) gq[j] = *(const f32x4*)(g2 + lane * 16 + 4 * j);
#pragma unroll
    for (int k = 0; k < NR; ++k) {
        const int row = row0 + k * stride, isv = row >= NEXP, e = row - (isv ? NEXP : 0);
        float v[16];
#pragma unroll
        for (int j = 0; j < 4; ++j) { const f32x4 x = isv ? a[k][j] : a[k][j] * gq[j]; v[4 * j] = x.x; v[4 * j + 1] = x.y; v[4 * j + 2] = x.z; v[4 * j + 3] = x.w; }
        float am = 0.f;
#pragma unroll
        for (int j = 0; j < 16; ++j) am = fmaxf(am, fabsf(v[j]));
#pragma unroll
        for (int o = 32; o >= 1; o >>= 1) am = fmaxf(am, __shfl_xor(am, o));
        const float sc = am > 0.f ? am * (1.f / 127.f) : 1.f, isc = 1.f / sc;
        unsigned w[4];
#pragma unroll
        for (int j = 0; j < 4; ++j) w[j] = q8x4(v[4 * j], v[4 * j + 1], v[4 * j + 2], v[4 * j + 3], isc);
        unsigned char* dst = (isv ? V8 : U8) + ((size_t)((lane >> 3) * NEXP + e)) * 128 + (lane & 7) * 16;
        *(u32x4*)dst = (u32x4){w[0], w[1], w[2], w[3]};
        if (lane == 0) (isv ? SV : SU)[e] = sc;
    }
}

typedef float f32x16 __attribute__((ext_vector_type(16)));
#define MFMA32(a, b, c) __builtin_amdgcn_mfma_f32_32x32x16_bf16((a), (b), (c), 0, 0, 0)
constexpr float FLT_MIN_ = 1.17549435e-38f;

struct KV { bf16x8 k[4], v[4]; };
DI void load_kv(KV& f, const bf16_t* kp, const bf16_t* vp) {
#pragma unroll
    for (int i = 0; i < 4; ++i) { f.k[i] = *(const bf16x8*)(kp + 512 * i); f.v[i] = *(const bf16x8*)(vp + 512 * i); }
}
DI void load_kv_async(KV& f, const bf16_t* kp, const bf16_t* vp) {
    asm volatile("global_load_dwordx4 %0, %4, off\n\tglobal_load_dwordx4 %1, %4, off offset:1024\n\tglobal_load_dwordx4 %2, %4, off offset:2048\n\tglobal_load_dwordx4 %3, %4, off offset:3072"
                 : "=&v"(f.k[0]), "=&v"(f.k[1]), "=&v"(f.k[2]), "=&v"(f.k[3]) : "v"(kp) : "memory");
    asm volatile("global_load_dwordx4 %0, %4, off\n\tglobal_load_dwordx4 %1, %4, off offset:1024\n\tglobal_load_dwordx4 %2, %4, off offset:2048\n\tglobal_load_dwordx4 %3, %4, off offset:3072"
                 : "=&v"(f.v[0]), "=&v"(f.v[1]), "=&v"(f.v[2]), "=&v"(f.v[3]) : "v"(vp) : "memory");
}
#define KV_WAIT_K(f, N) asm volatile("s_waitcnt vmcnt(" #N ")" : "+v"(f.k[0]), "+v"(f.k[1]), "+v"(f.k[2]), "+v"(f.k[3]) :: "memory")
#define KV_WAIT_V(f, N) asm volatile("s_waitcnt vmcnt(" #N ")" : "+v"(f.v[0]), "+v"(f.v[1]), "+v"(f.v[2]), "+v"(f.v[3]) :: "memory")
DI bf16x8 pack8(const f32x16& p, int s) {
    u32x4 w;
    if (s == 0) { w.x = cvtpk(p[0], p[1]); w.y = cvtpk(p[2], p[3]); w.z = cvtpk(p[4], p[5]); w.w = cvtpk(p[6], p[7]); }
    else { w.x = cvtpk(p[8], p[9]); w.y = cvtpk(p[10], p[11]); w.z = cvtpk(p[12], p[13]); w.w = cvtpk(p[14], p[15]); }
    return __builtin_bit_cast(bf16x8, w);
}
struct SmState { float m, l; f32x16 o0, o1; };
typedef float f32x2 __attribute__((ext_vector_type(2)));
DI float sum16(const f32x16& p) {
    const f32x2 s0 = (f32x2){p[0], p[1]} + (f32x2){p[2], p[3]}, s1 = (f32x2){p[4], p[5]} + (f32x2){p[6], p[7]};
    const f32x2 s2 = (f32x2){p[8], p[9]} + (f32x2){p[10], p[11]}, s3 = (f32x2){p[12], p[13]} + (f32x2){p[14], p[15]};
    const f32x2 t0 = s0 + s1, t1 = s2 + s3, u = t0 + t1;
    return u.x + u.y;
}
constexpr float LAZY_THR = 1.0995116e12f;
template <int WK = -1, int WV = -1>
DI void moba_tile_first(SmState& st, KV& f, const bf16x8 (&qf)[4], float bias0, float slopeL, int maskrow, int hh) {
    f32x16 acc;
#pragma unroll
    for (int r = 0; r < 16; ++r) acc[r] = bias0 + slopeL * (float)((r & 3) + 8 * (r >> 2));
    if constexpr (WK == 12) KV_WAIT_K(f, 12); else if constexpr (WK == 4) KV_WAIT_K(f, 4);
#pragma unroll
    for (int ks = 0; ks < 4; ++ks) acc = MFMA32(f.k[ks], qf[ks], acc);
    if (maskrow < 32) {
#pragma unroll
        for (int r = 0; r < 16; ++r) if ((r & 3) + 8 * (r >> 2) + 4 * hh > maskrow) acc[r] = -1e30f;
    }
    float tm = acc[0];
#pragma unroll
    for (int r = 1; r < 16; ++r) tm = fmaxf(tm, acc[r]);
    tm = fmaxf(tm, __shfl_xor(tm, 32));
    f32x16 pw;
#pragma unroll
    for (int r = 0; r < 16; ++r) pw[r] = __builtin_amdgcn_exp2f(acc[r] - tm);
    st.m = tm; st.l = sum16(pw);
    const bf16x8 p0 = pack8(pw, 0), p1 = pack8(pw, 1);
    if constexpr (WV == 8) KV_WAIT_V(f, 8); else if constexpr (WV == 0) KV_WAIT_V(f, 0);
    f32x16 z;
#pragma unroll
    for (int r = 0; r < 16; ++r) z[r] = 0.f;
    st.o0 = MFMA32(f.v[0], p0, z); st.o0 = MFMA32(f.v[1], p1, st.o0);
    st.o1 = MFMA32(f.v[2], p0, z); st.o1 = MFMA32(f.v[3], p1, st.o1);
}
template <int WK = -1, int WV = -1>
DI void moba_tile_lazy(SmState& st, KV& f, const bf16x8 (&qf)[4], float bias0, float slopeL, int hh) {
    f32x16 acc;
    const float b0 = bias0 - st.m;
#pragma unroll
    for (int r = 0; r < 16; ++r) acc[r] = b0 + slopeL * (float)((r & 3) + 8 * (r >> 2));
    if constexpr (WK == 12) KV_WAIT_K(f, 12); else if constexpr (WK == 4) KV_WAIT_K(f, 4);
#pragma unroll
    for (int ks = 0; ks < 4; ++ks) acc = MFMA32(f.k[ks], qf[ks], acc);
    f32x16 pw;
#pragma unroll
    for (int r = 0; r < 16; ++r) pw[r] = __builtin_amdgcn_exp2f(acc[r]);
    float ps = sum16(pw);
    if (__builtin_expect(__any(!(ps <= LAZY_THR)), 0)) {
        const int nl = !(ps <= LAZY_THR);
        const bool need = (nl | __shfl_xor(nl, 32)) != 0;
        float tm = acc[0];
#pragma unroll
        for (int r = 1; r < 16; ++r) tm = fmaxf(tm, acc[r]);
        tm = fmaxf(tm, __shfl_xor(tm, 32));
        const float d = need ? tm : 0.f, al = __builtin_amdgcn_exp2f(-d);
        st.m += d; st.l *= al; st.o0 = st.o0 * al; st.o1 = st.o1 * al;
#pragma unroll
        for (int r = 0; r < 16; ++r) pw[r] = __builtin_amdgcn_exp2f(acc[r] - d);
        ps = sum16(pw);
    }
    st.l += ps;
    const bf16x8 p0 = pack8(pw, 0), p1 = pack8(pw, 1);
    if constexpr (WV == 8) KV_WAIT_V(f, 8); else if constexpr (WV == 0) KV_WAIT_V(f, 0);
    st.o0 = MFMA32(f.v[0], p0, st.o0); st.o0 = MFMA32(f.v[1], p1, st.o0);
    st.o1 = MFMA32(f.v[2], p0, st.o1); st.o1 = MFMA32(f.v[3], p1, st.o1);
}
DI void moba_pass_own(SmState& st, const bf16x8 (&qf)[4], const bf16_t* kt0, const bf16_t* vt0, int w, int maskrow, float bb, float slopeL, int hh) {
    KV fa, fb;
    const float bs = slopeL * 32.f;
    load_kv(fa, kt0 + (size_t)w * 2048, vt0 + (size_t)w * 2048);
    if (w >= 1) load_kv(fb, kt0 + (size_t)(w - 1) * 2048, vt0 + (size_t)(w - 1) * 2048);
    moba_tile_first(st, fa, qf, bb + (float)w * bs, slopeL, maskrow, hh);
#pragma unroll 1
    for (int kt = w - 1; kt >= 0; kt -= 2) {
        if (kt >= 1) load_kv(fa, kt0 + (size_t)(kt - 1) * 2048, vt0 + (size_t)(kt - 1) * 2048);
        moba_tile_lazy(st, fb, qf, bb + (float)kt * bs, slopeL, hh);
        if (kt >= 1) {
            if (kt >= 2) load_kv(fb, kt0 + (size_t)(kt - 2) * 2048, vt0 + (size_t)(kt - 2) * 2048);
            moba_tile_lazy(st, fa, qf, bb + (float)(kt - 1) * bs, slopeL, hh);
        }
    }
}
template <bool MASKED>
DI void sb_tile(f32x16& o0, f32x16& o1, float& carry, const KV& f, const bf16x8 (&qf)[4], int maskrow, int hh) {
    f32x16 acc;
#pragma unroll
    for (int r = 0; r < 16; ++r) acc[r] = 0.f;
#pragma unroll
    for (int ks = 0; ks < 4; ++ks) acc = MFMA32(f.k[ks], qf[ks], acc);
    float bt[16], fc[16];
#pragma unroll
    for (int r = 0; r < 16; ++r) {
        const float z = acc[r];
        const float e = __builtin_amdgcn_exp2f(-fabsf(z)), rr = __builtin_amdgcn_rcpf(1.f + e), er = e * rr;
        const bool pos = z >= 0.f, msk = MASKED && ((r & 3) + 8 * (r >> 2) + 4 * hh) >= maskrow;
        bt[r] = msk ? 0.f : (pos ? rr : er);
        fc[r] = msk ? 1.f : (pos ? er : rr);
    }
    float G[4], Gp[4], wf[16];
#pragma unroll
    for (int g = 0; g < 4; ++g) {
        const float s3 = fc[4 * g + 3], s2 = s3 * fc[4 * g + 2], s1 = s2 * fc[4 * g + 1];
        G[g] = s1 * fc[4 * g];
        wf[4 * g + 3] = bt[4 * g + 3]; wf[4 * g + 2] = bt[4 * g + 2] * s3; wf[4 * g + 1] = bt[4 * g + 1] * s2; wf[4 * g] = bt[4 * g] * s1;
    }
#pragma unroll
    for (int g = 0; g < 4; ++g) Gp[g] = __shfl_xor(G[g], 32);
    const float T0 = G[0] * Gp[0], T1 = G[1] * Gp[1], T2 = G[2] * Gp[2], T3 = G[3] * Gp[3];
    const float RR2 = T3, RR1 = T3 * T2, RR0 = RR1 * T1, total = RR0 * T0;
    float base[4];
    base[3] = carry * (hh == 0 ? Gp[3] : 1.f);
    base[2] = carry * RR2 * (hh == 0 ? Gp[2] : 1.f);
    base[1] = carry * RR1 * (hh == 0 ? Gp[1] : 1.f);
    base[0] = carry * RR0 * (hh == 0 ? Gp[0] : 1.f);
    f32x16 pw;
#pragma unroll
    for (int r = 0; r < 16; ++r) pw[r] = wf[r] * base[r >> 2];
    carry *= total;
    const bf16x8 p0 = pack8(pw, 0), p1 = pack8(pw, 1);
    o0 = MFMA32(f.v[0], p0, o0); o0 = MFMA32(f.v[1], p1, o0);
    o1 = MFMA32(f.v[2], p0, o1); o1 = MFMA32(f.v[3], p1, o1);
}
DI void store_o(bf16_t* orow  , const f32x16& o0, const f32x16& o1, float sc) {
#pragma unroll
    for (int g = 0; g < 4; ++g) {
        u32x2 a; a.x = cvtpk(o0[4 * g] * sc, o0[4 * g + 1] * sc); a.y = cvtpk(o0[4 * g + 2] * sc, o0[4 * g + 3] * sc); *(u32x2*)(orow + 8 * g) = a;
        u32x2 c; c.x = cvtpk(o1[4 * g] * sc, o1[4 * g + 1] * sc); c.y = cvtpk(o1[4 * g + 2] * sc, o1[4 * g + 3] * sc); *(u32x2*)(orow + 32 + 8 * g) = c;
    }
}
constexpr int ML_OPART = 0;
constexpr int ML_ML = 4 * 256 * 68 * 2;
constexpr int ML_LISTS = ML_ML + 4 * 256 * 2 * 4;
constexpr int ML_SELS = ML_LISTS + 32 * 256;
constexpr int ML_CNT = ML_SELS + 1024;
constexpr int ML_UST = ML_CNT + 128;
constexpr int ML_QCTR = ML_UST + 144;
constexpr int ML_ITEM = ML_QCTR + 16;
constexpr int ML_UJ = ML_ITEM + 16;
static_assert(ML_UJ + 64 <= LDS_BYTES - 16, "MoBA LDS map");
DI void top3_insert(float s, int b, float& v0, float& v1, float& v2, int& i0, int& i1, int& i2) {
    const bool g0 = s > v0, g1 = s > v1, g2 = s > v2;
    v2 = g1 ? v1 : (g2 ? s : v2); i2 = g1 ? i1 : (g2 ? b : i2);
    v1 = g0 ? v0 : (g1 ? s : v1); i1 = g0 ? i0 : (g1 ? b : i1);
    v0 = g0 ? s : v0; i0 = g0 ? b : i0;
}
DI int p3_order(int i) {
    constexpr unsigned long long W0 = 0x1918171612151413ull, W1 = 0x1d1c1e1b0b1f1a11ull, W2 = 0x08070d0e0f0c0a10ull, W3 = 0x0001020403050906ull;
    const unsigned long long w = (i >> 3) == 0 ? W0 : ((i >> 3) == 1 ? W1 : ((i >> 3) == 2 ? W2 : W3));
    return (int)((w >> (8 * (i & 7))) & 255ull);
}
DI void sb_group(const bf16_t* QK, const bf16_t* KF, const bf16_t* VT, bf16_t* OB, int b, int head, int qt) {
    const int tid = threadIdx.x, wave = tid >> 6; int lane = tid & 63;
    asm volatile("" : "+v"(lane));
    const int r = lane & 31, hh = lane >> 5;
    const bf16_t* kp = KF + (size_t)((1 * 2 + b) * NH + head) * 256 * 2048 + lane * 8;
    const bf16_t* vp = VT + (size_t)((1 * 2 + b) * NH + head) * 256 * 2048 + lane * 8;
    const int kt0 = 8 * qt + wave, t = 32 * kt0 + r;
    const bf16_t* qp = QK + (size_t)(b * SEQ + t) * 1024 + 512 + head * HD + 8 * hh;
    bf16x8 qf[4];
#pragma unroll
    for (int ks = 0; ks < 4; ++ks) qf[ks] = *(const bf16x8*)(qp + 16 * ks);
    f32x16 o0, o1;
#pragma unroll
    for (int x = 0; x < 16; ++x) { o0[x] = 0.f; o1[x] = 0.f; }
    float carry = 1.f;
    KV fa, fb;
    int kt = kt0;
    load_kv(fa, kp + (size_t)kt * 2048, vp + (size_t)kt * 2048);
    if (kt >= 1) load_kv(fb, kp + (size_t)(kt - 1) * 2048, vp + (size_t)(kt - 1) * 2048);
    asm volatile("" ::: "memory");
    sb_tile<true>(o0, o1, carry, fa, qf, r, hh);
    if (!(kt < 1 || __all(carry < FLT_MIN_))) {
        for (;;) {
            if (kt >= 2) load_kv(fa, kp + (size_t)(kt - 2) * 2048, vp + (size_t)(kt - 2) * 2048);
            asm volatile("" ::: "memory");
            sb_tile<false>(o0, o1, carry, fb, qf, 32, hh);
            if (kt < 2 || __all(carry < FLT_MIN_)) break;
            if (kt >= 3) load_kv(fb, kp + (size_t)(kt - 3) * 2048, vp + (size_t)(kt - 3) * 2048);
            asm volatile("" ::: "memory");
            sb_tile<false>(o0, o1, carry, fa, qf, 32, hh);
            if (kt < 3 || __all(carry < FLT_MIN_)) break;
            kt -= 2;
        }
    }
    store_o(OB + (size_t)(b * SEQ + t) * (2 * WA) + WA + head * HD + 4 * hh, o0, o1, 1.f);
}
DI void moba_group(unsigned char* lds, const bf16_t* QK, const bf16_t* KF, const bf16_t* VT, const float* KSUM, bf16_t* OA, int b, int head, int og, bool with_sb) {
    const int tid = threadIdx.x, wave = tid >> 6; int lane = tid & 63;
    asm volatile("" : "+v"(lane));
    const int r = lane & 31, hh = lane >> 5;
    bf16_t* OPART = (bf16_t*)(lds + ML_OPART); float* MLS = (float*)(lds + ML_ML); unsigned char* LISTS = lds + ML_LISTS; unsigned char* SELS = lds + ML_SELS;
    int* CNT = (int*)(lds + ML_CNT); int* UST = (int*)(lds + ML_UST);
    const float slopeL = 1.4426950408889634f * exp2f(-(float)(head + 1));
    const bf16_t* kp = KF + (size_t)((0 * 2 + b) * NH + head) * 256 * 2048 + lane * 8;
    const bf16_t* vp = VT + (size_t)((0 * 2 + b) * NH + head) * 256 * 2048 + lane * 8;
    const bf16_t* qbase = QK + (size_t)(b * SEQ) * 1024 + head * HD + 8 * hh;
    __syncthreads();
    if (tid < 32) CNT[tid] = 0;
    __syncthreads();
    {
        const int c = 32 * wave + r;
        const bf16_t* qp = qbase + (size_t)(256 * og + c) * 1024;
        bf16x8 qf[4];
#pragma unroll
        for (int ks = 0; ks < 4; ++ks) qf[ks] = *(const bf16x8*)(qp + 16 * ks);
        f32x16 acc;
#pragma unroll
        for (int i = 0; i < 16; ++i) acc[i] = 0.f;
        const float* km = KSUM + ((size_t)(b * NH + head) * NBLK + r) * HD + 8 * hh;
#pragma unroll
        for (int ks = 0; ks < 4; ++ks) {
            const float* km2 = km + NBATCH * NH * NBLK * HD;
            const f32x4 s0 = (*(const f32x4*)(km + 16 * ks) + *(const f32x4*)(km2 + 16 * ks)) * (1.f / MBLK), s1 = (*(const f32x4*)(km + 16 * ks + 4) + *(const f32x4*)(km2 + 16 * ks + 4)) * (1.f / MBLK);
            const float mv[8] = {s0.x, s0.y, s0.z, s0.w, s1.x, s1.y, s1.z, s1.w};
            unsigned hb[8], lb[8];
#pragma unroll
            for (int e = 0; e < 8; ++e) { hb[e] = f2bf(mv[e]); lb[e] = f2bf(mv[e] - bf2f(hb[e])); }
            const u32x4 hw = {hb[0] | (hb[1] << 16), hb[2] | (hb[3] << 16), hb[4] | (hb[5] << 16), hb[6] | (hb[7] << 16)};
            const u32x4 lw = {lb[0] | (lb[1] << 16), lb[2] | (lb[3] << 16), lb[4] | (lb[5] << 16), lb[6] | (lb[7] << 16)};
            acc = MFMA32(__builtin_bit_cast(bf16x8, hw), qf[ks], acc); acc = MFMA32(__builtin_bit_cast(bf16x8, lw), qf[ks], acc);
        }
        float v0 = -INFINITY, v1 = -INFINITY, v2 = -INFINITY; int i0 = -1, i1 = -1, i2 = -1;
#pragma unroll
        for (int i = 0; i < 16; ++i) { const int blk = (i & 3) + 8 * (i >> 2) + 4 * hh; const float sv = blk < og ? acc[i] : -INFINITY; top3_insert(sv, blk, v0, v1, v2, i0, i1, i2); }
        const float pv0 = __shfl_xor(v0, 32), pv1 = __shfl_xor(v1, 32), pv2 = __shfl_xor(v2, 32);
        const int pi0 = __shfl_xor(i0, 32), pi1 = __shfl_xor(i1, 32), pi2 = __shfl_xor(i2, 32);
        top3_insert(pv0, pi0, v0, v1, v2, i0, i1, i2); top3_insert(pv1, pi1, v0, v1, v2, i0, i1, i2); top3_insert(pv2, pi2, v0, v1, v2, i0, i1, i2);
        if (hh == 0) {
            SELS[c * 4 + 0] = (unsigned char)(i0 < 0 ? 255 : i0); SELS[c * 4 + 1] = (unsigned char)(i1 < 0 ? 255 : i1); SELS[c * 4 + 2] = (unsigned char)(i2 < 0 ? 255 : i2);
            if (i0 >= 0) { const int ps = atomicAdd(&CNT[i0], 1); LISTS[i0 * 256 + ps] = (unsigned char)c; }
            if (i1 >= 0) { const int ps = atomicAdd(&CNT[i1], 1); LISTS[i1 * 256 + ps] = (unsigned char)c; }
            if (i2 >= 0) { const int ps = atomicAdd(&CNT[i2], 1); LISTS[i2 * 256 + ps] = (unsigned char)c; }
        }
    }
    __syncthreads();
    if (wave == 0) {
        const int jx = lane & 31, n = (CNT[jx] + 31) >> 5;
        int inc = n;
#pragma unroll
        for (int o = 1; o < 32; o <<= 1) { const int v = __shfl_up(inc, o, 32); if (jx >= o) inc += v; }
        const int st0 = inc - n;
        if (lane < 32) {
            UST[jx] = st0;
            unsigned char* UJ = lds + ML_UJ;
            for (int q = 0; q < n; ++q) UJ[st0 + q] = (unsigned char)jx;
            if (jx == 31) UST[32] = inc;
        }
        if (lane == 0) { *(volatile int*)(lds + ML_QCTR) = 0; }
    }
    __syncthreads();
    {
        const int Usel = UST[32], Utot = Usel + 8;
        int* qctr = (int*)(lds + ML_QCTR);
        int u = 0;
        if (lane == 0) u = atomicAdd(qctr, 1);
        u = __builtin_amdgcn_readfirstlane(u);
        const int sb_after = __builtin_amdgcn_readfirstlane(wave) >> 1;
        bool sb_done = !with_sb; int nun = 0;
        for (;;) {
            const bool have = u < Utot;
            if (!sb_done && (nun == sb_after || !have)) { sb_group(QK, KF, VT, OA, b, head, og); sb_done = true; }
            if (!have) break;
            ++nun;
            int un = 0;
            if (lane == 0) un = atomicAdd(qctr, 1);
            int j, slot, qi; bool valid;
            SmState st;
            if (u < Usel) {
                j = __builtin_amdgcn_readfirstlane((int)(lds + ML_UJ)[u]);
                const bf16_t* kt0 = kp + (size_t)(8 * j) * 2048; const bf16_t* vt0 = vp + (size_t)(8 * j) * 2048;
                KV fa, fb;
                load_kv_async(fa, kt0 + 7 * 2048, vt0 + 7 * 2048); load_kv_async(fb, kt0 + 6 * 2048, vt0 + 6 * 2048);
                const int i = u - UST[j], idx = 32 * i + r;
                valid = idx < CNT[j];
                qi = LISTS[j * 256 + (valid ? idx : 32 * i)];
                slot = (SELS[qi * 4] == j) ? 0 : ((SELS[qi * 4 + 1] == j) ? 1 : 2);
                const int t = 256 * og + qi;
                const bf16_t* qp = qbase + (size_t)t * 1024;
                bf16x8 qf[4];
#pragma unroll
                for (int ks = 0; ks < 4; ++ks) qf[ks] = *(const bf16x8*)(qp + 16 * ks);
                const float bb = slopeL * (float)(256 * j + 4 * hh - t), bs = slopeL * 32.f;
                moba_tile_first<12, 8>(st, fa, qf, bb + 7.f * bs, slopeL, 64, hh);   load_kv_async(fa, kt0 + 5 * 2048, vt0 + 5 * 2048);
                moba_tile_lazy<12, 8>(st, fb, qf, bb + 6.f * bs, slopeL, hh);        load_kv_async(fb, kt0 + 4 * 2048, vt0 + 4 * 2048);
                moba_tile_lazy<12, 8>(st, fa, qf, bb + 5.f * bs, slopeL, hh);        load_kv_async(fa, kt0 + 3 * 2048, vt0 + 3 * 2048);
                moba_tile_lazy<12, 8>(st, fb, qf, bb + 4.f * bs, slopeL, hh);        load_kv_async(fb, kt0 + 2 * 2048, vt0 + 2 * 2048);
                moba_tile_lazy<12, 8>(st, fa, qf, bb + 3.f * bs, slopeL, hh);        load_kv_async(fa, kt0 + 1 * 2048, vt0 + 1 * 2048);
                moba_tile_lazy<12, 8>(st, fb, qf, bb + 2.f * bs, slopeL, hh);        load_kv_async(fb, kt0, vt0);
                moba_tile_lazy<12, 8>(st, fa, qf, bb + bs, slopeL, hh);
                moba_tile_lazy<4, 0>(st, fb, qf, bb, slopeL, hh);
            } else {
                const int w = 7 - (u - Usel);
                j = og; qi = 32 * w + r; valid = true; slot = 3;
                const int t = 256 * og + qi;
                const bf16_t* qp = qbase + (size_t)t * 1024;
                bf16x8 qf[4];
#pragma unroll
                for (int ks = 0; ks < 4; ++ks) qf[ks] = *(const bf16x8*)(qp + 16 * ks);
                moba_pass_own(st, qf, kp + (size_t)(8 * og) * 2048, vp + (size_t)(8 * og) * 2048, w, r, slopeL * (float)(256 * og + 4 * hh - t), slopeL, hh);
            }
            const float lt = st.l + __shfl_xor(st.l, 32), inv = 1.f / lt;
            if (valid) {
                bf16_t* op = OPART + (size_t)(slot * 256 + qi) * 68 + 4 * hh;
#pragma unroll
                for (int g = 0; g < 4; ++g) {
                    u32x2 a; a.x = cvtpk(st.o0[4 * g] * inv, st.o0[4 * g + 1] * inv); a.y = cvtpk(st.o0[4 * g + 2] * inv, st.o0[4 * g + 3] * inv); *(u32x2*)(op + 8 * g) = a;
                    u32x2 c; c.x = cvtpk(st.o1[4 * g] * inv, st.o1[4 * g + 1] * inv); c.y = cvtpk(st.o1[4 * g + 2] * inv, st.o1[4 * g + 3] * inv); *(u32x2*)(op + 32 + 8 * g) = c;
                }
                if (hh == 0) { MLS[(slot * 256 + qi) * 2] = st.m; MLS[(slot * 256 + qi) * 2 + 1] = lt; }
            }
            u = __builtin_amdgcn_readfirstlane(un);
        }
    }
    __syncthreads();
    {
        const int c = 32 * wave + r, t = 256 * og + c;
        float M = -1e30f, ms[4], ls[4];
#pragma unroll
        for (int sl = 0; sl < 4; ++sl) {
            const bool v = sl == 3 || SELS[c * 4 + sl] != 255;
            ms[sl] = v ? MLS[(sl * 256 + c) * 2] : -1e30f; ls[sl] = v ? MLS[(sl * 256 + c) * 2 + 1] : 0.f;
            M = fmaxf(M, ms[sl]);
        }
        float L = 0.f; f32x16 o0, o1;
#pragma unroll
        for (int x = 0; x < 16; ++x) { o0[x] = 0.f; o1[x] = 0.f; }
#pragma unroll
        for (int sl = 0; sl < 4; ++sl) {
            const float w = ls[sl] * __builtin_amdgcn_exp2f(ms[sl] - M);
            L += w;
            const bf16_t* op = OPART + (size_t)(sl * 256 + c) * 68 + 4 * hh;
            if (ls[sl] > 0.f) {
#pragma unroll
                for (int g = 0; g < 4; ++g) {
                    const u32x2 a = *(const u32x2*)(op + 8 * g), cc = *(const u32x2*)(op + 32 + 8 * g);
                    o0[4 * g] += w * bflo(a.x); o0[4 * g + 1] += w * bfhi(a.x); o0[4 * g + 2] += w * bflo(a.y); o0[4 * g + 3] += w * bfhi(a.y);
                    o1[4 * g] += w * bflo(cc.x); o1[4 * g + 1] += w * bfhi(cc.x); o1[4 * g + 2] += w * bflo(cc.y); o1[4 * g + 3] += w * bfhi(cc.y);
                }
            }
        }
        store_o(OA + (size_t)(b * SEQ + t) * (2 * WA) + head * HD + 4 * hh, o0, o1, 1.f / L);
    }
}


#define CE(a, b) do { const unsigned lo_ = min(a, b), hi_ = max(a, b); a = lo_; b = hi_; } while (0)
DI void sort16_asc(unsigned (&k)[16]) {
    CE(k[0], k[1]); CE(k[2], k[3]); CE(k[0], k[2]); CE(k[1], k[3]); CE(k[1], k[2]); CE(k[4], k[5]); CE(k[6], k[7]); CE(k[4], k[6]); CE(k[5], k[7]); CE(k[5], k[6]);
    CE(k[0], k[4]); CE(k[2], k[6]); CE(k[2], k[4]); CE(k[1], k[5]); CE(k[3], k[7]); CE(k[3], k[5]); CE(k[1], k[2]); CE(k[3], k[4]); CE(k[5], k[6]); CE(k[8], k[9]);
    CE(k[10], k[11]); CE(k[8], k[10]); CE(k[9], k[11]); CE(k[9], k[10]); CE(k[12], k[13]); CE(k[14], k[15]); CE(k[12], k[14]); CE(k[13], k[15]); CE(k[13], k[14]);
    CE(k[8], k[12]); CE(k[10], k[14]); CE(k[10], k[12]); CE(k[9], k[13]); CE(k[11], k[15]); CE(k[11], k[13]); CE(k[9], k[10]); CE(k[11], k[12]); CE(k[13], k[14]);
    CE(k[0], k[8]); CE(k[4], k[12]); CE(k[4], k[8]); CE(k[2], k[10]); CE(k[6], k[14]); CE(k[6], k[10]); CE(k[2], k[4]); CE(k[6], k[8]); CE(k[10], k[12]);
    CE(k[1], k[9]); CE(k[5], k[13]); CE(k[5], k[9]); CE(k[3], k[11]); CE(k[7], k[15]); CE(k[7], k[11]); CE(k[3], k[5]); CE(k[7], k[9]); CE(k[11], k[13]);
    CE(k[1], k[2]); CE(k[3], k[4]); CE(k[5], k[6]); CE(k[7], k[8]); CE(k[9], k[10]); CE(k[11], k[12]); CE(k[13], k[14]);
}
DI void bitonic16_asc(unsigned (&k)[16]) {
    CE(k[0], k[8]); CE(k[1], k[9]); CE(k[2], k[10]); CE(k[3], k[11]); CE(k[4], k[12]); CE(k[5], k[13]); CE(k[6], k[14]); CE(k[7], k[15]); CE(k[0], k[4]);
    CE(k[1], k[5]); CE(k[2], k[6]); CE(k[3], k[7]); CE(k[8], k[12]); CE(k[9], k[13]); CE(k[10], k[14]); CE(k[11], k[15]); CE(k[0], k[2]); CE(k[1], k[3]);
    CE(k[4], k[6]); CE(k[5], k[7]); CE(k[8], k[10]); CE(k[9], k[11]); CE(k[12], k[14]); CE(k[13], k[15]); CE(k[0], k[1]); CE(k[2], k[3]); CE(k[4], k[5]);
    CE(k[6], k[7]); CE(k[8], k[9]); CE(k[10], k[11]); CE(k[12], k[13]); CE(k[14], k[15]);
}

DI unsigned fkey(float v, unsigned idx) { unsigned b = __float_as_uint(v); b = (b & 0x80000000u) ? ~b : (b | 0x80000000u); return (b & ~127u) | idx; }
DI float fkey_val(unsigned k) { unsigned b = k & ~127u; b = (b & 0x80000000u) ? (b & 0x7fffffffu) : ~b; return __uint_as_float(b); }
DI void top16_of_128(const f32x4 (&acc)[8], int g, unsigned (&t)[16]) {
    unsigned ka[16], kb[16];
#pragma unroll
    for (int ni = 0; ni < 4; ++ni)
#pragma unroll
        for (int j = 0; j < 4; ++j) { ka[4 * ni + j] = fkey(acc[ni][j], 16 * ni + 4 * g + j); kb[4 * ni + j] = fkey(acc[ni + 4][j], 16 * (ni + 4) + 4 * g + j); }
    sort16_asc(ka); sort16_asc(kb);
#pragma unroll
    for (int i = 0; i < 16; ++i) t[i] = max(ka[i], kb[15 - i]);
    bitonic16_asc(t);
#pragma unroll
    for (int xo = 16; xo <= 32; xo <<= 1) {
        unsigned pp[16];
#pragma unroll
        for (int i = 0; i < 16; ++i) pp[i] = (unsigned)__shfl_xor((int)t[i], xo);
#pragma unroll
        for (int i = 0; i < 16; ++i) t[i] = max(t[i], pp[15 - i]);
        bitonic16_asc(t);
    }
}

#define LAS __attribute__((address_space(3)))
#define XB_TMO      128
#define XB_XCNT(j)  (256  + 64 * (j))
#define XB_XSUB(j)  (1280 + 64 * (j))
#define XB_XGEN(j)  (2304 + 64 * (j))
#define XB_TOP      3328
#define XB_TOPGEN   3392
#define XCD_BAR_WORDS 3456
#define XB_SPIN_CAP (1u << 18)

__device__ __forceinline__ unsigned xb_ld(unsigned* p)              { return __hip_atomic_load(p, __ATOMIC_RELAXED, __HIP_MEMORY_SCOPE_AGENT); }
__device__ __forceinline__ unsigned xb_add(unsigned* p, unsigned v) { return __hip_atomic_fetch_add(p, v, __ATOMIC_RELAXED, __HIP_MEMORY_SCOPE_AGENT); }
__device__ __forceinline__ unsigned xb_xcc_id() { return (unsigned)__builtin_amdgcn_s_getreg((3 << 11) | 20) & 0xFu; }
#define XB_SPIN(cond, bar) do { unsigned _sp = 0; while (cond) { __builtin_amdgcn_s_sleep(1); \
    if ((++_sp & 255u) == 0u) { if (xb_ld(&(bar)[XB_TMO])) break; if (_sp > XB_SPIN_CAP) { atomicAdd(&(bar)[XB_TMO], 1u); break; } } } } while (0)

struct XcdBarrier {
    unsigned* bar; unsigned x;
    volatile LAS unsigned* st;
};

__device__ __forceinline__ XcdBarrier xcd_barrier_post(unsigned* bar, volatile LAS unsigned* st, unsigned& rank) {
    XcdBarrier b; b.bar = bar; b.x = xb_xcc_id(); b.st = st;
    rank = 0u;
    if (threadIdx.x == 0) rank = xb_add(&bar[XB_XCNT(b.x)], 1u);
    return b;
}
__device__ __forceinline__ void xcd_barrier_complete(unsigned* bar, unsigned x, unsigned& nloc, unsigned& nx, unsigned& zmask) {
    const unsigned G = gridDim.x * gridDim.y * gridDim.z;
    unsigned sum, cnt, mine, zm, sp = 0u;
    for (;;) {
        sum = 0u; cnt = 0u; mine = 0u; zm = 0u;
#pragma unroll
        for (unsigned j = 0; j < 16; ++j) { const unsigned c = xb_ld(&bar[XB_XCNT(j)]); sum += c; cnt += (c > 0u) ? 1u : 0u; mine = (j == x) ? c : mine; zm |= (c == 0u && j < 8u) ? (1u << j) : 0u; }
        if (sum == G) break;
        __builtin_amdgcn_s_sleep(1);
        if ((++sp & 255u) == 0u) { if (xb_ld(&bar[XB_TMO])) break; if (sp > XB_SPIN_CAP) { atomicAdd(&bar[XB_TMO], 1u); break; } }
    }
    nloc = mine > 0u ? mine : 1u; nx = cnt > 0u ? cnt : 1u; zmask = zm;
}

__device__ __forceinline__ void xcd_barrier(const XcdBarrier& b) {
    asm volatile("s_waitcnt vmcnt(0)" ::: "memory");
    __syncthreads();
    if (threadIdx.x == 0) {
        unsigned* bar = b.bar;
        __builtin_amdgcn_s_waitcnt(0);
        unsigned nloc = b.st[0], nx = b.st[1];
        if (nloc == 0u) { unsigned zmask; xcd_barrier_complete(bar, b.x, nloc, nx, zmask); b.st[0] = nloc; b.st[1] = nx; b.st[2] = zmask; }
        const unsigned old = xb_add(&bar[XB_XSUB(b.x)], 1u);
        const unsigned gen = old / nloc;
        if (old + 1u == (gen + 1u) * nloc) {
            __builtin_amdgcn_fence(__ATOMIC_RELEASE, "agent");
            asm volatile("s_waitcnt vmcnt(0)" ::: "memory");
            const unsigned og = xb_add(&bar[XB_TOP], 1u);
            const unsigned tg = og / nx;
            if (og + 1u == (tg + 1u) * nx) xb_add(&bar[XB_TOPGEN], 1u);
            else XB_SPIN(xb_ld(&bar[XB_TOPGEN]) == tg, bar);
            __builtin_amdgcn_fence(__ATOMIC_ACQUIRE, "agent");
            xb_add(&bar[XB_XGEN(b.x)], 1u);
            asm volatile("s_waitcnt vmcnt(0)" ::: "memory");
        } else {
            XB_SPIN(xb_ld(&bar[XB_XGEN(b.x)]) == gen, bar);
            __builtin_amdgcn_fence(__ATOMIC_ACQUIRE, "agent");
            asm volatile("s_waitcnt vmcnt(0)" ::: "memory");
        }
    }
    __syncthreads();
}


__global__ void __launch_bounds__(NTHREADS, 2) fwd_kernel(Params p) {
    extern __shared__ __attribute__((aligned(16))) unsigned char lds[];
    const int tid = threadIdx.x, lane = tid & 63, wave = tid >> 6;
    const int G = gridDim.x, bid = blockIdx.x;
    const long gtid = (long)bid * NTHREADS + tid, gth = (long)G * NTHREADS;
    const int gwave = bid * NWAVES + wave, ngw = G * NWAVES;
    unsigned char* ws = p.ws;
    bf16_t* WIN = (bf16_t*)(ws + WS_WIN); bf16_t* WOA = (bf16_t*)(ws + WS_WOA);
    bf16_t* WMIX = (bf16_t*)(ws + WS_WMIX); bf16_t* WQ = (bf16_t*)(ws + WS_WQ); bf16_t* SK = (bf16_t*)(ws + WS_SK);
    float* RS1 = (float*)(ws + WS_RS1); float* RS2 = (float*)(ws + WS_RS2);
    bf16_t* XB = (bf16_t*)(ws + WS_XB); bf16_t* OA = (bf16_t*)(ws + WS_OA);
    unsigned short* EIDX = (unsigned short*)(ws + WS_EIDX); float* GW = (float*)(ws + WS_GW);
    bf16_t* QK = (bf16_t*)(ws + WS_QK); bf16_t* KF = (bf16_t*)(ws + WS_KF); bf16_t* VT = (bf16_t*)(ws + WS_VT); bf16_t* MIXED = (bf16_t*)(ws + WS_MIXED); bf16_t* HB = (bf16_t*)(ws + WS_HB);
    bf16_t* GATES = (bf16_t*)(ws + WS_GATES); bf16_t* Q2 = (bf16_t*)(ws + WS_Q2);
    float* SU = (float*)(ws + WS_SU); float* SV = (float*)(ws + WS_SV); float* SSP = (float*)(ws + WS_SSP); float* SH = (float*)(ws + WS_SH);
    signed char* H8 = (signed char*)(ws + WS_H8); int* AP = (int*)(ws + WS_AP); unsigned char* U8 = ws + WS_U8; unsigned char* V8 = ws + WS_V8;
    unsigned* CTL = (unsigned*)(ws + WS_CTL); float* KSUM = (float*)(ws + WS_KSUM); float* SWMAX = (float*)(ws + WS_SWMAX); float* WSC = (float*)(ws + WS_WSC); signed char* WH = (signed char*)(ws + WS_WH); signed char* WL = (signed char*)(ws + WS_WL);
    volatile LAS unsigned* bst = (volatile LAS unsigned*)((LAS unsigned char*)lds + (LDS_BYTES - 16));
    if (tid < 4) bst[tid] = 0u;
    __syncthreads();
    unsigned xrank;
    const XcdBarrier xbar = xcd_barrier_post((unsigned*)(ws + WS_CTL) + 1024, bst, xrank);
    volatile unsigned* rankw = (volatile unsigned*)(lds + (LDS_BYTES - 32));
    const int lo = p.ph_lo, hi = p.ph_hi;
#ifdef ONLY_PHASE
#define IN(k) ((k) == ONLY_PHASE && lo <= (k) && (k) < hi)
#else
#define IN(k) (lo <= (k) && (k) < hi)
#endif
#define SEAM(k) do { if (IN(k) && IN((k) + 1)) xcd_barrier(xbar); } while (0)

    for (int rep_ = 0; rep_ < (IN(0) ? 1 : 0); ++rep_) {
        for (int nb = bid; nb < INW / 32; nb += G) {
            float* scr = (float*)(lds + wave * (128 * 33 * 4));
            float* AMX = (float*)(lds + 8 * (128 * 33 * 4));
            const int n0 = 32 * nb, kw = 128 * wave;
            float am = 0.f;
            __syncthreads();
            {
#pragma unroll
                for (int hf = 0; hf < 2; ++hf) {
                    float wv[32], gv[32];
#pragma unroll
                    for (int i = 0; i < 32; ++i) { const int kk = 64 * hf + 2 * i + (lane >> 5); wv[i] = p.w_in[(size_t)(kw + kk) * INW + n0 + (lane & 31)]; gv[i] = p.g1[kw + kk]; }
#pragma unroll
                    for (int i = 0; i < 32; ++i) { const int kk = 64 * hf + 2 * i + (lane >> 5); const float v = wv[i] * gv[i]; scr[kk * 33 + (lane & 31)] = v; am = fmaxf(am, fabsf(v)); }
                }
            }
            am = fmaxf(am, __shfl_xor(am, 32));
            if (lane < 32) AMX[wave * 32 + lane] = am;
            __syncthreads();
            const int kc = lane & 15;
#pragma unroll
            for (int j = 0; j < 8; ++j) {
                const int n = (lane >> 4) + 4 * j;
                float cm = AMX[n];
#pragma unroll
                for (int w2 = 1; w2 < 8; ++w2) cm = fmaxf(cm, AMX[w2 * 32 + n]);
                const float isc = cm > 0.f ? 127.f / cm : 0.f;
                const float* sp = scr + (8 * kc) * 33 + n;
                unsigned lo, hi;
                lo = q8x4(sp[0], sp[33], sp[66], sp[99], isc); hi = q8x4(sp[4 * 33], sp[5 * 33], sp[6 * 33], sp[7 * 33], isc);
                *(u32x2*)((signed char*)WIN + (size_t)(n0 + n) * DM + kw + 8 * kc) = (u32x2){lo, hi};
                if (wave == 0 && kc == 0) SWMAX[n0 + n] = cm;
            }
        }
        __syncthreads();
        {
            float* scr = (float*)(lds + wave * 16384);
            constexpr int I_OA = (WA / 64) * (DM / 32), I_MIX = (DM / 64) * (DM / 32), I_Q = (DM / 64) * (PQW / 32);
            for (int it = gwave; it < 2 * I_OA + I_MIX + I_Q; it += ngw) {
                int r = it;
                if (r < I_OA) { transpose_item(p.w_oa, WA, DM, WOA, 2 * WA, 0, nullptr, scr, r, lane); continue; } r -= I_OA;
                if (r < I_OA) { transpose_item(p.w_ob, WA, DM, WOA, 2 * WA, WA, nullptr, scr, r, lane); continue; } r -= I_OA;
                if (r < I_MIX) { transpose_item(p.w_mix, DM, DM, WMIX, DM, 0, nullptr, scr, r, lane); continue; } r -= I_MIX;
                transpose_item(p.w_q, DM, PQW, WQ, DM, 0, p.g2, scr, r, lane);
            }
            for (long i = gtid; i < 16L * 128 * 128; i += gth) SK[i] = (bf16_t)f2bf(p.skeys[i]);
        }
        for (int row0 = gwave; row0 < T; row0 += 8 * ngw) {
            f32x4 xv[8][4];
#pragma unroll
            for (int k = 0; k < 8; ++k) {
                const int row = row0 + k * ngw;
                if (row < T) {
#pragma unroll
                    for (int j = 0; j < 4; ++j) xv[k][j] = ((const f32x4*)(p.x + (size_t)row * DM) + lane)[64 * j];
                }
            }
#pragma unroll
            for (int k = 0; k < 8; ++k) {
                const int row = row0 + k * ngw;
                if (row < T) {
                    float sq = 0.f, am = 0.f;
#pragma unroll
                    for (int j = 0; j < 4; ++j) { const f32x4 v = xv[k][j]; sq += v.x * v.x + v.y * v.y + v.z * v.z + v.w * v.w; am = fmaxf(fmaxf(am, fmaxf(fabsf(v.x), fabsf(v.y))), fmaxf(fabsf(v.z), fabsf(v.w))); }
                    sq = wave_sum(sq);
#pragma unroll
                    for (int o = 32; o >= 1; o >>= 1) am = fmaxf(am, __shfl_xor(am, o));
                    const float sc = am > 0.f ? am * (1.f / 127.f) : 1.f, isc = 1.f / sc;
                    unsigned* ob = (unsigned*)(XB + (size_t)row * (DM / 2)) + lane;
#pragma unroll
                    for (int j = 0; j < 4; ++j) { const f32x4 v = xv[k][j]; ob[64 * j] = q8x4(v.x, v.y, v.z, v.w, isc); }
                    if (lane == 0) RS1[row] = sc * rsqrtf(sq * (1.f / DM) + RMS_EPS);
                }
            }
        }
    }
    if (tid == 0) rankw[0] = xrank;
    SEAM(0);

    for (int rep_ = 0; rep_ < (IN(1) ? (PROBE_REP == 1 ? 2 : 1) : 0); ++rep_) {
        pg8::Gemm gm{XB, WIN, T, INW, DM / 2}; pg8::StaticOrder S; S.init(T, INW, G, bid);
        EpiInProj E{QK, KF, VT, GATES, RS1, SWMAX, KSUM, rep_ == 0};
        pg8::gemm_phase<EpiInProj, pg8::StaticOrder, true, true>((PG8_LAS unsigned char*)lds, gm, S, E);
    }
    SEAM(1);

    for (int rep_ = 0; rep_ < (IN(3) ? (PROBE_REP == 3 ? 2 : 1) : 0); ++rep_) {
        {
            const unsigned xcc = (unsigned)__builtin_amdgcn_s_getreg((3 << 11) | 20) & 7u;
            const int rank = __builtin_amdgcn_readfirstlane((int)rankw[0]), nloc = __builtin_amdgcn_readfirstlane((int)bst[0]), zmask = __builtin_amdgcn_readfirstlane((int)bst[2]);
            for (int pass = 0; pass < 9; ++pass) {
                int qx, r0, step;
                if (pass == 0) { qx = (int)xcc; r0 = rank; step = nloc; }
                else { qx = pass - 1; if (!((zmask >> qx) & 1)) continue; r0 = bid; step = G; }
                for (int t = 0; t * step < 64; ++t) {
                    const int k = t * step + ((t & 1) ? step - 1 - r0 : r0);
                    if (k >= 64) continue;
                    const int og = p3_order(k >> 1), bh = 2 * qx + (k & 1);
                    moba_group(lds, QK, KF, VT, KSUM, OA, bh >> 3, bh & 7, og, true);
                }
            }
        }
    }
    SEAM(3);

    for (int rep_ = 0; rep_ < (IN(4) ? 1 : 0); ++rep_) {
        pg8::Gemm gm{OA, WOA, T, DM, 2 * WA}; pg8::StaticOrder S; S.init(T, DM, G, bid);
        EpiMix E{GATES, MIXED};
        pg8::gemm_phase<EpiMix, pg8::StaticOrder, true, true, true>((PG8_LAS unsigned char*)lds, gm, S, E);
    }
    SEAM(4);

    for (int rep_ = 0; rep_ < (IN(5) ? (PROBE_REP == 5 ? 2 : 1) : 0); ++rep_) {
        pg8::Gemm gm{MIXED, WMIX, T, DM, DM}; pg8::StaticOrder S; S.init(T, DM, G, bid);
        EpiResid E{p.x, HB};
        pg8::gemm_phase<EpiResid, pg8::StaticOrder, true, true>((PG8_LAS unsigned char*)lds, gm, S, E);
    }
    SEAM(5);

    for (int rep_ = 0; rep_ < (IN(7) ? 1 : 0); ++rep_) {
        pg8::Gemm gm{HB, WQ, T, PQW, DM}; pg8::StaticOrder S; S.init(T, PQW, G, bid);
        EpiPeerQ E{Q2};
        pg8::gemm_phase<EpiPeerQ, pg8::StaticOrder, true, true>((PG8_LAS unsigned char*)lds, gm, S, E);
    }
    SEAM(7);

    for (int rep_ = 0; rep_ < (IN(8) ? (PROBE_REP == 8 ? 2 : 1) : 0); ++rep_) {
        bf16_t* Qs = (bf16_t*)lds;
        bf16_t* Ks = Qs + 128 * 264;
        unsigned* LST = (unsigned*)(lds + 128 * 264 * 2 + 2 * 128 * 136 * 2);
        int h_loaded = -1;
        __syncthreads();
        if (bid < (T / 128) * 8) {
            const int h0 = bid & 7, t00 = (bid >> 3) * 128;
#pragma unroll
            for (int i = 0; i < 8; ++i) { const int c = tid + i * NTHREADS, r = c >> 5, ch = c & 31; *(u32x4*)(Qs + r * 264 + ch * 8) = *(const u32x4*)(Q2 + (size_t)(t00 + r) * PQW + h0 * 256 + ch * 8); }
        }
        for (int it = bid; it < (T / 128) * 8; it += G) {
            const int h = it & 7, t0 = (it >> 3) * 128;
            if (h != h_loaded) {
#pragma unroll
                for (int i = 0; i < 8; ++i) {
                    const int c = tid + i * NTHREADS, r = c >> 4, ch = c & 15;
                    *(u32x4*)(Ks + r * 136 + ch * 8) = *(const u32x4*)(SK + (size_t)(2 * h * 128 + r) * 128 + ch * 8);
                }
                h_loaded = h;
            }
            __syncthreads();
#pragma unroll 1
            for (int ph = 0; ph < 2; ++ph) {
                f32x4 acc[8];
#pragma unroll
                for (int ni = 0; ni < 8; ++ni) acc[ni] = (f32x4){0.f, 0.f, 0.f, 0.f};
#pragma unroll
                for (int ks = 0; ks < 4; ++ks) {
                    const bf16x8 qf = *(const bf16x8*)(Qs + (wave * 16 + (lane & 15)) * 264 + ph * 128 + ks * 32 + (lane >> 4) * 8);
#pragma unroll
                    for (int ni = 0; ni < 8; ++ni) {
                        const bf16x8 kf = *(const bf16x8*)(Ks + (ph * 128 + ni * 16 + (lane & 15)) * 136 + ks * 32 + (lane >> 4) * 8);
                        acc[ni] = __builtin_amdgcn_mfma_f32_16x16x32_bf16(kf, qf, acc[ni], 0, 0, 0);
                    }
                }
                unsigned tk[16];
                top16_of_128(acc, lane >> 4, tk);
                if (lane < 16) {
                    unsigned* dst = LST + ((wave * 16 + lane) * 2 + ph) * 16;
#pragma unroll
                    for (int i = 0; i < 4; ++i) { u32x4 w; w.x = tk[15 - 4 * i]; w.y = tk[14 - 4 * i]; w.z = tk[13 - 4 * i]; w.w = tk[12 - 4 * i]; *(u32x4*)(dst + 4 * i) = w; }
                }
            }
            __syncthreads();
            if (tid >= 128 && it + G < (T / 128) * 8) {
                const int itn = it + G, hn = itn & 7, tn0 = (itn >> 3) * 128;
                for (int c = tid - 128; c < 128 * 32; c += NTHREADS - 128) { const int r = c >> 5, ch = c & 31; *(u32x4*)(Qs + r * 264 + ch * 8) = *(const u32x4*)(Q2 + (size_t)(tn0 + r) * PQW + hn * 256 + ch * 8); }
            }
            if (wave >= 6) quant_rows<8>(p.pu, p.pv, p.g2, U8, V8, SU, SV, it * 32 + 16 + (wave - 6) * 8, 1, lane);
            else if (wave >= 2) quant_rows<4>(p.pu, p.pv, p.g2, U8, V8, SU, SV, it * 32 + (wave - 2) * 4, 1, lane);
            if (tid >= 128 && tid < 384) h_rows4(HB, RS2, SH, H8, it * 16 + (wave - 2) * 4, 1, lane);
            if (tid < 128) {
                const unsigned* La = LST + (tid * 2) * 16; const unsigned* Lb = La + 16;
                float cand[16];
                const float b0 = fkey_val(Lb[0]);
#pragma unroll
                for (int i = 0; i < 4; ++i) { const u32x4 w = *(const u32x4*)(La + 4 * i); cand[4 * i] = fkey_val(w.x) + b0; cand[4 * i + 1] = fkey_val(w.y) + b0; cand[4 * i + 2] = fkey_val(w.z) + b0; cand[4 * i + 3] = fkey_val(w.w) + b0; }
                unsigned long long ptrs = 0ull;
                float selv[16]; unsigned sele[16];
#pragma unroll
                for (int r = 0; r < 16; ++r) {
                    float best = cand[0];
#pragma unroll
                    for (int i = 1; i < 16; ++i) best = fmaxf(best, cand[i]);
                    int istar = 15;
#pragma unroll
                    for (int i = 14; i >= 0; --i) istar = (cand[i] == best) ? i : istar;
                    const int j = (int)((ptrs >> (4 * istar)) & 15ull);
                    const unsigned ka = La[istar], kb = Lb[j];
                    selv[r] = best; sele[r] = (ka & 127u) * PNK + (kb & 127u);
                    const bool more = j < 15;
                    const float nc = more ? fkey_val(ka) + fkey_val(Lb[more ? j + 1 : j]) : -INFINITY;
                    if (more) ptrs += 1ull << (4 * istar);
#pragma unroll
                    for (int i = 0; i < 16; ++i) cand[i] = (i == istar) ? nc : cand[i];
                }
                float* go = GW + (size_t)(t0 + tid) * 128 + h * 16;
#pragma unroll
                for (int r = 0; r < 8; ++r) *(unsigned*)(EIDX + (size_t)(t0 + tid) * 128 + r * 16 + 2 * h) = sele[r] | (sele[r + 8] << 16);
#pragma unroll
                for (int i = 0; i < 4; ++i) *(f32x4*)(go + 4 * i) = (f32x4){selv[4 * i], selv[4 * i + 1], selv[4 * i + 2], selv[4 * i + 3]};
            }
        }
    }
    SEAM(8);

#define PEER_ID(ia, ib, i) ((((i) < 8 ? (ia) : (ib))[((i) & 7) >> 1] >> (((i) & 1) * 16)) & 0xffffu)
#define PEER_ROWS4(dst, base, ia, ib, m) do { _Pragma("unroll") for (int q_ = 0; q_ < 4; ++q_) dst[4 * (m) + q_] = *(const u32x4*)((base) + (unsigned)(PEER_ID(ia, ib, 4 * (m) + q_) * 128u + jp16)); } while (0)
#define PEER_IDS(ia, ib, t) do { const unsigned short* ep_ = EIDX + (size_t)(t) * 128; ia = *(const u32x4*)(ep_ + (unsigned)(g * 16)); ib = *(const u32x4*)(ep_ + (unsigned)(g * 16 + 8)); } while (0)
    for (int rep_ = 0; rep_ < (IN(9) ? (PROBE_REP == 9 ? 2 : 1) : 0); ++rep_) {
        volatile int* ubox = (volatile int*)lds;
        const unsigned xcc = (unsigned)__builtin_amdgcn_s_getreg((3 << 11) | 20) & 7u;
        int ln = lane; asm volatile("" : "+v"(ln));
        const int g = ln >> 3, jp = ln & 7;
        const bool b2 = (ln & 4) != 0, b1 = (ln & 2) != 0, b0 = (ln & 1) != 0;
        const int wv = __builtin_amdgcn_readfirstlane(wave); const unsigned jp16 = (unsigned)jp * 16u;
        constexpr int NTW = 32;
        constexpr int NU = T / (8 * NTW);
        const int rank = __builtin_amdgcn_readfirstlane((int)rankw[0]), nloc = __builtin_amdgcn_readfirstlane((int)bst[0]), zmask = __builtin_amdgcn_readfirstlane((int)bst[2]);
        for (int pass = 0; pass < 9; ++pass) {
            int sl, u0, ustep;
            if (pass == 0) { sl = (int)xcc; u0 = rank; ustep = nloc; }
            else { sl = pass - 1; if (!((zmask >> sl) & 1)) continue; u0 = bid; ustep = G; }
            const unsigned char* U8s = U8 + (size_t)sl * NEXP * 128;
            for (int u = u0; u < NU; u += ustep) {
                const int tb = u * (8 * NTW) + wv;
#define P1_HQ(hq, t) hq = *(const u32x4*)(H8 + (size_t)(t) * DM + sl * 128 + jp16)
#define P1_DOT4(d, rw, hq, m) do { _Pragma("unroll") for (int q_ = 0; q_ < 4; ++q_) { int x_ = __builtin_amdgcn_sdot4((int)hq.x, (int)rw[4 * (m) + q_].x, 0, false); x_ = __builtin_amdgcn_sdot4((int)hq.y, (int)rw[4 * (m) + q_].y, x_, false); \
        x_ = __builtin_amdgcn_sdot4((int)hq.z, (int)rw[4 * (m) + q_].z, x_, false); d[4 * (m) + q_] = __builtin_amdgcn_sdot4((int)hq.w, (int)rw[4 * (m) + q_].w, x_, false); } } while (0)
#define P1_FINISH(d_, t) do { int v8_[8], v4_[4]; \
    _Pragma("unroll") for (int i_ = 0; i_ < 8; ++i_) v8_[i_] = (b2 ? d_[8 + i_] : d_[i_]) + __shfl_xor(b2 ? d_[i_] : d_[8 + i_], 4); \
    _Pragma("unroll") for (int i_ = 0; i_ < 4; ++i_) v4_[i_] = (b1 ? v8_[4 + i_] : v8_[i_]) + __shfl_xor(b1 ? v8_[i_] : v8_[4 + i_], 2); \
    const int k0_ = (b0 ? v4_[2] : v4_[0]) + __shfl_xor(b0 ? v4_[0] : v4_[2], 1), k1_ = (b0 ? v4_[3] : v4_[1]) + __shfl_xor(b0 ? v4_[1] : v4_[3], 1); \
    int* ap_ = AP + ((size_t)sl * T + (t)) * 128 + 16 * jp + g; ap_[0] = k0_; ap_[8] = k1_; } while (0)
#define P1_STEP(rw, hq, ea, eb, i, REISSUE) do { int d_[16]; \
    _Pragma("unroll") for (int m_ = 0; m_ < 4; ++m_) { P1_DOT4(d_, rw, hq, m_); __builtin_amdgcn_sched_barrier(0); if (REISSUE) { PEER_ROWS4(rw, U8s, ea, eb, m_); __builtin_amdgcn_sched_barrier(0); } } \
    P1_FINISH(d_, tb + 8 * (i)); } while (0)
                u32x4 e0a, e0b, e1a, e1b, h0, h1, rwA[16], rwB[16];
                PEER_IDS(e0a, e0b, tb); PEER_IDS(e1a, e1b, tb + 8); P1_HQ(h0, tb);
#pragma unroll
                for (int m_ = 0; m_ < 4; ++m_) PEER_ROWS4(rwA, U8s, e0a, e0b, m_);
#pragma unroll
                for (int m_ = 0; m_ < 4; ++m_) PEER_ROWS4(rwB, U8s, e1a, e1b, m_);
                PEER_IDS(e0a, e0b, tb + 16);
#pragma unroll 1
                for (int i = 0; i < NTW - 2; i += 2) {
                    PEER_IDS(e1a, e1b, tb + 8 * (i + 3));
                    P1_HQ(h1, tb + 8 * (i + 1));
                    P1_STEP(rwA, h0, e0a, e0b, i, true);
                    { const int tn = tb + 8 * (i + 4 < NTW ? i + 4 : NTW - 1); PEER_IDS(e0a, e0b, tn); }
                    P1_HQ(h0, tb + 8 * (i + 2));
                    P1_STEP(rwB, h1, e1a, e1b, i + 1, true);
                }
                P1_HQ(h1, tb + 8 * (NTW - 1));
                P1_STEP(rwA, h0, e0a, e0b, NTW - 2, false);
                P1_STEP(rwB, h1, e1a, e1b, NTW - 1, false);
            }
        }
    }
    SEAM(9);

    for (int rep_ = 0; rep_ < (IN(10) ? (PROBE_REP == 10 ? 2 : 1) : 0); ++rep_) {
        for (int t = gwave; t < T; t += ngw) {
            int s0 = 0, s1 = 0;
#pragma unroll
            for (int q = 0; q < 8; ++q) { const int* ap = AP + ((size_t)q * T + t) * 128; s0 += ap[lane]; s1 += ap[64 + lane]; }
            const int p0 = (lane & 7) * 16 + (lane >> 3), p1 = p0 + 8;
            const int e0 = EIDX[(size_t)t * 128 + p0], e1 = EIDX[(size_t)t * 128 + p1];
            const float sc = SH[t] * RS2[t];
            const float a0 = (float)s0 * (sc * SU[e0]), a1 = (float)s1 * (sc * SU[e1]);
            const float rs2t = RS2[t];
            const float c0 = GW[(size_t)t * 128 + lane] * rs2t, c1 = GW[(size_t)t * 128 + 64 + lane] * rs2t;
            float m0 = c0, m1 = c1;
#pragma unroll
            for (int o = 8; o >= 1; o >>= 1) { m0 = fmaxf(m0, __shfl_xor(m0, o)); m1 = fmaxf(m1, __shfl_xor(m1, o)); }
            const float x0e = __expf(c0 - m0), x1e = __expf(c1 - m1);
            float z0 = x0e, z1 = x1e;
#pragma unroll
            for (int o = 8; o >= 1; o >>= 1) { z0 += __shfl_xor(z0, o); z1 += __shfl_xor(z1, o); }
            const float w0 = (x0e * __builtin_amdgcn_rcpf(z0)) * (0.5f * a0 * (1.f + erff(a0 * 0.70710678118654752f))) * SV[e0];
            const float w1 = (x1e * __builtin_amdgcn_rcpf(z1)) * (0.5f * a1 * (1.f + erff(a1 * 0.70710678118654752f))) * SV[e1];
            float wm = fmaxf(fabsf(w0), fabsf(w1));
#pragma unroll
            for (int o = 32; o >= 1; o >>= 1) wm = fmaxf(wm, __shfl_xor(wm, o));
            const float wsc = wm > 0.f ? wm * (1.f / 127.f) : 1.f, iw = 1.f / wsc;
            const float x0 = w0 * iw, x1 = w1 * iw;
            int h0 = (int)rintf(x0), h1 = (int)rintf(x1);
            h0 = h0 < -127 ? -127 : (h0 > 127 ? 127 : h0); h1 = h1 < -127 ? -127 : (h1 > 127 ? 127 : h1);
            WH[(size_t)t * 128 + p0] = (signed char)h0; WH[(size_t)t * 128 + p1] = (signed char)h1;
            if (lane == 0) WSC[t] = wsc;
        }
    }
    SEAM(10);

    for (int rep_ = 0; rep_ < (IN(11) ? (PROBE_REP == 11 ? 2 : 1) : 0); ++rep_) {
        const bool dry_ = (PROBE_REP == 11) && rep_ == 0;
        volatile int* ubox = (volatile int*)lds;
        const unsigned xcc = (unsigned)__builtin_amdgcn_s_getreg((3 << 11) | 20) & 7u;
        int ln = lane; asm volatile("" : "+v"(ln));
        const int g = ln >> 3, jp = ln & 7;
        const bool b5 = (ln & 32) != 0, b4 = (ln & 16) != 0, b3 = (ln & 8) != 0;
        const int wv = __builtin_amdgcn_readfirstlane(wave); const unsigned jp16 = (unsigned)jp * 16u;
        constexpr int NTW = 32;
        constexpr int NU = T / (8 * NTW);
        const int rank = __builtin_amdgcn_readfirstlane((int)rankw[0]), nloc = __builtin_amdgcn_readfirstlane((int)bst[0]), zmask = __builtin_amdgcn_readfirstlane((int)bst[2]);
        for (int pass = 0; pass < 9; ++pass) {
            int sl, u0, ustep;
            if (pass == 0) { sl = (int)xcc; u0 = rank; ustep = nloc; }
            else { sl = pass - 1; if (!((zmask >> sl) & 1)) continue; u0 = bid; ustep = G; }
            const unsigned char* V8s = V8 + (size_t)sl * NEXP * 128;
            for (int u = u0; u < NU; u += ustep) {
                const int tb = u * (8 * NTW) + wv;
#define P2_WM(wh, hv, wsc, t) do { wh = *(const u32x4*)(WH + (size_t)(t) * 128 + (unsigned)(g * 16)); { const unsigned hw_ = *(const unsigned*)(HB + (size_t)(t) * DM + sl * 128 + (unsigned)(jp * 16 + 2 * g)); hv = (f32x2_t){bflo(hw_), bfhi(hw_)}; } wsc = WSC[t]; } while (0)
#define P2_COL(rw, wh, ah, c, cb, m) do { const unsigned t0_ = __builtin_amdgcn_perm(rw[4 * (m) + 1].c, rw[4 * (m)].c, 0x05010400u), t1_ = __builtin_amdgcn_perm(rw[4 * (m) + 3].c, rw[4 * (m) + 2].c, 0x05010400u); \
    const unsigned t2_ = __builtin_amdgcn_perm(rw[4 * (m) + 1].c, rw[4 * (m)].c, 0x07030602u), t3_ = __builtin_amdgcn_perm(rw[4 * (m) + 3].c, rw[4 * (m) + 2].c, 0x07030602u); \
    ah[(cb) + 0] = __builtin_amdgcn_sdot4((int)__builtin_amdgcn_perm(t1_, t0_, 0x05040100u), (int)wh[m], ah[(cb) + 0], false); ah[(cb) + 1] = __builtin_amdgcn_sdot4((int)__builtin_amdgcn_perm(t1_, t0_, 0x07060302u), (int)wh[m], ah[(cb) + 1], false); \
    ah[(cb) + 2] = __builtin_amdgcn_sdot4((int)__builtin_amdgcn_perm(t3_, t2_, 0x05040100u), (int)wh[m], ah[(cb) + 2], false); ah[(cb) + 3] = __builtin_amdgcn_sdot4((int)__builtin_amdgcn_perm(t3_, t2_, 0x07060302u), (int)wh[m], ah[(cb) + 3], false); } while (0)
#define P2_FINISH(d_, hv, wsc, t) do { int v8_[8], v4_[4]; \
    _Pragma("unroll") for (int i_ = 0; i_ < 8; ++i_) v8_[i_] = (b5 ? d_[8 + i_] : d_[i_]) + __shfl_xor(b5 ? d_[i_] : d_[8 + i_], 32); \
    _Pragma("unroll") for (int i_ = 0; i_ < 4; ++i_) v4_[i_] = (b4 ? v8_[4 + i_] : v8_[i_]) + __shfl_xor(b4 ? v8_[i_] : v8_[4 + i_], 16); \
    const int k0_ = (b3 ? v4_[2] : v4_[0]) + __shfl_xor(b3 ? v4_[0] : v4_[2], 8), k1_ = (b3 ? v4_[3] : v4_[1]) + __shfl_xor(b3 ? v4_[1] : v4_[3], 8); \
    bf16_t* orow_ = MIXED + (size_t)(t) * DM + sl * 128 + jp * 16 + 2 * g;     \
    const unsigned ob_ = cvtpk((hv).x + (float)k0_ * (wsc), (hv).y + (float)k1_ * (wsc)); const float o0_ = bflo(ob_), o1_ = bfhi(ob_); \
    if (!dry_) *(unsigned*)orow_ = ob_; \
    const float ss_ = wave_sum(o0_ * o0_ + o1_ * o1_); if (ln == 0 && !dry_) SSP[(size_t)(t) * 8 + sl] = ss_; asm volatile("" :: "v"(ss_)); } while (0)
#define P2_STEP(rw, wh, hv, wsc, ea, eb, i, REISSUE) do { int d_[16]; _Pragma("unroll") for (int i_ = 0; i_ < 16; ++i_) d_[i_] = 0; \
    _Pragma("unroll") for (int m_ = 0; m_ < 4; ++m_) { P2_COL(rw, wh, d_, x, 0, m_); P2_COL(rw, wh, d_, y, 4, m_); P2_COL(rw, wh, d_, z, 8, m_); P2_COL(rw, wh, d_, w, 12, m_); __builtin_amdgcn_sched_barrier(0); \
        if (REISSUE) { PEER_ROWS4(rw, V8s, ea, eb, m_); __builtin_amdgcn_sched_barrier(0); } } \
    P2_FINISH(d_, hv, wsc, tb + 8 * (i)); } while (0)
                u32x4 e0a, e0b, e1a, e1b, w0, w1, rwA[16], rwB[16]; f32x2_t hv0, hv1; float ws0, ws1;
                PEER_IDS(e0a, e0b, tb); PEER_IDS(e1a, e1b, tb + 8); P2_WM(w0, hv0, ws0, tb);
#pragma unroll
                for (int m_ = 0; m_ < 4; ++m_) PEER_ROWS4(rwA, V8s, e0a, e0b, m_);
#pragma unroll
                for (int m_ = 0; m_ < 4; ++m_) PEER_ROWS4(rwB, V8s, e1a, e1b, m_);
                PEER_IDS(e0a, e0b, tb + 16);
#pragma unroll 1
                for (int i = 0; i < NTW - 2; i += 2) {
                    PEER_IDS(e1a, e1b, tb + 8 * (i + 3));
                    P2_WM(w1, hv1, ws1, tb + 8 * (i + 1));
                    P2_STEP(rwA, w0, hv0, ws0, e0a, e0b, i, true);
                    { const int tn = tb + 8 * (i + 4 < NTW ? i + 4 : NTW - 1); PEER_IDS(e0a, e0b, tn); }
                    P2_WM(w0, hv0, ws0, tb + 8 * (i + 2));
                    P2_STEP(rwB, w1, hv1, ws1, e1a, e1b, i + 1, true);
                }
                P2_WM(w1, hv1, ws1, tb + 8 * (NTW - 1));
                P2_STEP(rwA, w0, hv0, ws0, e0a, e0b, NTW - 2, false);
                P2_STEP(rwB, w1, hv1, ws1, e1a, e1b, NTW - 1, false);
            }
        }
    }
    SEAM(11);

    for (int rep_ = 0; rep_ < (IN(12) ? 1 : 0); ++rep_) {
        for (int row = gwave; row < T; row += ngw) {
            float tot = 0.f;
#pragma unroll
            for (int q = 0; q < 8; ++q) tot += SSP[(size_t)row * 8 + q];
            const float rs = rsqrtf(tot * (1.f / DM) + RMS_EPS);
            f32x4* orow = (f32x4*)(p.out + (size_t)row * DM) + lane; const u32x2* ob = (const u32x2*)(MIXED + (size_t)row * DM) + lane;
#pragma unroll
            for (int j = 0; j < 4; ++j) { const f32x4 gv = ((const f32x4*)p.gf)[lane + 64 * j]; const u32x2 w = ob[64 * j]; orow[64 * j] = (f32x4){bflo(w.x), bfhi(w.x), bflo(w.y), bfhi(w.y)} * rs * gv; }
        }
    }
#undef IN
#undef SEAM
}

extern "C" void kernel_launch(void* const* d_in, const int* in_sizes, int n_in, void* d_out, int out_size, void* d_ws, size_t ws_size, hipStream_t stream) {
    static int grid = 0;
    if (grid == 0) {
        int dev = 0, cus = 0, per_cu = 0;
        (void)hipGetDevice(&dev);
        (void)hipDeviceGetAttribute(&cus, hipDeviceAttributeMultiprocessorCount, dev);
        (void)hipFuncSetAttribute((const void*)fwd_kernel, hipFuncAttributeMaxDynamicSharedMemorySize, LDS_BYTES);
        (void)hipOccupancyMaxActiveBlocksPerMultiprocessor(&per_cu, (const void*)fwd_kernel, NTHREADS, LDS_BYTES);
        if (per_cu < 1) { fprintf(stderr, "kernel_launch: occupancy query says %d blocks per CU\n", per_cu); per_cu = 1; }
        grid = cus * 1;
        if (ws_size < WS_END) { fprintf(stderr, "kernel_launch: workspace too small: %zu < %zu\n", ws_size, (size_t)WS_END); grid = -1; }
    }
    if (grid < 0) return;
    Params p{};
    p.x = (const float*)d_in[0]; p.g1 = (const float*)d_in[1]; p.w_in = (const float*)d_in[2]; p.w_oa = (const float*)d_in[3]; p.w_ob = (const float*)d_in[4];
    p.w_mix = (const float*)d_in[5]; p.g2 = (const float*)d_in[6]; p.w_q = (const float*)d_in[7]; p.skeys = (const float*)d_in[8]; p.pu = (const float*)d_in[9];
    p.pv = (const float*)d_in[10]; p.gf = (const float*)d_in[11]; p.out = (float*)d_out; p.ws = (unsigned char*)d_ws;
    p.ph_lo = 0; p.ph_hi = 13;
    if (hipMemsetAsync((char*)d_ws + WS_CTL, 0, 65536, stream) != hipSuccess) { fprintf(stderr, "kernel_launch: hipMemsetAsync failed\n"); return; }
    hipLaunchKernelGGL(fwd_kernel, dim3(grid), dim3(NTHREADS), LDS_BYTES, stream, p);
}
```
